# Optimizing an MI355X kernel written in HIP

```python
import jax, jax.numpy as jnp
from jax import lax
import numpy as np

D_MODEL = 1024
BATCH = 8
SEQ = 8192
DEPTH = 2

HEAD = 64
RMS_EPS = 1e-6
A_WIDTH = D_MODEL
A_HEADS = A_WIDTH // HEAD
DECAY_LORA = 64
ICL_LORA = 64
GATE_LORA = 128
VRES_LORA = 32
A_COLS = 3 * A_WIDTH + DECAY_LORA + ICL_LORA + GATE_LORA
A_SPLITS = (A_WIDTH, 2 * A_WIDTH, 3 * A_WIDTH, 3 * A_WIDTH + DECAY_LORA, 3 * A_WIDTH + DECAY_LORA + ICL_LORA)
GN_EPS = 64e-5
DILATION_GROUPS = ((128, 1), (512, 4), (2048, 16))
B_HEADS_PER_GROUP = 4
B_HEADS = B_HEADS_PER_GROUP * len(DILATION_GROUPS)
B_WIDTH = B_HEADS * HEAD
B_OUT = B_HEADS_PER_GROUP * HEAD
B_COLS = 3 * B_WIDTH
DIL_BLOCK = 128
ROPE_THETA = 10000.0
C_WIDTH = D_MODEL
C_GROUPS = 8
C_CHUNK = 128
C_COLS = 2 * C_WIDTH
LN_EPS = 1e-5
N_BRANCHES = 3
GATE_COLS = N_BRANCHES * D_MODEL
IN_COLS = A_COLS + B_COLS + C_COLS + GATE_COLS
IN_SPLITS = (A_COLS, A_COLS + B_COLS, A_COLS + B_COLS + C_COLS)
N_GROUPS = 4
EXPERTS_PER_GROUP = 8
N_EXPERTS = N_GROUPS * EXPERTS_PER_GROUP
TOP_K = 2
EXPERT_FF = D_MODEL // 2
MOE_BLOCK = 256

kernel_name = "hybrid_rwkv7_dilated_gmlp_hiermoe"

f32 = jnp.float32


def rms_norm(x, g):
    xf = x.astype(f32)
    y = xf * lax.rsqrt(jnp.mean(xf * xf, axis=-1, keepdims=True) + RMS_EPS)
    return y.astype(x.dtype) * g


def token_shift_lerp(z, mu):
    prev = jnp.pad(z, ((0, 0), (1, 0), (0, 0)))[:, :-1]
    return z + (prev - z) * mu


def wkv7_scan(r, decay, k, v, a, b):
    Bsz, T, H, N = r.shape

    def step(S, inp):
        r_t, w_t, k_t, v_t, a_t, b_t = inp
        Sa = jnp.einsum('bhij,bhj->bhi', S, a_t)
        S = S * w_t[:, :, None, :] + Sa[..., None] * b_t[:, :, None, :] + v_t[..., None] * k_t[:, :, None, :]
        return S, jnp.einsum('bhij,bhj->bhi', S, r_t)

    seq = tuple(jnp.moveaxis(z.astype(f32), 1, 0) for z in (r, decay, k, v, a, b))
    _, y = lax.scan(step, jnp.zeros((Bsz, H, N, N), f32), seq)
    return jnp.moveaxis(y, 0, 1)


def rwkv7_time_mix(r, k, v, w_lo, a_lo, g_lo, w0, w2, a0, a2, g2, k_k, k_a, r_k, lnx_w, lnx_b):
    Bsz, T, _ = r.shape
    heads = lambda z: z.reshape(Bsz, T, A_HEADS, HEAD)
    w = -jax.nn.softplus(-(w0 + jnp.tanh(w_lo) @ w2).astype(f32)) - 0.5
    decay = jnp.exp(-jnp.exp(w))
    a = jax.nn.sigmoid((a0 + a_lo @ a2).astype(f32))
    g = jax.nn.sigmoid(g_lo) @ g2
    kk = heads((k * k_k).astype(f32))
    kk = kk / jnp.maximum(jnp.sqrt(jnp.sum(kk * kk, axis=-1, keepdims=True)), 1e-12)
    k = k.astype(f32) * (1.0 + (a - 1.0) * k_a.astype(f32))
    rh, kh, vh, ah = heads(r.astype(f32)), heads(k), heads(v.astype(f32)), heads(a)
    y = wkv7_scan(rh, heads(decay), kh, vh, -kk, kk * ah)
    mean = jnp.mean(y, axis=-1, keepdims=True)
    var = jnp.mean(jnp.square(y - mean), axis=-1, keepdims=True)
    y = (y - mean) * lax.rsqrt(var + GN_EPS)
    y = y.reshape(Bsz, T, A_WIDTH) * lnx_w.astype(f32) + lnx_b.astype(f32)
    bonus = jnp.sum(rh * kh * r_k.astype(f32), axis=-1, keepdims=True) * vh
    y = y + bonus.reshape(Bsz, T, A_WIDTH)
    return (y * g.astype(f32)).astype(r.dtype)


def rotary(z, cos, sin):
    z1, z2 = jnp.split(z.astype(f32), 2, axis=-1)
    c, s = cos[:, None, :], sin[:, None, :]
    return jnp.concatenate([z1 * c - z2 * s, z1 * s + z2 * c], axis=-1).astype(z.dtype)


def dilated_group_attention(q, k, v, dilation, span):
    Bsz, T, Hg, hd = q.shape
    L = T // dilation
    nb = -(-L // DIL_BLOCK)
    Lp = nb * DIL_BLOCK

    def strided(z):
        z = z.reshape(Bsz, L, dilation, Hg, hd).transpose(0, 2, 3, 1, 4)
        return jnp.pad(z, ((0, 0), (0, 0), (0, 0), (0, Lp - L), (0, 0)))

    def windows(z):
        z = jnp.pad(strided(z), ((0, 0), (0, 0), (0, 0), (DIL_BLOCK, 0), (0, 0)))
        z = z.reshape(Bsz, dilation, Hg, nb + 1, DIL_BLOCK, hd)
        return jnp.concatenate([z[:, :, :, :-1], z[:, :, :, 1:]], axis=-2)

    qs = strided(q).reshape(Bsz, dilation, Hg, nb, DIL_BLOCK, hd).astype(f32)
    ks, vs = windows(k).astype(f32), windows(v).astype(f32)
    s = jnp.einsum('bdhnqc,bdhnkc->bdhnqk', qs, ks) * (hd ** -0.5)
    qi = jnp.arange(DIL_BLOCK)[:, None]
    kj = jnp.arange(2 * DIL_BLOCK)[None, :]
    dist = qi + DIL_BLOCK - kj
    key_idx = jnp.arange(nb)[:, None, None] * DIL_BLOCK - DIL_BLOCK + kj
    mask = (dist >= 0) & (dist <= span) & (key_idx >= 0)
    s = jnp.where(mask, s, -jnp.inf)
    m = jnp.max(s, axis=-1, keepdims=True)
    e = jnp.exp(s - m)
    den = jnp.sum(e, axis=-1, keepdims=True)
    o = jnp.einsum('bdhnqk,bdhnkc->bdhnqc', e, vs) / den
    lse = (m + jnp.log(den))[..., 0]

    def unstride(z):
        z = z.reshape(Bsz, dilation, Hg, Lp, *z.shape[5:])[:, :, :, :L]
        z = jnp.moveaxis(z, 3, 1)
        return z.reshape(Bsz, T, Hg, *z.shape[4:])

    return unstride(o), unstride(lse)


def dilated_attention(q, k, v):
    outs, lses = [], []
    for gi, (window, dilation) in enumerate(DILATION_GROUPS):
        sl = slice(gi * B_HEADS_PER_GROUP, (gi + 1) * B_HEADS_PER_GROUP)
        o, lse = dilated_group_attention(q[:, :, sl], k[:, :, sl], v[:, :, sl], dilation, window // dilation)
        outs.append(o)
        lses.append(lse)
    wts = jax.nn.softmax(jnp.stack(lses, axis=0), axis=0)
    o = jnp.einsum('gbth,gbthc->bthc', wts, jnp.stack(outs, axis=0))
    Bsz, T = q.shape[:2]
    return o.reshape(Bsz, T, B_OUT).astype(q.dtype)


def spatial_gating(zc, ln_w, ln_b, ws, bs):
    z = jax.nn.gelu(zc, approximate=False)
    u, v = jnp.split(z, 2, axis=-1)
    vf = v.astype(f32)
    mean = jnp.mean(vf, axis=-1, keepdims=True)
    var = jnp.mean(jnp.square(vf - mean), axis=-1, keepdims=True)
    v = ((vf - mean) * lax.rsqrt(var + LN_EPS)).astype(v.dtype) * ln_w + ln_b
    Bsz, T, _ = v.shape
    vg = v.reshape(Bsz, T // C_CHUNK, C_CHUNK, C_GROUPS, C_WIDTH // C_GROUPS)
    ws_causal = ws * jnp.tril(jnp.ones((C_CHUNK, C_CHUNK), ws.dtype))
    mixed = jnp.einsum('gts,bnsgc->bntgc', ws_causal, vg) + bs.T[:, :, None]
    return u * mixed.reshape(Bsz, T, C_WIDTH)


def hierarchical_moe(h, rg, rgb, re, reb, w1, w3, w2):
    Bsz, T, D = h.shape
    N = Bsz * T
    NK = N * TOP_K
    xf = h.reshape(N, D)
    glog = (xf @ rg + rgb).astype(f32)
    gprob = jax.nn.softmax(glog, axis=-1)
    gsel = jnp.argmax(glog, axis=-1)
    p_g = jnp.take_along_axis(gprob, gsel[:, None], axis=1)[:, 0]
    elog = (xf @ re + reb).astype(f32).reshape(N, N_GROUPS, EXPERTS_PER_GROUP)
    elog_g = jnp.take_along_axis(elog, gsel[:, None, None], axis=1)[:, 0]
    top_v, top_i = lax.top_k(elog_g, TOP_K)
    wts = jax.nn.softmax(top_v, axis=-1) * p_g[:, None]
    eid = gsel[:, None] * EXPERTS_PER_GROUP + top_i
    flat_e = eid.reshape(-1).astype(jnp.int32)
    flat_t = jnp.repeat(jnp.arange(N, dtype=jnp.int32), TOP_K)
    flat_w = wts.reshape(-1)
    order = jnp.argsort(flat_e)
    se, st, sw = flat_e[order], flat_t[order], flat_w[order]
    counts = jnp.bincount(flat_e, length=N_EXPERTS)
    padded = (counts + MOE_BLOCK - 1) // MOE_BLOCK * MOE_BLOCK
    pend = jnp.cumsum(padded)
    pstart = pend - padded
    cstart = jnp.cumsum(counts) - counts
    dest = pstart[se] + jnp.arange(NK, dtype=jnp.int32) - cstart[se]
    nblk = -(-NK // MOE_BLOCK) + N_EXPERTS
    P = nblk * MOE_BLOCK
    tok_buf = jnp.full((P,), N, jnp.int32).at[dest].set(st)
    w_buf = jnp.zeros((P,), f32).at[dest].set(sw)
    blk_e = jnp.minimum(jnp.searchsorted(pend, jnp.arange(nblk) * MOE_BLOCK, side='right'), N_EXPERTS - 1)
    xpad = jnp.concatenate([xf, jnp.zeros((1, D), xf.dtype)], axis=0)
    xb = xpad[tok_buf].reshape(nblk, MOE_BLOCK, D)

    def expert_block(args):
        xblk, e = args
        hid = jax.nn.silu(xblk @ w1[e]) * (xblk @ w3[e])
        return hid @ w2[e]

    yb = lax.map(expert_block, (xb, blk_e)).reshape(P, D)
    y = jax.ops.segment_sum(yb * w_buf[:, None].astype(yb.dtype), tok_buf, num_segments=N + 1)[:N]
    return y.reshape(Bsz, T, D)


def setup_inputs(seed: int = 0) -> dict:
    key = jax.random.key(seed)
    ks = iter(jax.random.split(key, 48))
    nrm = lambda shape, scale: scale * jax.random.normal(next(ks), shape, f32)
    unif = lambda shape, lo, hi: jax.random.uniform(next(ks), shape, f32, lo, hi)
    L, D = DEPTH, D_MODEL
    return {
        "x": nrm((BATCH, SEQ, D), 1.0),
        "norm_mix": 1.0 + nrm((L, D), 0.02),
        "w_in": nrm((L, D, IN_COLS), D ** -0.5),
        "mu_a": unif((L, A_COLS), 0.0, 1.0),
        "w_decay0": unif((L, A_WIDTH), -6.0, -1.0),
        "w_decay2": nrm((L, DECAY_LORA, A_WIDTH), 0.1),
        "a0": nrm((L, A_WIDTH), 0.1),
        "a2": nrm((L, ICL_LORA, A_WIDTH), 0.5 * ICL_LORA ** -0.5),
        "g2": nrm((L, GATE_LORA, A_WIDTH), GATE_LORA ** -0.5),
        "k_k": 0.85 + nrm((L, A_WIDTH), 0.02),
        "k_a": 1.0 + nrm((L, A_WIDTH), 0.02),
        "r_k": nrm((L, A_HEADS, HEAD), 0.1),
        "lnx_w": 1.0 + nrm((L, A_WIDTH), 0.02),
        "lnx_b": nrm((L, A_WIDTH), 0.02),
        "vres_mu": unif((L - 1, VRES_LORA), 0.0, 1.0),
        "vres_w1": nrm((L - 1, D, VRES_LORA), D ** -0.5),
        "vres_w2": nrm((L - 1, VRES_LORA, A_WIDTH), 0.5 * VRES_LORA ** -0.5),
        "vres_b": 1.0 + nrm((L - 1, A_WIDTH), 0.1),
        "sgu_ln_w": 1.0 + nrm((L, C_WIDTH), 0.02),
        "sgu_ln_b": nrm((L, C_WIDTH), 0.02),
        "sgu_ws": nrm((L, C_GROUPS, C_CHUNK, C_CHUNK), C_CHUNK ** -0.5),
        "sgu_bs": 1.0 + nrm((L, C_GROUPS, C_CHUNK), 0.02),
        "gate_b": nrm((L, N_BRANCHES, D), 0.1),
        "w_pa": nrm((L, A_WIDTH, D), A_WIDTH ** -0.5),
        "w_pb": nrm((L, B_OUT, D), B_OUT ** -0.5),
        "w_pc": nrm((L, C_WIDTH, D), C_WIDTH ** -0.5),
        "w_out": nrm((L, D, D), D ** -0.5),
        "norm_ffn": 1.0 + nrm((L, D), 0.02),
        "router_grp": nrm((L, D, N_GROUPS), D ** -0.5),
        "router_grp_b": nrm((L, N_GROUPS), 0.01),
        "router_exp": nrm((L, D, N_EXPERTS), D ** -0.5),
        "router_exp_b": nrm((L, N_EXPERTS), 0.01),
        "moe_w1": nrm((L, N_EXPERTS, D, EXPERT_FF), D ** -0.5),
        "moe_w3": nrm((L, N_EXPERTS, D, EXPERT_FF), D ** -0.5),
        "moe_w2": nrm((L, N_EXPERTS, EXPERT_FF, D), EXPERT_FF ** -0.5),
        "norm_final": 1.0 + nrm((D,), 0.02),
    }


def reference(x, norm_mix, w_in, mu_a, w_decay0, w_decay2, a0, a2, g2, k_k, k_a, r_k, lnx_w, lnx_b,
              vres_mu, vres_w1, vres_w2, vres_b, sgu_ln_w, sgu_ln_b, sgu_ws, sgu_bs, gate_b,
              w_pa, w_pb, w_pc, w_out, norm_ffn, router_grp, router_grp_b, router_exp, router_exp_b,
              moe_w1, moe_w3, moe_w2, norm_final):
    Bsz, T, D = x.shape
    pos = jnp.arange(T, dtype=f32)
    inv_freq = ROPE_THETA ** (-jnp.arange(0, HEAD, 2, dtype=f32) / HEAD)
    ang = pos[:, None] * inv_freq[None, :]
    cos, sin = jnp.cos(ang), jnp.sin(ang)
    v_first = None
    for l in range(DEPTH):
        h = rms_norm(x, norm_mix[l])
        proj = h @ w_in[l]
        za, zb, zc, zg = jnp.split(proj, IN_SPLITS, axis=-1)
        za = token_shift_lerp(za, mu_a[l])
        r, k, v, w_lo, a_lo, g_lo = jnp.split(za, A_SPLITS, axis=-1)
        if l == 0:
            v_first = v
        else:
            vlo = token_shift_lerp(h @ vres_w1[l - 1], vres_mu[l - 1])
            v = v + (v_first - v) * jax.nn.sigmoid(vres_b[l - 1] + vlo @ vres_w2[l - 1])
        ya = rwkv7_time_mix(r, k, v, w_lo, a_lo, g_lo, w_decay0[l], w_decay2[l], a0[l], a2[l], g2[l],
                            k_k[l], k_a[l], r_k[l], lnx_w[l], lnx_b[l])
        qb, kb, vb = (z.reshape(Bsz, T, B_HEADS, HEAD) for z in jnp.split(zb, 3, axis=-1))
        yb = dilated_attention(rotary(qb, cos, sin), rotary(kb, cos, sin), vb)
        yc = spatial_gating(zc, sgu_ln_w[l], sgu_ln_b[l], sgu_ws[l], sgu_bs[l])
        gates = jax.nn.sigmoid(zg.reshape(Bsz, T, N_BRANCHES, D) + gate_b[l])
        merged = (gates[:, :, 0] * (ya @ w_pa[l]) + gates[:, :, 1] * (yb @ w_pb[l])
                  + gates[:, :, 2] * (yc @ w_pc[l]))
        x = x + merged @ w_out[l]
        x = x + hierarchical_moe(rms_norm(x, norm_ffn[l]), router_grp[l], router_grp_b[l], router_exp[l],
                                 router_exp_b[l], moe_w1[l], moe_w3[l], moe_w2[l])
    return rms_norm(x, norm_final)
```

```cpp
#include <hip/hip_runtime.h>
#include <cstdint>
#include <cstdio>

#define DBG_PROJ_N (l == 0 ? IN_COLS : WIN_ROWS)
#ifndef DUP_MASK
#define DUP_MASK 0
#endif
#ifndef PH_MASK
#define PH_MASK 0xFFFF
#endif
#ifndef MK_ONE_LAUNCH
#define MK_ONE_LAUNCH 1
#endif

#define LAS __attribute__((address_space(3)))
#define GAS __attribute__((address_space(1)))
typedef unsigned short bf16;
typedef unsigned u32;
typedef short bf16x8 __attribute__((ext_vector_type(8)));
typedef float f32x4 __attribute__((ext_vector_type(4)));
typedef float f32x2 __attribute__((ext_vector_type(2)));
typedef float f32x16 __attribute__((ext_vector_type(16)));
typedef unsigned u32x4 __attribute__((ext_vector_type(4)));
typedef unsigned u32x2 __attribute__((ext_vector_type(2)));
typedef int i32x4 __attribute__((ext_vector_type(4)));

constexpr int NBATCH = 8, T = 8192, D = 1024, NLAYER = 2;
constexpr int M = 2 * T;
constexpr int NCH = 4;
constexpr int NIT = NLAYER * NCH;
constexpr int A_COLS = 3328, B_COLS = 2304, C_COLS = 2048, G_COLS = 3072, IN_COLS = 10752;
constexpr int WIN_ROWS = 11008;
constexpr int LORA_K = 384, LORA_N = 4096;
constexpr int NEXP = 32, EFF = 512;
constexpr int SEGL = 256, NSEG = T / SEGL;
constexpr int MOE_MAXROWS = 40960;

constexpr size_t MiB = 1u << 20;
constexpr size_t WS_CTL = 0, CTL_ZERO_BYTES = 1 * MiB;
constexpr size_t WS_ROPE = 1 * MiB;
constexpr size_t WS_WSC = 3 * MiB;
constexpr size_t WS_WIN = 4 * MiB;
constexpr size_t WS_LORAB = 26 * MiB;
constexpr size_t WS_PA = 29 * MiB, WS_PB = 31 * MiB, WS_PC = 32 * MiB, WS_WOUT = 34 * MiB;
constexpr size_t WS_W13 = 36 * MiB;
constexpr size_t WS_W2 = 100 * MiB;
constexpr size_t WS_VFIRST = 132 * MiB;
constexpr size_t WS_HN = 260 * MiB;
constexpr size_t WS_VP = 292 * MiB;
constexpr size_t WS_YB = 324 * MiB;
constexpr size_t WS_YC = 332 * MiB;
constexpr size_t WS_VLO = 364 * MiB;
constexpr size_t WS_BONUS = 365 * MiB;
constexpr size_t WS_TOK = 366 * MiB;
constexpr size_t WS_LSE = 367 * MiB;
constexpr size_t WS_ZG = 368 * MiB;
constexpr size_t WS_R4 = 464 * MiB;
constexpr size_t WS_R2 = 592 * MiB;
constexpr size_t WS_R1 = 696 * MiB;
constexpr size_t WS_END = 1016 * MiB;
constexpr size_t R4_G = 0, R4_WPRE = 32 * MiB, R4_APRE = 64 * MiB, R4_VPRE = 96 * MiB;
constexpr size_t R4_SEGS = 32 * MiB, R4_SEGP = 64 * MiB;
constexpr size_t R4_MTMP = 0, R4_MERGED = 64 * MiB;
constexpr size_t R2_ZA = 0;
constexpr size_t R2_YLOC = 0, R2_Z = 32 * MiB, R2_SSTART = 64 * MiB;
constexpr size_t R1_ZB = 0, R1_ZC = 72 * MiB, R1_ALORA = 136 * MiB, R1_OG = 148 * MiB;
constexpr size_t R1_SCANIN = 0;
constexpr size_t R1_XG = 0, R1_HID = 80 * MiB, R1_YEXP = 120 * MiB, R1_ROWMAP = 300 * MiB, R1_HNX = 256 * MiB;
constexpr size_t R1_LW = 0, R1_AA = 64 * MiB, R1_BB = 96 * MiB, R1_KK = 128 * MiB, R1_RR = 160 * MiB;
constexpr size_t R1_MT = 192 * MiB, R1_NC = 224 * MiB;
constexpr size_t R1_YLOC = 0, R1_Q = 32 * MiB, R1_SST = 64 * MiB;
constexpr int CHK = 64, NCHK = T / CHK;
constexpr int CW_BAR = 4096;
constexpr int CW_CNT = 16384;
constexpr int CW_WMAX = 32768;
constexpr int CW_WMAX13 = 65536;
constexpr size_t HNX_RS = 16 * MiB;

constexpr int RING_BYTES = 131072;
constexpr int LDSCTL_OFF = RING_BYTES;
constexpr int LDS_BYTES = 147456;

__device__ __forceinline__ float bf2f(u32 v) { return __uint_as_float(v << 16); }
__device__ __forceinline__ float bflo(u32 v) { return __uint_as_float(v << 16); }
__device__ __forceinline__ float bfhi(u32 v) { return __uint_as_float(v & 0xffff0000u); }
typedef __bf16 bf16x2_t __attribute__((ext_vector_type(2)));
__device__ __forceinline__ u32 cvt_pk_bf16(float lo, float hi) { f32x2 v = {lo, hi}; bf16x2_t b = __builtin_convertvector(v, bf16x2_t); return __builtin_bit_cast(u32, b); }
__device__ __forceinline__ u32 f2bf(float f) { return cvt_pk_bf16(f, 0.f) & 0xffffu; }
__device__ __forceinline__ float wave_sum(float v) {
#pragma unroll
    for (int o = 1; o < 64; o <<= 1) v += __shfl_xor(v, o);
    return v;
}
__device__ __forceinline__ float sigmoidf_(float x) { return __builtin_amdgcn_rcpf(1.0f + __expf(-x)); }
#define LDS_WAIT() asm volatile("s_waitcnt lgkmcnt(0)" ::: "memory")
typedef short v4i16_t __attribute__((ext_vector_type(4)));
__device__ __forceinline__ u32x2 lds_tr16(const LAS bf16* p) { return __builtin_bit_cast(u32x2, __builtin_amdgcn_ds_read_tr16_b64_v4i16((LAS v4i16_t*)p)); }

namespace pg8 {
#define PG8_LAS __attribute__((address_space(3)))
constexpr int BM = 256, BK = 64, HALF = 128, HTB = HALF * BK * 2, STAGE_BYTES = 8 * HTB, NXCD = 8, WGM = 2;
__host__ __device__ __forceinline__ int lds_byte(int r, int c) { const int st = (r >> 4) * 2 + (c >> 5), rr = r & 15, cc = c & 31, ob = rr * 64 + cc * 2; return st * 1024 + (ob ^ (((ob >> 9) & 1) << 5)); }
__host__ __device__ __forceinline__ void stage_rc(int b, int& R, int& C) { const int st = b / 1024, sb = b % 1024, swz = sb ^ (((sb >> 9) & 1) << 5); R = (st >> 1) * 16 + swz / 64; C = (st & 1) * 32 + (swz % 64) / 2; }
__host__ __device__ __forceinline__ int perm32(int rho) { const int n = rho >> 4, i = rho & 15; return 8 * (i >> 2) + 4 * n + (i & 3); }

struct Unit { int pm, pn, e; };
struct Gemm { const bf16* A; const bf16* Bt; int lda, ldb, K; size_t b_estride; const int* rowmap; const LAS int* tb; };

struct StaticOrder {
    int nM, nN, nwg, G, c;
    __device__ void init(int Mr, int N, int G_, int c_) { nM = Mr / BM; nN = N / BM; nwg = nM * nN; G = G_; c = c_; }
    __device__ bool next(int i, Unit& u) const {
        const long L = (long)i * G + c; if (L >= nwg) return false;
        int wgid = (int)L; { const int q = nwg / NXCD, r = nwg % NXCD, xcd = wgid % NXCD, off = wgid / NXCD; wgid = (xcd < r ? xcd * (q + 1) : r * (q + 1) + (xcd - r) * q) + off; }
        const int nig = WGM * nN, gid = wgid / nig, fm = gid * WGM, gsz = (nM - fm) < WGM ? (nM - fm) : WGM;
        u.pm = fm + ((wgid % nig) % gsz); u.pn = (wgid % nig) / gsz; u.e = 0; return true;
    }
};
struct MoeOrder {
    const LAS int* tb; int nN, G, c;
    __device__ bool next(int i, Unit& u) const {
        const int L = i * G + c; const int total = tb[32] * nN; if (L >= total) return false;
        const int q = total / NXCD, r = total % NXCD, xcd = L % NXCD, off = L / NXCD; const int wg = (xcd < r ? xcd * (q + 1) : r * (q + 1) + (xcd - r) * q) + off;
        const int rt = wg / nN; u.pn = wg % nN; u.pm = rt; int e = 0;
#pragma unroll 1
        for (int k = 1; k < 32; ++k) e += (rt >= tb[k]) ? 1 : 0;
        u.e = e; return true;
    }
};

template <bool I8> struct AccSel { typedef f32x4 t; };
template <> struct AccSel<true> { typedef i32x4 t; };
template <class Epi, class Sched, bool GATHER = false, bool I8 = false>
__device__ __forceinline__ void gemm_phase(PG8_LAS unsigned char* lds, const Gemm g, const Sched& S, const Epi& E) {
    int tid_ = threadIdx.x; asm volatile("" : "+v"(tid_));
    const int tid = tid_, wid = __builtin_amdgcn_readfirstlane(tid >> 6), lane = tid & 63, wr = wid >> 2, wc = wid & 3, fr = lane & 15, fq = lane >> 4;
    const int K = g.K, nt = K / BK;
    unsigned voffA[2], voffB[2];
#pragma unroll
    for (int i = 0; i < 2; ++i) { int R, C; stage_rc(tid * 16 + i * 8192, R, C); const int Rb = (R & ~31) + perm32(R & 31);
        voffA[i] = (unsigned)(R * g.lda + C) * 2u; voffB[i] = (unsigned)(Rb * g.ldb + C) * 2u; }
#define PG8_GOFFS(u_, go_) do { if constexpr (GATHER) { const int e_ = (u_).e; const int ti_ = (u_).pm - g.tb[e_]; const int cn_ = g.tb[40 + e_]; \
        _Pragma("unroll") for (int h_ = 0; h_ < 2; ++h_) _Pragma("unroll") for (int i_ = 0; i_ < 2; ++i_) { int R_, C_; stage_rc(tid * 16 + i_ * 8192, R_, C_); const int sl_ = ti_ * 256 + h_ * 128 + R_; \
            const int tr_ = (sl_ < cn_) ? g.rowmap[e_ * 16384 + sl_] : 0; go_[h_][i_] = (unsigned)(tr_ * g.lda + C_) * 2u; } } } while (0)
    unsigned goC[2][2] = {{0u, 0u}, {0u, 0u}}, goN[2][2] = {{0u, 0u}, {0u, 0u}};
    const size_t kstep = (size_t)(BK * 2);
    const size_t hA = GATHER ? 0 : (size_t)HALF * g.lda * 2, hB = (size_t)HALF * g.ldb * 2;
    const size_t tA = 2 * hA, tB = 2 * hB;
    const unsigned ldsw = (unsigned)wid * 1024u;
    const int aoff = lds_byte(wr * 64 + fr, fq * 8), boff = lds_byte(wc * 32 + fr, fq * 8);
#define PG8_SA(b, h) (((b) * 2 + (h)) * HTB)
#define PG8_SB(b, h) ((4 + (b) * 2 + (h)) * HTB)
#define PG8_STAGE(bufoff, gbase, voff) do { _Pragma("unroll") for (int _i = 0; _i < 2; ++_i) \
        __builtin_amdgcn_global_load_lds((const unsigned*)((const char*)(gbase) + (voff)[_i]), (PG8_LAS unsigned*)(lds + (bufoff) + ldsw + _i * 8192), 16, 0, 0); } while (0)
#define PG8_LDA(dst, b, h) do { _Pragma("unroll") for (int m = 0; m < 4; ++m) _Pragma("unroll") for (int k = 0; k < 2; ++k) dst[m][k] = *(const PG8_LAS bf16x8*)(lds + PG8_SA(b, h) + aoff + m * 2048 + k * 1024); } while (0)
#define PG8_LDB(dst, b, h) do { _Pragma("unroll") for (int n = 0; n < 2; ++n) _Pragma("unroll") for (int k = 0; k < 2; ++k) dst[n][k] = *(const PG8_LAS bf16x8*)(lds + PG8_SB(b, h) + boff + n * 2048 + k * 1024); } while (0)
#define PG8_MMA(ai, bj, At, Bt) do { __builtin_amdgcn_s_setprio(1); _Pragma("unroll") for (int m = 0; m < 4; ++m) _Pragma("unroll") for (int n = 0; n < 2; ++n) _Pragma("unroll") for (int k = 0; k < 2; ++k) { \
        if constexpr (I8) acc[ai][bj][m][n] = __builtin_amdgcn_mfma_i32_16x16x64_i8(__builtin_bit_cast(i32x4, Bt[n][k]), __builtin_bit_cast(i32x4, At[m][k]), acc[ai][bj][m][n], 0, 0, 0); \
        else acc[ai][bj][m][n] = __builtin_amdgcn_mfma_f32_16x16x32_bf16(Bt[n][k], At[m][k], acc[ai][bj][m][n], 0, 0, 0); } __builtin_amdgcn_s_setprio(0); } while (0)
#define PG8_WAIT_V(n) asm volatile("s_waitcnt vmcnt(" #n ")" ::: "memory")
#define PG8_WAIT_L(n) asm volatile("s_waitcnt lgkmcnt(" #n ")" ::: "memory")
#define PG8_BAR __builtin_amdgcn_s_barrier()
#define PG8_SCHED __builtin_amdgcn_sched_barrier(0)
    Unit cur, nxt; int ui = 0;
    if (!S.next(0, cur)) return;
    typedef typename AccSel<I8>::t acc_t;
    acc_t acc[2][2][4][2];
#pragma unroll
    for (int a = 0; a < 2; ++a)
#pragma unroll
        for (int b = 0; b < 2; ++b)
#pragma unroll
            for (int m = 0; m < 4; ++m)
#pragma unroll
                for (int n = 0; n < 2; ++n) acc[a][b][m][n] = (acc_t){0, 0, 0, 0};
    bf16x8 At[4][2], B0[2][2], B1[2][2];
    const char* cA = (const char*)g.A + (GATHER ? 0 : (size_t)cur.pm * tA); const char* cB = (const char*)g.Bt + (size_t)cur.e * g.b_estride * 2 + (size_t)cur.pn * tB;
    PG8_GOFFS(cur, goC);
#define PG8_VA(cond_, h_) (GATHER ? ((cond_) ? goN[h_] : goC[h_]) : voffA)
    PG8_STAGE(PG8_SB(0, 0), cB, voffB); PG8_STAGE(PG8_SB(0, 1), cB + hB, voffB); PG8_STAGE(PG8_SA(0, 0), cA, PG8_VA(false, 0)); PG8_STAGE(PG8_SA(0, 1), cA + hA, PG8_VA(false, 1));
    if (wr == 1) PG8_BAR;
    PG8_WAIT_V(2); PG8_BAR;
    PG8_STAGE(PG8_SB(1, 0), cB + kstep, voffB); PG8_STAGE(PG8_SA(1, 0), cA + kstep, PG8_VA(false, 0)); PG8_STAGE(PG8_SB(1, 1), cB + hB + kstep, voffB);
    PG8_WAIT_V(6); PG8_BAR;
    for (;;) {
        const bool has_next = S.next(ui + 1, nxt);
        const char* nA = (has_next && !GATHER) ? (const char*)g.A + (size_t)nxt.pm * tA : cA;
        if (has_next) PG8_GOFFS(nxt, goN); else { goN[0][0] = goC[0][0]; goN[0][1] = goC[0][1]; goN[1][0] = goC[1][0]; goN[1][1] = goC[1][1]; }
        const char* nB = has_next ? (const char*)g.Bt + (size_t)nxt.e * g.b_estride * 2 + (size_t)nxt.pn * tB : cB;
#pragma unroll 1
        for (int t = 0; t < nt; t += 2) {
            const bool last = (t == nt - 2);
            const char* a1 = cA + (size_t)(t + 1) * kstep;
            const char* a2 = last ? nA : cA + (size_t)(t + 2) * kstep; const char* b2 = last ? nB : cB + (size_t)(t + 2) * kstep;
            const char* a3 = a2 + kstep; const char* b3 = b2 + kstep;
            const bool post_epi = (t == 0) && (ui > 0);
            PG8_LDB(B0, 0, 0); PG8_LDB(B1, 0, 1); PG8_SCHED; PG8_LDA(At, 0, 0); PG8_STAGE(PG8_SA(1, 1), a1 + hA, PG8_VA(false, 1));
            if (post_epi) PG8_WAIT_V(24); else PG8_WAIT_V(8);
            PG8_WAIT_L(0); PG8_BAR; PG8_MMA(0, 0, At, B0); PG8_MMA(0, 1, At, B1); PG8_BAR; PG8_SCHED;
            PG8_LDA(At, 0, 1); PG8_STAGE(PG8_SB(0, 0), b2, voffB); PG8_STAGE(PG8_SB(0, 1), b2 + hB, voffB); PG8_STAGE(PG8_SA(0, 0), a2, PG8_VA(last, 0));
            if (post_epi) PG8_WAIT_V(24); else PG8_WAIT_V(8);
            PG8_WAIT_L(0); PG8_BAR; PG8_MMA(1, 0, At, B0); PG8_MMA(1, 1, At, B1); PG8_BAR; PG8_SCHED;
            PG8_LDB(B0, 1, 0); PG8_LDB(B1, 1, 1); PG8_SCHED; PG8_LDA(At, 1, 0); PG8_STAGE(PG8_SA(0, 1), a2 + hA, PG8_VA(last, 1));
            PG8_WAIT_V(8); PG8_WAIT_L(0); PG8_BAR; PG8_MMA(0, 0, At, B0); PG8_MMA(0, 1, At, B1); PG8_BAR; PG8_SCHED;
            PG8_LDA(At, 1, 1); PG8_STAGE(PG8_SB(1, 0), b3, voffB); PG8_STAGE(PG8_SB(1, 1), b3 + hB, voffB); PG8_STAGE(PG8_SA(1, 0), a3, PG8_VA(last, 0));
            PG8_WAIT_V(8); PG8_WAIT_L(0); PG8_BAR; PG8_MMA(1, 0, At, B0); PG8_MMA(1, 1, At, B1); PG8_BAR; PG8_SCHED;
        }
        PG8_WAIT_V(0);
        if (wr == 0) PG8_BAR;
        E(acc, cur, wr, wc, fr, fq);
        if (!has_next) break;
#pragma unroll
        for (int a = 0; a < 2; ++a)
#pragma unroll
            for (int b = 0; b < 2; ++b)
#pragma unroll
                for (int m = 0; m < 4; ++m)
#pragma unroll
                    for (int n = 0; n < 2; ++n) acc[a][b][m][n] = (acc_t){0, 0, 0, 0};
        cur = nxt; cA = nA; cB = nB; ++ui; goC[0][0] = goN[0][0]; goC[0][1] = goN[0][1]; goC[1][0] = goN[1][0]; goC[1][1] = goN[1][1];
        if (wr == 1) PG8_BAR;
    }
    PG8_WAIT_V(0);
    PG8_BAR;
#undef PG8_GOFFS
#undef PG8_VA
#undef PG8_SA
#undef PG8_SB
#undef PG8_STAGE
#undef PG8_LDA
#undef PG8_LDB
#undef PG8_MMA
#undef PG8_WAIT_V
#undef PG8_WAIT_L
#undef PG8_BAR
#undef PG8_SCHED
}

template <class Epi, class Sched>
__device__ __forceinline__ void gemm_chain3(PG8_LAS unsigned char* lds, const Gemm g0, const Gemm g1, const Gemm g2, const Sched& S, const Epi& E) {
    int tid_ = threadIdx.x; asm volatile("" : "+v"(tid_));
    const int tid = tid_, wid = __builtin_amdgcn_readfirstlane(tid >> 6), lane = tid & 63, wr = wid >> 2, wc = wid & 3, fr = lane & 15, fq = lane >> 4;
    int Rr[2], Cc[2], Rbb[2];
#pragma unroll
    for (int i = 0; i < 2; ++i) { int R, C; stage_rc(tid * 16 + i * 8192, R, C); Rr[i] = R; Cc[i] = C; Rbb[i] = (R & ~31) + perm32(R & 31); }
#define PG8_SEL(br_, f_) ((br_) == 0 ? g0.f_ : ((br_) == 1 ? g1.f_ : g2.f_))
#define PG8_VOFF(br_, va_, vb_) do { const int lda_ = PG8_SEL(br_, lda), ldb_ = PG8_SEL(br_, ldb); _Pragma("unroll") for (int i_ = 0; i_ < 2; ++i_) { \
        va_[i_] = (unsigned)(Rr[i_] * lda_ + Cc[i_]) * 2u; vb_[i_] = (unsigned)(Rbb[i_] * ldb_ + Cc[i_]) * 2u; } } while (0)
    const size_t kstep = (size_t)(BK * 2);
    const unsigned ldsw = (unsigned)wid * 1024u;
    const int aoff = lds_byte(wr * 64 + fr, fq * 8), boff = lds_byte(wc * 32 + fr, fq * 8);
#define PG8_SA(b, h) (((b) * 2 + (h)) * HTB)
#define PG8_SB(b, h) ((4 + (b) * 2 + (h)) * HTB)
#define PG8_STAGE(bufoff, gbase, voff) do { _Pragma("unroll") for (int _i = 0; _i < 2; ++_i) \
        __builtin_amdgcn_global_load_lds((const unsigned*)((const char*)(gbase) + (voff)[_i]), (PG8_LAS unsigned*)(lds + (bufoff) + ldsw + _i * 8192), 16, 0, 0); } while (0)
#define PG8_LDA(dst, b, h) do { _Pragma("unroll") for (int m = 0; m < 4; ++m) _Pragma("unroll") for (int k = 0; k < 2; ++k) dst[m][k] = *(const PG8_LAS bf16x8*)(lds + PG8_SA(b, h) + aoff + m * 2048 + k * 1024); } while (0)
#define PG8_LDB(dst, b, h) do { _Pragma("unroll") for (int n = 0; n < 2; ++n) _Pragma("unroll") for (int k = 0; k < 2; ++k) dst[n][k] = *(const PG8_LAS bf16x8*)(lds + PG8_SB(b, h) + boff + n * 2048 + k * 1024); } while (0)
#define PG8_MMA(ai, bj, At, Bt) do { __builtin_amdgcn_s_setprio(1); _Pragma("unroll") for (int m = 0; m < 4; ++m) _Pragma("unroll") for (int n = 0; n < 2; ++n) _Pragma("unroll") for (int k = 0; k < 2; ++k) \
        acc[ai][bj][m][n] = __builtin_amdgcn_mfma_f32_16x16x32_bf16(Bt[n][k], At[m][k], acc[ai][bj][m][n], 0, 0, 0); __builtin_amdgcn_s_setprio(0); } while (0)
#define PG8_WAIT_V(n) asm volatile("s_waitcnt vmcnt(" #n ")" ::: "memory")
#define PG8_WAIT_L(n) asm volatile("s_waitcnt lgkmcnt(" #n ")" ::: "memory")
#define PG8_BAR __builtin_amdgcn_s_barrier()
#define PG8_SCHED __builtin_amdgcn_sched_barrier(0)
    Unit cur, nxt; int ui = 0;
    if (!S.next(0, cur)) return;
    int brc = 0;
    f32x4 acc[2][2][4][2];
#pragma unroll
    for (int a = 0; a < 2; ++a)
#pragma unroll
        for (int b = 0; b < 2; ++b)
#pragma unroll
            for (int m = 0; m < 4; ++m)
#pragma unroll
                for (int n = 0; n < 2; ++n) acc[a][b][m][n] = (f32x4){0.f, 0.f, 0.f, 0.f};
    bf16x8 At[4][2], B0[2][2], B1[2][2];
    unsigned vAc[2], vBc[2], vAn[2], vBn[2];
    PG8_VOFF(0, vAc, vBc);
    size_t hAc = (size_t)HALF * g0.lda * 2, hBc = (size_t)HALF * g0.ldb * 2, hAn = hAc, hBn = hBc; int ntc = g0.K / BK;
    const char* cA = (const char*)g0.A + (size_t)cur.pm * 2 * hAc; const char* cB = (const char*)g0.Bt + (size_t)cur.pn * 2 * hBc;
    PG8_STAGE(PG8_SB(0, 0), cB, vBc); PG8_STAGE(PG8_SB(0, 1), cB + hBc, vBc); PG8_STAGE(PG8_SA(0, 0), cA, vAc); PG8_STAGE(PG8_SA(0, 1), cA + hAc, vAc);
    if (wr == 1) PG8_BAR;
    PG8_WAIT_V(2); PG8_BAR;
    PG8_STAGE(PG8_SB(1, 0), cB + kstep, vBc); PG8_STAGE(PG8_SA(1, 0), cA + kstep, vAc); PG8_STAGE(PG8_SB(1, 1), cB + hBc + kstep, vBc);
    PG8_WAIT_V(6); PG8_BAR;
    for (;;) {
        const int brn = (brc == 2) ? 0 : brc + 1; bool has_next = true;
        if (brc == 2) has_next = S.next(ui / 3 + 1, nxt); else nxt = cur;
        const char* nA = cA; const char* nB = cB;
        if (has_next) { PG8_VOFF(brn, vAn, vBn); hAn = (size_t)HALF * PG8_SEL(brn, lda) * 2; hBn = (size_t)HALF * PG8_SEL(brn, ldb) * 2;
            nA = (const char*)PG8_SEL(brn, A) + (size_t)nxt.pm * 2 * hAn; nB = (const char*)PG8_SEL(brn, Bt) + (size_t)nxt.pn * 2 * hBn; }
        else { vAn[0] = vAc[0]; vAn[1] = vAc[1]; vBn[0] = vBc[0]; vBn[1] = vBc[1]; hAn = hAc; hBn = hBc; }
#pragma unroll 1
        for (int t = 0; t < ntc; t += 2) {
            const bool last = (t == ntc - 2);
            const char* a1 = cA + (size_t)(t + 1) * kstep;
            const char* a2 = last ? nA : cA + (size_t)(t + 2) * kstep; const char* b2 = last ? nB : cB + (size_t)(t + 2) * kstep;
            const char* a3 = a2 + kstep; const char* b3 = b2 + kstep;
            const size_t hA2 = last ? hAn : hAc, hB2 = last ? hBn : hBc;
            PG8_LDB(B0, 0, 0); PG8_LDB(B1, 0, 1); PG8_SCHED; PG8_LDA(At, 0, 0); PG8_STAGE(PG8_SA(1, 1), a1 + hAc, vAc);
            PG8_WAIT_V(8); PG8_WAIT_L(0); PG8_BAR; PG8_MMA(0, 0, At, B0); PG8_MMA(0, 1, At, B1); PG8_BAR; PG8_SCHED;
            PG8_LDA(At, 0, 1); PG8_STAGE(PG8_SB(0, 0), b2, (last ? vBn : vBc)); PG8_STAGE(PG8_SB(0, 1), b2 + hB2, (last ? vBn : vBc)); PG8_STAGE(PG8_SA(0, 0), a2, (last ? vAn : vAc));
            PG8_WAIT_V(8); PG8_WAIT_L(0); PG8_BAR; PG8_MMA(1, 0, At, B0); PG8_MMA(1, 1, At, B1); PG8_BAR; PG8_SCHED;
            PG8_LDB(B0, 1, 0); PG8_LDB(B1, 1, 1); PG8_SCHED; PG8_LDA(At, 1, 0); PG8_STAGE(PG8_SA(0, 1), a2 + hA2, (last ? vAn : vAc));
            PG8_WAIT_V(8); PG8_WAIT_L(0); PG8_BAR; PG8_MMA(0, 0, At, B0); PG8_MMA(0, 1, At, B1); PG8_BAR; PG8_SCHED;
            PG8_LDA(At, 1, 1); PG8_STAGE(PG8_SB(1, 0), b3, (last ? vBn : vBc)); PG8_STAGE(PG8_SB(1, 1), b3 + hB2, (last ? vBn : vBc)); PG8_STAGE(PG8_SA(1, 0), a3, (last ? vAn : vAc));
            PG8_WAIT_V(8); PG8_WAIT_L(0); PG8_BAR; PG8_MMA(1, 0, At, B0); PG8_MMA(1, 1, At, B1); PG8_BAR; PG8_SCHED;
        }
        if (wr == 0) PG8_BAR;
        if (brc < 2) E.link(acc, cur, brc, wr, wc, fr, fq); else E.fin(acc, cur, wr, wc, fr, fq);
        if (!has_next) break;
        if (brc == 2) {
#pragma unroll
            for (int a = 0; a < 2; ++a)
#pragma unroll
                for (int b = 0; b < 2; ++b)
#pragma unroll
                    for (int m = 0; m < 4; ++m)
#pragma unroll
                        for (int n = 0; n < 2; ++n) acc[a][b][m][n] = (f32x4){0.f, 0.f, 0.f, 0.f}; }
        cur = nxt; cA = nA; cB = nB; ++ui; brc = brn; vAc[0] = vAn[0]; vAc[1] = vAn[1]; vBc[0] = vBn[0]; vBc[1] = vBn[1]; hAc = hAn; hBc = hBn; ntc = PG8_SEL(brc, K) / BK;
        if (wr == 1) PG8_BAR;
    }
    PG8_WAIT_V(0);
    PG8_BAR;
#undef PG8_SEL
#undef PG8_VOFF
#undef PG8_SA
#undef PG8_SB
#undef PG8_STAGE
#undef PG8_LDA
#undef PG8_LDB
#undef PG8_MMA
#undef PG8_WAIT_V
#undef PG8_WAIT_L
#undef PG8_BAR
#undef PG8_SCHED
}

__device__ __forceinline__ f32x2 gelu_pk(f32x2 v) {
    const f32x2 av = __builtin_elementwise_abs(v), d = av * 0.2316418882f + 1.0f;
    f32x2 t; t.x = __builtin_amdgcn_rcpf(d.x); t.y = __builtin_amdgcn_rcpf(d.y);
    f32x2 q = t * 0.5307027145f + (-0.7265760135f); q = q * t + 0.7107068705f; q = q * t + (-0.142248368f); q = q * t + 0.127414796f; q = q * t;
    const f32x2 s = (v * v) * (-0.72134752044f);
    f32x2 e; e.x = __builtin_amdgcn_exp2f(s.x); e.y = __builtin_amdgcn_exp2f(s.y);
    const f32x2 m = v * (q * e), r = v - m;
    f32x2 o; o.x = v.x < 0.f ? m.x : r.x; o.y = v.y < 0.f ? m.y : r.y; return o;
}
__device__ __forceinline__ u32x4 pack8(f32x4 v0, f32x4 v1) { u32x4 w; w.x = cvt_pk_bf16(v0[0], v0[1]); w.y = cvt_pk_bf16(v0[2], v0[3]); w.z = cvt_pk_bf16(v1[0], v1[1]); w.w = cvt_pk_bf16(v1[2], v1[3]); return w; }

struct EpiBf16 {
    bf16* O; int ldc; int split_cols; size_t split_stride;
    __device__ __forceinline__ void operator()(const f32x4 (&acc)[2][2][4][2], const Unit& u, int wr, int wc, int fr, int fq) const {
        const int row0 = u.pm * BM + wr * 64 + fr; int colt = u.pn * BM; bf16* base = O;
        if (split_cols) { const int t = colt / split_cols; base += (size_t)t * split_stride; colt -= t * split_cols; }
        const int col0 = colt + wc * 32 + 8 * fq;
#pragma unroll
        for (int ai = 0; ai < 2; ++ai)
#pragma unroll
            for (int m = 0; m < 4; ++m) { bf16* rowp = base + (size_t)(row0 + ai * HALF + m * 16) * ldc + col0;
#pragma unroll
                for (int bj = 0; bj < 2; ++bj) *(u32x4*)(rowp + bj * HALF) = pack8(acc[ai][bj][m][0], acc[ai][bj][m][1]); }
    }
};
struct EpiProj {
    bf16 *za, *zb, *zc, *zg, *vlo; const float* gate_b; const float* rs; const unsigned* cmax;
    __device__ __forceinline__ void operator()(const i32x4 (&acc)[2][2][4][2], const Unit& u, int wr, int wc, int fr, int fq) const {
        const int row0 = u.pm * BM + wr * 64 + fr; const int pn = u.pn;
        bf16* base; int ld, ct, mode;
        if (pn < 13) { base = za; ld = A_COLS; ct = pn; mode = 0; }
        else if (pn < 22) { base = zb; ld = B_COLS; ct = pn - 13; mode = 0; }
        else if (pn < 30) { base = zc; ld = C_COLS; ct = pn - 22; mode = 1; }
        else if (pn < 42) { base = zg; ld = G_COLS; ct = pn - 30; mode = 2; }
        else { base = vlo; ld = 32; ct = 0; mode = 3; }
        const int col0 = ct * BM + wc * 32 + 8 * fq;
        f32x4 cs[2][2];
#pragma unroll
        for (int bj = 0; bj < 2; ++bj)
#pragma unroll
            for (int n = 0; n < 2; ++n) { const u32x4 b = *(const u32x4*)(cmax + pn * BM + wc * 32 + 8 * fq + bj * HALF + 4 * n);
                cs[bj][n] = (f32x4){__uint_as_float(b.x), __uint_as_float(b.y), __uint_as_float(b.z), __uint_as_float(b.w)} * (1.f / 127.f); }
#define PG8_DQ(ai, bj, m, n, r) (__builtin_convertvector(acc[ai][bj][m][n], f32x4) * (cs[bj][n] * (r)))
        if (mode == 0) {
#pragma unroll
            for (int ai = 0; ai < 2; ++ai)
#pragma unroll
                for (int m = 0; m < 4; ++m) { const int row = row0 + ai * HALF + m * 16; const float r = rs[row]; bf16* rowp = base + (size_t)row * ld + col0;
#pragma unroll
                    for (int bj = 0; bj < 2; ++bj) *(u32x4*)(rowp + bj * HALF) = pack8(PG8_DQ(ai, bj, m, 0, r), PG8_DQ(ai, bj, m, 1, r)); }
        } else if (mode == 1) {
#pragma unroll
            for (int ai = 0; ai < 2; ++ai)
#pragma unroll
                for (int m = 0; m < 4; ++m) { const int row = row0 + ai * HALF + m * 16; const float r = rs[row]; bf16* rowp = base + (size_t)row * ld + col0;
#pragma unroll
                    for (int bj = 0; bj < 2; ++bj) { const f32x4 v0 = PG8_DQ(ai, bj, m, 0, r), v1 = PG8_DQ(ai, bj, m, 1, r);
                        const f32x2 a = gelu_pk((f32x2){v0[0], v0[1]}), b = gelu_pk((f32x2){v0[2], v0[3]}), c = gelu_pk((f32x2){v1[0], v1[1]}), d = gelu_pk((f32x2){v1[2], v1[3]});
                        *(u32x4*)(rowp + bj * HALF) = pack8((f32x4){a.x, a.y, b.x, b.y}, (f32x4){c.x, c.y, d.x, d.y}); } }
        } else if (mode == 2) {
            f32x4 bv[2][2];
#pragma unroll
            for (int bj = 0; bj < 2; ++bj)
#pragma unroll
                for (int n = 0; n < 2; ++n) bv[bj][n] = *(const f32x4*)(gate_b + col0 + bj * HALF + 4 * n);
#pragma unroll
            for (int ai = 0; ai < 2; ++ai)
#pragma unroll
                for (int m = 0; m < 4; ++m) { const int row = row0 + ai * HALF + m * 16; const float r = rs[row];
#pragma unroll
                    for (int bj = 0; bj < 2; ++bj) { f32x4 v0 = PG8_DQ(ai, bj, m, 0, r) + bv[bj][0], v1 = PG8_DQ(ai, bj, m, 1, r) + bv[bj][1]; u32 q[8];
#pragma unroll
                        for (int e = 0; e < 4; ++e) { q[e] = (u32)__builtin_amdgcn_fmed3f(__builtin_rintf(sigmoidf_(v0[e]) * 255.f), 1.f, 255.f); q[4 + e] = (u32)__builtin_amdgcn_fmed3f(__builtin_rintf(sigmoidf_(v1[e]) * 255.f), 1.f, 255.f); }
                        *(u32x2*)((unsigned char*)zg + (size_t)row * G_COLS + col0 + bj * HALF) = (u32x2){q[0] | (q[1] << 8) | (q[2] << 16) | (q[3] << 24), q[4] | (q[5] << 8) | (q[6] << 16) | (q[7] << 24)}; } }
        } else {
            if (wc == 0) {
#pragma unroll
                for (int ai = 0; ai < 2; ++ai)
#pragma unroll
                    for (int m = 0; m < 4; ++m) { const int row = row0 + ai * HALF + m * 16; const float r = rs[row]; bf16* rowp = base + (size_t)row * 32 + 8 * fq;
                        *(u32x4*)(rowp) = pack8(PG8_DQ(ai, 0, m, 0, r), PG8_DQ(ai, 0, m, 1, r)); }
            }
        }
#undef PG8_DQ
    }
};
template <int MODE> struct EpiGate {
    const bf16* gate; bf16* tmp; bf16* merged;
    __device__ __forceinline__ void operator()(const f32x4 (&acc)[2][2][4][2], const Unit& u, int wr, int wc, int fr, int fq) const {
        const int row0 = u.pm * BM + wr * 64 + fr; const int col0 = u.pn * BM + wc * 32 + 8 * fq;
#pragma unroll
        for (int ai = 0; ai < 2; ++ai)
#pragma unroll
            for (int m = 0; m < 4; ++m) { const size_t row = (size_t)(row0 + ai * HALF + m * 16);
#pragma unroll
                for (int bj = 0; bj < 2; ++bj) { const int col = col0 + bj * HALF;
                    const u32x4 gq = *(const u32x4*)(gate + row * G_COLS + col);
                    f32x4 g0 = (f32x4){bflo(gq.x), bfhi(gq.x), bflo(gq.y), bfhi(gq.y)}, g1 = (f32x4){bflo(gq.z), bfhi(gq.z), bflo(gq.w), bfhi(gq.w)};
                    f32x4 v0 = acc[ai][bj][m][0] * g0, v1 = acc[ai][bj][m][1] * g1;
                    bf16* tp = tmp + row * D + col;
                    if (MODE != 0) { const u32x4 tq = *(const u32x4*)tp; v0 += (f32x4){bflo(tq.x), bfhi(tq.x), bflo(tq.y), bfhi(tq.y)}; v1 += (f32x4){bflo(tq.z), bfhi(tq.z), bflo(tq.w), bfhi(tq.w)}; }
                    if (MODE != 2) *(u32x4*)tp = pack8(v0, v1);
                    else *(u32x4*)(merged + row * D + col) = pack8(v0, v1); }
                asm volatile("" ::: "memory"); }
    }
};
struct EpiChainGate {
    const unsigned char* gate; bf16* merged;
    __device__ __forceinline__ void link(f32x4 (&acc)[2][2][4][2], const Unit& u, int br, int wr, int wc, int fr, int fq) const {
        const int row0 = u.pm * BM + wr * 64 + fr; const int col0 = u.pn * BM + wc * 32 + 8 * fq;
#pragma unroll
        for (int ai = 0; ai < 2; ++ai)
#pragma unroll
            for (int m = 0; m < 4; ++m) { const size_t row = (size_t)(row0 + ai * HALF + m * 16);
#pragma unroll
                for (int bj = 0; bj < 2; ++bj) { const unsigned char* gp = gate + row * G_COLS + br * 1024 + col0 + bj * HALF;
                    const u32x2 ga = *(const u32x2*)gp, gb = *(const u32x2*)(gp + 1024);
#pragma unroll
                    for (int e = 0; e < 8; ++e) { const u32 wa = (e < 4) ? ga.x : ga.y, wb = (e < 4) ? gb.x : gb.y; const int sh = 8 * (e & 3);
                        const float r = (float)((wa >> sh) & 255u) * __builtin_amdgcn_rcpf((float)((wb >> sh) & 255u));
                        if (e < 4) acc[ai][bj][m][0][e] *= r; else acc[ai][bj][m][1][e - 4] *= r; } }
                asm volatile("" ::: "memory"); }
    }
    __device__ __forceinline__ void fin(const f32x4 (&acc)[2][2][4][2], const Unit& u, int wr, int wc, int fr, int fq) const {
        const int row0 = u.pm * BM + wr * 64 + fr; const int col0 = u.pn * BM + wc * 32 + 8 * fq;
#pragma unroll
        for (int ai = 0; ai < 2; ++ai)
#pragma unroll
            for (int m = 0; m < 4; ++m) { const size_t row = (size_t)(row0 + ai * HALF + m * 16);
#pragma unroll
                for (int bj = 0; bj < 2; ++bj) { const int col = col0 + bj * HALF; const u32x2 gq = *(const u32x2*)(gate + row * G_COLS + 2048 + col); f32x4 g0_, g1_;
#pragma unroll
                    for (int e = 0; e < 4; ++e) { g0_[e] = (float)((gq.x >> (8 * e)) & 255u) * (1.f / 255.f); g1_[e] = (float)((gq.y >> (8 * e)) & 255u) * (1.f / 255.f); }
                    *(u32x4*)(merged + row * D + col) = pack8(acc[ai][bj][m][0] * g0_, acc[ai][bj][m][1] * g1_); }
                asm volatile("" ::: "memory"); }
    }
};
struct EpiResid {
    const float* xin; float* xout;
    __device__ __forceinline__ void operator()(const f32x4 (&acc)[2][2][4][2], const Unit& u, int wr, int wc, int fr, int fq) const {
        const int row0 = u.pm * BM + wr * 64 + fr; const int col0 = u.pn * BM + wc * 32 + 8 * fq;
#pragma unroll
        for (int ai = 0; ai < 2; ++ai)
#pragma unroll
            for (int m = 0; m < 4; ++m) { const size_t off = (size_t)(row0 + ai * HALF + m * 16) * D + col0;
#pragma unroll
                for (int bj = 0; bj < 2; ++bj) { const float* ip = xin + off + bj * HALF; float* op = xout + off + bj * HALF;
                    const f32x4 a = *(const f32x4*)ip, b = *(const f32x4*)(ip + 4);
                    *(f32x4*)op = a + acc[ai][bj][m][0]; *(f32x4*)(op + 4) = b + acc[ai][bj][m][1]; }
                asm volatile("" ::: "memory"); }
    }
};
struct EpiSwiglu {
    bf16* hid; const float* rs; const int* rowmap; const LAS int* tb; const unsigned* cmax;
    __device__ __forceinline__ void operator()(const i32x4 (&acc)[2][2][4][2], const Unit& u, int wr, int wc, int fr, int fq) const {
        const int row0 = u.pm * BM + wr * 64 + fr; const int col0 = u.pn * HALF + wc * 32 + 8 * fq;
        const int e = u.e, slot0 = (u.pm - tb[e]) * BM + wr * 64 + fr, cn = tb[40 + e];
        f32x4 cs[2][2];
#pragma unroll
        for (int bj = 0; bj < 2; ++bj)
#pragma unroll
            for (int n = 0; n < 2; ++n) { const u32x4 b = *(const u32x4*)(cmax + e * 1024 + u.pn * BM + bj * HALF + wc * 32 + 8 * fq + 4 * n);
                cs[bj][n] = (f32x4){__uint_as_float(b.x), __uint_as_float(b.y), __uint_as_float(b.z), __uint_as_float(b.w)} * (1.f / 127.f); }
#pragma unroll
        for (int ai = 0; ai < 2; ++ai)
#pragma unroll
            for (int m = 0; m < 4; ++m) { bf16* rowp = hid + (size_t)(row0 + ai * HALF + m * 16) * EFF + col0;
                const int slot = slot0 + ai * HALF + m * 16; const bool ok = slot < cn; const int t = ok ? rowmap[e * 16384 + slot] : 0; const float r = ok ? rs[t] : 0.f;
                const f32x4 a0 = __builtin_convertvector(acc[ai][0][m][0], f32x4) * (cs[0][0] * r), a1 = __builtin_convertvector(acc[ai][0][m][1], f32x4) * (cs[0][1] * r);
                const f32x4 b0 = __builtin_convertvector(acc[ai][1][m][0], f32x4) * (cs[1][0] * r), b1 = __builtin_convertvector(acc[ai][1][m][1], f32x4) * (cs[1][1] * r);
                f32x4 h0, h1;
#pragma unroll
                for (int q = 0; q < 4; ++q) { h0[q] = a0[q] * sigmoidf_(a0[q]) * b0[q]; h1[q] = a1[q] * sigmoidf_(a1[q]) * b1[q]; }
                *(u32x4*)rowp = pack8(h0, h1); }
    }
};
struct EpiLora { bf16* w; bf16* a; bf16* g; bf16* v;
    __device__ __forceinline__ void operator()(const f32x4 (&acc)[2][2][4][2], const Unit& u, int wr, int wc, int fr, int fq) const {
        const int sec = u.pn >> 2; bf16* base = sec == 0 ? w : (sec == 1 ? a : (sec == 2 ? g : v)); Unit u2 = u; u2.pn = u.pn & 3;
        EpiBf16 e{base, D, 0, 0}; e(acc, u2, wr, wc, fr, fq); } };
}

#define XB_TMO      128
#define XB_XCNT(j)  (256  + 64 * (j))
#define XB_XSUB(j)  (1280 + 64 * (j))
#define XB_XGEN(j)  (2304 + 64 * (j))
#define XB_TOP      3328
#define XB_TOPGEN   3392
#define XCD_BAR_WORDS 3456
#define XB_SPIN_CAP (1u << 22)
__device__ __forceinline__ unsigned xb_ld(unsigned* p)              { return __hip_atomic_load(p, __ATOMIC_RELAXED, __HIP_MEMORY_SCOPE_AGENT); }
__device__ __forceinline__ unsigned xb_add(unsigned* p, unsigned v) { return __hip_atomic_fetch_add(p, v, __ATOMIC_RELAXED, __HIP_MEMORY_SCOPE_AGENT); }
__device__ __forceinline__ unsigned xb_xcc_id() { return (unsigned)__builtin_amdgcn_s_getreg((3 << 11) | 20) & 0xFu; }
#define XB_SPIN(cond, bar) do { unsigned _sp = 0; while (cond) { __builtin_amdgcn_s_sleep(1); \
    if ((++_sp & 255u) == 0u) { if (xb_ld(&(bar)[XB_TMO])) break; if (_sp > XB_SPIN_CAP) { atomicAdd(&(bar)[XB_TMO], 1u); break; } } } } while (0)
struct XcdBarrier { unsigned* bar; unsigned x; volatile LAS unsigned* st; };
__device__ __forceinline__ XcdBarrier xcd_barrier_post(unsigned* bar, volatile LAS unsigned* st) {
    XcdBarrier b; b.bar = bar; b.x = xb_xcc_id(); b.st = st;
    if (threadIdx.x == 0) (void)xb_add(&bar[XB_XCNT(b.x)], 1u);
    return b;
}
__device__ __forceinline__ void xcd_barrier_complete(unsigned* bar, unsigned x, unsigned& nloc, unsigned& nx) {
    const unsigned G = gridDim.x * gridDim.y * gridDim.z;
    unsigned sum, cnt, mine, sp = 0u;
    for (;;) {
        sum = 0u; cnt = 0u; mine = 0u;
#pragma unroll
        for (unsigned j = 0; j < 16; ++j) { const unsigned c = xb_ld(&bar[XB_XCNT(j)]); sum += c; cnt += (c > 0u) ? 1u : 0u; mine = (j == x) ? c : mine; }
        if (sum == G) break;
        __builtin_amdgcn_s_sleep(1);
        if ((++sp & 255u) == 0u) { if (xb_ld(&bar[XB_TMO])) break; if (sp > XB_SPIN_CAP) { atomicAdd(&bar[XB_TMO], 1u); break; } }
    }
    nloc = mine > 0u ? mine : 1u; nx = cnt > 0u ? cnt : 1u;
}
__device__ __forceinline__ void xcd_barrier(const XcdBarrier& b) {
    asm volatile("s_waitcnt vmcnt(0)" ::: "memory");
    __syncthreads();
    if (threadIdx.x == 0) {
        unsigned* bar = b.bar;
        __builtin_amdgcn_s_waitcnt(0);
        unsigned nloc = b.st[0], nx = b.st[1];
        if (nloc == 0u) { xcd_barrier_complete(bar, b.x, nloc, nx); b.st[0] = nloc; b.st[1] = nx; }
        const unsigned old = xb_add(&bar[XB_XSUB(b.x)], 1u);
        const unsigned gen = old / nloc;
        if (old + 1u == (gen + 1u) * nloc) {
            __builtin_amdgcn_fence(__ATOMIC_RELEASE, "agent");
            asm volatile("s_waitcnt vmcnt(0)" ::: "memory");
            const unsigned og = xb_add(&bar[XB_TOP], 1u);
            const unsigned tg = og / nx;
            if (og + 1u == (tg + 1u) * nx) xb_add(&bar[XB_TOPGEN], 1u);
            else XB_SPIN(xb_ld(&bar[XB_TOPGEN]) == tg, bar);
            __builtin_amdgcn_fence(__ATOMIC_ACQUIRE, "agent");
            xb_add(&bar[XB_XGEN(b.x)], 1u);
            asm volatile("s_waitcnt vmcnt(0)" ::: "memory");
        } else {
            XB_SPIN(xb_ld(&bar[XB_XGEN(b.x)]) == gen, bar);
            __builtin_amdgcn_fence(__ATOMIC_ACQUIRE, "agent");
            asm volatile("s_waitcnt vmcnt(0)" ::: "memory");
        }
    }
    __syncthreads();
}

struct Args { const float* in[36]; float* out; unsigned char* ws; int s_lo, s_hi; };
enum { I_X = 0, I_NORM_MIX, I_W_IN, I_MU_A, I_W_DECAY0, I_W_DECAY2, I_A0, I_A2, I_G2, I_K_K, I_K_A, I_R_K, I_LNX_W, I_LNX_B, I_VRES_MU, I_VRES_W1, I_VRES_W2, I_VRES_B,
       I_SGU_LN_W, I_SGU_LN_B, I_SGU_WS, I_SGU_BS, I_GATE_B, I_W_PA, I_W_PB, I_W_PC, I_W_OUT, I_NORM_FFN, I_RGRP, I_RGRP_B, I_REXP, I_REXP_B, I_MOE_W1, I_MOE_W3, I_MOE_W2, I_NORM_FINAL };

struct Ctx {
    LAS unsigned char* lds; unsigned char* ws; const float* const* in; float* out;
    int tid, lane, wave, G, bid, gw, ngw;
};
__device__ __forceinline__ Ctx launder(const Ctx& C0) {
    Ctx C = C0; asm volatile("" : "+v"(C.tid), "+v"(C.lane)); asm volatile("" : "+s"(C.wave), "+s"(C.bid), "+s"(C.gw), "+s"(C.ws)); return C;
}

__device__ __forceinline__ void tr_item(const float* W, int N, int k0, int n0, bf16* WT, int ldk, int drow0, LAS float* scr, int lane) {
    float wv_[32];
#pragma unroll
    for (int i = 0; i < 32; ++i) { const int kk = 2 * i + (lane >> 5); wv_[i] = W[(size_t)(k0 + kk) * N + n0 + (lane & 31)]; }
#pragma unroll
    for (int i = 0; i < 32; ++i) { const int kk = 2 * i + (lane >> 5); scr[kk * 33 + (lane & 31)] = wv_[i]; }
    LDS_WAIT(); asm volatile("" ::: "memory");
    const int c = lane & 7;
#pragma unroll
    for (int j = 0; j < 4; ++j) { const int n = (lane >> 3) + 8 * j; const LAS float* s = scr + (8 * c) * 33 + n;
        u32x4 o; o.x = cvt_pk_bf16(s[0 * 33], s[1 * 33]); o.y = cvt_pk_bf16(s[2 * 33], s[3 * 33]); o.z = cvt_pk_bf16(s[4 * 33], s[5 * 33]); o.w = cvt_pk_bf16(s[6 * 33], s[7 * 33]);
        *(u32x4*)(WT + (size_t)(drow0 + n) * ldk + k0 + 8 * c) = o; }
    LDS_WAIT(); asm volatile("" ::: "memory");
}

__device__ __forceinline__ void tr_item_i8(const float* W, int N, int k0, int n0, unsigned char* WT, int ldkb, int drow0, const unsigned* cmax, LAS float* scr, int lane) {
    float wv_[32];
    const float sc = 127.f / fmaxf(__uint_as_float(cmax[drow0 + (lane & 31)]), 1e-30f);
#pragma unroll
    for (int i = 0; i < 32; ++i) { const int kk = 2 * i + (lane >> 5); wv_[i] = W[(size_t)(k0 + kk) * N + n0 + (lane & 31)]; }
#pragma unroll
    for (int i = 0; i < 32; ++i) { const int kk = 2 * i + (lane >> 5); scr[kk * 33 + (lane & 31)] = __builtin_rintf(wv_[i] * sc); }
    LDS_WAIT(); asm volatile("" ::: "memory");
    const int c = lane & 7;
#pragma unroll
    for (int j = 0; j < 4; ++j) { const int n = (lane >> 3) + 8 * j; const LAS float* s = scr + (8 * c) * 33 + n; u32 q[8];
#pragma unroll
        for (int e = 0; e < 8; ++e) q[e] = (u32)(int)s[e * 33] & 255u;
        *(u32x2*)(WT + (size_t)(drow0 + n) * ldkb + k0 + 8 * c) = (u32x2){q[0] | (q[1] << 8) | (q[2] << 16) | (q[3] << 24), q[4] | (q[5] << 8) | (q[6] << 16) | (q[7] << 24)}; }
    LDS_WAIT(); asm volatile("" ::: "memory");
}
__device__ __forceinline__ void phase_wmax(const Ctx& C0) {
    const Ctx C = launder(C0);
    unsigned* cm = (unsigned*)(C.ws + WS_CTL) + CW_WMAX;
    const int gt = C.bid * 512 + C.tid, ngt = C.G * 512;
    constexpr int NF4 = IN_COLS / 4;
    for (int i = gt; i < NLAYER * 32 * NF4; i += ngt) { const int n4 = i % NF4, kb = (i / NF4) % 32, l = i / (NF4 * 32);
        const float* p = C.in[I_W_IN] + ((size_t)l * D + kb * 32) * IN_COLS + n4 * 4; f32x4 m = {0.f, 0.f, 0.f, 0.f};
#pragma unroll 8
        for (int k = 0; k < 32; ++k) { const f32x4 v = *(const f32x4*)(p + (size_t)k * IN_COLS); m = __builtin_elementwise_max(m, __builtin_elementwise_abs(v)); }
        unsigned* d = cm + l * WIN_ROWS + n4 * 4;
#pragma unroll
        for (int e = 0; e < 4; ++e) __hip_atomic_fetch_max(d + e, __float_as_uint(m[e]), __ATOMIC_RELAXED, __HIP_MEMORY_SCOPE_AGENT); }
    for (int i = gt; i < 32 * 8; i += ngt) { const int n4 = i % 8, kb = i / 8;
        const float* p = C.in[I_VRES_W1] + (size_t)(kb * 32) * 32 + n4 * 4; f32x4 m = {0.f, 0.f, 0.f, 0.f};
#pragma unroll 8
        for (int k = 0; k < 32; ++k) { const f32x4 v = *(const f32x4*)(p + (size_t)k * 32); m = __builtin_elementwise_max(m, __builtin_elementwise_abs(v)); }
        unsigned* d = cm + WIN_ROWS + IN_COLS + n4 * 4;
#pragma unroll
        for (int e = 0; e < 4; ++e) __hip_atomic_fetch_max(d + e, __float_as_uint(m[e]), __ATOMIC_RELAXED, __HIP_MEMORY_SCOPE_AGENT); }
    unsigned* cm13 = (unsigned*)(C.ws + WS_CTL) + CW_WMAX13;
    for (int i = gt; i < NLAYER * NEXP * 2 * 16 * 128; i += ngt) { const int n4 = i % 128, kb = (i / 128) % 16, sel = (i / 2048) % 2, le = i / 4096;
        const float* p = C.in[sel ? I_MOE_W3 : I_MOE_W1] + ((size_t)le * D + kb * 64) * EFF + n4 * 4; f32x4 m = {0.f, 0.f, 0.f, 0.f};
#pragma unroll 8
        for (int k = 0; k < 64; ++k) { const f32x4 v = *(const f32x4*)(p + (size_t)k * EFF); m = __builtin_elementwise_max(m, __builtin_elementwise_abs(v)); }
        const int n = n4 * 4; unsigned* d = cm13 + le * 1024 + (n / 128) * 256 + (n % 128) + sel * 128;
#pragma unroll
        for (int e = 0; e < 4; ++e) __hip_atomic_fetch_max(d + e, __float_as_uint(m[e]), __ATOMIC_RELAXED, __HIP_MEMORY_SCOPE_AGENT); }
}

__device__ __forceinline__ void phase_convert(const Ctx& C0, int l, bool first) {
    const Ctx C = launder(C0);
    LAS float* scr = (LAS float*)(C.lds + C.wave * 16384);
    unsigned char* ws = C.ws;
    constexpr int I_WIN = 16 * 336, I_VR = 16, I_SQ = 16 * 32, I_PB = 4 * 32, I_E13 = 256 * 32, I_E2 = 256 * 32;
    constexpr int NIT_ = I_WIN + I_VR + 3 * I_SQ + I_PB + 2 * I_E13 + I_E2;
    for (int it = C.gw; it < NIT_; it += C.ngw) {
        int r = it;
        if (r < I_WIN) { tr_item_i8(C.in[I_W_IN] + (size_t)l * D * IN_COLS, IN_COLS, (r / 336) * 64, (r % 336) * 32, ws + WS_WIN, D, (r % 336) * 32, (const unsigned*)(ws + WS_CTL) + CW_WMAX + l * WIN_ROWS, scr, C.lane); continue; } r -= I_WIN;
        if (r < I_VR) { if (l == 1) tr_item_i8(C.in[I_VRES_W1], 32, r * 64, 0, ws + WS_WIN, D, IN_COLS, (const unsigned*)(ws + WS_CTL) + CW_WMAX + WIN_ROWS, scr, C.lane); continue; } r -= I_VR;
        if (r < I_SQ) { tr_item(C.in[I_W_PA] + (size_t)l * D * D, D, (r / 32) * 64, (r % 32) * 32, (bf16*)(ws + WS_PA), D, (r % 32) * 32, scr, C.lane); continue; } r -= I_SQ;
        if (r < I_SQ) { tr_item(C.in[I_W_PC] + (size_t)l * D * D, D, (r / 32) * 64, (r % 32) * 32, (bf16*)(ws + WS_PC), D, (r % 32) * 32, scr, C.lane); continue; } r -= I_SQ;
        if (r < I_SQ) { tr_item(C.in[I_W_OUT] + (size_t)l * D * D, D, (r / 32) * 64, (r % 32) * 32, (bf16*)(ws + WS_WOUT), D, (r % 32) * 32, scr, C.lane); continue; } r -= I_SQ;
        if (r < I_PB) { tr_item(C.in[I_W_PB] + (size_t)l * 256 * D, D, (r / 32) * 64, (r % 32) * 32, (bf16*)(ws + WS_PB), 256, (r % 32) * 32, scr, C.lane); continue; } r -= I_PB;
        if (r < 2 * I_E13) { const int sel = r / I_E13; r -= sel * I_E13; const int e = r / 256, q = r % 256, kb = q / 16, nb = q % 16, n0 = nb * 32;
            tr_item_i8(C.in[sel ? I_MOE_W3 : I_MOE_W1] + ((size_t)l * NEXP + e) * D * EFF, EFF, kb * 64, n0, ws + WS_W13 + (size_t)e * D * D, D, (n0 / 128) * 256 + (n0 % 128) + sel * 128, (const unsigned*)(ws + WS_CTL) + CW_WMAX13 + (l * NEXP + e) * 1024, scr, C.lane); continue; }
        r -= 2 * I_E13;
        { const int e = r / 256, q = r % 256, kb = q / 32, nb = q % 32;
            tr_item(C.in[I_MOE_W2] + ((size_t)l * NEXP + e) * EFF * D, D, kb * 64, nb * 32, (bf16*)(ws + WS_W2) + (size_t)e * D * EFF, EFF, nb * 32, scr, C.lane); }
    }
    const int gt = C.bid * 512 + C.tid, ngt = C.G * 512;
    if (l == 1) { u32 zz_ = 0u; asm volatile("" : "+v"(zz_));
        for (int i = gt; i < 224 * 64; i += ngt) *(u32x4*)(ws + WS_WIN + (size_t)(10784 + i / 64) * D + (i % 64) * 16) = (u32x4){zz_, zz_, zz_, zz_}; }
    for (int i = gt; i < LORA_N * (LORA_K / 8); i += ngt) {
        const int n = i % LORA_N, k8 = i / LORA_N, sec = n >> 10, nn = n & 1023; float v[8];
#pragma unroll
        for (int e = 0; e < 8; ++e) { const int k = k8 * 8 + e; float x = 0.f;
            if (sec == 0) { if (k < 64) x = C.in[I_W_DECAY2][((size_t)l * 64 + k) * D + nn]; }
            else if (sec == 1) { if (k >= 64 && k < 128) x = C.in[I_A2][((size_t)l * 64 + (k - 64)) * D + nn]; }
            else if (sec == 2) { if (k >= 128 && k < 256) x = C.in[I_G2][((size_t)l * 128 + (k - 128)) * D + nn]; }
            else { if (l == 1 && k >= 256 && k < 288) x = C.in[I_VRES_W2][(size_t)(k - 256) * D + nn]; }
            v[e] = x; }
        u32x4 o; o.x = cvt_pk_bf16(v[0], v[1]); o.y = cvt_pk_bf16(v[2], v[3]); o.z = cvt_pk_bf16(v[4], v[5]); o.w = cvt_pk_bf16(v[6], v[7]);
        *(u32x4*)((bf16*)(ws + WS_LORAB) + (size_t)n * LORA_K + k8 * 8) = o;
    }
    for (int i = gt; i < 8 * 128 * 16; i += ngt) { const int s8 = i & 15, t = (i >> 4) & 127, g = i >> 11; const float* src = C.in[I_SGU_WS] + (((size_t)l * 8 + g) * 128 + t) * 128 + s8 * 8; float v[8];
#pragma unroll
        for (int e = 0; e < 8; ++e) v[e] = (s8 * 8 + e <= t) ? src[e] : 0.f;
        u32x4 o; o.x = cvt_pk_bf16(v[0], v[1]); o.y = cvt_pk_bf16(v[2], v[3]); o.z = cvt_pk_bf16(v[4], v[5]); o.w = cvt_pk_bf16(v[6], v[7]);
        *(u32x4*)((bf16*)(ws + WS_WSC) + (size_t)i * 8) = o; }
    for (int i = gt; i < 48 * (D / 8); i += ngt) { const int e = i / (D / 8), k8 = i % (D / 8); u32 hi[4], lo[4]; float h2[8], l2[8];
#pragma unroll
        for (int q = 0; q < 8; ++q) { const int k = k8 * 8 + q; float w = 0.f;
            if (e < 4) w = C.in[I_RGRP][((size_t)l * D + k) * 4 + e]; else if (e < 36) w = C.in[I_REXP][((size_t)l * D + k) * 32 + (e - 4)];
            w *= C.in[I_NORM_FFN][(size_t)l * D + k];
            const float wh = bf2f(f2bf(w)); h2[q] = wh; l2[q] = w - wh; }
#pragma unroll
        for (int q = 0; q < 4; ++q) { hi[q] = cvt_pk_bf16(h2[2 * q], h2[2 * q + 1]); lo[q] = cvt_pk_bf16(l2[2 * q], l2[2 * q + 1]); }
        *(u32x4*)((bf16*)(ws + WS_WSC + 512 * 1024) + (size_t)e * D + k8 * 8) = (u32x4){hi[0], hi[1], hi[2], hi[3]};
        *(u32x4*)((bf16*)(ws + WS_WSC + 640 * 1024) + (size_t)e * D + k8 * 8) = (u32x4){lo[0], lo[1], lo[2], lo[3]}; }
    if (first) for (int i = gt; i < T * 32; i += ngt) { const int t = i >> 5, f = i & 31;
        double invd = 1.0; for (int q = 0; q < f; ++q) invd *= 0.74989420933245582;
        const float inv = (float)invd;
        const float ang = (float)t * inv;
        double rev = (double)ang * 0.15915494309189535; rev -= __builtin_rint(rev);
        const float rv = (float)rev;
        ((f32x2*)(ws + WS_ROPE))[i] = (f32x2){__builtin_amdgcn_cosf(rv), __builtin_amdgcn_sinf(rv)}; }
}

__device__ __forceinline__ void row_load(const float* p, int lane, f32x4 (&v)[4]) {
#pragma unroll
    for (int j = 0; j < 4; ++j) v[j] = ((const f32x4*)p)[lane + 64 * j];
}
__device__ __forceinline__ float row_ss(const f32x4 (&v)[4]) {
    float s = 0.f;
#pragma unroll
    for (int j = 0; j < 4; ++j) s += (v[j].x * v[j].x + v[j].y * v[j].y) + (v[j].z * v[j].z + v[j].w * v[j].w);
    return wave_sum(s);
}
__device__ __forceinline__ void norm2_rows(const float* xsrc, const float* g, bf16* out, int gw, int ngw, int lane) {
    f32x4 gv[4];
#pragma unroll
    for (int j = 0; j < 4; ++j) gv[j] = ((const f32x4*)g)[lane + 64 * j];
    for (int ml = gw; ml < M; ml += 2 * ngw) { const int m2 = ml + ngw; const bool has2 = m2 < M; const int mb = has2 ? m2 : ml;
        f32x4 va[4], vb[4]; row_load(xsrc + (size_t)ml * D, lane, va); row_load(xsrc + (size_t)mb * D, lane, vb);
        const float ra = __builtin_amdgcn_rsqf(row_ss(va) * (1.f / D) + 1e-6f), rb = __builtin_amdgcn_rsqf(row_ss(vb) * (1.f / D) + 1e-6f);
#pragma unroll
        for (int j = 0; j < 4; ++j) { const f32x4 oa = va[j] * ra * gv[j]; ((u32x2*)(out + (size_t)ml * D))[lane + 64 * j] = (u32x2){cvt_pk_bf16(oa.x, oa.y), cvt_pk_bf16(oa.z, oa.w)}; }
        if (has2) {
#pragma unroll
            for (int j = 0; j < 4; ++j) { const f32x4 ob = vb[j] * rb * gv[j]; ((u32x2*)(out + (size_t)m2 * D))[lane + 64 * j] = (u32x2){cvt_pk_bf16(ob.x, ob.y), cvt_pk_bf16(ob.z, ob.w)}; } } }
}
__device__ __forceinline__ float wave_max(float v) {
#pragma unroll
    for (int o = 1; o < 64; o <<= 1) v = fmaxf(v, __shfl_xor(v, o));
    return v;
}
__device__ __forceinline__ void norm_q8_store(f32x4 (&v)[4], const f32x4 (&gv)[4], float r, unsigned char* orow, float* rsp, int lane) {
    float mx = 0.f;
#pragma unroll
    for (int j = 0; j < 4; ++j) { v[j] = v[j] * r * gv[j]; const f32x4 a = __builtin_elementwise_abs(v[j]); mx = fmaxf(mx, fmaxf(fmaxf(a.x, a.y), fmaxf(a.z, a.w))); }
    mx = fmaxf(wave_max(mx), 1e-20f);
    const float sc = 127.f / mx;
#pragma unroll
    for (int j = 0; j < 4; ++j) { const u32 q0 = (u32)(int)__builtin_rintf(v[j].x * sc) & 255u, q1 = (u32)(int)__builtin_rintf(v[j].y * sc) & 255u, q2 = (u32)(int)__builtin_rintf(v[j].z * sc) & 255u, q3 = (u32)(int)__builtin_rintf(v[j].w * sc);
        ((u32*)orow)[lane + 64 * j] = q0 | (q1 << 8) | (q2 << 16) | (q3 << 24); }
    if (lane == 0) *rsp = mx * (1.f / 127.f);
}
__device__ __forceinline__ void norm2_rows_i8(const float* xsrc, const float* g, unsigned char* out8, float* rs, int gw, int ngw, int lane) {
    f32x4 gv[4];
#pragma unroll
    for (int j = 0; j < 4; ++j) gv[j] = ((const f32x4*)g)[lane + 64 * j];
    for (int ml = gw; ml < M; ml += 2 * ngw) { const int m2 = ml + ngw; const bool has2 = m2 < M; const int mb = has2 ? m2 : ml;
        f32x4 va[4], vb[4]; row_load(xsrc + (size_t)ml * D, lane, va); row_load(xsrc + (size_t)mb * D, lane, vb);
        const float ra = __builtin_amdgcn_rsqf(row_ss(va) * (1.f / D) + 1e-6f), rb = __builtin_amdgcn_rsqf(row_ss(vb) * (1.f / D) + 1e-6f);
        norm_q8_store(va, gv, ra, out8 + (size_t)ml * D, rs + ml, lane);
        if (has2) norm_q8_store(vb, gv, rb, out8 + (size_t)m2 * D, rs + m2, lane); }
}
__device__ __forceinline__ void row_add_moe(const Ctx& C, int ml, f32x4 (&v)[4], const LAS int* tb) {
#ifdef DBG_NOMOE
    return;
#endif
    const int* tk = (const int*)(C.ws + WS_TOK) + 4 * ml; const float* wt = (const float*)(C.ws + WS_TOK + 512 * 1024) + 2 * ml;
    const int d0 = tb[tk[0]] * 256 + tk[1], d1 = tb[tk[2]] * 256 + tk[3]; const float w0 = wt[0], w1 = wt[1];
    const bf16* y0 = (const bf16*)(C.ws + WS_R1 + R1_YEXP) + (size_t)d0 * D; const bf16* y1 = (const bf16*)(C.ws + WS_R1 + R1_YEXP) + (size_t)d1 * D;
#pragma unroll
    for (int j = 0; j < 4; ++j) { const u32x2 a = ((const u32x2*)y0)[C.lane + 64 * j], b = ((const u32x2*)y1)[C.lane + 64 * j];
        v[j].x += w0 * bflo(a.x) + w1 * bflo(b.x); v[j].y += w0 * bfhi(a.x) + w1 * bfhi(b.x); v[j].z += w0 * bflo(a.y) + w1 * bflo(b.y); v[j].w += w0 * bfhi(a.y) + w1 * bfhi(b.y); }
}

__device__ __forceinline__ void mixer_norm(const Ctx& C, int it, int widx, int nw) {
    const int l = it / NCH, c = it % NCH;
    norm2_rows_i8((l == 0 ? C.in[I_X] : C.out) + (size_t)c * M * D, C.in[I_NORM_MIX] + (size_t)l * D, C.ws + WS_R1 + R1_HNX, (float*)(C.ws + WS_R1 + R1_HNX + HNX_RS), widx, nw, C.lane);
}
__device__ __forceinline__ void moe_table(const Ctx& C, int it, LAS int* tb);
__device__ __forceinline__ void phase_prep(const Ctx& C0, int it, LAS int* tb) {
    const Ctx C = launder(C0);
    if (it > 0) moe_table(C, it - 1, tb);
    const int l = it / NCH, c = it % NCH;
    if (it > 0) {
        const int pl = (it - 1) / NCH, pc = (it - 1) % NCH; const float* nf = C.in[I_NORM_FINAL];
        const int* tkb = (const int*)(C.ws + WS_TOK); const float* wtb = (const float*)(C.ws + WS_TOK + 512 * 1024); const bf16* yex = (const bf16*)(C.ws + WS_R1 + R1_YEXP);
        int t0 = 0, t1 = 0, t2 = 0, t3 = 0; float w0 = 0.f, w1 = 0.f;
        if (C.gw < M) { const int* tk = tkb + 4 * C.gw; t0 = tk[0]; t1 = tk[1]; t2 = tk[2]; t3 = tk[3]; w0 = wtb[2 * C.gw]; w1 = wtb[2 * C.gw + 1]; }
        for (int ml = C.gw; ml < M; ml += C.ngw) { float* xr = C.out + ((size_t)pc * M + ml) * D; f32x4 v[4];
            const int d0 = tb[t0] * 256 + t1, d1 = tb[t2] * 256 + t3; const float cw0 = w0, cw1 = w1;
            { const int mn = (ml + C.ngw < M) ? ml + C.ngw : ml; const int* tk = tkb + 4 * mn; t0 = tk[0]; t1 = tk[1]; t2 = tk[2]; t3 = tk[3]; w0 = wtb[2 * mn]; w1 = wtb[2 * mn + 1]; }
            row_load(xr, C.lane, v);
            { const bf16* y0 = yex + (size_t)d0 * D; const bf16* y1 = yex + (size_t)d1 * D;
#pragma unroll
              for (int j = 0; j < 4; ++j) { const u32x2 a = ((const u32x2*)y0)[C.lane + 64 * j], b = ((const u32x2*)y1)[C.lane + 64 * j];
                  v[j].x += cw0 * bflo(a.x) + cw1 * bflo(b.x); v[j].y += cw0 * bfhi(a.x) + cw1 * bfhi(b.x); v[j].z += cw0 * bflo(a.y) + cw1 * bflo(b.y); v[j].w += cw0 * bfhi(a.y) + cw1 * bfhi(b.y); } }
            if (pl == 1) { const float rs = __builtin_amdgcn_rsqf(row_ss(v) * (1.f / D) + 1e-6f);
#pragma unroll
                for (int j = 0; j < 4; ++j) v[j] = v[j] * rs * ((const f32x4*)nf)[C.lane + 64 * j]; }
#pragma unroll
            for (int j = 0; j < 4; ++j) ((f32x4*)xr)[C.lane + 64 * j] = v[j]; }
    }
    if (it == 0) mixer_norm(C, 0, C.gw, C.ngw);
}

__device__ __forceinline__ void sub_lora_prep(const Ctx& C0, int l) {
    const Ctx C = launder(C0);
    const bf16* za = (const bf16*)(C.ws + WS_R2 + R2_ZA); const bf16* vlo = (const bf16*)(C.ws + WS_VLO); bf16* al = (bf16*)(C.ws + WS_R1 + R1_ALORA);
    const float* mu = C.in[I_MU_A] + (size_t)l * A_COLS + 3072; const float* vmu = C.in[I_VRES_MU];
    const int gt = C.bid * 512 + C.tid, ngt = C.G * 512;
    for (int i = gt; i < M * 48; i += ngt) { const int ml = i / 48, k8 = i % 48; const int t = ml & (T - 1); float v[8];
        if (k8 < 32) { const u32x4 cur = *(const u32x4*)(za + (size_t)ml * A_COLS + 3072 + k8 * 8); u32x4 prv = (u32x4){0u, 0u, 0u, 0u};
            if (t > 0) prv = *(const u32x4*)(za + (size_t)(ml - 1) * A_COLS + 3072 + k8 * 8);
            const u32 cw[4] = {cur.x, cur.y, cur.z, cur.w}, pw[4] = {prv.x, prv.y, prv.z, prv.w};
#pragma unroll
            for (int e = 0; e < 8; ++e) { const float zc = (e & 1) ? bfhi(cw[e >> 1]) : bflo(cw[e >> 1]), zp = (e & 1) ? bfhi(pw[e >> 1]) : bflo(pw[e >> 1]);
                float x = zc + (zp - zc) * mu[k8 * 8 + e];
                if (k8 < 8) x = 1.f - 2.f * __builtin_amdgcn_rcpf(__expf(2.f * x) + 1.f);
                else if (k8 >= 16) x = sigmoidf_(x);
                v[e] = x; }
        } else if (k8 < 36 && l == 1) { const int c8 = k8 - 32; const u32x4 cur = *(const u32x4*)(vlo + (size_t)ml * 32 + c8 * 8); u32x4 prv = (u32x4){0u, 0u, 0u, 0u};
            if (t > 0) prv = *(const u32x4*)(vlo + (size_t)(ml - 1) * 32 + c8 * 8);
            const u32 cw[4] = {cur.x, cur.y, cur.z, cur.w}, pw[4] = {prv.x, prv.y, prv.z, prv.w};
#pragma unroll
            for (int e = 0; e < 8; ++e) { const float zc = (e & 1) ? bfhi(cw[e >> 1]) : bflo(cw[e >> 1]), zp = (e & 1) ? bfhi(pw[e >> 1]) : bflo(pw[e >> 1]);
                v[e] = zc + (zp - zc) * vmu[c8 * 8 + e]; }
        } else {
#pragma unroll
            for (int e = 0; e < 8; ++e) v[e] = 0.f;
        }
        u32x4 o; o.x = cvt_pk_bf16(v[0], v[1]); o.y = cvt_pk_bf16(v[2], v[3]); o.z = cvt_pk_bf16(v[4], v[5]); o.w = cvt_pk_bf16(v[6], v[7]);
        *(u32x4*)(al + (size_t)ml * LORA_K + k8 * 8) = o; }
}

__device__ __forceinline__ void sub_gmlp(const Ctx& C0, int l) {
    const Ctx C = launder(C0);
    const bf16* zc = (const bf16*)(C.ws + WS_R1 + R1_ZC); bf16* yc = (bf16*)(C.ws + WS_YC); const bf16* wsc = (const bf16*)(C.ws + WS_WSC);
    const float* lnw = C.in[I_SGU_LN_W] + (size_t)l * D; const float* lnb = C.in[I_SGU_LN_B] + (size_t)l * D; const float* bs = C.in[I_SGU_BS] + (size_t)l * 8 * 128;
    LAS bf16* VT = (LAS bf16*)C.lds;
    LAS float* ST = (LAS float*)(C.lds + 40960);
    const int lane = C.lane, w = C.wave;
    for (int u = C.bid; u < 256; u += C.G) {
        const int nloc = u >> 1, gq = u & 1; const int r0 = nloc * 128;
#pragma unroll 1
        for (int tb4 = 0; tb4 < 4; ++tb4) { u32x4 ra[4], rb4[4]; float s1[4], s2[4];
#pragma unroll
            for (int q4 = 0; q4 < 4; ++q4) { const bf16* vr = zc + (size_t)(r0 + 16 * w + 4 * tb4 + q4) * C_COLS + 1024; ra[q4] = ((const u32x4*)vr)[lane]; rb4[q4] = ((const u32x4*)vr)[lane + 64]; }
#pragma unroll
            for (int q4 = 0; q4 < 4; ++q4) { const u32 q[8] = {ra[q4].x, ra[q4].y, ra[q4].z, ra[q4].w, rb4[q4].x, rb4[q4].y, rb4[q4].z, rb4[q4].w}; float a = 0.f, b = 0.f;
#pragma unroll
                for (int e = 0; e < 8; ++e) { const float x0 = bflo(q[e]), x1 = bfhi(q[e]); a += x0 + x1; b += x0 * x0 + x1 * x1; }
                s1[q4] = a; s2[q4] = b; }
#pragma unroll
            for (int o = 1; o < 64; o <<= 1) {
#pragma unroll
                for (int q4 = 0; q4 < 4; ++q4) { const float t1 = __shfl_xor(s1[q4], o), t2 = __shfl_xor(s2[q4], o); s1[q4] += t1; s2[q4] += t2; } }
            if (lane == 0) {
#pragma unroll
                for (int q4 = 0; q4 < 4; ++q4) { const int tk = 16 * w + 4 * tb4 + q4; const float mean = s1[q4] * (1.f / 1024.f); const float var = fmaxf(s2[q4] * (1.f / 1024.f) - mean * mean, 0.f);
                    ST[2 * tk] = mean; ST[2 * tk + 1] = __builtin_amdgcn_rsqf(var + 1e-5f); } } }
        __syncthreads();
        u32x4 gr[4];
#define GM_ISSUE(g_) do { _Pragma("unroll") for (int p_ = 0; p_ < 4; ++p_) { const int idx_ = C.tid + 512 * p_; gr[p_] = *(const u32x4*)(zc + (size_t)(r0 + (idx_ >> 4)) * C_COLS + 1024 + (g_) * 128 + (idx_ & 15) * 8); } } while (0)
        GM_ISSUE(gq * 4);
        for (int gi = 0; gi < 4; ++gi) { const int g = gq * 4 + gi;
#pragma unroll
            for (int p = 0; p < 4; ++p) { const int idx = C.tid + 512 * p; const int tk = idx >> 4, c8 = idx & 15;
                const u32 q[4] = {gr[p].x, gr[p].y, gr[p].z, gr[p].w};
                const float mean = ST[2 * tk], rstd = ST[2 * tk + 1];
#pragma unroll
                for (int e = 0; e < 8; ++e) { const int cc = c8 * 8 + e; const float x = (e & 1) ? bfhi(q[e >> 1]) : bflo(q[e >> 1]);
                    const float y = (x - mean) * rstd * lnw[g * 128 + cc] + lnb[g * 128 + cc];
                    VT[cc * 136 + ((((tk >> 3) + c8) & 15) << 3) + (tk & 7)] = (bf16)f2bf(y); } }
            asm volatile("" ::: "memory");
            if (gi < 3) GM_ISSUE(g + 1);
            __syncthreads();
            const int ct = w & 3, th = w >> 2;
#pragma unroll 1
            for (int tq = 0; tq < 2; ++tq) { const int tau = 2 * th + tq; f32x16 acc;
#pragma unroll
                for (int e = 0; e < 16; ++e) acc[e] = 0.f;
                const int nks = 2 * tau + 2; const int crow = ct * 32 + (lane & 31); const bf16* wrow = wsc + ((size_t)g * 128 + tau * 32 + (lane & 31)) * 128 + (lane >> 5) * 8;
                bf16x8 bb[8];
#pragma unroll
                for (int ks = 0; ks < 8; ++ks) if (ks < nks) bb[ks] = *(const bf16x8*)(wrow + ks * 16);
#pragma unroll
                for (int ks = 0; ks < 8; ++ks) if (ks < nks) { const int s0 = ks * 16 + (lane >> 5) * 8;
                    const bf16x8 a = *(const LAS bf16x8*)(VT + crow * 136 + ((((s0 >> 3) + (crow >> 3)) & 15) << 3));
                    acc = __builtin_amdgcn_mfma_f32_32x32x16_bf16(a, bb[ks], acc, 0, 0, 0); }
                const int tk = tau * 32 + (lane & 31); const float bsv = bs[g * 128 + tk];
                const bf16* ur = zc + (size_t)(r0 + tk) * C_COLS + g * 128 + ct * 32; bf16* yr = yc + (size_t)(r0 + tk) * D + g * 128 + ct * 32;
#pragma unroll
                for (int rq = 0; rq < 4; ++rq) { const int cb = 8 * rq + 4 * (lane >> 5); const u32x2 uu = *(const u32x2*)(ur + cb);
                    const float o0 = bflo(uu.x) * (acc[4 * rq + 0] + bsv), o1 = bfhi(uu.x) * (acc[4 * rq + 1] + bsv), o2 = bflo(uu.y) * (acc[4 * rq + 2] + bsv), o3 = bfhi(uu.y) * (acc[4 * rq + 3] + bsv);
                    *(u32x2*)(yr + cb) = (u32x2){cvt_pk_bf16(o0, o1), cvt_pk_bf16(o2, o3)}; } }
            __syncthreads();
        }
    }
}

__device__ __forceinline__ void sub_attn(const Ctx& C0) {
    const Ctx C = launder(C0);
    const bf16* zb = (const bf16*)(C.ws + WS_R1 + R1_ZB); bf16* og = (bf16*)(C.ws + WS_R1 + R1_OG); float* lse = (float*)(C.ws + WS_LSE); const f32x2* rope = (const f32x2*)(C.ws + WS_ROPE);
    LAS bf16* Qs = (LAS bf16*)C.lds;
    LAS bf16* Ks = (LAS bf16*)(C.lds + 18432);
    LAS bf16* Vs = (LAS bf16*)(C.lds + 18432 + 36864);
    const int lane = C.lane, w = C.wave, fr = lane & 15, fq = lane >> 4;
    u32x4 rqa, rqb, rka[2], rkb[2], rv[4];
#define AT_DECODE(u_, bl_, hd_, gi_, d_, r_, n_) const int bl_ = (u_) / 768, rem_##bl_ = (u_) % 768, hd_ = rem_##bl_ / 64, blk_##bl_ = rem_##bl_ % 64; \
        const int gi_ = hd_ >> 2, d_ = (gi_ == 0) ? 1 : (gi_ == 1 ? 4 : 16), nb_##bl_ = 64 / d_, r_ = blk_##bl_ / nb_##bl_, n_ = blk_##bl_ % nb_##bl_
#define AT_ISSUE(u_) do { AT_DECODE(u_, xbl, xhd, xgi, xd, xr, xn); const int rb_ = xbl * T; const u32x4 z4_ = (u32x4){0u, 0u, 0u, 0u}; \
        { const int row_ = C.tid >> 2, c0_ = (C.tid & 3) * 8; const int t_ = (128 * xn + row_) * xd + xr; const bf16* s_ = zb + (size_t)(rb_ + t_) * B_COLS + xhd * 64; rqa = *(const u32x4*)(s_ + c0_); rqb = *(const u32x4*)(s_ + 32 + c0_); } \
        _Pragma("unroll") for (int p_ = 0; p_ < 2; ++p_) { const int row_ = (C.tid >> 2) + 128 * p_, c0_ = (C.tid & 3) * 8; const int ms_ = 128 * (xn - 1) + row_; rka[p_] = z4_; rkb[p_] = z4_; \
            if (ms_ >= 0) { const int t_ = ms_ * xd + xr; const bf16* s_ = zb + (size_t)(rb_ + t_) * B_COLS + 768 + xhd * 64; rka[p_] = *(const u32x4*)(s_ + c0_); rkb[p_] = *(const u32x4*)(s_ + 32 + c0_); } } \
        _Pragma("unroll") for (int p_ = 0; p_ < 4; ++p_) { const int idx_ = C.tid + 512 * p_; const int row_ = idx_ >> 3, c8_ = idx_ & 7; const int ms_ = 128 * (xn - 1) + row_; rv[p_] = z4_; \
            if (ms_ >= 0) { const int t_ = ms_ * xd + xr; rv[p_] = *(const u32x4*)(zb + (size_t)(rb_ + t_) * B_COLS + 1536 + xhd * 64 + c8_ * 8); } } } while (0)
    if (C.bid < 1536) AT_ISSUE(C.bid);
    for (int u = C.bid; u < 1536; u += C.G) {
        AT_DECODE(u, bl, hd, gi, d, r, n);
        const int rowbase = bl * T;
        { const int row = C.tid >> 2, c0 = (C.tid & 3) * 8; const int t = (128 * n + row) * d + r;
            const u32 qa[4] = {rqa.x, rqa.y, rqa.z, rqa.w}, qb[4] = {rqb.x, rqb.y, rqb.z, rqb.w}; float o1[8], o2[8];
#pragma unroll
            for (int e = 0; e < 8; ++e) { const f32x2 cs = rope[t * 32 + c0 + e]; const float z1 = (e & 1) ? bfhi(qa[e >> 1]) : bflo(qa[e >> 1]), z2 = (e & 1) ? bfhi(qb[e >> 1]) : bflo(qb[e >> 1]);
                o1[e] = (z1 * cs.x - z2 * cs.y) * 0.125f; o2[e] = (z1 * cs.y + z2 * cs.x) * 0.125f; }
            *(LAS u32x4*)(Qs + row * 72 + c0) = (u32x4){cvt_pk_bf16(o1[0], o1[1]), cvt_pk_bf16(o1[2], o1[3]), cvt_pk_bf16(o1[4], o1[5]), cvt_pk_bf16(o1[6], o1[7])};
            *(LAS u32x4*)(Qs + row * 72 + 32 + c0) = (u32x4){cvt_pk_bf16(o2[0], o2[1]), cvt_pk_bf16(o2[2], o2[3]), cvt_pk_bf16(o2[4], o2[5]), cvt_pk_bf16(o2[6], o2[7])}; }
#pragma unroll
        for (int p = 0; p < 2; ++p) { const int row = (C.tid >> 2) + 128 * p, c0 = (C.tid & 3) * 8; const int ms = 128 * (n - 1) + row; u32x4 oa = (u32x4){0u, 0u, 0u, 0u}, ob = oa;
            if (ms >= 0) { const int t = ms * d + r;
                const u32 qa[4] = {rka[p].x, rka[p].y, rka[p].z, rka[p].w}, qb[4] = {rkb[p].x, rkb[p].y, rkb[p].z, rkb[p].w}; float o1[8], o2[8];
#pragma unroll
                for (int e = 0; e < 8; ++e) { const f32x2 cs = rope[t * 32 + c0 + e]; const float z1 = (e & 1) ? bfhi(qa[e >> 1]) : bflo(qa[e >> 1]), z2 = (e & 1) ? bfhi(qb[e >> 1]) : bflo(qb[e >> 1]);
                    o1[e] = z1 * cs.x - z2 * cs.y; o2[e] = z1 * cs.y + z2 * cs.x; }
                oa = (u32x4){cvt_pk_bf16(o1[0], o1[1]), cvt_pk_bf16(o1[2], o1[3]), cvt_pk_bf16(o1[4], o1[5]), cvt_pk_bf16(o1[6], o1[7])};
                ob = (u32x4){cvt_pk_bf16(o2[0], o2[1]), cvt_pk_bf16(o2[2], o2[3]), cvt_pk_bf16(o2[4], o2[5]), cvt_pk_bf16(o2[6], o2[7])}; }
            *(LAS u32x4*)(Ks + row * 72 + c0) = oa; *(LAS u32x4*)(Ks + row * 72 + 32 + c0) = ob; }
#pragma unroll
        for (int p = 0; p < 4; ++p) { const int idx = C.tid + 512 * p; const int row = idx >> 3, c8 = idx & 7;
            *(LAS u32x4*)(Vs + row * 72 + c8 * 8) = rv[p]; }
        asm volatile("" ::: "memory");
        if (u + C.G < 1536) AT_ISSUE(u + C.G);
        __syncthreads();
        f32x4 sc[9];
        { const bf16x8 q0 = *(const LAS bf16x8*)(Qs + (16 * w + fr) * 72 + fq * 8), q1 = *(const LAS bf16x8*)(Qs + (16 * w + fr) * 72 + 32 + fq * 8);
#pragma unroll
            for (int ti = 0; ti < 9; ++ti) { const int kr = 16 * w + 16 * ti + fr;
                const bf16x8 k0 = *(const LAS bf16x8*)(Ks + kr * 72 + fq * 8), k1 = *(const LAS bf16x8*)(Ks + kr * 72 + 32 + fq * 8);
                f32x4 a = (f32x4){0.f, 0.f, 0.f, 0.f};
                a = __builtin_amdgcn_mfma_f32_16x16x32_bf16(k0, q0, a, 0, 0, 0); a = __builtin_amdgcn_mfma_f32_16x16x32_bf16(k1, q1, a, 0, 0, 0); sc[ti] = a; } }
        float mx = -3.0e38f;
#pragma unroll
        for (int ti = 0; ti < 9; ++ti)
#pragma unroll
            for (int e = 0; e < 4; ++e) { const int rel = 16 * ti + 4 * fq + e; const bool ok = (rel >= fr) && (rel <= fr + 128) && (n > 0 || (16 * w + rel) >= 128);
                sc[ti][e] = ok ? sc[ti][e] : -3.0e38f; mx = fmaxf(mx, sc[ti][e]); }
        mx = fmaxf(mx, __shfl_xor(mx, 16)); mx = fmaxf(mx, __shfl_xor(mx, 32));
        float sum = 0.f;
#pragma unroll
        for (int ti = 0; ti < 9; ++ti)
#pragma unroll
            for (int e = 0; e < 4; ++e) { const float p = __expf(sc[ti][e] - mx); sc[ti][e] = p; sum += p; }
        sum += __shfl_xor(sum, 16); sum += __shfl_xor(sum, 32);
        f32x4 oacc[4];
#pragma unroll
        for (int ct = 0; ct < 4; ++ct) oacc[ct] = (f32x4){0.f, 0.f, 0.f, 0.f};
#pragma unroll
        for (int kp = 0; kp < 5; ++kp) { const int t0 = 2 * kp, t1 = (2 * kp + 1 < 9) ? 2 * kp + 1 : 8;
            u32x4 pw; pw.x = cvt_pk_bf16(sc[t0][0], sc[t0][1]); pw.y = cvt_pk_bf16(sc[t0][2], sc[t0][3]);
            if (2 * kp + 1 < 9) { pw.z = cvt_pk_bf16(sc[t1][0], sc[t1][1]); pw.w = cvt_pk_bf16(sc[t1][2], sc[t1][3]); } else { pw.z = 0u; pw.w = 0u; }
            const bf16x8 pb = __builtin_bit_cast(bf16x8, pw);
            const int k0 = 16 * w + 16 * t0 + 4 * fq, k1 = 16 * w + 16 * t1 + 4 * fq;
#pragma unroll
            for (int ct = 0; ct < 4; ++ct) {
                const u32x2 va = lds_tr16(Vs + (k0 + (fr >> 2)) * 72 + ct * 16 + 4 * (fr & 3)), vb = lds_tr16(Vs + (k1 + (fr >> 2)) * 72 + ct * 16 + 4 * (fr & 3));
                const bf16x8 av = __builtin_bit_cast(bf16x8, (u32x4){va.x, va.y, vb.x, vb.y});
                oacc[ct] = __builtin_amdgcn_mfma_f32_16x16x32_bf16(av, pb, oacc[ct], 0, 0, 0); } }
        { const float inv = __builtin_amdgcn_rcpf(sum); const int t = (128 * n + 16 * w + fr) * d + r; const size_t ml = (size_t)(rowbase + t);
            bf16* orow = og + ((size_t)gi * M + ml) * 256 + (hd & 3) * 64;
#pragma unroll
            for (int ct = 0; ct < 4; ++ct) *(u32x2*)(orow + ct * 16 + 4 * fq) = (u32x2){cvt_pk_bf16(oacc[ct][0] * inv, oacc[ct][1] * inv), cvt_pk_bf16(oacc[ct][2] * inv, oacc[ct][3] * inv)};
            if (fq == 0) lse[((size_t)gi * M + ml) * 4 + (hd & 3)] = mx + __logf(sum); }
        __syncthreads();
    }
}

__device__ __forceinline__ void sub_yb_combine(const Ctx& C0) {
    const Ctx C = launder(C0);
    const bf16* og = (const bf16*)(C.ws + WS_R1 + R1_OG); const float* lse = (const float*)(C.ws + WS_LSE); bf16* yb = (bf16*)(C.ws + WS_YB);
    const int gt = C.bid * 512 + C.tid, ngt = C.G * 512;
    for (int i = gt; i < M * 32; i += ngt) { const int ml = i >> 5, c8 = i & 31, hp = c8 >> 3;
        const float l0 = lse[((size_t)0 * M + ml) * 4 + hp], l1 = lse[((size_t)1 * M + ml) * 4 + hp], l2 = lse[((size_t)2 * M + ml) * 4 + hp];
        const float mx = fmaxf(l0, fmaxf(l1, l2)); float w0 = __expf(l0 - mx), w1 = __expf(l1 - mx), w2 = __expf(l2 - mx); const float inv = __builtin_amdgcn_rcpf(w0 + w1 + w2); w0 *= inv; w1 *= inv; w2 *= inv;
        const u32x4 a = *(const u32x4*)(og + ((size_t)0 * M + ml) * 256 + c8 * 8), b = *(const u32x4*)(og + ((size_t)1 * M + ml) * 256 + c8 * 8), c = *(const u32x4*)(og + ((size_t)2 * M + ml) * 256 + c8 * 8);
        const u32 qa[4] = {a.x, a.y, a.z, a.w}, qb[4] = {b.x, b.y, b.z, b.w}, qc[4] = {c.x, c.y, c.z, c.w}; u32 o[4];
#pragma unroll
        for (int e = 0; e < 4; ++e) o[e] = cvt_pk_bf16(w0 * bflo(qa[e]) + w1 * bflo(qb[e]) + w2 * bflo(qc[e]), w0 * bfhi(qa[e]) + w1 * bfhi(qb[e]) + w2 * bfhi(qc[e]));
        *(u32x4*)(yb + (size_t)ml * 256 + c8 * 8) = (u32x4){o[0], o[1], o[2], o[3]}; }
}

__device__ __forceinline__ void ld8(const bf16* p, float (&v)[8]) { const u32x4 a = *(const u32x4*)p; v[0] = bflo(a.x); v[1] = bfhi(a.x); v[2] = bflo(a.y); v[3] = bfhi(a.y); v[4] = bflo(a.z); v[5] = bfhi(a.z); v[6] = bflo(a.w); v[7] = bfhi(a.w); }
__device__ __forceinline__ void ldl8(const LAS float* p, float (&v)[8]) { const f32x4 a = *(const LAS f32x4*)p, b = *(const LAS f32x4*)(p + 4); v[0] = a.x; v[1] = a.y; v[2] = a.z; v[3] = a.w; v[4] = b.x; v[5] = b.y; v[6] = b.z; v[7] = b.w; }
__device__ __forceinline__ void ldf8(const float* p, float (&v)[8]) { const f32x4 a = *(const f32x4*)p, b = *(const f32x4*)(p + 4); v[0] = a.x; v[1] = a.y; v[2] = a.z; v[3] = a.w; v[4] = b.x; v[5] = b.y; v[6] = b.z; v[7] = b.w; }
constexpr int TS = 9216;
template <int KS, bool SW1, bool SW2>
__device__ __forceinline__ f32x16 mm_tile(const LAS bf16* t1, int r1, const LAS bf16* t2, int r2, f32x16 acc, int lane) {
    const int row1 = r1 + (lane & 31), row2 = r2 + (lane & 31), hb = lane >> 5;
    const LAS bf16* p1 = t1 + row1 * 72; const LAS bf16* p2 = t2 + row2 * 72; const int s1 = SW1 ? (row1 >> 3) : 0, s2 = SW2 ? (row2 >> 3) : 0;
#pragma unroll
    for (int ks = 0; ks < KS; ++ks) { const int cb = 2 * ks + hb;
        acc = __builtin_amdgcn_mfma_f32_32x32x16_bf16(*(const LAS bf16x8*)(p1 + ((cb + s1) & 7) * 8), *(const LAS bf16x8*)(p2 + ((cb + s2) & 7) * 8), acc, 0, 0, 0); }
    return acc;
}
__device__ __forceinline__ f32x16 zero16() { f32x16 a;
#pragma unroll
    for (int e = 0; e < 16; ++e) a[e] = 0.f;
    return a; }

__device__ __forceinline__ void phase_chunkpre(const Ctx& C0, int l, int c) {
    const Ctx C = launder(C0);
    LAS unsigned char* L = C.lds;
    LAS bf16* sA = (LAS bf16*)(L + 0 * TS);  LAS bf16* sR = (LAS bf16*)(L + 1 * TS);  LAS bf16* sB = (LAS bf16*)(L + 2 * TS);  LAS bf16* sK = (LAS bf16*)(L + 3 * TS);
    LAS bf16* sBhT = (LAS bf16*)(L + 4 * TS); LAS bf16* sKhT = (LAS bf16*)(L + 5 * TS); LAS bf16* sVT = (LAS bf16*)(L + 6 * TS); LAS bf16* sAT = (LAS bf16*)(L + 7 * TS);
    LAS bf16* sUT = (LAS bf16*)(L + 8 * TS); LAS bf16* sAab = (LAS bf16*)(L + 9 * TS);
    LAS bf16* sPT = (LAS bf16*)(L + 0 * TS);
    LAS bf16* sAak = (LAS bf16*)(L + 10 * TS); LAS bf16* sArb = (LAS bf16*)(L + 11 * TS); LAS bf16* sArk = (LAS bf16*)(L + 12 * TS);
    LAS float* TOT = (LAS float*)(L + 13 * TS);
    LAS bf16* TBB = (LAS bf16*)(L + 13 * TS + 2048);
    LAS float* WC = (LAS float*)(L + 13 * TS + 2048 + 4352);
    LAS float* PAR = (LAS float*)(L + 13 * TS + 2048 + 4352 + 256);
    LAS bf16* sZT = sB;
    const int tid = C.tid, w = C.wave;
    const bf16* ZAg = (const bf16*)(C.ws + WS_R2 + R2_ZA); const bf16* WPg = (const bf16*)(C.ws + WS_R4 + R4_WPRE); const bf16* APg = (const bf16*)(C.ws + WS_R4 + R4_APRE); const bf16* VRg = (const bf16*)(C.ws + WS_R4 + R4_VPRE);
    bf16* VFg = (bf16*)(C.ws + WS_VFIRST) + (size_t)c * M * D; bf16* VPg = (bf16*)(C.ws + WS_VP); float* BNg = (float*)(C.ws + WS_BONUS);
    bf16* YLg = (bf16*)(C.ws + WS_R1 + R1_YLOC); bf16* Qg = (bf16*)(C.ws + WS_R1 + R1_Q); bf16* MTg = (bf16*)(C.ws + WS_R1 + R1_MT); bf16* NCg = (bf16*)(C.ws + WS_R1 + R1_NC);
    const float* mu = C.in[I_MU_A] + (size_t)l * A_COLS;
    u32x4 qr, qk, qv, qrp, qkp, qvp, qw, qa, qvr, qvf;
#define CP_ISSUE(u_) do { const int bh_ = (u_) / NCHK, ck_ = (u_) % NCHK; const size_t row_ = (size_t)(bh_ >> 4) * T + ck_ * CHK + (tid >> 3); const int chn_ = (bh_ & 15) * 64 + (tid & 7) * 8; \
        const bf16* z_ = ZAg + row_ * A_COLS + chn_; const bool hp_ = (ck_ * CHK + (tid >> 3)) > 0; const u32x4 zero_ = (u32x4){0u, 0u, 0u, 0u}; \
        qr = *(const u32x4*)z_; qk = *(const u32x4*)(z_ + 1024); qv = *(const u32x4*)(z_ + 2048); \
        qrp = hp_ ? *(const u32x4*)(z_ - A_COLS) : zero_; qkp = hp_ ? *(const u32x4*)(z_ - A_COLS + 1024) : zero_; qvp = hp_ ? *(const u32x4*)(z_ - A_COLS + 2048) : zero_; \
        qw = *(const u32x4*)(WPg + row_ * D + chn_); qa = *(const u32x4*)(APg + row_ * D + chn_); \
        if (l == 1) { qvr = *(const u32x4*)(VRg + row_ * D + chn_); qvf = *(const u32x4*)(VFg + row_ * D + chn_); } } while (0)
#define CP_UNPK(v_, q_) do { v_[0] = bflo(q_.x); v_[1] = bfhi(q_.x); v_[2] = bflo(q_.y); v_[3] = bfhi(q_.y); v_[4] = bflo(q_.z); v_[5] = bfhi(q_.z); v_[6] = bflo(q_.w); v_[7] = bfhi(q_.w); } while (0)
    qvr = qvf = (u32x4){0u, 0u, 0u, 0u};
    const int UPB = (32 * NCHK + C.G - 1) / C.G; const int u_lo = C.bid * UPB, u_hi = (u_lo + UPB < 32 * NCHK) ? u_lo + UPB : 32 * NCHK;
    if (u_lo < u_hi) CP_ISSUE(u_lo);
    int par_bh = -1;
#pragma unroll 1
    for (int unit = u_lo; unit < u_hi; ++unit) {
        const int bh = unit / NCHK, ck = unit % NCHK, bl = bh >> 4, h = bh & 15; const size_t row0 = (size_t)bl * T + ck * CHK;
        int lane = C.lane; asm volatile("" : "+v"(lane));
        if (bh != par_bh) { par_bh = bh; __syncthreads();
            for (int i = tid; i < 9 * 64; i += 512) { const int k9 = i >> 6, jj = i & 63, chn = h * 64 + jj; float v;
                if (k9 < 3) v = mu[k9 * 1024 + chn]; else if (k9 == 3) v = C.in[I_W_DECAY0][(size_t)l * D + chn]; else if (k9 == 4) v = C.in[I_A0][(size_t)l * D + chn];
                else if (k9 == 5) v = C.in[I_K_K][(size_t)l * D + chn]; else if (k9 == 6) v = C.in[I_K_A][(size_t)l * D + chn]; else if (k9 == 7) v = C.in[I_R_K][(size_t)l * D + chn];
                else v = (l == 1) ? C.in[I_VRES_B][chn] : 0.f;
                PAR[i] = v; }
            __syncthreads(); }
        { const int t = tid >> 3, o = tid & 7, j0 = o * 8; const int ch = h * 64 + j0; const size_t row = row0 + t;
          float lw[8], av[8], bv[8], kv[8], rv[8], vv[8], Lc[8];
          { float tmp[8], p[8], kk[8], aa[8];
            CP_UNPK(rv, qr); CP_UNPK(tmp, qrp); ldl8(PAR + 0 * 64 + j0, p);
#pragma unroll
            for (int e = 0; e < 8; ++e) rv[e] = rv[e] + (tmp[e] - rv[e]) * p[e];
            CP_UNPK(kv, qk); CP_UNPK(tmp, qkp); ldl8(PAR + 1 * 64 + j0, p);
#pragma unroll
            for (int e = 0; e < 8; ++e) kv[e] = kv[e] + (tmp[e] - kv[e]) * p[e];
            CP_UNPK(vv, qv); CP_UNPK(tmp, qvp); ldl8(PAR + 2 * 64 + j0, p);
#pragma unroll
            for (int e = 0; e < 8; ++e) vv[e] = vv[e] + (tmp[e] - vv[e]) * p[e];
            if (l == 0) { *(u32x4*)(VFg + row * D + ch) = (u32x4){cvt_pk_bf16(vv[0], vv[1]), cvt_pk_bf16(vv[2], vv[3]), cvt_pk_bf16(vv[4], vv[5]), cvt_pk_bf16(vv[6], vv[7])}; }
            else { float vf[8], vb[8]; CP_UNPK(vf, qvf); CP_UNPK(tmp, qvr); ldl8(PAR + 8 * 64 + j0, vb);
#pragma unroll
                for (int e = 0; e < 8; ++e) vv[e] = vv[e] + (vf[e] - vv[e]) * sigmoidf_(vb[e] + tmp[e]); }
            const u32x4 vpk = (u32x4){cvt_pk_bf16(vv[0], vv[1]), cvt_pk_bf16(vv[2], vv[3]), cvt_pk_bf16(vv[4], vv[5]), cvt_pk_bf16(vv[6], vv[7])};
            *(u32x4*)(VPg + row * D + ch) = vpk; CP_UNPK(vv, vpk);
            CP_UNPK(tmp, qw); ldl8(PAR + 3 * 64 + j0, p);
#pragma unroll
            for (int e = 0; e < 8; ++e) { const float x = -(p[e] + tmp[e]); const float sp = fmaxf(x, 0.f) + __logf(1.f + __expf(-fabsf(x))); lw[e] = -__expf(-sp - 0.5f); }
            CP_UNPK(tmp, qa); ldl8(PAR + 4 * 64 + j0, p);
#pragma unroll
            for (int e = 0; e < 8; ++e) aa[e] = sigmoidf_(p[e] + tmp[e]);
            ldl8(PAR + 5 * 64 + j0, p); float ss = 0.f;
#pragma unroll
            for (int e = 0; e < 8; ++e) { kk[e] = kv[e] * p[e]; ss += kk[e] * kk[e]; }
            ss += __shfl_xor(ss, 1); ss += __shfl_xor(ss, 2); ss += __shfl_xor(ss, 4);
            const float kn = 1.0f / fmaxf(sqrtf(ss), 1e-12f);
            ldl8(PAR + 6 * 64 + j0, p); ldl8(PAR + 7 * 64 + j0, tmp); float bs = 0.f;
#pragma unroll
            for (int e = 0; e < 8; ++e) { kk[e] *= kn; kv[e] = kv[e] * (1.f + (aa[e] - 1.f) * p[e]); bs += rv[e] * kv[e] * tmp[e]; av[e] = -kk[e]; bv[e] = kk[e] * aa[e]; }
            bs += __shfl_xor(bs, 1); bs += __shfl_xor(bs, 2); bs += __shfl_xor(bs, 4);
            if (o == 0) BNg[row * 16 + h] = bs;
          }
#pragma unroll
          for (int e = 0; e < 8; ++e) { float x = lw[e]; float y;
              y = __shfl_up(x, 8); if (lane >= 8) x += y; y = __shfl_up(x, 16); if (lane >= 16) x += y; y = __shfl_up(x, 32); if (lane >= 32) x += y; Lc[e] = x; }
          if (lane >= 56) {
#pragma unroll
              for (int e = 0; e < 8; ++e) TOT[w * 64 + j0 + e] = Lc[e]; }
          __syncthreads();
          float LC[8];
#pragma unroll
          for (int e = 0; e < 8; ++e) { float off = 0.f, tot = 0.f;
#pragma unroll
              for (int q = 0; q < 8; ++q) { const float x = TOT[q * 64 + j0 + e]; tot += x; off += (q < w) ? x : 0.f; }
              Lc[e] += off; LC[e] = tot; }
          float ta[8], tr[8], tb[8], tk[8], hb[8], hk[8];
#pragma unroll
          for (int e = 0; e < 8; ++e) { const float eL = __expf(Lc[e]), emL = __expf(-Lc[e]), eLm = __expf(Lc[e] - lw[e]), eh = __expf(LC[e] - Lc[e]);
              ta[e] = av[e] * eLm; tr[e] = rv[e] * eL; tb[e] = bv[e] * emL; tk[e] = kv[e] * emL; hb[e] = bv[e] * eh; hk[e] = kv[e] * eh; }
          *(LAS u32x4*)(sA + t * 72 + j0) = (u32x4){cvt_pk_bf16(ta[0], ta[1]), cvt_pk_bf16(ta[2], ta[3]), cvt_pk_bf16(ta[4], ta[5]), cvt_pk_bf16(ta[6], ta[7])};
          *(LAS u32x4*)(sR + t * 72 + j0) = (u32x4){cvt_pk_bf16(tr[0], tr[1]), cvt_pk_bf16(tr[2], tr[3]), cvt_pk_bf16(tr[4], tr[5]), cvt_pk_bf16(tr[6], tr[7])};
          *(LAS u32x4*)(sB + t * 72 + j0) = (u32x4){cvt_pk_bf16(tb[0], tb[1]), cvt_pk_bf16(tb[2], tb[3]), cvt_pk_bf16(tb[4], tb[5]), cvt_pk_bf16(tb[6], tb[7])};
          *(LAS u32x4*)(sK + t * 72 + j0) = (u32x4){cvt_pk_bf16(tk[0], tk[1]), cvt_pk_bf16(tk[2], tk[3]), cvt_pk_bf16(tk[4], tk[5]), cvt_pk_bf16(tk[6], tk[7])};
#pragma unroll
          for (int e = 0; e < 8; ++e) { const int ad = (j0 + e) * 72 + ((((t >> 3) + o) & 7) << 3) + (t & 7); sAT[ad] = (bf16)f2bf(ta[e]); sBhT[ad] = (bf16)f2bf(hb[e]); sKhT[ad] = (bf16)f2bf(hk[e]); sVT[ad] = (bf16)f2bf(vv[e]); }
          if (t == 0) {
#pragma unroll
              for (int e = 0; e < 8; ++e) WC[j0 + e] = __expf(LC[e]); }
          asm volatile("" ::: "memory");
          if (unit + 1 < u_hi) CP_ISSUE(unit + 1);
        }
        __syncthreads();
        { const int mq = w >> 1, tt = w & 1; const LAS bf16* o1b = (mq & 1) ? sK : sB; const LAS bf16* o2b = (mq & 2) ? sR : sA; const bool incl = (mq & 2) != 0;
          LAS bf16* dst = (mq == 0) ? sAab : ((mq == 1) ? sAak : (mq == 2 ? sArb : sArk));
#pragma unroll
          for (int mt = 0; mt < 2; ++mt) { f32x16 acc = zero16();
              if (mt <= tt) acc = mm_tile<4, false, false>(o1b, mt * 32, o2b, tt * 32, acc, lane);
              const int tg = tt * 32 + (lane & 31);
#pragma unroll
              for (int rq = 0; rq < 4; ++rq) { const int tau0 = mt * 32 + 8 * rq + 4 * (lane >> 5); float v4[4];
#pragma unroll
                  for (int e = 0; e < 4; ++e) { const int tau = tau0 + e; const bool keep = incl ? (tau <= tg) : (tau < tg); v4[e] = keep ? acc[4 * rq + e] : 0.f; }
                  *(LAS u32x2*)(dst + tg * 72 + tau0) = (u32x2){cvt_pk_bf16(v4[0], v4[1]), cvt_pk_bf16(v4[2], v4[3])}; } } }
        __syncthreads();
        if (w < 4) { if (lane < 16) { const int b0 = 16 * w; float tc[16];
#pragma unroll
            for (int r = 0; r < 16; ++r) tc[r] = (r == lane) ? 1.f : 0.f;
#pragma unroll
            for (int q = 0; q < 15; ++q) { const float tq = tc[q];
#pragma unroll
                for (int r = q + 1; r < 16; ++r) tc[r] += bf2f(sAab[(b0 + r) * 72 + b0 + q]) * tq; }
#pragma unroll
            for (int r = 0; r < 16; ++r) TBB[(w * 16 + r) * 16 + lane] = (bf16)f2bf(tc[r]); } }
        else { const int tt = w & 1, itl = (w >> 1) & 1; f32x16 acc = zero16();
            acc = mm_tile<4, false, true>(sAak, tt * 32, sVT, itl * 32, acc, lane);
            const int i = itl * 32 + (lane & 31);
#pragma unroll
            for (int rq = 0; rq < 4; ++rq) { const int t0 = tt * 32 + 8 * rq + 4 * (lane >> 5);
                *(LAS u32x2*)(sZT + i * 72 + t0) = (u32x2){cvt_pk_bf16(acc[4 * rq], acc[4 * rq + 1]), cvt_pk_bf16(acc[4 * rq + 2], acc[4 * rq + 3])}; } }
        __syncthreads();
        { const int fr = lane & 15, fq = lane >> 4; LAS bf16* xt = ((w < 4) ? sUT : sPT) + ((w & 3) * 16) * 72;
          const int zr = (w & 3) * 16 + fr;
          { u32 zz_ = 0u; asm volatile("" : "+v"(zz_)); const u32x4 z4 = (u32x4){zz_, zz_, zz_, zz_};
            *(LAS u32x4*)(xt + (lane >> 2) * 72 + (lane & 3) * 16) = z4; *(LAS u32x4*)(xt + (lane >> 2) * 72 + (lane & 3) * 16 + 8) = z4; }
          LDS_WAIT();
#pragma unroll
          for (int b = 0; b < 4; ++b) { const int t0 = 16 * b + 4 * fq;
              u32x2 zq;
              if (w < 4) zq = *(const LAS u32x2*)(sZT + zr * 72 + t0); else zq = *(const LAS u32x2*)(sAT + zr * 72 + ((((t0 >> 3) + (zr >> 3)) & 7) << 3) + (t0 & 7));
              f32x4 acc = (f32x4){bflo(zq.x), bfhi(zq.x), bflo(zq.y), bfhi(zq.y)};
              if (b > 0) {
#pragma unroll
                  for (int ks = 0; ks < (b + 1) / 2; ++ks) { const bf16x8 oa = *(const LAS bf16x8*)(sAab + (16 * b + fr) * 72 + 32 * ks + 8 * fq), ox = *(const LAS bf16x8*)(xt + fr * 72 + 32 * ks + 8 * fq);
                      acc = __builtin_amdgcn_mfma_f32_16x16x32_bf16(oa, ox, acc, 0, 0, 0); } }
              const u32x2 tq = *(const LAS u32x2*)(TBB + (b * 16 + fr) * 16 + 4 * fq);
              const bf16x8 ot = __builtin_bit_cast(bf16x8, (u32x4){tq.x, tq.y, 0u, 0u}), ow = __builtin_bit_cast(bf16x8, (u32x4){cvt_pk_bf16(acc[0], acc[1]), cvt_pk_bf16(acc[2], acc[3]), 0u, 0u});
              const f32x4 xb = __builtin_amdgcn_mfma_f32_16x16x32_bf16(ot, ow, (f32x4){0.f, 0.f, 0.f, 0.f}, 0, 0, 0);
              *(LAS u32x2*)(xt + fr * 72 + t0) = (u32x2){cvt_pk_bf16(xb[0], xb[1]), cvt_pk_bf16(xb[2], xb[3])};
              LDS_WAIT(); asm volatile("" ::: "memory"); } }
        __syncthreads();
        { const int mt = (w >> 1) & 1, nt = w & 1, ln = lane & 31, lh = lane >> 5;
          if (w < 4) {
              { f32x16 acc = zero16();
                acc = mm_tile<4, false, false>(sUT, mt * 32, sArb, nt * 32, acc, lane); acc = mm_tile<4, true, false>(sVT, mt * 32, sArk, nt * 32, acc, lane);
                bf16* yr = YLg + (row0 + nt * 32 + ln) * D + h * 64 + mt * 32;
#pragma unroll
                for (int rq = 0; rq < 4; ++rq) *(u32x2*)(yr + 8 * rq + 4 * lh) = (u32x2){cvt_pk_bf16(acc[4 * rq], acc[4 * rq + 1]), cvt_pk_bf16(acc[4 * rq + 2], acc[4 * rq + 3])}; }
              { f32x16 acc = zero16();
                acc = mm_tile<4, false, false>(sPT, mt * 32, sArb, nt * 32, acc, lane);
                const int tl = nt * 32 + ln; bf16* qr_ = Qg + (row0 + tl) * D + h * 64 + mt * 32;
#pragma unroll
                for (int rq = 0; rq < 4; ++rq) { const int m0 = mt * 32 + 8 * rq + 4 * lh; const u32x2 rr = *(const LAS u32x2*)(sR + tl * 72 + m0);
                    *(u32x2*)(qr_ + 8 * rq + 4 * lh) = (u32x2){cvt_pk_bf16(acc[4 * rq] + bflo(rr.x), acc[4 * rq + 1] + bfhi(rr.x)), cvt_pk_bf16(acc[4 * rq + 2] + bflo(rr.y), acc[4 * rq + 3] + bfhi(rr.y))}; } }
          } else {
              { f32x16 acc = zero16();
                acc = mm_tile<4, true, false>(sBhT, mt * 32, sUT, nt * 32, acc, lane); acc = mm_tile<4, true, true>(sKhT, mt * 32, sVT, nt * 32, acc, lane);
                const int i_ = nt * 32 + ln;
#pragma unroll
                for (int rq = 0; rq < 4; ++rq) { const int j0_ = mt * 32 + 8 * rq + 4 * lh;
                    bf16* np = NCg + ((((size_t)unit * 4 + (i_ >> 4)) * 64 + (i_ & 15) + 16 * ((j0_ & 15) >> 2)) * 4 + (j0_ >> 4)) * 4;
                    *(u32x2*)np = (u32x2){cvt_pk_bf16(acc[4 * rq], acc[4 * rq + 1]), cvt_pk_bf16(acc[4 * rq + 2], acc[4 * rq + 3])}; } }
              { f32x16 acc = zero16();
                acc = mm_tile<4, false, true>(sPT, mt * 32, sBhT, nt * 32, acc, lane);
                const int j = nt * 32 + ln; const float wc = WC[j];
#pragma unroll
                for (int rq = 0; rq < 4; ++rq) { const int m0 = mt * 32 + 8 * rq + 4 * lh; float v4[4];
#pragma unroll
                    for (int e = 0; e < 4; ++e) v4[e] = acc[4 * rq + e] + ((m0 + e == j) ? wc : 0.f);
                    bf16* mp = MTg + ((((size_t)unit * 8 + 2 * (j >> 4) + (m0 >> 5)) * 64 + (j & 15) + 16 * ((m0 & 15) >> 2)) * 2 + ((m0 >> 4) & 1)) * 4;
                    *(u32x2*)mp = (u32x2){cvt_pk_bf16(v4[0], v4[1]), cvt_pk_bf16(v4[2], v4[3])}; } }
          } }
        __syncthreads();
    }
}

struct CarryBuf { u32x4 m[8]; u32x4 n[2]; };
__device__ __forceinline__ void carry_load(CarryBuf& B, const bf16* MTg, const bf16* NCg, size_t unit, int slab, int lane) {
    const bf16* mb = MTg + unit * 4096; const bf16* nb = NCg + (unit * 4 + slab) * 1024; const unsigned vm = (unsigned)lane * 16u, vm2 = vm + 4096u, vn = (unsigned)lane * 32u;
    asm volatile("global_load_dwordx4 %0, %1, %2" : "=v"(B.m[0]) : "v"(vm), "s"(mb) : "memory");
    asm volatile("global_load_dwordx4 %0, %1, %2 offset:1024" : "=v"(B.m[1]) : "v"(vm), "s"(mb) : "memory");
    asm volatile("global_load_dwordx4 %0, %1, %2 offset:2048" : "=v"(B.m[2]) : "v"(vm), "s"(mb) : "memory");
    asm volatile("global_load_dwordx4 %0, %1, %2 offset:3072" : "=v"(B.m[3]) : "v"(vm), "s"(mb) : "memory");
    asm volatile("global_load_dwordx4 %0, %1, %2" : "=v"(B.m[4]) : "v"(vm2), "s"(mb) : "memory");
    asm volatile("global_load_dwordx4 %0, %1, %2 offset:1024" : "=v"(B.m[5]) : "v"(vm2), "s"(mb) : "memory");
    asm volatile("global_load_dwordx4 %0, %1, %2 offset:2048" : "=v"(B.m[6]) : "v"(vm2), "s"(mb) : "memory");
    asm volatile("global_load_dwordx4 %0, %1, %2 offset:3072" : "=v"(B.m[7]) : "v"(vm2), "s"(mb) : "memory");
    asm volatile("global_load_dwordx4 %0, %1, %2" : "=v"(B.n[0]) : "v"(vn), "s"(nb) : "memory");
    asm volatile("global_load_dwordx4 %0, %1, %2 offset:16" : "=v"(B.n[1]) : "v"(vn), "s"(nb) : "memory");
}
#define CARRY_WAIT(B, N) asm volatile("s_waitcnt vmcnt(" #N ")" : "+v"(B.m[0]), "+v"(B.m[1]), "+v"(B.m[2]), "+v"(B.m[3]), "+v"(B.m[4]), "+v"(B.m[5]), "+v"(B.m[6]), "+v"(B.m[7]), "+v"(B.n[0]), "+v"(B.n[1]) :: "memory")
__device__ __forceinline__ void carry_step(f32x4 (&acc)[4], const CarryBuf& B, bf16* sp) {
    u32 pk[4][2];
#pragma unroll
    for (int jt = 0; jt < 4; ++jt) { pk[jt][0] = cvt_pk_bf16(acc[jt][0], acc[jt][1]); pk[jt][1] = cvt_pk_bf16(acc[jt][2], acc[jt][3]); }
#pragma unroll
    for (int jt = 0; jt < 4; ++jt) *(GAS u32x2*)(sp + jt * 16) = (u32x2){pk[jt][0], pk[jt][1]};
    const bf16x8 sb0 = __builtin_bit_cast(bf16x8, (u32x4){pk[0][0], pk[0][1], pk[1][0], pk[1][1]}), sb1 = __builtin_bit_cast(bf16x8, (u32x4){pk[2][0], pk[2][1], pk[3][0], pk[3][1]});
    const u32 nw[8] = {B.n[0].x, B.n[0].y, B.n[0].z, B.n[0].w, B.n[1].x, B.n[1].y, B.n[1].z, B.n[1].w};
#pragma unroll
    for (int jt = 0; jt < 4; ++jt) { f32x4 a = (f32x4){bflo(nw[2 * jt]), bfhi(nw[2 * jt]), bflo(nw[2 * jt + 1]), bfhi(nw[2 * jt + 1])};
        a = __builtin_amdgcn_mfma_f32_16x16x32_bf16(__builtin_bit_cast(bf16x8, B.m[2 * jt]), sb0, a, 0, 0, 0);
        a = __builtin_amdgcn_mfma_f32_16x16x32_bf16(__builtin_bit_cast(bf16x8, B.m[2 * jt + 1]), sb1, a, 0, 0, 0);
        acc[jt] = a; }
}
__device__ __forceinline__ void phase_carry2(const Ctx& C0) {
    const Ctx C = launder(C0);
    const bf16* MTg = (const bf16*)(C.ws + WS_R1 + R1_MT); const bf16* NCg = (const bf16*)(C.ws + WS_R1 + R1_NC); bf16* sst = (bf16*)(C.ws + WS_R1 + R1_SST);
    const int lane = C.lane, fr = lane & 15, fq = lane >> 4;
    if (C.wave != 0) return;
    for (int task = C.bid; task < 128; task += C.G) { const int bh = task >> 2, slab = task & 3; const size_t u0 = (size_t)bh * NCHK;
        f32x4 acc[4]; acc[0] = acc[1] = acc[2] = acc[3] = (f32x4){0.f, 0.f, 0.f, 0.f};
        CarryBuf B0, B1, B2, B3;
        asm volatile("s_waitcnt vmcnt(0)" ::: "memory");
        carry_load(B0, MTg, NCg, u0, slab, lane); carry_load(B1, MTg, NCg, u0 + 1, slab, lane); carry_load(B2, MTg, NCg, u0 + 2, slab, lane); carry_load(B3, MTg, NCg, u0 + 3, slab, lane);
        bf16* sp = sst + (u0 * 64 + slab * 16 + fr) * 64 + 4 * fq;
        CARRY_WAIT(B0, 30); carry_step(acc, B0, sp + (size_t)0 * 4096); carry_load(B0, MTg, NCg, u0 + 4, slab, lane);
        CARRY_WAIT(B1, 34); carry_step(acc, B1, sp + (size_t)1 * 4096); carry_load(B1, MTg, NCg, u0 + 5, slab, lane);
        CARRY_WAIT(B2, 38); carry_step(acc, B2, sp + (size_t)2 * 4096); carry_load(B2, MTg, NCg, u0 + 6, slab, lane);
        CARRY_WAIT(B3, 42); carry_step(acc, B3, sp + (size_t)3 * 4096); carry_load(B3, MTg, NCg, u0 + 7, slab, lane);
#pragma unroll 1
        for (int c = 4; c < NCHK; c += 4) {
            const size_t un = u0 + ((c + 4 < NCHK) ? c + 4 : c);
            CARRY_WAIT(B0, 42); carry_step(acc, B0, sp + (size_t)(c + 0) * 4096); carry_load(B0, MTg, NCg, un + 0, slab, lane);
            CARRY_WAIT(B1, 42); carry_step(acc, B1, sp + (size_t)(c + 1) * 4096); carry_load(B1, MTg, NCg, un + 1, slab, lane);
            CARRY_WAIT(B2, 42); carry_step(acc, B2, sp + (size_t)(c + 2) * 4096); carry_load(B2, MTg, NCg, un + 2, slab, lane);
            CARRY_WAIT(B3, 42); carry_step(acc, B3, sp + (size_t)(c + 3) * 4096); carry_load(B3, MTg, NCg, un + 3, slab, lane);
        }
        asm volatile("s_waitcnt vmcnt(0)" ::: "memory");
    }
}

__device__ __forceinline__ void phase_post2(const Ctx& C0, int l) {
    const Ctx C = launder(C0);
    const bf16* yl = (const bf16*)(C.ws + WS_R1 + R1_YLOC); const bf16* zz = (const bf16*)(C.ws + WS_R1 + R1_Q); const bf16* sst = (const bf16*)(C.ws + WS_R1 + R1_SST);
    const bf16* vp = (const bf16*)(C.ws + WS_VP); const bf16* gg = (const bf16*)(C.ws + WS_R4 + R4_G); const float* bonus = (const float*)(C.ws + WS_BONUS); bf16* ya = (bf16*)(C.ws + WS_HN);
    LAS float* LWs = (LAS float*)C.lds; LAS float* LBs = LWs + 1024;
    for (int i = C.tid; i < 1024; i += 512) { LWs[i] = C.in[I_LNX_W][(size_t)l * D + i]; LBs[i] = C.in[I_LNX_B][(size_t)l * D + i]; }
    __syncthreads();
    const int lane = C.lane, lr = lane & 31, lh = lane >> 5;
    for (int task = C.gw; task < 8192; task += C.ngw) { const int unit = task >> 1, sub = task & 1; const int bh = unit / NCHK, ck = unit % NCHK, bl = bh >> 4, h = bh & 15;
        const size_t ml = (size_t)bl * T + ck * CHK + sub * 32 + lr;
        const bf16* srow = sst + (size_t)unit * 4096; const bf16* zrow = zz + ml * D + h * 64; const bf16* ylr = yl + ml * D + h * 64;
        bf16x8 ob[4], oa0[4], oa1[4]; u32x2 yq[8], vq[8], gq[8];
#pragma unroll
        for (int ks = 0; ks < 4; ++ks) { const int m0 = ks * 16 + lh * 8; ob[ks] = *(const bf16x8*)(zrow + m0); oa0[ks] = *(const bf16x8*)(srow + (size_t)lr * 64 + m0); oa1[ks] = *(const bf16x8*)(srow + (size_t)(32 + lr) * 64 + m0); }
#pragma unroll
        for (int q = 0; q < 8; ++q) { const int i0 = (q >> 2) * 32 + 8 * (q & 3) + 4 * lh; yq[q] = *(const u32x2*)(ylr + i0); vq[q] = *(const u32x2*)(vp + ml * D + h * 64 + i0); gq[q] = *(const u32x2*)(gg + ml * D + h * 64 + i0); }
        const float bn = bonus[ml * 16 + h];
        f32x16 d0 = zero16(), d1 = zero16();
#pragma unroll
        for (int ks = 0; ks < 4; ++ks) { d0 = __builtin_amdgcn_mfma_f32_32x32x16_bf16(oa0[ks], ob[ks], d0, 0, 0, 0); d1 = __builtin_amdgcn_mfma_f32_32x32x16_bf16(oa1[ks], ob[ks], d1, 0, 0, 0); }
        float y[32]; float s = 0.f;
#pragma unroll
        for (int itl = 0; itl < 2; ++itl)
#pragma unroll
            for (int rq = 0; rq < 4; ++rq) { const u32x2 q = yq[itl * 4 + rq];
                const float dd0 = itl ? d1[4 * rq] : d0[4 * rq], dd1 = itl ? d1[4 * rq + 1] : d0[4 * rq + 1], dd2 = itl ? d1[4 * rq + 2] : d0[4 * rq + 2], dd3 = itl ? d1[4 * rq + 3] : d0[4 * rq + 3];
                float* yy = y + itl * 16 + rq * 4; yy[0] = bflo(q.x) + dd0; yy[1] = bfhi(q.x) + dd1; yy[2] = bflo(q.y) + dd2; yy[3] = bfhi(q.y) + dd3; s += (yy[0] + yy[1]) + (yy[2] + yy[3]); }
        s += __shfl_xor(s, 32); const float mean = s * (1.f / 64.f); float s2 = 0.f;
#pragma unroll
        for (int e = 0; e < 32; ++e) { const float dlt = y[e] - mean; s2 += dlt * dlt; }
        s2 += __shfl_xor(s2, 32); const float rstd = __builtin_amdgcn_rsqf(s2 * (1.f / 64.f) + 64e-5f);
#pragma unroll
        for (int itl = 0; itl < 2; ++itl)
#pragma unroll
            for (int rq = 0; rq < 4; ++rq) { const int i0 = itl * 32 + 8 * rq + 4 * lh; const int cc = h * 64 + i0; const float* yy = y + itl * 16 + rq * 4;
                const f32x4 w4 = *(const LAS f32x4*)(LWs + cc), b4 = *(const LAS f32x4*)(LBs + cc); const u32x2 vv = vq[itl * 4 + rq], gv = gq[itl * 4 + rq];
                const float o0 = ((yy[0] - mean) * rstd * w4.x + b4.x + bn * bflo(vv.x)) * bflo(gv.x), o1 = ((yy[1] - mean) * rstd * w4.y + b4.y + bn * bfhi(vv.x)) * bfhi(gv.x);
                const float o2 = ((yy[2] - mean) * rstd * w4.z + b4.z + bn * bflo(vv.y)) * bflo(gv.y), o3 = ((yy[3] - mean) * rstd * w4.w + b4.w + bn * bfhi(vv.y)) * bfhi(gv.y);
                *(u32x2*)(ya + ml * D + cc) = (u32x2){cvt_pk_bf16(o0, o1), cvt_pk_bf16(o2, o3)}; }
    }
}

__device__ __forceinline__ void phase_route(const Ctx& C0, int it) {
    const Ctx C = launder(C0);
    const int l = it / NCH, c = it % NCH; const float* xs = C.out + (size_t)c * M * D; const float* g = C.in[I_NORM_FFN] + (size_t)l * D; bf16* hn = (bf16*)(C.ws + WS_HN);
    const float* rgb = C.in[I_RGRP_B] + (size_t)l * 4; const float* reb = C.in[I_REXP_B] + (size_t)l * 32;
    unsigned* cnt = (unsigned*)(C.ws + WS_CTL) + CW_CNT + it * 64; int* tok = (int*)(C.ws + WS_TOK); float* wt = (float*)(C.ws + WS_TOK + 512 * 1024);
    const bf16* wrh = (const bf16*)(C.ws + WS_WSC + 512 * 1024); const bf16* wrl = (const bf16*)(C.ws + WS_WSC + 640 * 1024);
    const int lane = C.lane, fr = lane & 15, fq = lane >> 4;
    for (int rep15 = 0; rep15 < 1 + ((DUP_MASK >> 15) & 1); ++rep15)
    norm2_rows_i8(xs, g, (unsigned char*)hn, (float*)(C.ws + WS_HN + HNX_RS), C.gw, C.ngw, lane);
    LAS float* LG = (LAS float*)(C.lds + C.wave * 4096);
    LAS float* PX = (LAS float*)(C.lds + 32768) + (C.wave >> 1) * (64 * 13);
    const int half = C.wave & 1;
    for (int tbase = C.bid * 4; tbase < M / 16; tbase += C.G * 4) { const int task = tbase + (C.wave >> 1); const int ml = task * 16 + fr; const float* xr = xs + (size_t)ml * D + fq * 8;
        f32x4 acc[3]; acc[0] = acc[1] = acc[2] = (f32x4){0.f, 0.f, 0.f, 0.f}; float ss = 0.f;
#pragma unroll 4
        for (int ks = half * 16; ks < half * 16 + 16; ++ks) { const f32x4 xa = *(const f32x4*)(xr + ks * 32), xb = *(const f32x4*)(xr + ks * 32 + 4);
            ss += (xa.x * xa.x + xa.y * xa.y) + (xa.z * xa.z + xa.w * xa.w) + (xb.x * xb.x + xb.y * xb.y) + (xb.z * xb.z + xb.w * xb.w);
            u32x4 hq; hq.x = cvt_pk_bf16(xa.x, xa.y); hq.y = cvt_pk_bf16(xa.z, xa.w); hq.z = cvt_pk_bf16(xb.x, xb.y); hq.w = cvt_pk_bf16(xb.z, xb.w);
            u32x4 lq; lq.x = cvt_pk_bf16(xa.x - bflo(hq.x), xa.y - bfhi(hq.x)); lq.y = cvt_pk_bf16(xa.z - bflo(hq.y), xa.w - bfhi(hq.y));
            lq.z = cvt_pk_bf16(xb.x - bflo(hq.z), xb.y - bfhi(hq.z)); lq.w = cvt_pk_bf16(xb.z - bflo(hq.w), xb.w - bfhi(hq.w));
            const bf16x8 xh = __builtin_bit_cast(bf16x8, hq), xl = __builtin_bit_cast(bf16x8, lq);
#pragma unroll
            for (int nt = 0; nt < 3; ++nt) { const size_t wo = (size_t)(nt * 16 + fr) * D + ks * 32 + fq * 8;
                const bf16x8 wh = *(const bf16x8*)(wrh + wo), wl = *(const bf16x8*)(wrl + wo);
                acc[nt] = __builtin_amdgcn_mfma_f32_16x16x32_bf16(wh, xh, acc[nt], 0, 0, 0);
                acc[nt] = __builtin_amdgcn_mfma_f32_16x16x32_bf16(wl, xh, acc[nt], 0, 0, 0);
                acc[nt] = __builtin_amdgcn_mfma_f32_16x16x32_bf16(wh, xl, acc[nt], 0, 0, 0); } }
        if (half) {
#pragma unroll
            for (int nt = 0; nt < 3; ++nt)
#pragma unroll
                for (int i = 0; i < 4; ++i) PX[lane * 13 + nt * 4 + i] = acc[nt][i];
            PX[lane * 13 + 12] = ss; }
        __syncthreads();
        if (!half) {
#pragma unroll
            for (int nt = 0; nt < 3; ++nt)
#pragma unroll
                for (int i = 0; i < 4; ++i) acc[nt][i] += PX[lane * 13 + nt * 4 + i];
            ss += PX[lane * 13 + 12]; }
        ss += __shfl_xor(ss, 16); ss += __shfl_xor(ss, 32); const float rs = __builtin_amdgcn_rsqf(ss * (1.f / D) + 1e-6f);
#pragma unroll
        for (int nt = 0; nt < 3; ++nt)
#pragma unroll
            for (int i = 0; i < 4; ++i) LG[fr * 48 + nt * 16 + 4 * fq + i] = acc[nt][i] * rs;
        LDS_WAIT(); asm volatile("" ::: "memory");
        if (lane < 16 && !half) { const LAS float* lg = LG + lane * 48;
            float gl[4]; int gs = 0; float gm;
#pragma unroll
            for (int e = 0; e < 4; ++e) gl[e] = lg[e] + rgb[e];
            gm = gl[0];
#pragma unroll
            for (int e = 1; e < 4; ++e) if (gl[e] > gm) { gm = gl[e]; gs = e; }
            float den = 0.f;
#pragma unroll
            for (int e = 0; e < 4; ++e) den += __expf(gl[e] - gm);
            const float pg = 1.f / den;
            float el[8];
#pragma unroll
            for (int e = 0; e < 8; ++e) el[e] = lg[4 + gs * 8 + e] + reb[gs * 8 + e];
            int i1 = 0; float v1 = el[0];
#pragma unroll
            for (int e = 1; e < 8; ++e) if (el[e] > v1) { v1 = el[e]; i1 = e; }
            int i2 = -1; float v2 = -3.0e38f;
#pragma unroll
            for (int e = 0; e < 8; ++e) if (e != i1 && el[e] > v2) { v2 = el[e]; i2 = e; }
            const float ex = __expf(v2 - v1); const float w1 = pg / (1.f + ex), w2 = pg * ex / (1.f + ex);
            const int e1 = gs * 8 + i1, e2 = gs * 8 + i2;
            const unsigned s1 = atomicAdd(cnt + e1, 1u), s2 = atomicAdd(cnt + e2, 1u);
            const int mt = task * 16 + lane;
            tok[4 * mt] = e1; tok[4 * mt + 1] = (int)s1; tok[4 * mt + 2] = e2; tok[4 * mt + 3] = (int)s2; wt[2 * mt] = w1; wt[2 * mt + 1] = w2;
            int* rowmap = (int*)(C.ws + WS_R1 + R1_ROWMAP); rowmap[e1 * 16384 + (int)s1] = mt; rowmap[e2 * 16384 + (int)s2] = mt;
        }
        __syncthreads();
    }
}
__device__ __forceinline__ void moe_table(const Ctx& C, int it, LAS int* tb) {
    __syncthreads();
    int tl_ = C.tid; asm volatile("" : "+v"(tl_));
    if (C.tid < 64) { const unsigned* cnt = (const unsigned*)(C.ws + WS_CTL) + CW_CNT + it * 64;
        const unsigned cv = (C.tid < 32) ? __hip_atomic_load(cnt + tl_, __ATOMIC_RELAXED, __HIP_MEMORY_SCOPE_AGENT) : 0u; const int tiles = (int)((cv + 255u) >> 8); int x = tiles;
#pragma unroll
        for (int o = 1; o < 32; o <<= 1) { const int y = __shfl_up(x, o); if (C.lane >= o) x += y; }
        if (C.tid < 32) { tb[tl_] = x - tiles; tb[40 + tl_] = (int)cv; } if (C.tid == 31) tb[32] = x; }
    __syncthreads();
}
constexpr int NPH = 14;
__global__ void __launch_bounds__(512, 2) mk_fwd(Args args) {
    extern __shared__ __attribute__((aligned(16))) unsigned char lds_raw[];
    Ctx C; C.lds = (LAS unsigned char*)lds_raw; C.ws = args.ws; C.in = args.in; C.out = args.out;
    C.tid = threadIdx.x; C.lane = C.tid & 63; C.wave = __builtin_amdgcn_readfirstlane(C.tid >> 6); C.G = gridDim.x; C.bid = blockIdx.x; C.gw = C.bid * 8 + C.wave; C.ngw = C.G * 8;
    volatile LAS unsigned* MISC = (volatile LAS unsigned*)(C.lds + LDSCTL_OFF);
    LAS int* tb = (LAS int*)(C.lds + LDSCTL_OFF + 256);
    for (int u = C.tid; u < 64; u += 512) MISC[u] = 0u;
    __syncthreads();
    XcdBarrier bar; bar.bar = (unsigned*)(C.ws + WS_CTL) + CW_BAR; bar.x = 0; bar.st = nullptr;
#if MK_ONE_LAUNCH
    bar = xcd_barrier_post((unsigned*)(C.ws + WS_CTL) + CW_BAR, MISC + 8);
#define GRID_BAR() xcd_barrier(bar)
#else
#define GRID_BAR() do {} while (0)
#endif
    const int s_lo = args.s_lo, s_hi = args.s_hi;
    if (s_lo == 0) { phase_wmax(C); GRID_BAR(); }
#pragma unroll 1
    for (int it = 0; it <= NIT; ++it) {
        const int l = it / NCH, c = it % NCH; const int sb = it * NPH;
#define IN(k) (((PH_MASK >> (k)) & 1) && s_lo <= sb + (k) && sb + (k) < s_hi)
        if (IN(0)) for (int rep_ = 0; rep_ < 1 + ((DUP_MASK >> 0) & 1); ++rep_) { unsigned char* ws = C.ws; asm volatile("" : "+s"(ws)); if (it < NIT && c == 0) phase_convert(C, l, it == 0); phase_prep(C, it, tb); GRID_BAR(); }
        if (it == NIT) break;
        if (IN(1)) for (int rep_ = 0; rep_ < 1 + ((DUP_MASK >> 1) & 1); ++rep_) { unsigned char* ws = C.ws; asm volatile("" : "+s"(ws)); pg8::Gemm g{(const bf16*)(ws + WS_R1 + R1_HNX), (const bf16*)(ws + WS_WIN), D / 2, D / 2, D / 2, 0, nullptr, nullptr};   pg8::StaticOrder S; S.init(M, DBG_PROJ_N, C.G, C.bid);
            pg8::EpiProj E{(bf16*)(ws + WS_R2 + R2_ZA), (bf16*)(ws + WS_R1 + R1_ZB), (bf16*)(ws + WS_R1 + R1_ZC), (bf16*)(ws + WS_ZG), (bf16*)(ws + WS_VLO), C.in[I_GATE_B] + (size_t)l * G_COLS, (const float*)(ws + WS_R1 + R1_HNX + HNX_RS), (const unsigned*)(ws + WS_CTL) + CW_WMAX + l * WIN_ROWS};
            pg8::gemm_phase<pg8::EpiProj, pg8::StaticOrder, false, true>(C.lds, g, S, E); GRID_BAR(); }
        if (IN(2)) for (int rep_ = 0; rep_ < 1 + ((DUP_MASK >> 2) & 1); ++rep_) { unsigned char* ws = C.ws; asm volatile("" : "+s"(ws)); sub_gmlp(C, l); sub_attn(C); sub_lora_prep(C, l); GRID_BAR(); }
        if (IN(3)) for (int rep_ = 0; rep_ < 1 + ((DUP_MASK >> 3) & 1); ++rep_) { unsigned char* ws = C.ws; asm volatile("" : "+s"(ws)); pg8::Gemm g{(const bf16*)(ws + WS_R1 + R1_ALORA), (const bf16*)(ws + WS_LORAB), LORA_K, LORA_K, (l == 0 ? 256 : LORA_K), 0, nullptr, nullptr};   pg8::StaticOrder S; S.init(M, l == 0 ? 3072 : 4096, C.G, C.bid);
            pg8::EpiLora EL{(bf16*)(ws + WS_R4 + R4_WPRE), (bf16*)(ws + WS_R4 + R4_APRE), (bf16*)(ws + WS_R4 + R4_G), (bf16*)(ws + WS_R4 + R4_VPRE)};
            pg8::gemm_phase(C.lds, g, S, EL); sub_yb_combine(C); GRID_BAR(); }
        if (IN(4)) for (int rep_ = 0; rep_ < 1 + ((DUP_MASK >> 4) & 1); ++rep_) { unsigned char* ws = C.ws; asm volatile("" : "+s"(ws)); }
        if (IN(5)) for (int rep_ = 0; rep_ < 1 + ((DUP_MASK >> 5) & 1); ++rep_) { unsigned char* ws = C.ws; asm volatile("" : "+s"(ws)); phase_chunkpre(C, l, c); GRID_BAR(); }
        if (IN(6)) for (int rep_ = 0; rep_ < 1 + ((DUP_MASK >> 6) & 1); ++rep_) { unsigned char* ws = C.ws; asm volatile("" : "+s"(ws)); phase_carry2(C); GRID_BAR(); }
        if (IN(7)) for (int rep_ = 0; rep_ < 1 + ((DUP_MASK >> 7) & 1); ++rep_) { unsigned char* ws = C.ws; asm volatile("" : "+s"(ws)); phase_post2(C, l); GRID_BAR(); }
        if (IN(8)) for (int rep_ = 0; rep_ < 1 + ((DUP_MASK >> 8) & 1); ++rep_) { unsigned char* ws = C.ws; asm volatile("" : "+s"(ws)); pg8::StaticOrder S; S.init(M, D, C.G, C.bid);
            pg8::Gemm ga{(const bf16*)(ws + WS_HN), (const bf16*)(ws + WS_PA), D, D, D, 0, nullptr, nullptr}; pg8::Gemm gb{(const bf16*)(ws + WS_YB), (const bf16*)(ws + WS_PB), 256, 256, 256, 0, nullptr, nullptr};
            pg8::Gemm gc{(const bf16*)(ws + WS_YC), (const bf16*)(ws + WS_PC), D, D, D, 0, nullptr, nullptr};
            pg8::EpiChainGate E{(const unsigned char*)(ws + WS_ZG), (bf16*)(ws + WS_R4 + R4_MERGED)}; pg8::gemm_chain3(C.lds, ga, gb, gc, S, E); GRID_BAR(); }
        if (IN(9)) for (int rep_ = 0; rep_ < 1 + ((DUP_MASK >> 9) & 1); ++rep_) { unsigned char* ws = C.ws; asm volatile("" : "+s"(ws));
#ifdef DBG_WOUT_ZG
            pg8::Gemm g{(const bf16*)(ws + WS_ZG), (const bf16*)(ws + WS_WOUT), G_COLS, D, D, 0, nullptr, nullptr};
#else
            pg8::Gemm g{(const bf16*)(ws + WS_R4 + R4_MERGED), (const bf16*)(ws + WS_WOUT), D, D, D, 0, nullptr, nullptr};
#endif
            pg8::StaticOrder S; S.init(M, D, C.G, C.bid);
            pg8::EpiResid E{(l == 0 ? C.in[I_X] : C.out) + (size_t)c * M * D, C.out + (size_t)c * M * D}; pg8::gemm_phase(C.lds, g, S, E); GRID_BAR(); }
        if (IN(10)) for (int rep_ = 0; rep_ < 1 + ((DUP_MASK >> 10) & 1); ++rep_) { unsigned char* ws = C.ws; asm volatile("" : "+s"(ws)); phase_route(C, it); GRID_BAR(); }
        if (IN(11)) for (int rep_ = 0; rep_ < 1 + ((DUP_MASK >> 11) & 1); ++rep_) { unsigned char* ws = C.ws; asm volatile("" : "+s"(ws)); }
        if (IN(12)) for (int rep_ = 0; rep_ < 1 + ((DUP_MASK >> 12) & 1); ++rep_) { unsigned char* ws = C.ws; asm volatile("" : "+s"(ws)); moe_table(C, it, tb); pg8::Gemm g{(const bf16*)(ws + WS_HN), (const bf16*)(ws + WS_W13), D / 2, D / 2, D / 2, (size_t)D * D / 2, (const int*)(ws + WS_R1 + R1_ROWMAP), tb};   pg8::MoeOrder S{tb, 4, C.G, C.bid};
            pg8::EpiSwiglu E{(bf16*)(ws + WS_R1 + R1_HID), (const float*)(ws + WS_HN + HNX_RS), (const int*)(ws + WS_R1 + R1_ROWMAP), tb, (const unsigned*)(ws + WS_CTL) + CW_WMAX13 + l * NEXP * 1024}; pg8::gemm_phase<pg8::EpiSwiglu, pg8::MoeOrder, true, true>(C.lds, g, S, E);
            if (it + 1 < NIT) {
                const int U = tb[32] * 4, rem = U % C.G; const int first = rem, nlow = C.G - rem;
                if (C.bid >= first) { const Ctx Cn = launder(C); mixer_norm(Cn, it + 1, (C.bid - first) * 8 + Cn.wave, nlow * 8); } }
            GRID_BAR(); }
        if (IN(13)) for (int rep_ = 0; rep_ < 1 + ((DUP_MASK >> 13) & 1); ++rep_) { unsigned char* ws = C.ws; asm volatile("" : "+s"(ws)); moe_table(C, it, tb); pg8::Gemm g{(const bf16*)(ws + WS_R1 + R1_HID), (const bf16*)(ws + WS_W2), EFF, EFF, EFF, (size_t)D * EFF, nullptr, nullptr}; pg8::MoeOrder S{tb, 4, C.G, C.bid};
            pg8::EpiBf16 E{(bf16*)(ws + WS_R1 + R1_YEXP), D, 0, 0}; pg8::gemm_phase(C.lds, g, S, E); GRID_BAR(); }
#undef IN
    }
}

extern "C" void kernel_launch(void* const* d_in, const int* in_sizes, int n_in, void* d_out, int out_size, void* d_ws, size_t ws_size, hipStream_t stream) {
    static int grid = 0;
    if (grid == 0) {
        if (n_in != 36 || out_size != NBATCH * T * D || ws_size < WS_END) { fprintf(stderr, "kernel_launch: unexpected shapes (n_in %d out %d ws %zu)\n", n_in, out_size, ws_size); grid = -1; return; }
        int dev = 0, cus = 0;
        if (hipGetDevice(&dev) != hipSuccess || hipDeviceGetAttribute(&cus, hipDeviceAttributeMultiprocessorCount, dev) != hipSuccess) { grid = -1; return; }
        if (hipFuncSetAttribute((const void*)mk_fwd, hipFuncAttributeMaxDynamicSharedMemorySize, LDS_BYTES) != hipSuccess) { grid = -1; return; }
        int per_cu = 0;
        if (hipOccupancyMaxActiveBlocksPerMultiprocessor(&per_cu, (const void*)mk_fwd, 512, LDS_BYTES) != hipSuccess || per_cu < 1) fprintf(stderr, "kernel_launch: occupancy query says %d\n", per_cu);
        (void)hipGetLastError();
        grid = cus;
    }
    if (grid < 0) return;
    (void)hipMemsetAsync((char*)d_ws + WS_CTL, 0, CTL_ZERO_BYTES, stream);
    Args a{};
    for (int i = 0; i < 36; ++i) a.in[i] = (const float*)d_in[i];
    a.out = (float*)d_out; a.ws = (unsigned char*)d_ws;
    const int total = NIT * NPH + 1;
#if MK_ONE_LAUNCH
    a.s_lo = 0; a.s_hi = total;
    hipLaunchKernelGGL(mk_fwd, dim3(grid), dim3(512), LDS_BYTES, stream, a);
#else
    for (int s = 0; s < total; ++s) { a.s_lo = s; a.s_hi = s + 1; hipLaunchKernelGGL(mk_fwd, dim3(grid), dim3(512), LDS_BYTES, stream, a); }
#endif
}
```

```cpp
#include <hip/hip_runtime.h>
#include <cstdint>
#include <cstdio>

#define DBG_PROJ_N (l == 0 ? IN_COLS : WIN_ROWS)
#ifndef DUP_MASK
#define DUP_MASK 0
#endif
#ifndef PH_MASK
#define PH_MASK 0xFFFF
#endif
#ifndef MK_ONE_LAUNCH
#define MK_ONE_LAUNCH 1
#endif

#define LAS __attribute__((address_space(3)))
#define GAS __attribute__((address_space(1)))
#define AS_GLOBAL(T, p) ({ GAS T* g_ = (GAS T*)(p); asm("" : "+s"(g_)); (T*)g_; })
typedef unsigned short bf16;
typedef unsigned u32;
typedef short bf16x8 __attribute__((ext_vector_type(8)));
typedef float f32x4 __attribute__((ext_vector_type(4)));
typedef float f32x2 __attribute__((ext_vector_type(2)));
typedef float f32x16 __attribute__((ext_vector_type(16)));
typedef unsigned u32x4 __attribute__((ext_vector_type(4)));
typedef unsigned u32x2 __attribute__((ext_vector_type(2)));
typedef int i32x4 __attribute__((ext_vector_type(4)));

constexpr int NBATCH = 8, T = 8192, D = 1024, NLAYER = 2;
constexpr int M = 2 * T;
constexpr int NCH = 4;
constexpr int NIT = NLAYER * NCH;
constexpr int A_COLS = 3328, B_COLS = 2304, C_COLS = 2048, G_COLS = 3072, IN_COLS = 10752;
constexpr int WIN_ROWS = 11008;
constexpr int LORA_K = 384, LORA_N = 4096;
constexpr int NEXP = 32, EFF = 512;
constexpr int SEGL = 256, NSEG = T / SEGL;
constexpr int MOE_MAXROWS = 40960;

constexpr size_t MiB = 1u << 20;
constexpr size_t WS_CTL = 0, CTL_ZERO_BYTES = 1 * MiB;
constexpr size_t WS_ROPE = 1 * MiB;
constexpr size_t WS_WSC = 3 * MiB;
constexpr size_t WS_WIN = 4 * MiB;
constexpr size_t WS_LORAB = 26 * MiB;
constexpr size_t WS_PA = 29 * MiB, WS_PB = 31 * MiB, WS_PC = 32 * MiB, WS_WOUT = 34 * MiB;
constexpr size_t WS_W13 = 36 * MiB;
constexpr size_t WS_W2 = 100 * MiB;
constexpr size_t WS_VFIRST = 132 * MiB;
constexpr size_t WS_HN = 260 * MiB;
constexpr size_t WS_VP = 292 * MiB;
constexpr size_t WS_YB = 324 * MiB;
constexpr size_t WS_YC = 332 * MiB;
constexpr size_t WS_VLO = 364 * MiB;
constexpr size_t WS_BONUS = 365 * MiB;
constexpr size_t WS_TOK = 366 * MiB;
constexpr size_t WS_LSE = 367 * MiB;
constexpr size_t WS_ZG = 368 * MiB;
constexpr size_t WS_R4 = 464 * MiB;
constexpr size_t WS_R2 = 592 * MiB;
constexpr size_t WS_R1 = 696 * MiB;
constexpr size_t WS_END = 1016 * MiB;
constexpr size_t R4_G = 0, R4_WPRE = 32 * MiB, R4_APRE = 64 * MiB, R4_VPRE = 96 * MiB;
constexpr size_t R4_SEGS = 32 * MiB, R4_SEGP = 64 * MiB;
constexpr size_t R4_MTMP = 0, R4_MERGED = 64 * MiB;
constexpr size_t R2_ZA = 0;
constexpr size_t R2_YLOC = 0, R2_Z = 32 * MiB, R2_SSTART = 64 * MiB;
constexpr size_t R1_ZB = 0, R1_ZC = 72 * MiB, R1_ALORA = 136 * MiB, R1_OG = 148 * MiB;
constexpr size_t R1_SCANIN = 0;
constexpr size_t R1_XG = 0, R1_HID = 80 * MiB, R1_YEXP = 120 * MiB, R1_ROWMAP = 300 * MiB, R1_HNX = 256 * MiB;
constexpr size_t R1_LW = 0, R1_AA = 64 * MiB, R1_BB = 96 * MiB, R1_KK = 128 * MiB, R1_RR = 160 * MiB;
constexpr size_t R1_MT = 192 * MiB, R1_NC = 224 * MiB;
constexpr size_t R1_YLOC = 0, R1_Q = 32 * MiB, R1_SST = 64 * MiB;
constexpr int CHK = 64, NCHK = T / CHK;
constexpr int CW_BAR = 4096;
constexpr int CW_CNT = 16384;
constexpr int CW_WMAX = 32768;
constexpr int CW_WMAX13 = 65536;
constexpr size_t HNX_RS = 16 * MiB;

constexpr int RING_BYTES = 131072;
constexpr int LDSCTL_OFF = RING_BYTES;
constexpr int LDS_BYTES = 147456;

__device__ __forceinline__ float bf2f(u32 v) { return __uint_as_float(v << 16); }
__device__ __forceinline__ float bflo(u32 v) { return __uint_as_float(v << 16); }
__device__ __forceinline__ float bfhi(u32 v) { return __uint_as_float(v & 0xffff0000u); }
typedef __bf16 bf16x2_t __attribute__((ext_vector_type(2)));
__device__ __forceinline__ u32 cvt_pk_bf16(float lo, float hi) { f32x2 v = {lo, hi}; bf16x2_t b = __builtin_convertvector(v, bf16x2_t); return __builtin_bit_cast(u32, b); }
__device__ __forceinline__ u32 f2bf(float f) { return cvt_pk_bf16(f, 0.f) & 0xffffu; }
__device__ __forceinline__ float wave_sum(float v) {
#pragma unroll
    for (int o = 1; o < 64; o <<= 1) v += __shfl_xor(v, o);
    return v;
}
__device__ __forceinline__ float sigmoidf_(float x) { return __builtin_amdgcn_rcpf(1.0f + __expf(-x)); }
#define LDS_WAIT() asm volatile("s_waitcnt lgkmcnt(0)" ::: "memory")
typedef short v4i16_t __attribute__((ext_vector_type(4)));
__device__ __forceinline__ u32x2 lds_tr16(const LAS bf16* p) { return __builtin_bit_cast(u32x2, __builtin_amdgcn_ds_read_tr16_b64_v4i16((LAS v4i16_t*)p)); }

namespace pg8 {
#define PG8_LAS __attribute__((address_space(3)))
constexpr int BM = 256, BK = 64, HALF = 128, HTB = HALF * BK * 2, STAGE_BYTES = 8 * HTB, NXCD = 8, WGM = 2;
__host__ __device__ __forceinline__ int lds_byte(int r, int c) { const int st = (r >> 4) * 2 + (c >> 5), rr = r & 15, cc = c & 31, ob = rr * 64 + cc * 2; return st * 1024 + (ob ^ (((ob >> 9) & 1) << 5)); }
__host__ __device__ __forceinline__ void stage_rc(int b, int& R, int& C) { const int st = b / 1024, sb = b % 1024, swz = sb ^ (((sb >> 9) & 1) << 5); R = (st >> 1) * 16 + swz / 64; C = (st & 1) * 32 + (swz % 64) / 2; }
__host__ __device__ __forceinline__ int perm32(int rho) { const int n = rho >> 4, i = rho & 15; return 8 * (i >> 2) + 4 * n + (i & 3); }

struct Unit { int pm, pn, e; };
struct Gemm { const bf16* A; const bf16* Bt; int lda, ldb, K; size_t b_estride; const int* rowmap; const LAS int* tb; };

struct StaticOrder {
    int nM, nN, nwg, G, c;
    __device__ void init(int Mr, int N, int G_, int c_) { nM = Mr / BM; nN = N / BM; nwg = nM * nN; G = G_; c = c_; }
    __device__ bool next(int i, Unit& u) const {
        const long L = (long)i * G + c; if (L >= nwg) return false;
        int wgid = (int)L; { const int q = nwg / NXCD, r = nwg % NXCD, xcd = wgid % NXCD, off = wgid / NXCD; wgid = (xcd < r ? xcd * (q + 1) : r * (q + 1) + (xcd - r) * q) + off; }
        const int nig = WGM * nN, gid = wgid / nig, fm = gid * WGM, gsz = (nM - fm) < WGM ? (nM - fm) : WGM;
        u.pm = fm + ((wgid % nig) % gsz); u.pn = (wgid % nig) / gsz; u.e = 0; return true;
    }
};
struct MoeOrder {
    const LAS int* tb; int nN, G, c;
    __device__ bool next(int i, Unit& u) const {
        const int L = i * G + c; const int total = tb[32] * nN; if (L >= total) return false;
        const int q = total / NXCD, r = total % NXCD, xcd = L % NXCD, off = L / NXCD; const int wg = (xcd < r ? xcd * (q + 1) : r * (q + 1) + (xcd - r) * q) + off;
        const int rt = wg / nN; u.pn = wg % nN; u.pm = rt; int e = 0;
#pragma unroll 1
        for (int k = 1; k < 32; ++k) e += (rt >= tb[k]) ? 1 : 0;
        u.e = e; return true;
    }
};

template <bool I8> struct AccSel { typedef f32x4 t; };
template <> struct AccSel<true> { typedef i32x4 t; };
template <class Epi, class Sched, bool GATHER = false, bool I8 = false>
__device__ __forceinline__ void gemm_phase(PG8_LAS unsigned char* lds, const Gemm g, const Sched& S, const Epi& E) {
    int tid_ = threadIdx.x; asm volatile("" : "+v"(tid_));
    const int tid = tid_, wid = __builtin_amdgcn_readfirstlane(tid >> 6), lane = tid & 63, wr = wid >> 2, wc = wid & 3, fr = lane & 15, fq = lane >> 4;
    const int K = g.K, nt = K / BK;
    unsigned voffA[2], voffB[2];
#pragma unroll
    for (int i = 0; i < 2; ++i) { int R, C; stage_rc(tid * 16 + i * 8192, R, C); const int Rb = (R & ~31) + perm32(R & 31);
        voffA[i] = (unsigned)(R * g.lda + C) * 2u; voffB[i] = (unsigned)(Rb * g.ldb + C) * 2u; }
#define PG8_GOFFS(u_, go_) do { if constexpr (GATHER) { const int e_ = (u_).e; const int ti_ = (u_).pm - g.tb[e_]; const int cn_ = g.tb[40 + e_]; \
        _Pragma("unroll") for (int h_ = 0; h_ < 2; ++h_) _Pragma("unroll") for (int i_ = 0; i_ < 2; ++i_) { int R_, C_; stage_rc(tid * 16 + i_ * 8192, R_, C_); const int sl_ = ti_ * 256 + h_ * 128 + R_; \
            const int tr_ = (sl_ < cn_) ? g.rowmap[e_ * 16384 + sl_] : 0; go_[h_][i_] = (unsigned)(tr_ * g.lda + C_) * 2u; } } } while (0)
    unsigned goC[2][2] = {{0u, 0u}, {0u, 0u}}, goN[2][2] = {{0u, 0u}, {0u, 0u}};
    const size_t kstep = (size_t)(BK * 2);
    const size_t hA = GATHER ? 0 : (size_t)HALF * g.lda * 2, hB = (size_t)HALF * g.ldb * 2;
    const size_t tA = 2 * hA, tB = 2 * hB;
    const unsigned ldsw = (unsigned)wid * 1024u;
    const int aoff = lds_byte(wr * 64 + fr, fq * 8), boff = lds_byte(wc * 32 + fr, fq * 8);
#define PG8_SA(b, h) (((b) * 2 + (h)) * HTB)
#define PG8_SB(b, h) ((4 + (b) * 2 + (h)) * HTB)
#define PG8_STAGE(bufoff, gbase, voff) do { _Pragma("unroll") for (int _i = 0; _i < 2; ++_i) \
        __builtin_amdgcn_global_load_lds((const unsigned*)((const char*)(gbase) + (voff)[_i]), (PG8_LAS unsigned*)(lds + (bufoff) + ldsw + _i * 8192), 16, 0, 0); } while (0)
#define PG8_LDA(dst, b, h) do { _Pragma("unroll") for (int m = 0; m < 4; ++m) _Pragma("unroll") for (int k = 0; k < 2; ++k) dst[m][k] = *(const PG8_LAS bf16x8*)(lds + PG8_SA(b, h) + aoff + m * 2048 + k * 1024); } while (0)
#define PG8_LDB(dst, b, h) do { _Pragma("unroll") for (int n = 0; n < 2; ++n) _Pragma("unroll") for (int k = 0; k < 2; ++k) dst[n][k] = *(const PG8_LAS bf16x8*)(lds + PG8_SB(b, h) + boff + n * 2048 + k * 1024); } while (0)
#define PG8_MMA(ai, bj, At, Bt) do { __builtin_amdgcn_s_setprio(1); _Pragma("unroll") for (int m = 0; m < 4; ++m) _Pragma("unroll") for (int n = 0; n < 2; ++n) _Pragma("unroll") for (int k = 0; k < 2; ++k) { \
        if constexpr (I8) acc[ai][bj][m][n] = __builtin_amdgcn_mfma_i32_16x16x64_i8(__builtin_bit_cast(i32x4, Bt[n][k]), __builtin_bit_cast(i32x4, At[m][k]), acc[ai][bj][m][n], 0, 0, 0); \
        else acc[ai][bj][m][n] = __builtin_amdgcn_mfma_f32_16x16x32_bf16(Bt[n][k], At[m][k], acc[ai][bj][m][n], 0, 0, 0); } __builtin_amdgcn_s_setprio(0); } while (0)
#define PG8_WAIT_V(n) asm volatile("s_waitcnt vmcnt(" #n ")" ::: "memory")
#define PG8_WAIT_L(n) asm volatile("s_waitcnt lgkmcnt(" #n ")" ::: "memory")
#define PG8_BAR __builtin_amdgcn_s_barrier()
#define PG8_SCHED __builtin_amdgcn_sched_barrier(0)
    Unit cur, nxt; int ui = 0;
    if (!S.next(0, cur)) return;
    typedef typename AccSel<I8>::t acc_t;
    acc_t acc[2][2][4][2];
#pragma unroll
    for (int a = 0; a < 2; ++a)
#pragma unroll
        for (int b = 0; b < 2; ++b)
#pragma unroll
            for (int m = 0; m < 4; ++m)
#pragma unroll
                for (int n = 0; n < 2; ++n) acc[a][b][m][n] = (acc_t){0, 0, 0, 0};
    bf16x8 At[4][2], B0[2][2], B1[2][2];
    const char* cA = (const char*)g.A + (GATHER ? 0 : (size_t)cur.pm * tA); const char* cB = (const char*)g.Bt + (size_t)cur.e * g.b_estride * 2 + (size_t)cur.pn * tB;
    PG8_GOFFS(cur, goC);
#define PG8_VA(cond_, h_) (GATHER ? ((cond_) ? goN[h_] : goC[h_]) : voffA)
    PG8_STAGE(PG8_SB(0, 0), cB, voffB); PG8_STAGE(PG8_SB(0, 1), cB + hB, voffB); PG8_STAGE(PG8_SA(0, 0), cA, PG8_VA(false, 0)); PG8_STAGE(PG8_SA(0, 1), cA + hA, PG8_VA(false, 1));
    if (wr == 1) PG8_BAR;
    PG8_WAIT_V(2); PG8_BAR;
    PG8_STAGE(PG8_SB(1, 0), cB + kstep, voffB); PG8_STAGE(PG8_SA(1, 0), cA + kstep, PG8_VA(false, 0)); PG8_STAGE(PG8_SB(1, 1), cB + hB + kstep, voffB);
    PG8_WAIT_V(6); PG8_BAR;
    for (;;) {
        const bool has_next = S.next(ui + 1, nxt);
        const char* nA = (has_next && !GATHER) ? (const char*)g.A + (size_t)nxt.pm * tA : cA;
        if (has_next) PG8_GOFFS(nxt, goN); else { goN[0][0] = goC[0][0]; goN[0][1] = goC[0][1]; goN[1][0] = goC[1][0]; goN[1][1] = goC[1][1]; }
        const char* nB = has_next ? (const char*)g.Bt + (size_t)nxt.e * g.b_estride * 2 + (size_t)nxt.pn * tB : cB;
#pragma unroll 1
        for (int t = 0; t < nt; t += 2) {
            const bool last = (t == nt - 2);
            const char* a1 = cA + (size_t)(t + 1) * kstep;
            const char* a2 = last ? nA : cA + (size_t)(t + 2) * kstep; const char* b2 = last ? nB : cB + (size_t)(t + 2) * kstep;
            const char* a3 = a2 + kstep; const char* b3 = b2 + kstep;
            PG8_LDB(B0, 0, 0); PG8_LDB(B1, 0, 1); PG8_SCHED; PG8_LDA(At, 0, 0); PG8_STAGE(PG8_SA(1, 1), a1 + hA, PG8_VA(false, 1));
            PG8_WAIT_V(8); PG8_WAIT_L(0); PG8_BAR; PG8_MMA(0, 0, At, B0); PG8_MMA(0, 1, At, B1); PG8_BAR; PG8_SCHED;
            PG8_LDA(At, 0, 1); PG8_STAGE(PG8_SB(0, 0), b2, voffB); PG8_STAGE(PG8_SB(0, 1), b2 + hB, voffB); PG8_STAGE(PG8_SA(0, 0), a2, PG8_VA(last, 0));
            PG8_WAIT_V(8); PG8_WAIT_L(0); PG8_BAR; PG8_MMA(1, 0, At, B0); PG8_MMA(1, 1, At, B1); PG8_BAR; PG8_SCHED;
            PG8_LDB(B0, 1, 0); PG8_LDB(B1, 1, 1); PG8_SCHED; PG8_LDA(At, 1, 0); PG8_STAGE(PG8_SA(0, 1), a2 + hA, PG8_VA(last, 1));
            PG8_WAIT_V(8); PG8_WAIT_L(0); PG8_BAR; PG8_MMA(0, 0, At, B0); PG8_MMA(0, 1, At, B1); PG8_BAR; PG8_SCHED;
            PG8_LDA(At, 1, 1); PG8_STAGE(PG8_SB(1, 0), b3, voffB); PG8_STAGE(PG8_SB(1, 1), b3 + hB, voffB); PG8_STAGE(PG8_SA(1, 0), a3, PG8_VA(last, 0));
            PG8_WAIT_V(8); PG8_WAIT_L(0); PG8_BAR; PG8_MMA(1, 0, At, B0); PG8_MMA(1, 1, At, B1); PG8_BAR; PG8_SCHED;
        }
        if (wr == 0) PG8_BAR;
        E(acc, cur, wr, wc, fr, fq);
        if (!has_next) break;
#pragma unroll
        for (int a = 0; a < 2; ++a)
#pragma unroll
            for (int b = 0; b < 2; ++b)
#pragma unroll
                for (int m = 0; m < 4; ++m)
#pragma unroll
                    for (int n = 0; n < 2; ++n) acc[a][b][m][n] = (acc_t){0, 0, 0, 0};
        cur = nxt; cA = nA; cB = nB; ++ui; goC[0][0] = goN[0][0]; goC[0][1] = goN[0][1]; goC[1][0] = goN[1][0]; goC[1][1] = goN[1][1];
        if (wr == 1) PG8_BAR;
    }
    PG8_WAIT_V(0);
    PG8_BAR;
#undef PG8_GOFFS
#undef PG8_VA
#undef PG8_SA
#undef PG8_SB
#undef PG8_STAGE
#undef PG8_LDA
#undef PG8_LDB
#undef PG8_MMA
#undef PG8_WAIT_V
#undef PG8_WAIT_L
#undef PG8_BAR
#undef PG8_SCHED
}

template <class Epi, class Sched>
__device__ __forceinline__ void gemm_chain3(PG8_LAS unsigned char* lds, const Gemm g0, const Gemm g1, const Gemm g2, const Sched& S, const Epi& E) {
    int tid_ = threadIdx.x; asm volatile("" : "+v"(tid_));
    const int tid = tid_, wid = __builtin_amdgcn_readfirstlane(tid >> 6), lane = tid & 63, wr = wid >> 2, wc = wid & 3, fr = lane & 15, fq = lane >> 4;
    int Rr[2], Cc[2], Rbb[2];
#pragma unroll
    for (int i = 0; i < 2; ++i) { int R, C; stage_rc(tid * 16 + i * 8192, R, C); Rr[i] = R; Cc[i] = C; Rbb[i] = (R & ~31) + perm32(R & 31); }
#define PG8_SEL(br_, f_) ((br_) == 0 ? g0.f_ : ((br_) == 1 ? g1.f_ : g2.f_))
#define PG8_VOFF(br_, va_, vb_) do { const int lda_ = PG8_SEL(br_, lda), ldb_ = PG8_SEL(br_, ldb); _Pragma("unroll") for (int i_ = 0; i_ < 2; ++i_) { \
        va_[i_] = (unsigned)(Rr[i_] * lda_ + Cc[i_]) * 2u; vb_[i_] = (unsigned)(Rbb[i_] * ldb_ + Cc[i_]) * 2u; } } while (0)
    const size_t kstep = (size_t)(BK * 2);
    const unsigned ldsw = (unsigned)wid * 1024u;
    const int aoff = lds_byte(wr * 64 + fr, fq * 8), boff = lds_byte(wc * 32 + fr, fq * 8);
#define PG8_SA(b, h) (((b) * 2 + (h)) * HTB)
#define PG8_SB(b, h) ((4 + (b) * 2 + (h)) * HTB)
#define PG8_STAGE(bufoff, gbase, voff) do { _Pragma("unroll") for (int _i = 0; _i < 2; ++_i) \
        __builtin_amdgcn_global_load_lds((const unsigned*)((const char*)(gbase) + (voff)[_i]), (PG8_LAS unsigned*)(lds + (bufoff) + ldsw + _i * 8192), 16, 0, 0); } while (0)
#define PG8_LDA(dst, b, h) do { _Pragma("unroll") for (int m = 0; m < 4; ++m) _Pragma("unroll") for (int k = 0; k < 2; ++k) dst[m][k] = *(const PG8_LAS bf16x8*)(lds + PG8_SA(b, h) + aoff + m * 2048 + k * 1024); } while (0)
#define PG8_LDB(dst, b, h) do { _Pragma("unroll") for (int n = 0; n < 2; ++n) _Pragma("unroll") for (int k = 0; k < 2; ++k) dst[n][k] = *(const PG8_LAS bf16x8*)(lds + PG8_SB(b, h) + boff + n * 2048 + k * 1024); } while (0)
#define PG8_MMA(ai, bj, At, Bt) do { __builtin_amdgcn_s_setprio(1); _Pragma("unroll") for (int m = 0; m < 4; ++m) _Pragma("unroll") for (int n = 0; n < 2; ++n) _Pragma("unroll") for (int k = 0; k < 2; ++k) \
        acc[ai][bj][m][n] = __builtin_amdgcn_mfma_f32_16x16x32_bf16(Bt[n][k], At[m][k], acc[ai][bj][m][n], 0, 0, 0); __builtin_amdgcn_s_setprio(0); } while (0)
#define PG8_WAIT_V(n) asm volatile("s_waitcnt vmcnt(" #n ")" ::: "memory")
#define PG8_WAIT_L(n) asm volatile("s_waitcnt lgkmcnt(" #n ")" ::: "memory")
#define PG8_BAR __builtin_amdgcn_s_barrier()
#define PG8_SCHED __builtin_amdgcn_sched_barrier(0)
    Unit cur, nxt; int ui = 0;
    if (!S.next(0, cur)) return;
    int brc = 0;
    f32x4 acc[2][2][4][2];
#pragma unroll
    for (int a = 0; a < 2; ++a)
#pragma unroll
        for (int b = 0; b < 2; ++b)
#pragma unroll
            for (int m = 0; m < 4; ++m)
#pragma unroll
                for (int n = 0; n < 2; ++n) acc[a][b][m][n] = (f32x4){0.f, 0.f, 0.f, 0.f};
    bf16x8 At[4][2], B0[2][2], B1[2][2];
    unsigned vAc[2], vBc[2], vAn[2], vBn[2];
    PG8_VOFF(0, vAc, vBc);
    size_t hAc = (size_t)HALF * g0.lda * 2, hBc = (size_t)HALF * g0.ldb * 2, hAn = hAc, hBn = hBc; int ntc = g0.K / BK;
    const char* cA = (const char*)g0.A + (size_t)cur.pm * 2 * hAc; const char* cB = (const char*)g0.Bt + (size_t)cur.pn * 2 * hBc;
    PG8_STAGE(PG8_SB(0, 0), cB, vBc); PG8_STAGE(PG8_SB(0, 1), cB + hBc, vBc); PG8_STAGE(PG8_SA(0, 0), cA, vAc); PG8_STAGE(PG8_SA(0, 1), cA + hAc, vAc);
    if (wr == 1) PG8_BAR;
    PG8_WAIT_V(2); PG8_BAR;
    PG8_STAGE(PG8_SB(1, 0), cB + kstep, vBc); PG8_STAGE(PG8_SA(1, 0), cA + kstep, vAc); PG8_STAGE(PG8_SB(1, 1), cB + hBc + kstep, vBc);
    PG8_WAIT_V(6); PG8_BAR;
    for (;;) {
        const int brn = (brc == 2) ? 0 : brc + 1; bool has_next = true;
        if (brc == 2) has_next = S.next(ui / 3 + 1, nxt); else nxt = cur;
        const char* nA = cA; const char* nB = cB;
        if (has_next) { PG8_VOFF(brn, vAn, vBn); hAn = (size_t)HALF * PG8_SEL(brn, lda) * 2; hBn = (size_t)HALF * PG8_SEL(brn, ldb) * 2;
            nA = (const char*)PG8_SEL(brn, A) + (size_t)nxt.pm * 2 * hAn; nB = (const char*)PG8_SEL(brn, Bt) + (size_t)nxt.pn * 2 * hBn; }
        else { vAn[0] = vAc[0]; vAn[1] = vAc[1]; vBn[0] = vBc[0]; vBn[1] = vBc[1]; hAn = hAc; hBn = hBc; }
#pragma unroll 1
        for (int t = 0; t < ntc; t += 2) {
            const bool last = (t == ntc - 2);
            const char* a1 = cA + (size_t)(t + 1) * kstep;
            const char* a2 = last ? nA : cA + (size_t)(t + 2) * kstep; const char* b2 = last ? nB : cB + (size_t)(t + 2) * kstep;
            const char* a3 = a2 + kstep; const char* b3 = b2 + kstep;
            const size_t hA2 = last ? hAn : hAc, hB2 = last ? hBn : hBc;
            PG8_LDB(B0, 0, 0); PG8_LDB(B1, 0, 1); PG8_SCHED; PG8_LDA(At, 0, 0); PG8_STAGE(PG8_SA(1, 1), a1 + hAc, vAc);
            PG8_WAIT_V(8); PG8_WAIT_L(0); PG8_BAR; PG8_MMA(0, 0, At, B0); PG8_MMA(0, 1, At, B1); PG8_BAR; PG8_SCHED;
            PG8_LDA(At, 0, 1); PG8_STAGE(PG8_SB(0, 0), b2, (last ? vBn : vBc)); PG8_STAGE(PG8_SB(0, 1), b2 + hB2, (last ? vBn : vBc)); PG8_STAGE(PG8_SA(0, 0), a2, (last ? vAn : vAc));
            PG8_WAIT_V(8); PG8_WAIT_L(0); PG8_BAR; PG8_MMA(1, 0, At, B0); PG8_MMA(1, 1, At, B1); PG8_BAR; PG8_SCHED;
            PG8_LDB(B0, 1, 0); PG8_LDB(B1, 1, 1); PG8_SCHED; PG8_LDA(At, 1, 0); PG8_STAGE(PG8_SA(0, 1), a2 + hA2, (last ? vAn : vAc));
            PG8_WAIT_V(8); PG8_WAIT_L(0); PG8_BAR; PG8_MMA(0, 0, At, B0); PG8_MMA(0, 1, At, B1); PG8_BAR; PG8_SCHED;
            PG8_LDA(At, 1, 1); PG8_STAGE(PG8_SB(1, 0), b3, (last ? vBn : vBc)); PG8_STAGE(PG8_SB(1, 1), b3 + hB2, (last ? vBn : vBc)); PG8_STAGE(PG8_SA(1, 0), a3, (last ? vAn : vAc));
            PG8_WAIT_V(8); PG8_WAIT_L(0); PG8_BAR; PG8_MMA(1, 0, At, B0); PG8_MMA(1, 1, At, B1); PG8_BAR; PG8_SCHED;
        }
        if (wr == 0) PG8_BAR;
        if (brc < 2) E.link(acc, cur, brc, wr, wc, fr, fq); else E.fin(acc, cur, wr, wc, fr, fq);
        if (!has_next) break;
        if (brc == 2) {
#pragma unroll
            for (int a = 0; a < 2; ++a)
#pragma unroll
                for (int b = 0; b < 2; ++b)
#pragma unroll
                    for (int m = 0; m < 4; ++m)
#pragma unroll
                        for (int n = 0; n < 2; ++n) acc[a][b][m][n] = (f32x4){0.f, 0.f, 0.f, 0.f}; }
        cur = nxt; cA = nA; cB = nB; ++ui; brc = brn; vAc[0] = vAn[0]; vAc[1] = vAn[1]; vBc[0] = vBn[0]; vBc[1] = vBn[1]; hAc = hAn; hBc = hBn; ntc = PG8_SEL(brc, K) / BK;
        if (wr == 1) PG8_BAR;
    }
    PG8_WAIT_V(0);
    PG8_BAR;
#undef PG8_SEL
#undef PG8_VOFF
#undef PG8_SA
#undef PG8_SB
#undef PG8_STAGE
#undef PG8_LDA
#undef PG8_LDB
#undef PG8_MMA
#undef PG8_WAIT_V
#undef PG8_WAIT_L
#undef PG8_BAR
#undef PG8_SCHED
}

__device__ __forceinline__ f32x2 gelu_pk(f32x2 v) {
    const f32x2 av = __builtin_elementwise_abs(v), d = av * 0.2316418882f + 1.0f;
    f32x2 t; t.x = __builtin_amdgcn_rcpf(d.x); t.y = __builtin_amdgcn_rcpf(d.y);
    f32x2 q = t * 0.5307027145f + (-0.7265760135f); q = q * t + 0.7107068705f; q = q * t + (-0.142248368f); q = q * t + 0.127414796f; q = q * t;
    const f32x2 s = (v * v) * (-0.72134752044f);
    f32x2 e; e.x = __builtin_amdgcn_exp2f(s.x); e.y = __builtin_amdgcn_exp2f(s.y);
    const f32x2 m = v * (q * e), r = v - m;
    f32x2 o; o.x = v.x < 0.f ? m.x : r.x; o.y = v.y < 0.f ? m.y : r.y; return o;
}
__device__ __forceinline__ u32x4 pack8(f32x4 v0, f32x4 v1) { u32x4 w; w.x = cvt_pk_bf16(v0[0], v0[1]); w.y = cvt_pk_bf16(v0[2], v0[3]); w.z = cvt_pk_bf16(v1[0], v1[1]); w.w = cvt_pk_bf16(v1[2], v1[3]); return w; }

struct EpiBf16 {
    bf16* O; int ldc; int split_cols; size_t split_stride;
    __device__ __forceinline__ void operator()(const f32x4 (&acc)[2][2][4][2], const Unit& u, int wr, int wc, int fr, int fq) const {
        const int row0 = u.pm * BM + wr * 64 + fr; int colt = u.pn * BM; bf16* base = O;
        if (split_cols) { const int t = colt / split_cols; base += (size_t)t * split_stride; colt -= t * split_cols; }
        const int col0 = colt + wc * 32 + 8 * fq;
#pragma unroll
        for (int ai = 0; ai < 2; ++ai)
#pragma unroll
            for (int m = 0; m < 4; ++m) { bf16* rowp = base + (size_t)(row0 + ai * HALF + m * 16) * ldc + col0;
#pragma unroll
                for (int bj = 0; bj < 2; ++bj) *(u32x4*)(rowp + bj * HALF) = pack8(acc[ai][bj][m][0], acc[ai][bj][m][1]); }
    }
};
struct EpiProj {
    bf16 *za, *zb, *zc, *zg, *vlo; const float* gate_b; const float* rs; const unsigned* cmax;
    __device__ __forceinline__ void operator()(const i32x4 (&acc)[2][2][4][2], const Unit& u, int wr, int wc, int fr, int fq) const {
        const int row0 = u.pm * BM + wr * 64 + fr; const int pn = u.pn;
        bf16* base; int ld, ct, mode;
        if (pn < 13) { base = za; ld = A_COLS; ct = pn; mode = 0; }
        else if (pn < 22) { base = zb; ld = B_COLS; ct = pn - 13; mode = 0; }
        else if (pn < 30) { base = zc; ld = C_COLS; ct = pn - 22; mode = 1; }
        else if (pn < 42) { base = zg; ld = G_COLS; ct = pn - 30; mode = 2; }
        else { base = vlo; ld = 32; ct = 0; mode = 3; }
        const int col0 = ct * BM + wc * 32 + 8 * fq;
        f32x4 cs[2][2];
#pragma unroll
        for (int bj = 0; bj < 2; ++bj)
#pragma unroll
            for (int n = 0; n < 2; ++n) { const u32x4 b = *(const u32x4*)(cmax + pn * BM + wc * 32 + 8 * fq + bj * HALF + 4 * n);
                cs[bj][n] = (f32x4){__uint_as_float(b.x), __uint_as_float(b.y), __uint_as_float(b.z), __uint_as_float(b.w)} * (1.f / 127.f); }
#define PG8_DQ(ai, bj, m, n, r) (__builtin_convertvector(acc[ai][bj][m][n], f32x4) * (cs[bj][n] * (r)))
        if (mode == 0) {
#pragma unroll
            for (int ai = 0; ai < 2; ++ai)
#pragma unroll
                for (int m = 0; m < 4; ++m) { const int row = row0 + ai * HALF + m * 16; const float r = rs[row]; bf16* rowp = base + (size_t)row * ld + col0;
#pragma unroll
                    for (int bj = 0; bj < 2; ++bj) *(u32x4*)(rowp + bj * HALF) = pack8(PG8_DQ(ai, bj, m, 0, r), PG8_DQ(ai, bj, m, 1, r)); }
        } else if (mode == 1) {
#pragma unroll
            for (int ai = 0; ai < 2; ++ai)
#pragma unroll
                for (int m = 0; m < 4; ++m) { const int row = row0 + ai * HALF + m * 16; const float r = rs[row]; bf16* rowp = base + (size_t)row * ld + col0;
#pragma unroll
                    for (int bj = 0; bj < 2; ++bj) { const f32x4 v0 = PG8_DQ(ai, bj, m, 0, r), v1 = PG8_DQ(ai, bj, m, 1, r);
                        const f32x2 a = gelu_pk((f32x2){v0[0], v0[1]}), b = gelu_pk((f32x2){v0[2], v0[3]}), c = gelu_pk((f32x2){v1[0], v1[1]}), d = gelu_pk((f32x2){v1[2], v1[3]});
                        *(u32x4*)(rowp + bj * HALF) = pack8((f32x4){a.x, a.y, b.x, b.y}, (f32x4){c.x, c.y, d.x, d.y}); } }
        } else if (mode == 2) {
            f32x4 bv[2][2];
#pragma unroll
            for (int bj = 0; bj < 2; ++bj)
#pragma unroll
                for (int n = 0; n < 2; ++n) bv[bj][n] = *(const f32x4*)(gate_b + col0 + bj * HALF + 4 * n);
#pragma unroll
            for (int ai = 0; ai < 2; ++ai)
#pragma unroll
                for (int m = 0; m < 4; ++m) { const int row = row0 + ai * HALF + m * 16; const float r = rs[row];
#pragma unroll
                    for (int bj = 0; bj < 2; ++bj) { f32x4 v0 = PG8_DQ(ai, bj, m, 0, r) + bv[bj][0], v1 = PG8_DQ(ai, bj, m, 1, r) + bv[bj][1]; u32 q[8];
#pragma unroll
                        for (int e = 0; e < 4; ++e) { q[e] = (u32)__builtin_amdgcn_fmed3f(__builtin_rintf(sigmoidf_(v0[e]) * 255.f), 1.f, 255.f); q[4 + e] = (u32)__builtin_amdgcn_fmed3f(__builtin_rintf(sigmoidf_(v1[e]) * 255.f), 1.f, 255.f); }
                        *(u32x2*)((unsigned char*)zg + (size_t)row * G_COLS + col0 + bj * HALF) = (u32x2){q[0] | (q[1] << 8) | (q[2] << 16) | (q[3] << 24), q[4] | (q[5] << 8) | (q[6] << 16) | (q[7] << 24)}; } }
        } else {
            if (wc == 0) {
#pragma unroll
                for (int ai = 0; ai < 2; ++ai)
#pragma unroll
                    for (int m = 0; m < 4; ++m) { const int row = row0 + ai * HALF + m * 16; const float r = rs[row]; bf16* rowp = base + (size_t)row * 32 + 8 * fq;
                        *(u32x4*)(rowp) = pack8(PG8_DQ(ai, 0, m, 0, r), PG8_DQ(ai, 0, m, 1, r)); }
            }
        }
#undef PG8_DQ
    }
};
template <int MODE> struct EpiGate {
    const bf16* gate; bf16* tmp; bf16* merged;
    __device__ __forceinline__ void operator()(const f32x4 (&acc)[2][2][4][2], const Unit& u, int wr, int wc, int fr, int fq) const {
        const int row0 = u.pm * BM + wr * 64 + fr; const int col0 = u.pn * BM + wc * 32 + 8 * fq;
#pragma unroll
        for (int ai = 0; ai < 2; ++ai)
#pragma unroll
            for (int m = 0; m < 4; ++m) { const size_t row = (size_t)(row0 + ai * HALF + m * 16);
#pragma unroll
                for (int bj = 0; bj < 2; ++bj) { const int col = col0 + bj * HALF;
                    const u32x4 gq = *(const u32x4*)(gate + row * G_COLS + col);
                    f32x4 g0 = (f32x4){bflo(gq.x), bfhi(gq.x), bflo(gq.y), bfhi(gq.y)}, g1 = (f32x4){bflo(gq.z), bfhi(gq.z), bflo(gq.w), bfhi(gq.w)};
                    f32x4 v0 = acc[ai][bj][m][0] * g0, v1 = acc[ai][bj][m][1] * g1;
                    bf16* tp = tmp + row * D + col;
                    if (MODE != 0) { const u32x4 tq = *(const u32x4*)tp; v0 += (f32x4){bflo(tq.x), bfhi(tq.x), bflo(tq.y), bfhi(tq.y)}; v1 += (f32x4){bflo(tq.z), bfhi(tq.z), bflo(tq.w), bfhi(tq.w)}; }
                    if (MODE != 2) *(u32x4*)tp = pack8(v0, v1);
                    else *(u32x4*)(merged + row * D + col) = pack8(v0, v1); }
                asm volatile("" ::: "memory"); }
    }
};
struct EpiChainGate {
    const unsigned char* gate; bf16* merged;
    __device__ __forceinline__ void link(f32x4 (&acc)[2][2][4][2], const Unit& u, int br, int wr, int wc, int fr, int fq) const {
        const int row0 = u.pm * BM + wr * 64 + fr; const int col0 = u.pn * BM + wc * 32 + 8 * fq;
#pragma unroll
        for (int ai = 0; ai < 2; ++ai)
#pragma unroll
            for (int m = 0; m < 4; ++m) { const size_t row = (size_t)(row0 + ai * HALF + m * 16);
#pragma unroll
                for (int bj = 0; bj < 2; ++bj) { const unsigned char* gp = gate + row * G_COLS + br * 1024 + col0 + bj * HALF;
                    const u32x2 ga = *(const u32x2*)gp, gb = *(const u32x2*)(gp + 1024);
#pragma unroll
                    for (int e = 0; e < 8; ++e) { const u32 wa = (e < 4) ? ga.x : ga.y, wb = (e < 4) ? gb.x : gb.y; const int sh = 8 * (e & 3);
                        const float r = (float)((wa >> sh) & 255u) * __builtin_amdgcn_rcpf((float)((wb >> sh) & 255u));
                        if (e < 4) acc[ai][bj][m][0][e] *= r; else acc[ai][bj][m][1][e - 4] *= r; } }
                asm volatile("" ::: "memory"); }
    }
    __device__ __forceinline__ void fin(const f32x4 (&acc)[2][2][4][2], const Unit& u, int wr, int wc, int fr, int fq) const {
        const int row0 = u.pm * BM + wr * 64 + fr; const int col0 = u.pn * BM + wc * 32 + 8 * fq;
#pragma unroll
        for (int ai = 0; ai < 2; ++ai)
#pragma unroll
            for (int m = 0; m < 4; ++m) { const size_t row = (size_t)(row0 + ai * HALF + m * 16);
#pragma unroll
                for (int bj = 0; bj < 2; ++bj) { const int col = col0 + bj * HALF; const u32x2 gq = *(const u32x2*)(gate + row * G_COLS + 2048 + col); f32x4 g0_, g1_;
#pragma unroll
                    for (int e = 0; e < 4; ++e) { g0_[e] = (float)((gq.x >> (8 * e)) & 255u) * (1.f / 255.f); g1_[e] = (float)((gq.y >> (8 * e)) & 255u) * (1.f / 255.f); }
                    *(u32x4*)(merged + row * D + col) = pack8(acc[ai][bj][m][0] * g0_, acc[ai][bj][m][1] * g1_); }
                asm volatile("" ::: "memory"); }
    }
};
struct EpiResid {
    const float* xin; float* xout;
    __device__ __forceinline__ void operator()(const f32x4 (&acc)[2][2][4][2], const Unit& u, int wr, int wc, int fr, int fq) const {
        const int row0 = u.pm * BM + wr * 64 + fr; const int col0 = u.pn * BM + wc * 32 + 8 * fq;
#pragma unroll
        for (int ai = 0; ai < 2; ++ai)
#pragma unroll
            for (int m = 0; m < 4; ++m) { const size_t off = (size_t)(row0 + ai * HALF + m * 16) * D + col0;
#pragma unroll
                for (int bj = 0; bj < 2; ++bj) { const float* ip = xin + off + bj * HALF; float* op = xout + off + bj * HALF;
                    const f32x4 a = *(const f32x4*)ip, b = *(const f32x4*)(ip + 4);
                    *(f32x4*)op = a + acc[ai][bj][m][0]; *(f32x4*)(op + 4) = b + acc[ai][bj][m][1]; }
                asm volatile("" ::: "memory"); }
    }
};
struct EpiSwiglu {
    bf16* hid; const float* rs; const int* rowmap; const LAS int* tb; const unsigned* cmax;
    __device__ __forceinline__ void operator()(const i32x4 (&acc)[2][2][4][2], const Unit& u, int wr, int wc, int fr, int fq) const {
        const int row0 = u.pm * BM + wr * 64 + fr; const int col0 = u.pn * HALF + wc * 32 + 8 * fq;
        const int e = u.e, slot0 = (u.pm - tb[e]) * BM + wr * 64 + fr, cn = tb[40 + e];
        f32x4 cs[2][2];
#pragma unroll
        for (int bj = 0; bj < 2; ++bj)
#pragma unroll
            for (int n = 0; n < 2; ++n) { const u32x4 b = *(const u32x4*)(cmax + e * 1024 + u.pn * BM + bj * HALF + wc * 32 + 8 * fq + 4 * n);
                cs[bj][n] = (f32x4){__uint_as_float(b.x), __uint_as_float(b.y), __uint_as_float(b.z), __uint_as_float(b.w)} * (1.f / 127.f); }
#pragma unroll
        for (int ai = 0; ai < 2; ++ai)
#pragma unroll
            for (int m = 0; m < 4; ++m) { bf16* rowp = hid + (size_t)(row0 + ai * HALF + m * 16) * EFF + col0;
                const int slot = slot0 + ai * HALF + m * 16; const bool ok = slot < cn; const int t = ok ? rowmap[e * 16384 + slot] : 0; const float r = ok ? rs[t] : 0.f;
                const f32x4 a0 = __builtin_convertvector(acc[ai][0][m][0], f32x4) * (cs[0][0] * r), a1 = __builtin_convertvector(acc[ai][0][m][1], f32x4) * (cs[0][1] * r);
                const f32x4 b0 = __builtin_convertvector(acc[ai][1][m][0], f32x4) * (cs[1][0] * r), b1 = __builtin_convertvector(acc[ai][1][m][1], f32x4) * (cs[1][1] * r);
                f32x4 h0, h1;
#pragma unroll
                for (int q = 0; q < 4; ++q) { h0[q] = a0[q] * sigmoidf_(a0[q]) * b0[q]; h1[q] = a1[q] * sigmoidf_(a1[q]) * b1[q]; }
                *(u32x4*)rowp = pack8(h0, h1); }
    }
};
struct EpiLora { bf16* w; bf16* a; bf16* g; bf16* v;
    __device__ __forceinline__ void operator()(const f32x4 (&acc)[2][2][4][2], const Unit& u, int wr, int wc, int fr, int fq) const {
        const int sec = u.pn >> 2; bf16* base = sec == 0 ? w : (sec == 1 ? a : (sec == 2 ? g : v)); Unit u2 = u; u2.pn = u.pn & 3;
        EpiBf16 e{base, D, 0, 0}; e(acc, u2, wr, wc, fr, fq); } };
}

#define XB_TMO      128
#define XB_XCNT(j)  (256  + 64 * (j))
#define XB_XSUB(j)  (1280 + 64 * (j))
#define XB_XGEN(j)  (2304 + 64 * (j))
#define XB_TOP      3328
#define XB_TOPGEN   3392
#define XCD_BAR_WORDS 3456
#define XB_SPIN_CAP (1u << 22)
__device__ __forceinline__ unsigned xb_ld(unsigned* p)              { return __hip_atomic_load(p, __ATOMIC_RELAXED, __HIP_MEMORY_SCOPE_AGENT); }
__device__ __forceinline__ unsigned xb_add(unsigned* p, unsigned v) { return __hip_atomic_fetch_add(p, v, __ATOMIC_RELAXED, __HIP_MEMORY_SCOPE_AGENT); }
__device__ __forceinline__ unsigned xb_xcc_id() { return (unsigned)__builtin_amdgcn_s_getreg((3 << 11) | 20) & 0xFu; }
#define XB_SPIN(cond, bar) do { unsigned _sp = 0; while (cond) { __builtin_amdgcn_s_sleep(1); \
    if ((++_sp & 255u) == 0u) { if (xb_ld(&(bar)[XB_TMO])) break; if (_sp > XB_SPIN_CAP) { atomicAdd(&(bar)[XB_TMO], 1u); break; } } } } while (0)
struct XcdBarrier { unsigned* bar; unsigned x; volatile LAS unsigned* st; };
__device__ __forceinline__ XcdBarrier xcd_barrier_post(unsigned* bar, volatile LAS unsigned* st) {
    XcdBarrier b; b.bar = bar; b.x = xb_xcc_id(); b.st = st;
    if (threadIdx.x == 0) (void)xb_add(&bar[XB_XCNT(b.x)], 1u);
    return b;
}
__device__ __forceinline__ void xcd_barrier_complete(unsigned* bar, unsigned x, unsigned& nloc, unsigned& nx) {
    const unsigned G = gridDim.x * gridDim.y * gridDim.z;
    unsigned sum, cnt, mine, sp = 0u;
    for (;;) {
        sum = 0u; cnt = 0u; mine = 0u;
#pragma unroll
        for (unsigned j = 0; j < 16; ++j) { const unsigned c = xb_ld(&bar[XB_XCNT(j)]); sum += c; cnt += (c > 0u) ? 1u : 0u; mine = (j == x) ? c : mine; }
        if (sum == G) break;
        __builtin_amdgcn_s_sleep(1);
        if ((++sp & 255u) == 0u) { if (xb_ld(&bar[XB_TMO])) break; if (sp > XB_SPIN_CAP) { atomicAdd(&bar[XB_TMO], 1u); break; } }
    }
    nloc = mine > 0u ? mine : 1u; nx = cnt > 0u ? cnt : 1u;
}
__device__ __forceinline__ void xcd_barrier(const XcdBarrier& b) {
    asm volatile("s_waitcnt vmcnt(0)" ::: "memory");
    __syncthreads();
    if (threadIdx.x == 0) {
        unsigned* bar = b.bar;
        __builtin_amdgcn_s_waitcnt(0);
        unsigned nloc = b.st[0], nx = b.st[1];
        if (nloc == 0u) { xcd_barrier_complete(bar, b.x, nloc, nx); b.st[0] = nloc; b.st[1] = nx; }
        const unsigned old = xb_add(&bar[XB_XSUB(b.x)], 1u);
        const unsigned gen = old / nloc;
        if (old + 1u == (gen + 1u) * nloc) {
            __builtin_amdgcn_fence(__ATOMIC_RELEASE, "agent");
            asm volatile("s_waitcnt vmcnt(0)" ::: "memory");
            const unsigned og = xb_add(&bar[XB_TOP], 1u);
            const unsigned tg = og / nx;
            if (og + 1u == (tg + 1u) * nx) xb_add(&bar[XB_TOPGEN], 1u);
            else XB_SPIN(xb_ld(&bar[XB_TOPGEN]) == tg, bar);
            __builtin_amdgcn_fence(__ATOMIC_ACQUIRE, "agent");
            xb_add(&bar[XB_XGEN(b.x)], 1u);
            asm volatile("s_waitcnt vmcnt(0)" ::: "memory");
        } else {
            XB_SPIN(xb_ld(&bar[XB_XGEN(b.x)]) == gen, bar);
            __builtin_amdgcn_fence(__ATOMIC_ACQUIRE, "agent");
            asm volatile("s_waitcnt vmcnt(0)" ::: "memory");
        }
    }
    __syncthreads();
}

struct Args { const float* in[36]; float* out; unsigned char* ws; int s_lo, s_hi; };
enum { I_X = 0, I_NORM_MIX, I_W_IN, I_MU_A, I_W_DECAY0, I_W_DECAY2, I_A0, I_A2, I_G2, I_K_K, I_K_A, I_R_K, I_LNX_W, I_LNX_B, I_VRES_MU, I_VRES_W1, I_VRES_W2, I_VRES_B,
       I_SGU_LN_W, I_SGU_LN_B, I_SGU_WS, I_SGU_BS, I_GATE_B, I_W_PA, I_W_PB, I_W_PC, I_W_OUT, I_NORM_FFN, I_RGRP, I_RGRP_B, I_REXP, I_REXP_B, I_MOE_W1, I_MOE_W3, I_MOE_W2, I_NORM_FINAL };

struct Ctx {
    LAS unsigned char* lds; unsigned char* ws; const float* const* in; float* out;
    int tid, lane, wave, G, bid, gw, ngw;
    __device__ __forceinline__ const float* inp(int k) const { return AS_GLOBAL(const float, in[k]); }
};
__device__ __forceinline__ Ctx launder(const Ctx& C0) {
    Ctx C = C0; asm volatile("" : "+v"(C.tid), "+v"(C.lane)); asm volatile("" : "+s"(C.wave), "+s"(C.bid), "+s"(C.gw), "+s"(C.ws)); C.ws = AS_GLOBAL(unsigned char, C.ws); C.out = AS_GLOBAL(float, C.out); return C;
}

__device__ __forceinline__ void tr_item(const float* W, int N, int k0, int n0, bf16* WT, int ldk, int drow0, LAS float* scr, int lane) {
    float wv_[32];
#pragma unroll
    for (int i = 0; i < 32; ++i) { const int kk = 2 * i + (lane >> 5); wv_[i] = W[(size_t)(k0 + kk) * N + n0 + (lane & 31)]; }
#pragma unroll
    for (int i = 0; i < 32; ++i) { const int kk = 2 * i + (lane >> 5); scr[kk * 33 + (lane & 31)] = wv_[i]; }
    LDS_WAIT(); asm volatile("" ::: "memory");
    const int c = lane & 7;
#pragma unroll
    for (int j = 0; j < 4; ++j) { const int n = (lane >> 3) + 8 * j; const LAS float* s = scr + (8 * c) * 33 + n;
        u32x4 o; o.x = cvt_pk_bf16(s[0 * 33], s[1 * 33]); o.y = cvt_pk_bf16(s[2 * 33], s[3 * 33]); o.z = cvt_pk_bf16(s[4 * 33], s[5 * 33]); o.w = cvt_pk_bf16(s[6 * 33], s[7 * 33]);
        *(u32x4*)(WT + (size_t)(drow0 + n) * ldk + k0 + 8 * c) = o; }
    LDS_WAIT(); asm volatile("" ::: "memory");
}

__device__ __forceinline__ void tr_item_i8(const float* W, int N, int k0, int n0, unsigned char* WT, int ldkb, int drow0, const unsigned* cmax, LAS float* scr, int lane) {
    float wv_[32];
    const float sc = 127.f / fmaxf(__uint_as_float(cmax[drow0 + (lane & 31)]), 1e-30f);
#pragma unroll
    for (int i = 0; i < 32; ++i) { const int kk = 2 * i + (lane >> 5); wv_[i] = W[(size_t)(k0 + kk) * N + n0 + (lane & 31)]; }
#pragma unroll
    for (int i = 0; i < 32; ++i) { const int kk = 2 * i + (lane >> 5); scr[kk * 33 + (lane & 31)] = __builtin_rintf(wv_[i] * sc); }
    LDS_WAIT(); asm volatile("" ::: "memory");
    const int c = lane & 7;
#pragma unroll
    for (int j = 0; j < 4; ++j) { const int n = (lane >> 3) + 8 * j; const LAS float* s = scr + (8 * c) * 33 + n; u32 q[8];
#pragma unroll
        for (int e = 0; e < 8; ++e) q[e] = (u32)(int)s[e * 33] & 255u;
        *(u32x2*)(WT + (size_t)(drow0 + n) * ldkb + k0 + 8 * c) = (u32x2){q[0] | (q[1] << 8) | (q[2] << 16) | (q[3] << 24), q[4] | (q[5] << 8) | (q[6] << 16) | (q[7] << 24)}; }
    LDS_WAIT(); asm volatile("" ::: "memory");
}
__device__ __forceinline__ void phase_wmax(const Ctx& C0) {
    const Ctx C = launder(C0);
    unsigned* cm = (unsigned*)(C.ws + WS_CTL) + CW_WMAX;
    const int gt = C.bid * 512 + C.tid, ngt = C.G * 512;
    constexpr int NF4 = IN_COLS / 4;
    for (int i = gt; i < NLAYER * 32 * NF4; i += ngt) { const int n4 = i % NF4, kb = (i / NF4) % 32, l = i / (NF4 * 32);
        const float* p = C.inp(I_W_IN) + ((size_t)l * D + kb * 32) * IN_COLS + n4 * 4; f32x4 m = {0.f, 0.f, 0.f, 0.f};
#pragma unroll 8
        for (int k = 0; k < 32; ++k) { const f32x4 v = *(const f32x4*)(p + (size_t)k * IN_COLS); m = __builtin_elementwise_max(m, __builtin_elementwise_abs(v)); }
        unsigned* d = cm + l * WIN_ROWS + n4 * 4;
#pragma unroll
        for (int e = 0; e < 4; ++e) __hip_atomic_fetch_max(d + e, __float_as_uint(m[e]), __ATOMIC_RELAXED, __HIP_MEMORY_SCOPE_AGENT); }
    for (int i = gt; i < 32 * 8; i += ngt) { const int n4 = i % 8, kb = i / 8;
        const float* p = C.inp(I_VRES_W1) + (size_t)(kb * 32) * 32 + n4 * 4; f32x4 m = {0.f, 0.f, 0.f, 0.f};
#pragma unroll 8
        for (int k = 0; k < 32; ++k) { const f32x4 v = *(const f32x4*)(p + (size_t)k * 32); m = __builtin_elementwise_max(m, __builtin_elementwise_abs(v)); }
        unsigned* d = cm + WIN_ROWS + IN_COLS + n4 * 4;
#pragma unroll
        for (int e = 0; e < 4; ++e) __hip_atomic_fetch_max(d + e, __float_as_uint(m[e]), __ATOMIC_RELAXED, __HIP_MEMORY_SCOPE_AGENT); }
    unsigned* cm13 = (unsigned*)(C.ws + WS_CTL) + CW_WMAX13; const float* w1_ = C.inp(I_MOE_W1); const float* w3_ = C.inp(I_MOE_W3);
    for (int i = gt; i < NLAYER * NEXP * 2 * 16 * 128; i += ngt) { const int n4 = i % 128, kb = (i / 128) % 16, sel = (i / 2048) % 2, le = i / 4096;
        const float* p = (sel ? w3_ : w1_) + ((size_t)le * D + kb * 64) * EFF + n4 * 4; f32x4 m = {0.f, 0.f, 0.f, 0.f};
#pragma unroll 8
        for (int k = 0; k < 64; ++k) { const f32x4 v = *(const f32x4*)(p + (size_t)k * EFF); m = __builtin_elementwise_max(m, __builtin_elementwise_abs(v)); }
        const int n = n4 * 4; unsigned* d = cm13 + le * 1024 + (n / 128) * 256 + (n % 128) + sel * 128;
#pragma unroll
        for (int e = 0; e < 4; ++e) __hip_atomic_fetch_max(d + e, __float_as_uint(m[e]), __ATOMIC_RELAXED, __HIP_MEMORY_SCOPE_AGENT); }
}

__device__ __forceinline__ void phase_convert(const Ctx& C0, int l, bool first) {
    const Ctx C = launder(C0);
    LAS float* scr = (LAS float*)(C.lds + C.wave * 16384);
    unsigned char* ws = C.ws;
    constexpr int I_WIN = 16 * 336, I_VR = 16, I_SQ = 16 * 32, I_PB = 4 * 32, I_E13 = 256 * 32, I_E2 = 256 * 32;
    constexpr int NIT_ = I_WIN + I_VR + 3 * I_SQ + I_PB + 2 * I_E13 + I_E2;
    for (int it = C.gw; it < NIT_; it += C.ngw) {
        int r = it;
        if (r < I_WIN) { tr_item_i8(C.inp(I_W_IN) + (size_t)l * D * IN_COLS, IN_COLS, (r / 336) * 64, (r % 336) * 32, ws + WS_WIN, D, (r % 336) * 32, (const unsigned*)(ws + WS_CTL) + CW_WMAX + l * WIN_ROWS, scr, C.lane); continue; } r -= I_WIN;
        if (r < I_VR) { if (l == 1) tr_item_i8(C.inp(I_VRES_W1), 32, r * 64, 0, ws + WS_WIN, D, IN_COLS, (const unsigned*)(ws + WS_CTL) + CW_WMAX + WIN_ROWS, scr, C.lane); continue; } r -= I_VR;
        if (r < I_SQ) { tr_item(C.inp(I_W_PA) + (size_t)l * D * D, D, (r / 32) * 64, (r % 32) * 32, (bf16*)(ws + WS_PA), D, (r % 32) * 32, scr, C.lane); continue; } r -= I_SQ;
        if (r < I_SQ) { tr_item(C.inp(I_W_PC) + (size_t)l * D * D, D, (r / 32) * 64, (r % 32) * 32, (bf16*)(ws + WS_PC), D, (r % 32) * 32, scr, C.lane); continue; } r -= I_SQ;
        if (r < I_SQ) { tr_item(C.inp(I_W_OUT) + (size_t)l * D * D, D, (r / 32) * 64, (r % 32) * 32, (bf16*)(ws + WS_WOUT), D, (r % 32) * 32, scr, C.lane); continue; } r -= I_SQ;
        if (r < I_PB) { tr_item(C.inp(I_W_PB) + (size_t)l * 256 * D, D, (r / 32) * 64, (r % 32) * 32, (bf16*)(ws + WS_PB), 256, (r % 32) * 32, scr, C.lane); continue; } r -= I_PB;
        if (r < 2 * I_E13) { const int sel = r / I_E13; r -= sel * I_E13; const int e = r / 256, q = r % 256, kb = q / 16, nb = q % 16, n0 = nb * 32;
            tr_item_i8(C.inp(sel ? I_MOE_W3 : I_MOE_W1) + ((size_t)l * NEXP + e) * D * EFF, EFF, kb * 64, n0, ws + WS_W13 + (size_t)e * D * D, D, (n0 / 128) * 256 + (n0 % 128) + sel * 128, (const unsigned*)(ws + WS_CTL) + CW_WMAX13 + (l * NEXP + e) * 1024, scr, C.lane); continue; }
        r -= 2 * I_E13;
        { const int e = r / 256, q = r % 256, kb = q / 32, nb = q % 32;
            tr_item(C.inp(I_MOE_W2) + ((size_t)l * NEXP + e) * EFF * D, D, kb * 64, nb * 32, (bf16*)(ws + WS_W2) + (size_t)e * D * EFF, EFF, nb * 32, scr, C.lane); }
    }
    const int gt = C.bid * 512 + C.tid, ngt = C.G * 512;
    if (l == 1) { u32 zz_ = 0u; asm volatile("" : "+v"(zz_));
        for (int i = gt; i < 224 * 64; i += ngt) *(u32x4*)(ws + WS_WIN + (size_t)(10784 + i / 64) * D + (i % 64) * 16) = (u32x4){zz_, zz_, zz_, zz_}; }
    for (int i = gt; i < LORA_N * (LORA_K / 8); i += ngt) {
        const int n = i % LORA_N, k8 = i / LORA_N, sec = n >> 10, nn = n & 1023; float v[8];
#pragma unroll
        for (int e = 0; e < 8; ++e) { const int k = k8 * 8 + e; float x = 0.f;
            if (sec == 0) { if (k < 64) x = C.inp(I_W_DECAY2)[((size_t)l * 64 + k) * D + nn]; }
            else if (sec == 1) { if (k >= 64 && k < 128) x = C.inp(I_A2)[((size_t)l * 64 + (k - 64)) * D + nn]; }
            else if (sec == 2) { if (k >= 128 && k < 256) x = C.inp(I_G2)[((size_t)l * 128 + (k - 128)) * D + nn]; }
            else { if (l == 1 && k >= 256 && k < 288) x = C.inp(I_VRES_W2)[(size_t)(k - 256) * D + nn]; }
            v[e] = x; }
        u32x4 o; o.x = cvt_pk_bf16(v[0], v[1]); o.y = cvt_pk_bf16(v[2], v[3]); o.z = cvt_pk_bf16(v[4], v[5]); o.w = cvt_pk_bf16(v[6], v[7]);
        *(u32x4*)((bf16*)(ws + WS_LORAB) + (size_t)n * LORA_K + k8 * 8) = o;
    }
    for (int i = gt; i < 8 * 128 * 16; i += ngt) { const int s8 = i & 15, t = (i >> 4) & 127, g = i >> 11; const float* src = C.inp(I_SGU_WS) + (((size_t)l * 8 + g) * 128 + t) * 128 + s8 * 8; float v[8];
#pragma unroll
        for (int e = 0; e < 8; ++e) v[e] = (s8 * 8 + e <= t) ? src[e] : 0.f;
        u32x4 o; o.x = cvt_pk_bf16(v[0], v[1]); o.y = cvt_pk_bf16(v[2], v[3]); o.z = cvt_pk_bf16(v[4], v[5]); o.w = cvt_pk_bf16(v[6], v[7]);
        *(u32x4*)((bf16*)(ws + WS_WSC) + (size_t)i * 8) = o; }
    for (int i = gt; i < 48 * (D / 8); i += ngt) { const int e = i / (D / 8), k8 = i % (D / 8); u32 hi[4], lo[4]; float h2[8], l2[8];
#pragma unroll
        for (int q = 0; q < 8; ++q) { const int k = k8 * 8 + q; float w = 0.f;
            if (e < 4) w = C.inp(I_RGRP)[((size_t)l * D + k) * 4 + e]; else if (e < 36) w = C.inp(I_REXP)[((size_t)l * D + k) * 32 + (e - 4)];
            w *= C.inp(I_NORM_FFN)[(size_t)l * D + k];
            const float wh = bf2f(f2bf(w)); h2[q] = wh; l2[q] = w - wh; }
#pragma unroll
        for (int q = 0; q < 4; ++q) { hi[q] = cvt_pk_bf16(h2[2 * q], h2[2 * q + 1]); lo[q] = cvt_pk_bf16(l2[2 * q], l2[2 * q + 1]); }
        *(u32x4*)((bf16*)(ws + WS_WSC + 512 * 1024) + (size_t)e * D + k8 * 8) = (u32x4){hi[0], hi[1], hi[2], hi[3]};
        *(u32x4*)((bf16*)(ws + WS_WSC + 640 * 1024) + (size_t)e * D + k8 * 8) = (u32x4){lo[0], lo[1], lo[2], lo[3]}; }
    if (first) for (int i = gt; i < T * 32; i += ngt) { const int t = i >> 5, f = i & 31;
        double invd = 1.0; for (int q = 0; q < f; ++q) invd *= 0.74989420933245582;
        const float inv = (float)invd;
        const float ang = (float)t * inv;
        double rev = (double)ang * 0.15915494309189535; rev -= __builtin_rint(rev);
        const float rv = (float)rev;
        ((f32x2*)(ws + WS_ROPE))[i] = (f32x2){__builtin_amdgcn_cosf(rv), __builtin_amdgcn_sinf(rv)}; }
}

__device__ __forceinline__ void row_load(const float* p, int lane, f32x4 (&v)[4]) {
#pragma unroll
    for (int j = 0; j < 4; ++j) v[j] = ((const f32x4*)p)[lane + 64 * j];
}
__device__ __forceinline__ float row_ss(const f32x4 (&v)[4]) {
    float s = 0.f;
#pragma unroll
    for (int j = 0; j < 4; ++j) s += (v[j].x * v[j].x + v[j].y * v[j].y) + (v[j].z * v[j].z + v[j].w * v[j].w);
    return wave_sum(s);
}
__device__ __forceinline__ void norm2_rows(const float* xsrc, const float* g, bf16* out, int gw, int ngw, int lane) {
    f32x4 gv[4];
#pragma unroll
    for (int j = 0; j < 4; ++j) gv[j] = ((const f32x4*)g)[lane + 64 * j];
    for (int ml = gw; ml < M; ml += 2 * ngw) { const int m2 = ml + ngw; const bool has2 = m2 < M; const int mb = has2 ? m2 : ml;
        f32x4 va[4], vb[4]; row_load(xsrc + (size_t)ml * D, lane, va); row_load(xsrc + (size_t)mb * D, lane, vb);
        const float ra = __builtin_amdgcn_rsqf(row_ss(va) * (1.f / D) + 1e-6f), rb = __builtin_amdgcn_rsqf(row_ss(vb) * (1.f / D) + 1e-6f);
#pragma unroll
        for (int j = 0; j < 4; ++j) { const f32x4 oa = va[j] * ra * gv[j]; ((u32x2*)(out + (size_t)ml * D))[lane + 64 * j] = (u32x2){cvt_pk_bf16(oa.x, oa.y), cvt_pk_bf16(oa.z, oa.w)}; }
        if (has2) {
#pragma unroll
            for (int j = 0; j < 4; ++j) { const f32x4 ob = vb[j] * rb * gv[j]; ((u32x2*)(out + (size_t)m2 * D))[lane + 64 * j] = (u32x2){cvt_pk_bf16(ob.x, ob.y), cvt_pk_bf16(ob.z, ob.w)}; } } }
}
__device__ __forceinline__ float wave_max(float v) {
#pragma unroll
    for (int o = 1; o < 64; o <<= 1) v = fmaxf(v, __shfl_xor(v, o));
    return v;
}
__device__ __forceinline__ void norm_q8_store(f32x4 (&v)[4], const f32x4 (&gv)[4], float r, unsigned char* orow, float* rsp, int lane) {
    float mx = 0.f;
#pragma unroll
    for (int j = 0; j < 4; ++j) { v[j] = v[j] * r * gv[j]; const f32x4 a = __builtin_elementwise_abs(v[j]); mx = fmaxf(mx, fmaxf(fmaxf(a.x, a.y), fmaxf(a.z, a.w))); }
    mx = fmaxf(wave_max(mx), 1e-20f);
    const float sc = 127.f / mx;
#pragma unroll
    for (int j = 0; j < 4; ++j) { const u32 q0 = (u32)(int)__builtin_rintf(v[j].x * sc) & 255u, q1 = (u32)(int)__builtin_rintf(v[j].y * sc) & 255u, q2 = (u32)(int)__builtin_rintf(v[j].z * sc) & 255u, q3 = (u32)(int)__builtin_rintf(v[j].w * sc);
        ((u32*)orow)[lane + 64 * j] = q0 | (q1 << 8) | (q2 << 16) | (q3 << 24); }
    if (lane == 0) *rsp = mx * (1.f / 127.f);
}
__device__ __forceinline__ void norm2_rows_i8(const float* xsrc, const float* g, unsigned char* out8, float* rs, int gw, int ngw, int lane) {
    f32x4 gv[4];
#pragma unroll
    for (int j = 0; j < 4; ++j) gv[j] = ((const f32x4*)g)[lane + 64 * j];
    for (int ml = gw; ml < M; ml += 2 * ngw) { const int m2 = ml + ngw; const bool has2 = m2 < M; const int mb = has2 ? m2 : ml;
        f32x4 va[4], vb[4]; row_load(xsrc + (size_t)ml * D, lane, va); row_load(xsrc + (size_t)mb * D, lane, vb);
        const float ra = __builtin_amdgcn_rsqf(row_ss(va) * (1.f / D) + 1e-6f), rb = __builtin_amdgcn_rsqf(row_ss(vb) * (1.f / D) + 1e-6f);
        norm_q8_store(va, gv, ra, out8 + (size_t)ml * D, rs + ml, lane);
        if (has2) norm_q8_store(vb, gv, rb, out8 + (size_t)m2 * D, rs + m2, lane); }
}
__device__ __forceinline__ void row_add_moe(const Ctx& C, int ml, f32x4 (&v)[4], const LAS int* tb) {
#ifdef DBG_NOMOE
    return;
#endif
    const int* tk = (const int*)(C.ws + WS_TOK) + 4 * ml; const float* wt = (const float*)(C.ws + WS_TOK + 512 * 1024) + 2 * ml;
    const int d0 = tb[tk[0]] * 256 + tk[1], d1 = tb[tk[2]] * 256 + tk[3]; const float w0 = wt[0], w1 = wt[1];
    const bf16* y0 = (const bf16*)(C.ws + WS_R1 + R1_YEXP) + (size_t)d0 * D; const bf16* y1 = (const bf16*)(C.ws + WS_R1 + R1_YEXP) + (size_t)d1 * D;
#pragma unroll
    for (int j = 0; j < 4; ++j) { const u32x2 a = ((const u32x2*)y0)[C.lane + 64 * j], b = ((const u32x2*)y1)[C.lane + 64 * j];
        v[j].x += w0 * bflo(a.x) + w1 * bflo(b.x); v[j].y += w0 * bfhi(a.x) + w1 * bfhi(b.x); v[j].z += w0 * bflo(a.y) + w1 * bflo(b.y); v[j].w += w0 * bfhi(a.y) + w1 * bfhi(b.y); }
}

__device__ __forceinline__ void mixer_norm(const Ctx& C, int it, int widx, int nw) {
    const int l = it / NCH, c = it % NCH;
    norm2_rows_i8((l == 0 ? C.inp(I_X) : C.out) + (size_t)c * M * D, C.inp(I_NORM_MIX) + (size_t)l * D, C.ws + WS_R1 + R1_HNX, (float*)(C.ws + WS_R1 + R1_HNX + HNX_RS), widx, nw, C.lane);
}
__device__ __forceinline__ void moe_table(const Ctx& C, int it, LAS int* tb);
__device__ __forceinline__ void phase_prep(const Ctx& C0, int it, LAS int* tb) {
    const Ctx C = launder(C0);
    if (it > 0) moe_table(C, it - 1, tb);
    const int l = it / NCH, c = it % NCH;
    if (it > 0) {
        const int pl = (it - 1) / NCH, pc = (it - 1) % NCH; const float* nf = C.inp(I_NORM_FINAL);
        const int* tkb = (const int*)(C.ws + WS_TOK); const float* wtb = (const float*)(C.ws + WS_TOK + 512 * 1024); const bf16* yex = (const bf16*)(C.ws + WS_R1 + R1_YEXP);
        int t0 = 0, t1 = 0, t2 = 0, t3 = 0; float w0 = 0.f, w1 = 0.f;
        if (C.gw < M) { const int* tk = tkb + 4 * C.gw; t0 = tk[0]; t1 = tk[1]; t2 = tk[2]; t3 = tk[3]; w0 = wtb[2 * C.gw]; w1 = wtb[2 * C.gw + 1]; }
        for (int ml = C.gw; ml < M; ml += C.ngw) { float* xr = C.out + ((size_t)pc * M + ml) * D; f32x4 v[4];
            const int d0 = tb[t0] * 256 + t1, d1 = tb[t2] * 256 + t3; const float cw0 = w0, cw1 = w1;
            { const int mn = (ml + C.ngw < M) ? ml + C.ngw : ml; const int* tk = tkb + 4 * mn; t0 = tk[0]; t1 = tk[1]; t2 = tk[2]; t3 = tk[3]; w0 = wtb[2 * mn]; w1 = wtb[2 * mn + 1]; }
            row_load(xr, C.lane, v);
            { const bf16* y0 = yex + (size_t)d0 * D; const bf16* y1 = yex + (size_t)d1 * D;
#pragma unroll
              for (int j = 0; j < 4; ++j) { const u32x2 a = ((const u32x2*)y0)[C.lane + 64 * j], b = ((const u32x2*)y1)[C.lane + 64 * j];
                  v[j].x += cw0 * bflo(a.x) + cw1 * bflo(b.x); v[j].y += cw0 * bfhi(a.x) + cw1 * bfhi(b.x); v[j].z += cw0 * bflo(a.y) + cw1 * bflo(b.y); v[j].w += cw0 * bfhi(a.y) + cw1 * bfhi(b.y); } }
            if (pl == 1) { const float rs = __builtin_amdgcn_rsqf(row_ss(v) * (1.f / D) + 1e-6f);
#pragma unroll
                for (int j = 0; j < 4; ++j) v[j] = v[j] * rs * ((const f32x4*)nf)[C.lane + 64 * j]; }
#pragma unroll
            for (int j = 0; j < 4; ++j) ((f32x4*)xr)[C.lane + 64 * j] = v[j]; }
    }
    if (it == 0) mixer_norm(C, 0, C.gw, C.ngw);
}

__device__ __forceinline__ void sub_lora_prep(const Ctx& C0, int l) {
    const Ctx C = launder(C0);
    const bf16* za = (const bf16*)(C.ws + WS_R2 + R2_ZA); const bf16* vlo = (const bf16*)(C.ws + WS_VLO); bf16* al = (bf16*)(C.ws + WS_R1 + R1_ALORA);
    const float* mu = C.inp(I_MU_A) + (size_t)l * A_COLS + 3072; const float* vmu = C.inp(I_VRES_MU);
    const int gt = C.bid * 512 + C.tid, ngt = C.G * 512;
    for (int i = gt; i < M * 48; i += ngt) { const int ml = i / 48, k8 = i % 48; const int t = ml & (T - 1); float v[8];
        if (k8 < 32) { const u32x4 cur = *(const u32x4*)(za + (size_t)ml * A_COLS + 3072 + k8 * 8); u32x4 prv = (u32x4){0u, 0u, 0u, 0u};
            if (t > 0) prv = *(const u32x4*)(za + (size_t)(ml - 1) * A_COLS + 3072 + k8 * 8);
            const u32 cw[4] = {cur.x, cur.y, cur.z, cur.w}, pw[4] = {prv.x, prv.y, prv.z, prv.w};
#pragma unroll
            for (int e = 0; e < 8; ++e) { const float zc = (e & 1) ? bfhi(cw[e >> 1]) : bflo(cw[e >> 1]), zp = (e & 1) ? bfhi(pw[e >> 1]) : bflo(pw[e >> 1]);
                float x = zc + (zp - zc) * mu[k8 * 8 + e];
                if (k8 < 8) x = 1.f - 2.f * __builtin_amdgcn_rcpf(__expf(2.f * x) + 1.f);
                else if (k8 >= 16) x = sigmoidf_(x);
                v[e] = x; }
        } else if (k8 < 36 && l == 1) { const int c8 = k8 - 32; const u32x4 cur = *(const u32x4*)(vlo + (size_t)ml * 32 + c8 * 8); u32x4 prv = (u32x4){0u, 0u, 0u, 0u};
            if (t > 0) prv = *(const u32x4*)(vlo + (size_t)(ml - 1) * 32 + c8 * 8);
            const u32 cw[4] = {cur.x, cur.y, cur.z, cur.w}, pw[4] = {prv.x, prv.y, prv.z, prv.w};
#pragma unroll
            for (int e = 0; e < 8; ++e) { const float zc = (e & 1) ? bfhi(cw[e >> 1]) : bflo(cw[e >> 1]), zp = (e & 1) ? bfhi(pw[e >> 1]) : bflo(pw[e >> 1]);
                v[e] = zc + (zp - zc) * vmu[c8 * 8 + e]; }
        } else {
#pragma unroll
            for (int e = 0; e < 8; ++e) v[e] = 0.f;
        }
        u32x4 o; o.x = cvt_pk_bf16(v[0], v[1]); o.y = cvt_pk_bf16(v[2], v[3]); o.z = cvt_pk_bf16(v[4], v[5]); o.w = cvt_pk_bf16(v[6], v[7]);
        *(u32x4*)(al + (size_t)ml * LORA_K + k8 * 8) = o; }
}

__device__ __forceinline__ void sub_gmlp(const Ctx& C0, int l) {
    const Ctx C = launder(C0);
    const bf16* zc = (const bf16*)(C.ws + WS_R1 + R1_ZC); bf16* yc = (bf16*)(C.ws + WS_YC); const bf16* wsc = (const bf16*)(C.ws + WS_WSC);
    const float* lnw = C.inp(I_SGU_LN_W) + (size_t)l * D; const float* lnb = C.inp(I_SGU_LN_B) + (size_t)l * D; const float* bs = C.inp(I_SGU_BS) + (size_t)l * 8 * 128;
    LAS bf16* VT = (LAS bf16*)C.lds;
    LAS float* ST = (LAS float*)(C.lds + 40960);
    const int lane = C.lane, w = C.wave;
    for (int u = C.bid; u < 256; u += C.G) {
        const int nloc = u >> 1, gq = u & 1; const int r0 = nloc * 128;
#pragma unroll 1
        for (int tb4 = 0; tb4 < 4; ++tb4) { u32x4 ra[4], rb4[4]; float s1[4], s2[4];
#pragma unroll
            for (int q4 = 0; q4 < 4; ++q4) { const bf16* vr = zc + (size_t)(r0 + 16 * w + 4 * tb4 + q4) * C_COLS + 1024; ra[q4] = ((const u32x4*)vr)[lane]; rb4[q4] = ((const u32x4*)vr)[lane + 64]; }
#pragma unroll
            for (int q4 = 0; q4 < 4; ++q4) { const u32 q[8] = {ra[q4].x, ra[q4].y, ra[q4].z, ra[q4].w, rb4[q4].x, rb4[q4].y, rb4[q4].z, rb4[q4].w}; float a = 0.f, b = 0.f;
#pragma unroll
                for (int e = 0; e < 8; ++e) { const float x0 = bflo(q[e]), x1 = bfhi(q[e]); a += x0 + x1; b += x0 * x0 + x1 * x1; }
                s1[q4] = a; s2[q4] = b; }
#pragma unroll
            for (int o = 1; o < 64; o <<= 1) {
#pragma unroll
                for (int q4 = 0; q4 < 4; ++q4) { const float t1 = __shfl_xor(s1[q4], o), t2 = __shfl_xor(s2[q4], o); s1[q4] += t1; s2[q4] += t2; } }
            if (lane == 0) {
#pragma unroll
                for (int q4 = 0; q4 < 4; ++q4) { const int tk = 16 * w + 4 * tb4 + q4; const float mean = s1[q4] * (1.f / 1024.f); const float var = fmaxf(s2[q4] * (1.f / 1024.f) - mean * mean, 0.f);
                    ST[2 * tk] = mean; ST[2 * tk + 1] = __builtin_amdgcn_rsqf(var + 1e-5f); } } }
        __syncthreads();
        u32x4 gr[4];
#define GM_ISSUE(g_) do { _Pragma("unroll") for (int p_ = 0; p_ < 4; ++p_) { const int idx_ = C.tid + 512 * p_; gr[p_] = *(const u32x4*)(zc + (size_t)(r0 + (idx_ >> 4)) * C_COLS + 1024 + (g_) * 128 + (idx_ & 15) * 8); } } while (0)
        GM_ISSUE(gq * 4);
        for (int gi = 0; gi < 4; ++gi) { const int g = gq * 4 + gi;
#pragma unroll
            for (int p = 0; p < 4; ++p) { const int idx = C.tid + 512 * p; const int tk = idx >> 4, c8 = idx & 15;
                const u32 q[4] = {gr[p].x, gr[p].y, gr[p].z, gr[p].w};
                const float mean = ST[2 * tk], rstd = ST[2 * tk + 1];
#pragma unroll
                for (int e = 0; e < 8; ++e) { const int cc = c8 * 8 + e; const float x = (e & 1) ? bfhi(q[e >> 1]) : bflo(q[e >> 1]);
                    const float y = (x - mean) * rstd * lnw[g * 128 + cc] + lnb[g * 128 + cc];
                    VT[cc * 136 + ((((tk >> 3) + c8) & 15) << 3) + (tk & 7)] = (bf16)f2bf(y); } }
            asm volatile("" ::: "memory");
            if (gi < 3) GM_ISSUE(g + 1);
            __syncthreads();
            const int ct = w & 3, th = w >> 2;
#pragma unroll 1
            for (int tq = 0; tq < 2; ++tq) { const int tau = 2 * th + tq; f32x16 acc;
#pragma unroll
                for (int e = 0; e < 16; ++e) acc[e] = 0.f;
                const int nks = 2 * tau + 2; const int crow = ct * 32 + (lane & 31); const bf16* wrow = wsc + ((size_t)g * 128 + tau * 32 + (lane & 31)) * 128 + (lane >> 5) * 8;
                bf16x8 bb[8];
#pragma unroll
                for (int ks = 0; ks < 8; ++ks) if (ks < nks) bb[ks] = *(const bf16x8*)(wrow + ks * 16);
#pragma unroll
                for (int ks = 0; ks < 8; ++ks) if (ks < nks) { const int s0 = ks * 16 + (lane >> 5) * 8;
                    const bf16x8 a = *(const LAS bf16x8*)(VT + crow * 136 + ((((s0 >> 3) + (crow >> 3)) & 15) << 3));
                    acc = __builtin_amdgcn_mfma_f32_32x32x16_bf16(a, bb[ks], acc, 0, 0, 0); }
                const int tk = tau * 32 + (lane & 31); const float bsv = bs[g * 128 + tk];
                const bf16* ur = zc + (size_t)(r0 + tk) * C_COLS + g * 128 + ct * 32; bf16* yr = yc + (size_t)(r0 + tk) * D + g * 128 + ct * 32;
#pragma unroll
                for (int rq = 0; rq < 4; ++rq) { const int cb = 8 * rq + 4 * (lane >> 5); const u32x2 uu = *(const u32x2*)(ur + cb);
                    const float o0 = bflo(uu.x) * (acc[4 * rq + 0] + bsv), o1 = bfhi(uu.x) * (acc[4 * rq + 1] + bsv), o2 = bflo(uu.y) * (acc[4 * rq + 2] + bsv), o3 = bfhi(uu.y) * (acc[4 * rq + 3] + bsv);
                    *(u32x2*)(yr + cb) = (u32x2){cvt_pk_bf16(o0, o1), cvt_pk_bf16(o2, o3)}; } }
            __syncthreads();
        }
    }
}

__device__ __forceinline__ void sub_attn(const Ctx& C0) {
    const Ctx C = launder(C0);
    const bf16* zb = (const bf16*)(C.ws + WS_R1 + R1_ZB); bf16* og = (bf16*)(C.ws + WS_R1 + R1_OG); float* lse = (float*)(C.ws + WS_LSE); const f32x2* rope = (const f32x2*)(C.ws + WS_ROPE);
    LAS bf16* Qs = (LAS bf16*)C.lds;
    LAS bf16* Ks = (LAS bf16*)(C.lds + 18432);
    LAS bf16* Vs = (LAS bf16*)(C.lds + 18432 + 36864);
    const int lane = C.lane, w = C.wave, fr = lane & 15, fq = lane >> 4;
    u32x4 rqa, rqb, rka[2], rkb[2], rv[4];
#define AT_DECODE(u_, bl_, hd_, gi_, d_, r_, n_) const int bl_ = (u_) / 768, rem_##bl_ = (u_) % 768, hd_ = rem_##bl_ / 64, blk_##bl_ = rem_##bl_ % 64; \
        const int gi_ = hd_ >> 2, d_ = (gi_ == 0) ? 1 : (gi_ == 1 ? 4 : 16), nb_##bl_ = 64 / d_, r_ = blk_##bl_ / nb_##bl_, n_ = blk_##bl_ % nb_##bl_
#define AT_ISSUE(u_) do { AT_DECODE(u_, xbl, xhd, xgi, xd, xr, xn); const int rb_ = xbl * T; const u32x4 z4_ = (u32x4){0u, 0u, 0u, 0u}; \
        { const int row_ = C.tid >> 2, c0_ = (C.tid & 3) * 8; const int t_ = (128 * xn + row_) * xd + xr; const bf16* s_ = zb + (size_t)(rb_ + t_) * B_COLS + xhd * 64; rqa = *(const u32x4*)(s_ + c0_); rqb = *(const u32x4*)(s_ + 32 + c0_); } \
        _Pragma("unroll") for (int p_ = 0; p_ < 2; ++p_) { const int row_ = (C.tid >> 2) + 128 * p_, c0_ = (C.tid & 3) * 8; const int ms_ = 128 * (xn - 1) + row_; rka[p_] = z4_; rkb[p_] = z4_; \
            if (ms_ >= 0) { const int t_ = ms_ * xd + xr; const bf16* s_ = zb + (size_t)(rb_ + t_) * B_COLS + 768 + xhd * 64; rka[p_] = *(const u32x4*)(s_ + c0_); rkb[p_] = *(const u32x4*)(s_ + 32 + c0_); } } \
        _Pragma("unroll") for (int p_ = 0; p_ < 4; ++p_) { const int idx_ = C.tid + 512 * p_; const int row_ = idx_ >> 3, c8_ = idx_ & 7; const int ms_ = 128 * (xn - 1) + row_; rv[p_] = z4_; \
            if (ms_ >= 0) { const int t_ = ms_ * xd + xr; rv[p_] = *(const u32x4*)(zb + (size_t)(rb_ + t_) * B_COLS + 1536 + xhd * 64 + c8_ * 8); } } } while (0)
    if (C.bid < 1536) AT_ISSUE(C.bid);
    for (int u = C.bid; u < 1536; u += C.G) {
        AT_DECODE(u, bl, hd, gi, d, r, n);
        const int rowbase = bl * T;
        { const int row = C.tid >> 2, c0 = (C.tid & 3) * 8; const int t = (128 * n + row) * d + r;
            const u32 qa[4] = {rqa.x, rqa.y, rqa.z, rqa.w}, qb[4] = {rqb.x, rqb.y, rqb.z, rqb.w}; float o1[8], o2[8];
#pragma unroll
            for (int e = 0; e < 8; ++e) { const f32x2 cs = rope[t * 32 + c0 + e]; const float z1 = (e & 1) ? bfhi(qa[e >> 1]) : bflo(qa[e >> 1]), z2 = (e & 1) ? bfhi(qb[e >> 1]) : bflo(qb[e >> 1]);
                o1[e] = (z1 * cs.x - z2 * cs.y) * 0.125f; o2[e] = (z1 * cs.y + z2 * cs.x) * 0.125f; }
            *(LAS u32x4*)(Qs + row * 72 + c0) = (u32x4){cvt_pk_bf16(o1[0], o1[1]), cvt_pk_bf16(o1[2], o1[3]), cvt_pk_bf16(o1[4], o1[5]), cvt_pk_bf16(o1[6], o1[7])};
            *(LAS u32x4*)(Qs + row * 72 + 32 + c0) = (u32x4){cvt_pk_bf16(o2[0], o2[1]), cvt_pk_bf16(o2[2], o2[3]), cvt_pk_bf16(o2[4], o2[5]), cvt_pk_bf16(o2[6], o2[7])}; }
#pragma unroll
        for (int p = 0; p < 2; ++p) { const int row = (C.tid >> 2) + 128 * p, c0 = (C.tid & 3) * 8; const int ms = 128 * (n - 1) + row; u32x4 oa = (u32x4){0u, 0u, 0u, 0u}, ob = oa;
            if (ms >= 0) { const int t = ms * d + r;
                const u32 qa[4] = {rka[p].x, rka[p].y, rka[p].z, rka[p].w}, qb[4] = {rkb[p].x, rkb[p].y, rkb[p].z, rkb[p].w}; float o1[8], o2[8];
#pragma unroll
                for (int e = 0; e < 8; ++e) { const f32x2 cs = rope[t * 32 + c0 + e]; const float z1 = (e & 1) ? bfhi(qa[e >> 1]) : bflo(qa[e >> 1]), z2 = (e & 1) ? bfhi(qb[e >> 1]) : bflo(qb[e >> 1]);
                    o1[e] = z1 * cs.x - z2 * cs.y; o2[e] = z1 * cs.y + z2 * cs.x; }
                oa = (u32x4){cvt_pk_bf16(o1[0], o1[1]), cvt_pk_bf16(o1[2], o1[3]), cvt_pk_bf16(o1[4], o1[5]), cvt_pk_bf16(o1[6], o1[7])};
                ob = (u32x4){cvt_pk_bf16(o2[0], o2[1]), cvt_pk_bf16(o2[2], o2[3]), cvt_pk_bf16(o2[4], o2[5]), cvt_pk_bf16(o2[6], o2[7])}; }
            *(LAS u32x4*)(Ks + row * 72 + c0) = oa; *(LAS u32x4*)(Ks + row * 72 + 32 + c0) = ob; }
#pragma unroll
        for (int p = 0; p < 4; ++p) { const int idx = C.tid + 512 * p; const int row = idx >> 3, c8 = idx & 7;
            *(LAS u32x4*)(Vs + row * 72 + c8 * 8) = rv[p]; }
        asm volatile("" ::: "memory");
        if (u + C.G < 1536) AT_ISSUE(u + C.G);
        __syncthreads();
        f32x4 sc[9];
        { const bf16x8 q0 = *(const LAS bf16x8*)(Qs + (16 * w + fr) * 72 + fq * 8), q1 = *(const LAS bf16x8*)(Qs + (16 * w + fr) * 72 + 32 + fq * 8);
#pragma unroll
            for (int ti = 0; ti < 9; ++ti) { const int kr = 16 * w + 16 * ti + fr;
                const bf16x8 k0 = *(const LAS bf16x8*)(Ks + kr * 72 + fq * 8), k1 = *(const LAS bf16x8*)(Ks + kr * 72 + 32 + fq * 8);
                f32x4 a = (f32x4){0.f, 0.f, 0.f, 0.f};
                a = __builtin_amdgcn_mfma_f32_16x16x32_bf16(k0, q0, a, 0, 0, 0); a = __builtin_amdgcn_mfma_f32_16x16x32_bf16(k1, q1, a, 0, 0, 0); sc[ti] = a; } }
        float mx = -3.0e38f;
#pragma unroll
        for (int ti = 0; ti < 9; ++ti)
#pragma unroll
            for (int e = 0; e < 4; ++e) { const int rel = 16 * ti + 4 * fq + e; const bool ok = (rel >= fr) && (rel <= fr + 128) && (n > 0 || (16 * w + rel) >= 128);
                sc[ti][e] = ok ? sc[ti][e] : -3.0e38f; mx = fmaxf(mx, sc[ti][e]); }
        mx = fmaxf(mx, __shfl_xor(mx, 16)); mx = fmaxf(mx, __shfl_xor(mx, 32));
        float sum = 0.f;
#pragma unroll
        for (int ti = 0; ti < 9; ++ti)
#pragma unroll
            for (int e = 0; e < 4; ++e) { const float p = __expf(sc[ti][e] - mx); sc[ti][e] = p; sum += p; }
        sum += __shfl_xor(sum, 16); sum += __shfl_xor(sum, 32);
        f32x4 oacc[4];
#pragma unroll
        for (int ct = 0; ct < 4; ++ct) oacc[ct] = (f32x4){0.f, 0.f, 0.f, 0.f};
#pragma unroll
        for (int kp = 0; kp < 5; ++kp) { const int t0 = 2 * kp, t1 = (2 * kp + 1 < 9) ? 2 * kp + 1 : 8;
            u32x4 pw; pw.x = cvt_pk_bf16(sc[t0][0], sc[t0][1]); pw.y = cvt_pk_bf16(sc[t0][2], sc[t0][3]);
            if (2 * kp + 1 < 9) { pw.z = cvt_pk_bf16(sc[t1][0], sc[t1][1]); pw.w = cvt_pk_bf16(sc[t1][2], sc[t1][3]); } else { pw.z = 0u; pw.w = 0u; }
            const bf16x8 pb = __builtin_bit_cast(bf16x8, pw);
            const int k0 = 16 * w + 16 * t0 + 4 * fq, k1 = 16 * w + 16 * t1 + 4 * fq;
#pragma unroll
            for (int ct = 0; ct < 4; ++ct) {
                const u32x2 va = lds_tr16(Vs + (k0 + (fr >> 2)) * 72 + ct * 16 + 4 * (fr & 3)), vb = lds_tr16(Vs + (k1 + (fr >> 2)) * 72 + ct * 16 + 4 * (fr & 3));
                const bf16x8 av = __builtin_bit_cast(bf16x8, (u32x4){va.x, va.y, vb.x, vb.y});
                oacc[ct] = __builtin_amdgcn_mfma_f32_16x16x32_bf16(av, pb, oacc[ct], 0, 0, 0); } }
        { const float inv = __builtin_amdgcn_rcpf(sum); const int t = (128 * n + 16 * w + fr) * d + r; const size_t ml = (size_t)(rowbase + t);
            bf16* orow = og + ((size_t)gi * M + ml) * 256 + (hd & 3) * 64;
#pragma unroll
            for (int ct = 0; ct < 4; ++ct) *(u32x2*)(orow + ct * 16 + 4 * fq) = (u32x2){cvt_pk_bf16(oacc[ct][0] * inv, oacc[ct][1] * inv), cvt_pk_bf16(oacc[ct][2] * inv, oacc[ct][3] * inv)};
            if (fq == 0) lse[((size_t)gi * M + ml) * 4 + (hd & 3)] = mx + __logf(sum); }
        __syncthreads();
    }
}

__device__ __forceinline__ void sub_yb_combine(const Ctx& C0) {
    const Ctx C = launder(C0);
    const bf16* og = (const bf16*)(C.ws + WS_R1 + R1_OG); const float* lse = (const float*)(C.ws + WS_LSE); bf16* yb = (bf16*)(C.ws + WS_YB);
    const int gt = C.bid * 512 + C.tid, ngt = C.G * 512;
    for (int i = gt; i < M * 32; i += ngt) { const int ml = i >> 5, c8 = i & 31, hp = c8 >> 3;
        const float l0 = lse[((size_t)0 * M + ml) * 4 + hp], l1 = lse[((size_t)1 * M + ml) * 4 + hp], l2 = lse[((size_t)2 * M + ml) * 4 + hp];
        const float mx = fmaxf(l0, fmaxf(l1, l2)); float w0 = __expf(l0 - mx), w1 = __expf(l1 - mx), w2 = __expf(l2 - mx); const float inv = __builtin_amdgcn_rcpf(w0 + w1 + w2); w0 *= inv; w1 *= inv; w2 *= inv;
        const u32x4 a = *(const u32x4*)(og + ((size_t)0 * M + ml) * 256 + c8 * 8), b = *(const u32x4*)(og + ((size_t)1 * M + ml) * 256 + c8 * 8), c = *(const u32x4*)(og + ((size_t)2 * M + ml) * 256 + c8 * 8);
        const u32 qa[4] = {a.x, a.y, a.z, a.w}, qb[4] = {b.x, b.y, b.z, b.w}, qc[4] = {c.x, c.y, c.z, c.w}; u32 o[4];
#pragma unroll
        for (int e = 0; e < 4; ++e) o[e] = cvt_pk_bf16(w0 * bflo(qa[e]) + w1 * bflo(qb[e]) + w2 * bflo(qc[e]), w0 * bfhi(qa[e]) + w1 * bfhi(qb[e]) + w2 * bfhi(qc[e]));
        *(u32x4*)(yb + (size_t)ml * 256 + c8 * 8) = (u32x4){o[0], o[1], o[2], o[3]}; }
}

__device__ __forceinline__ void ld8(const bf16* p, float (&v)[8]) { const u32x4 a = *(const u32x4*)p; v[0] = bflo(a.x); v[1] = bfhi(a.x); v[2] = bflo(a.y); v[3] = bfhi(a.y); v[4] = bflo(a.z); v[5] = bfhi(a.z); v[6] = bflo(a.w); v[7] = bfhi(a.w); }
__device__ __forceinline__ void ldl8(const LAS float* p, float (&v)[8]) { const f32x4 a = *(const LAS f32x4*)p, b = *(const LAS f32x4*)(p + 4); v[0] = a.x; v[1] = a.y; v[2] = a.z; v[3] = a.w; v[4] = b.x; v[5] = b.y; v[6] = b.z; v[7] = b.w; }
__device__ __forceinline__ void ldf8(const float* p, float (&v)[8]) { const f32x4 a = *(const f32x4*)p, b = *(const f32x4*)(p + 4); v[0] = a.x; v[1] = a.y; v[2] = a.z; v[3] = a.w; v[4] = b.x; v[5] = b.y; v[6] = b.z; v[7] = b.w; }
constexpr int TS = 9216;
template <int KS, bool SW1, bool SW2>
__device__ __forceinline__ f32x16 mm_tile(const LAS bf16* t1, int r1, const LAS bf16* t2, int r2, f32x16 acc, int lane) {
    const int row1 = r1 + (lane & 31), row2 = r2 + (lane & 31), hb = lane >> 5;
    const LAS bf16* p1 = t1 + row1 * 72; const LAS bf16* p2 = t2 + row2 * 72; const int s1 = SW1 ? (row1 >> 3) : 0, s2 = SW2 ? (row2 >> 3) : 0;
#pragma unroll
    for (int ks = 0; ks < KS; ++ks) { const int cb = 2 * ks + hb;
        acc = __builtin_amdgcn_mfma_f32_32x32x16_bf16(*(const LAS bf16x8*)(p1 + ((cb + s1) & 7) * 8), *(const LAS bf16x8*)(p2 + ((cb + s2) & 7) * 8), acc, 0, 0, 0); }
    return acc;
}
__device__ __forceinline__ f32x16 zero16() { f32x16 a;
#pragma unroll
    for (int e = 0; e < 16; ++e) a[e] = 0.f;
    return a; }

__device__ __forceinline__ void phase_chunkpre(const Ctx& C0, int l, int c) {
    const Ctx C = launder(C0);
    LAS unsigned char* L = C.lds;
    LAS bf16* sA = (LAS bf16*)(L + 0 * TS);  LAS bf16* sR = (LAS bf16*)(L + 1 * TS);  LAS bf16* sB = (LAS bf16*)(L + 2 * TS);  LAS bf16* sK = (LAS bf16*)(L + 3 * TS);
    LAS bf16* sBhT = (LAS bf16*)(L + 4 * TS); LAS bf16* sKhT = (LAS bf16*)(L + 5 * TS); LAS bf16* sVT = (LAS bf16*)(L + 6 * TS); LAS bf16* sAT = (LAS bf16*)(L + 7 * TS);
    LAS bf16* sUT = (LAS bf16*)(L + 8 * TS); LAS bf16* sAab = (LAS bf16*)(L + 9 * TS);
    LAS bf16* sPT = (LAS bf16*)(L + 0 * TS);
    LAS bf16* sAak = (LAS bf16*)(L + 10 * TS); LAS bf16* sArb = (LAS bf16*)(L + 11 * TS); LAS bf16* sArk = (LAS bf16*)(L + 12 * TS);
    LAS float* TOT = (LAS float*)(L + 13 * TS);
    LAS bf16* TBB = (LAS bf16*)(L + 13 * TS + 2048);
    LAS float* WC = (LAS float*)(L + 13 * TS + 2048 + 4352);
    LAS float* PAR = (LAS float*)(L + 13 * TS + 2048 + 4352 + 256);
    LAS bf16* sZT = sB;
    const int tid = C.tid, w = C.wave;
    const bf16* ZAg = (const bf16*)(C.ws + WS_R2 + R2_ZA); const bf16* WPg = (const bf16*)(C.ws + WS_R4 + R4_WPRE); const bf16* APg = (const bf16*)(C.ws + WS_R4 + R4_APRE); const bf16* VRg = (const bf16*)(C.ws + WS_R4 + R4_VPRE);
    bf16* VFg = (bf16*)(C.ws + WS_VFIRST) + (size_t)c * M * D; bf16* VPg = (bf16*)(C.ws + WS_VP); float* BNg = (float*)(C.ws + WS_BONUS);
    bf16* YLg = (bf16*)(C.ws + WS_R1 + R1_YLOC); bf16* Qg = (bf16*)(C.ws + WS_R1 + R1_Q); bf16* MTg = (bf16*)(C.ws + WS_R1 + R1_MT); bf16* NCg = (bf16*)(C.ws + WS_R1 + R1_NC);
    const float* mu = C.inp(I_MU_A) + (size_t)l * A_COLS;
    u32x4 qr, qk, qv, qrp, qkp, qvp, qw, qa, qvr, qvf;
#define CP_ISSUE(u_) do { const int bh_ = (u_) / NCHK, ck_ = (u_) % NCHK; const size_t row_ = (size_t)(bh_ >> 4) * T + ck_ * CHK + (tid >> 3); const int chn_ = (bh_ & 15) * 64 + (tid & 7) * 8; \
        const bf16* z_ = ZAg + row_ * A_COLS + chn_; const bool hp_ = (ck_ * CHK + (tid >> 3)) > 0; const u32x4 zero_ = (u32x4){0u, 0u, 0u, 0u}; \
        qr = *(const u32x4*)z_; qk = *(const u32x4*)(z_ + 1024); qv = *(const u32x4*)(z_ + 2048); \
        qrp = hp_ ? *(const u32x4*)(z_ - A_COLS) : zero_; qkp = hp_ ? *(const u32x4*)(z_ - A_COLS + 1024) : zero_; qvp = hp_ ? *(const u32x4*)(z_ - A_COLS + 2048) : zero_; \
        qw = *(const u32x4*)(WPg + row_ * D + chn_); qa = *(const u32x4*)(APg + row_ * D + chn_); \
        if (l == 1) { qvr = *(const u32x4*)(VRg + row_ * D + chn_); qvf = *(const u32x4*)(VFg + row_ * D + chn_); } } while (0)
#define CP_UNPK(v_, q_) do { v_[0] = bflo(q_.x); v_[1] = bfhi(q_.x); v_[2] = bflo(q_.y); v_[3] = bfhi(q_.y); v_[4] = bflo(q_.z); v_[5] = bfhi(q_.z); v_[6] = bflo(q_.w); v_[7] = bfhi(q_.w); } while (0)
    qvr = qvf = (u32x4){0u, 0u, 0u, 0u};
    const int UPB = (32 * NCHK + C.G - 1) / C.G; const int u_lo = C.bid * UPB, u_hi = (u_lo + UPB < 32 * NCHK) ? u_lo + UPB : 32 * NCHK;
    if (u_lo < u_hi) CP_ISSUE(u_lo);
    int par_bh = -1;
#pragma unroll 1
    for (int unit = u_lo; unit < u_hi; ++unit) {
        const int bh = unit / NCHK, ck = unit % NCHK, bl = bh >> 4, h = bh & 15; const size_t row0 = (size_t)bl * T + ck * CHK;
        int lane = C.lane; asm volatile("" : "+v"(lane));
        if (bh != par_bh) { par_bh = bh; __syncthreads();
            for (int i = tid; i < 9 * 64; i += 512) { const int k9 = i >> 6, jj = i & 63, chn = h * 64 + jj; float v;
                if (k9 < 3) v = mu[k9 * 1024 + chn]; else if (k9 == 3) v = C.inp(I_W_DECAY0)[(size_t)l * D + chn]; else if (k9 == 4) v = C.inp(I_A0)[(size_t)l * D + chn];
                else if (k9 == 5) v = C.inp(I_K_K)[(size_t)l * D + chn]; else if (k9 == 6) v = C.inp(I_K_A)[(size_t)l * D + chn]; else if (k9 == 7) v = C.inp(I_R_K)[(size_t)l * D + chn];
                else v = (l == 1) ? C.inp(I_VRES_B)[chn] : 0.f;
                PAR[i] = v; }
            __syncthreads(); }
        { const int t = tid >> 3, o = tid & 7, j0 = o * 8; const int ch = h * 64 + j0; const size_t row = row0 + t;
          float lw[8], av[8], bv[8], kv[8], rv[8], vv[8], Lc[8];
          { float tmp[8], p[8], kk[8], aa[8];
            CP_UNPK(rv, qr); CP_UNPK(tmp, qrp); ldl8(PAR + 0 * 64 + j0, p);
#pragma unroll
            for (int e = 0; e < 8; ++e) rv[e] = rv[e] + (tmp[e] - rv[e]) * p[e];
            CP_UNPK(kv, qk); CP_UNPK(tmp, qkp); ldl8(PAR + 1 * 64 + j0, p);
#pragma unroll
            for (int e = 0; e < 8; ++e) kv[e] = kv[e] + (tmp[e] - kv[e]) * p[e];
            CP_UNPK(vv, qv); CP_UNPK(tmp, qvp); ldl8(PAR + 2 * 64 + j0, p);
#pragma unroll
            for (int e = 0; e < 8; ++e) vv[e] = vv[e] + (tmp[e] - vv[e]) * p[e];
            if (l == 0) { *(u32x4*)(VFg + row * D + ch) = (u32x4){cvt_pk_bf16(vv[0], vv[1]), cvt_pk_bf16(vv[2], vv[3]), cvt_pk_bf16(vv[4], vv[5]), cvt_pk_bf16(vv[6], vv[7])}; }
            else { float vf[8], vb[8]; CP_UNPK(vf, qvf); CP_UNPK(tmp, qvr); ldl8(PAR + 8 * 64 + j0, vb);
#pragma unroll
                for (int e = 0; e < 8; ++e) vv[e] = vv[e] + (vf[e] - vv[e]) * sigmoidf_(vb[e] + tmp[e]); }
            const u32x4 vpk = (u32x4){cvt_pk_bf16(vv[0], vv[1]), cvt_pk_bf16(vv[2], vv[3]), cvt_pk_bf16(vv[4], vv[5]), cvt_pk_bf16(vv[6], vv[7])};
            *(u32x4*)(VPg + row * D + ch) = vpk; CP_UNPK(vv, vpk);
            CP_UNPK(tmp, qw); ldl8(PAR + 3 * 64 + j0, p);
#pragma unroll
            for (int e = 0; e < 8; ++e) { const float x = -(p[e] + tmp[e]); const float sp = fmaxf(x, 0.f) + __logf(1.f + __expf(-fabsf(x))); lw[e] = -__expf(-sp - 0.5f); }
            CP_UNPK(tmp, qa); ldl8(PAR + 4 * 64 + j0, p);
#pragma unroll
            for (int e = 0; e < 8; ++e) aa[e] = sigmoidf_(p[e] + tmp[e]);
            ldl8(PAR + 5 * 64 + j0, p); float ss = 0.f;
#pragma unroll
            for (int e = 0; e < 8; ++e) { kk[e] = kv[e] * p[e]; ss += kk[e] * kk[e]; }
            ss += __shfl_xor(ss, 1); ss += __shfl_xor(ss, 2); ss += __shfl_xor(ss, 4);
            const float kn = 1.0f / fmaxf(sqrtf(ss), 1e-12f);
            ldl8(PAR + 6 * 64 + j0, p); ldl8(PAR + 7 * 64 + j0, tmp); float bs = 0.f;
#pragma unroll
            for (int e = 0; e < 8; ++e) { kk[e] *= kn; kv[e] = kv[e] * (1.f + (aa[e] - 1.f) * p[e]); bs += rv[e] * kv[e] * tmp[e]; av[e] = -kk[e]; bv[e] = kk[e] * aa[e]; }
            bs += __shfl_xor(bs, 1); bs += __shfl_xor(bs, 2); bs += __shfl_xor(bs, 4);
            if (o == 0) BNg[row * 16 + h] = bs;
          }
#pragma unroll
          for (int e = 0; e < 8; ++e) { float x = lw[e]; float y;
              y = __shfl_up(x, 8); if (lane >= 8) x += y; y = __shfl_up(x, 16); if (lane >= 16) x += y; y = __shfl_up(x, 32); if (lane >= 32) x += y; Lc[e] = x; }
          if (lane >= 56) {
#pragma unroll
              for (int e = 0; e < 8; ++e) TOT[w * 64 + j0 + e] = Lc[e]; }
          __syncthreads();
          float LC[8];
#pragma unroll
          for (int e = 0; e < 8; ++e) { float off = 0.f, tot = 0.f;
#pragma unroll
              for (int q = 0; q < 8; ++q) { const float x = TOT[q * 64 + j0 + e]; tot += x; off += (q < w) ? x : 0.f; }
              Lc[e] += off; LC[e] = tot; }
          float ta[8], tr[8], tb[8], tk[8], hb[8], hk[8];
#pragma unroll
          for (int e = 0; e < 8; ++e) { const float eL = __expf(Lc[e]), emL = __expf(-Lc[e]), eLm = __expf(Lc[e] - lw[e]), eh = __expf(LC[e] - Lc[e]);
              ta[e] = av[e] * eLm; tr[e] = rv[e] * eL; tb[e] = bv[e] * emL; tk[e] = kv[e] * emL; hb[e] = bv[e] * eh; hk[e] = kv[e] * eh; }
          *(LAS u32x4*)(sA + t * 72 + j0) = (u32x4){cvt_pk_bf16(ta[0], ta[1]), cvt_pk_bf16(ta[2], ta[3]), cvt_pk_bf16(ta[4], ta[5]), cvt_pk_bf16(ta[6], ta[7])};
          *(LAS u32x4*)(sR + t * 72 + j0) = (u32x4){cvt_pk_bf16(tr[0], tr[1]), cvt_pk_bf16(tr[2], tr[3]), cvt_pk_bf16(tr[4], tr[5]), cvt_pk_bf16(tr[6], tr[7])};
          *(LAS u32x4*)(sB + t * 72 + j0) = (u32x4){cvt_pk_bf16(tb[0], tb[1]), cvt_pk_bf16(tb[2], tb[3]), cvt_pk_bf16(tb[4], tb[5]), cvt_pk_bf16(tb[6], tb[7])};
          *(LAS u32x4*)(sK + t * 72 + j0) = (u32x4){cvt_pk_bf16(tk[0], tk[1]), cvt_pk_bf16(tk[2], tk[3]), cvt_pk_bf16(tk[4], tk[5]), cvt_pk_bf16(tk[6], tk[7])};
#pragma unroll
          for (int e = 0; e < 8; ++e) { const int ad = (j0 + e) * 72 + ((((t >> 3) + o) & 7) << 3) + (t & 7); sAT[ad] = (bf16)f2bf(ta[e]); sBhT[ad] = (bf16)f2bf(hb[e]); sKhT[ad] = (bf16)f2bf(hk[e]); sVT[ad] = (bf16)f2bf(vv[e]); }
          if (t == 0) {
#pragma unroll
              for (int e = 0; e < 8; ++e) WC[j0 + e] = __expf(LC[e]); }
          asm volatile("" ::: "memory");
          if (unit + 1 < u_hi) CP_ISSUE(unit + 1);
        }
        __syncthreads();
        { const int mq = w >> 1, tt = w & 1; const LAS bf16* o1b = (mq & 1) ? sK : sB; const LAS bf16* o2b = (mq & 2) ? sR : sA; const bool incl = (mq & 2) != 0;
          LAS bf16* dst = (mq == 0) ? sAab : ((mq == 1) ? sAak : (mq == 2 ? sArb : sArk));
#pragma unroll
          for (int mt = 0; mt < 2; ++mt) { f32x16 acc = zero16();
              if (mt <= tt) acc = mm_tile<4, false, false>(o1b, mt * 32, o2b, tt * 32, acc, lane);
              const int tg = tt * 32 + (lane & 31);
#pragma unroll
              for (int rq = 0; rq < 4; ++rq) { const int tau0 = mt * 32 + 8 * rq + 4 * (lane >> 5); float v4[4];
#pragma unroll
                  for (int e = 0; e < 4; ++e) { const int tau = tau0 + e; const bool keep = incl ? (tau <= tg) : (tau < tg); v4[e] = keep ? acc[4 * rq + e] : 0.f; }
                  *(LAS u32x2*)(dst + tg * 72 + tau0) = (u32x2){cvt_pk_bf16(v4[0], v4[1]), cvt_pk_bf16(v4[2], v4[3])}; } } }
        __syncthreads();
        if (w < 4) { if (lane < 16) { const int b0 = 16 * w; float tc[16];
#pragma unroll
            for (int r = 0; r < 16; ++r) tc[r] = (r == lane) ? 1.f : 0.f;
#pragma unroll
            for (int q = 0; q < 15; ++q) { const float tq = tc[q];
#pragma unroll
                for (int r = q + 1; r < 16; ++r) tc[r] += bf2f(sAab[(b0 + r) * 72 + b0 + q]) * tq; }
#pragma unroll
            for (int r = 0; r < 16; ++r) TBB[(w * 16 + r) * 16 + lane] = (bf16)f2bf(tc[r]); } }
        else { const int tt = w & 1, itl = (w >> 1) & 1; f32x16 acc = zero16();
            acc = mm_tile<4, false, true>(sAak, tt * 32, sVT, itl * 32, acc, lane);
            const int i = itl * 32 + (lane & 31);
#pragma unroll
            for (int rq = 0; rq < 4; ++rq) { const int t0 = tt * 32 + 8 * rq + 4 * (lane >> 5);
                *(LAS u32x2*)(sZT + i * 72 + t0) = (u32x2){cvt_pk_bf16(acc[4 * rq], acc[4 * rq + 1]), cvt_pk_bf16(acc[4 * rq + 2], acc[4 * rq + 3])}; } }
        __syncthreads();
        { const int fr = lane & 15, fq = lane >> 4; LAS bf16* xt = ((w < 4) ? sUT : sPT) + ((w & 3) * 16) * 72;
          const int zr = (w & 3) * 16 + fr;
          { u32 zz_ = 0u; asm volatile("" : "+v"(zz_)); const u32x4 z4 = (u32x4){zz_, zz_, zz_, zz_};
            *(LAS u32x4*)(xt + (lane >> 2) * 72 + (lane & 3) * 16) = z4; *(LAS u32x4*)(xt + (lane >> 2) * 72 + (lane & 3) * 16 + 8) = z4; }
          LDS_WAIT();
#pragma unroll
          for (int b = 0; b < 4; ++b) { const int t0 = 16 * b + 4 * fq;
              u32x2 zq;
              if (w < 4) zq = *(const LAS u32x2*)(sZT + zr * 72 + t0); else zq = *(const LAS u32x2*)(sAT + zr * 72 + ((((t0 >> 3) + (zr >> 3)) & 7) << 3) + (t0 & 7));
              f32x4 acc = (f32x4){bflo(zq.x), bfhi(zq.x), bflo(zq.y), bfhi(zq.y)};
              if (b > 0) {
#pragma unroll
                  for (int ks = 0; ks < (b + 1) / 2; ++ks) { const bf16x8 oa = *(const LAS bf16x8*)(sAab + (16 * b + fr) * 72 + 32 * ks + 8 * fq), ox = *(const LAS bf16x8*)(xt + fr * 72 + 32 * ks + 8 * fq);
                      acc = __builtin_amdgcn_mfma_f32_16x16x32_bf16(oa, ox, acc, 0, 0, 0); } }
              const u32x2 tq = *(const LAS u32x2*)(TBB + (b * 16 + fr) * 16 + 4 * fq);
              const bf16x8 ot = __builtin_bit_cast(bf16x8, (u32x4){tq.x, tq.y, 0u, 0u}), ow = __builtin_bit_cast(bf16x8, (u32x4){cvt_pk_bf16(acc[0], acc[1]), cvt_pk_bf16(acc[2], acc[3]), 0u, 0u});
              const f32x4 xb = __builtin_amdgcn_mfma_f32_16x16x32_bf16(ot, ow, (f32x4){0.f, 0.f, 0.f, 0.f}, 0, 0, 0);
              *(LAS u32x2*)(xt + fr * 72 + t0) = (u32x2){cvt_pk_bf16(xb[0], xb[1]), cvt_pk_bf16(xb[2], xb[3])};
              LDS_WAIT(); asm volatile("" ::: "memory"); } }
        __syncthreads();
        { const int mt = (w >> 1) & 1, nt = w & 1, ln = lane & 31, lh = lane >> 5;
          if (w < 4) {
              { f32x16 acc = zero16();
                acc = mm_tile<4, false, false>(sUT, mt * 32, sArb, nt * 32, acc, lane); acc = mm_tile<4, true, false>(sVT, mt * 32, sArk, nt * 32, acc, lane);
                bf16* yr = YLg + (row0 + nt * 32 + ln) * D + h * 64 + mt * 32;
#pragma unroll
                for (int rq = 0; rq < 4; ++rq) *(u32x2*)(yr + 8 * rq + 4 * lh) = (u32x2){cvt_pk_bf16(acc[4 * rq], acc[4 * rq + 1]), cvt_pk_bf16(acc[4 * rq + 2], acc[4 * rq + 3])}; }
              { f32x16 acc = zero16();
                acc = mm_tile<4, false, false>(sPT, mt * 32, sArb, nt * 32, acc, lane);
                const int tl = nt * 32 + ln; bf16* qr_ = Qg + (row0 + tl) * D + h * 64 + mt * 32;
#pragma unroll
                for (int rq = 0; rq < 4; ++rq) { const int m0 = mt * 32 + 8 * rq + 4 * lh; const u32x2 rr = *(const LAS u32x2*)(sR + tl * 72 + m0);
                    *(u32x2*)(qr_ + 8 * rq + 4 * lh) = (u32x2){cvt_pk_bf16(acc[4 * rq] + bflo(rr.x), acc[4 * rq + 1] + bfhi(rr.x)), cvt_pk_bf16(acc[4 * rq + 2] + bflo(rr.y), acc[4 * rq + 3] + bfhi(rr.y))}; } }
          } else {
              { f32x16 acc = zero16();
                acc = mm_tile<4, true, false>(sBhT, mt * 32, sUT, nt * 32, acc, lane); acc = mm_tile<4, true, true>(sKhT, mt * 32, sVT, nt * 32, acc, lane);
                const int i_ = nt * 32 + ln;
#pragma unroll
                for (int rq = 0; rq < 4; ++rq) { const int j0_ = mt * 32 + 8 * rq + 4 * lh;
                    bf16* np = NCg + ((((size_t)unit * 4 + (i_ >> 4)) * 64 + (i_ & 15) + 16 * ((j0_ & 15) >> 2)) * 4 + (j0_ >> 4)) * 4;
                    *(u32x2*)np = (u32x2){cvt_pk_bf16(acc[4 * rq], acc[4 * rq + 1]), cvt_pk_bf16(acc[4 * rq + 2], acc[4 * rq + 3])}; } }
              { f32x16 acc = zero16();
                acc = mm_tile<4, false, true>(sPT, mt * 32, sBhT, nt * 32, acc, lane);
                const int j = nt * 32 + ln; const float wc = WC[j];
#pragma unroll
                for (int rq = 0; rq < 4; ++rq) { const int m0 = mt * 32 + 8 * rq + 4 * lh; float v4[4];
#pragma unroll
                    for (int e = 0; e < 4; ++e) v4[e] = acc[4 * rq + e] + ((m0 + e == j) ? wc : 0.f);
                    bf16* mp = MTg + ((((size_t)unit * 8 + 2 * (j >> 4) + (m0 >> 5)) * 64 + (j & 15) + 16 * ((m0 & 15) >> 2)) * 2 + ((m0 >> 4) & 1)) * 4;
                    *(u32x2*)mp = (u32x2){cvt_pk_bf16(v4[0], v4[1]), cvt_pk_bf16(v4[2], v4[3])}; } }
          } }
        __syncthreads();
    }
}

struct CarryBuf { u32x4 m[8]; u32x4 n[2]; };
__device__ __forceinline__ void carry_load(CarryBuf& B, const bf16* MTg, const bf16* NCg, size_t unit, int slab, int lane) {
    const bf16* mb = MTg + unit * 4096; const bf16* nb = NCg + (unit * 4 + slab) * 1024; const unsigned vm = (unsigned)lane * 16u, vm2 = vm + 4096u, vn = (unsigned)lane * 32u;
    asm volatile("global_load_dwordx4 %0, %1, %2" : "=v"(B.m[0]) : "v"(vm), "s"(mb) : "memory");
    asm volatile("global_load_dwordx4 %0, %1, %2 offset:1024" : "=v"(B.m[1]) : "v"(vm), "s"(mb) : "memory");
    asm volatile("global_load_dwordx4 %0, %1, %2 offset:2048" : "=v"(B.m[2]) : "v"(vm), "s"(mb) : "memory");
    asm volatile("global_load_dwordx4 %0, %1, %2 offset:3072" : "=v"(B.m[3]) : "v"(vm), "s"(mb) : "memory");
    asm volatile("global_load_dwordx4 %0, %1, %2" : "=v"(B.m[4]) : "v"(vm2), "s"(mb) : "memory");
    asm volatile("global_load_dwordx4 %0, %1, %2 offset:1024" : "=v"(B.m[5]) : "v"(vm2), "s"(mb) : "memory");
    asm volatile("global_load_dwordx4 %0, %1, %2 offset:2048" : "=v"(B.m[6]) : "v"(vm2), "s"(mb) : "memory");
    asm volatile("global_load_dwordx4 %0, %1, %2 offset:3072" : "=v"(B.m[7]) : "v"(vm2), "s"(mb) : "memory");
    asm volatile("global_load_dwordx4 %0, %1, %2" : "=v"(B.n[0]) : "v"(vn), "s"(nb) : "memory");
    asm volatile("global_load_dwordx4 %0, %1, %2 offset:16" : "=v"(B.n[1]) : "v"(vn), "s"(nb) : "memory");
}
#define CARRY_WAIT(B, N) asm volatile("s_waitcnt vmcnt(" #N ")" : "+v"(B.m[0]), "+v"(B.m[1]), "+v"(B.m[2]), "+v"(B.m[3]), "+v"(B.m[4]), "+v"(B.m[5]), "+v"(B.m[6]), "+v"(B.m[7]), "+v"(B.n[0]), "+v"(B.n[1]) :: "memory")
__device__ __forceinline__ void carry_step(f32x4 (&acc)[4], const CarryBuf& B, bf16* sp) {
    u32 pk[4][2];
#pragma unroll
    for (int jt = 0; jt < 4; ++jt) { pk[jt][0] = cvt_pk_bf16(acc[jt][0], acc[jt][1]); pk[jt][1] = cvt_pk_bf16(acc[jt][2], acc[jt][3]); }
#pragma unroll
    for (int jt = 0; jt < 4; ++jt) *(GAS u32x2*)(sp + jt * 16) = (u32x2){pk[jt][0], pk[jt][1]};
    const bf16x8 sb0 = __builtin_bit_cast(bf16x8, (u32x4){pk[0][0], pk[0][1], pk[1][0], pk[1][1]}), sb1 = __builtin_bit_cast(bf16x8, (u32x4){pk[2][0], pk[2][1], pk[3][0], pk[3][1]});
    const u32 nw[8] = {B.n[0].x, B.n[0].y, B.n[0].z, B.n[0].w, B.n[1].x, B.n[1].y, B.n[1].z, B.n[1].w};
#pragma unroll
    for (int jt = 0; jt < 4; ++jt) { f32x4 a = (f32x4){bflo(nw[2 * jt]), bfhi(nw[2 * jt]), bflo(nw[2 * jt + 1]), bfhi(nw[2 * jt + 1])};
        a = __builtin_amdgcn_mfma_f32_16x16x32_bf16(__builtin_bit_cast(bf16x8, B.m[2 * jt]), sb0, a, 0, 0, 0);
        a = __builtin_amdgcn_mfma_f32_16x16x32_bf16(__builtin_bit_cast(bf16x8, B.m[2 * jt + 1]), sb1, a, 0, 0, 0);
        acc[jt] = a; }
}
__device__ __forceinline__ void phase_carry2(const Ctx& C0) {
    const Ctx C = launder(C0);
    const bf16* MTg = (const bf16*)(C.ws + WS_R1 + R1_MT); const bf16* NCg = (const bf16*)(C.ws + WS_R1 + R1_NC); bf16* sst = (bf16*)(C.ws + WS_R1 + R1_SST);
    const int lane = C.lane, fr = lane & 15, fq = lane >> 4;
    if (C.wave != 0) return;
    for (int task = C.bid; task < 128; task += C.G) { const int bh = task >> 2, slab = task & 3; const size_t u0 = (size_t)bh * NCHK;
        f32x4 acc[4]; acc[0] = acc[1] = acc[2] = acc[3] = (f32x4){0.f, 0.f, 0.f, 0.f};
        CarryBuf B0, B1, B2, B3;
        asm volatile("s_waitcnt vmcnt(0)" ::: "memory");
        carry_load(B0, MTg, NCg, u0, slab, lane); carry_load(B1, MTg, NCg, u0 + 1, slab, lane); carry_load(B2, MTg, NCg, u0 + 2, slab, lane); carry_load(B3, MTg, NCg, u0 + 3, slab, lane);
        bf16* sp = sst + (u0 * 64 + slab * 16 + fr) * 64 + 4 * fq;
        CARRY_WAIT(B0, 30); carry_step(acc, B0, sp + (size_t)0 * 4096); carry_load(B0, MTg, NCg, u0 + 4, slab, lane);
        CARRY_WAIT(B1, 34); carry_step(acc, B1, sp + (size_t)1 * 4096); carry_load(B1, MTg, NCg, u0 + 5, slab, lane);
        CARRY_WAIT(B2, 38); carry_step(acc, B2, sp + (size_t)2 * 4096); carry_load(B2, MTg, NCg, u0 + 6, slab, lane);
        CARRY_WAIT(B3, 42); carry_step(acc, B3, sp + (size_t)3 * 4096); carry_load(B3, MTg, NCg, u0 + 7, slab, lane);
#pragma unroll 1
        for (int c = 4; c < NCHK; c += 4) {
            const size_t un = u0 + ((c + 4 < NCHK) ? c + 4 : c);
            CARRY_WAIT(B0, 42); carry_step(acc, B0, sp + (size_t)(c + 0) * 4096); carry_load(B0, MTg, NCg, un + 0, slab, lane);
            CARRY_WAIT(B1, 42); carry_step(acc, B1, sp + (size_t)(c + 1) * 4096); carry_load(B1, MTg, NCg, un + 1, slab, lane);
            CARRY_WAIT(B2, 42); carry_step(acc, B2, sp + (size_t)(c + 2) * 4096); carry_load(B2, MTg, NCg, un + 2, slab, lane);
            CARRY_WAIT(B3, 42); carry_step(acc, B3, sp + (size_t)(c + 3) * 4096); carry_load(B3, MTg, NCg, un + 3, slab, lane);
        }
        asm volatile("s_waitcnt vmcnt(0)" ::: "memory");
    }
}

__device__ __forceinline__ void phase_post2(const Ctx& C0, int l) {
    const Ctx C = launder(C0);
    const bf16* yl = (const bf16*)(C.ws + WS_R1 + R1_YLOC); const bf16* zz = (const bf16*)(C.ws + WS_R1 + R1_Q); const bf16* sst = (const bf16*)(C.ws + WS_R1 + R1_SST);
    const bf16* vp = (const bf16*)(C.ws + WS_VP); const bf16* gg = (const bf16*)(C.ws + WS_R4 + R4_G); const float* bonus = (const float*)(C.ws + WS_BONUS); bf16* ya = (bf16*)(C.ws + WS_HN);
    LAS float* LWs = (LAS float*)C.lds; LAS float* LBs = LWs + 1024;
    for (int i = C.tid; i < 1024; i += 512) { LWs[i] = C.inp(I_LNX_W)[(size_t)l * D + i]; LBs[i] = C.inp(I_LNX_B)[(size_t)l * D + i]; }
    __syncthreads();
    const int lane = C.lane, lr = lane & 31, lh = lane >> 5;
    for (int task = C.gw; task < 8192; task += C.ngw) { const int unit = task >> 1, sub = task & 1; const int bh = unit / NCHK, ck = unit % NCHK, bl = bh >> 4, h = bh & 15;
        const size_t ml = (size_t)bl * T + ck * CHK + sub * 32 + lr;
        const bf16* srow = sst + (size_t)unit * 4096; const bf16* zrow = zz + ml * D + h * 64; const bf16* ylr = yl + ml * D + h * 64;
        bf16x8 ob[4], oa0[4], oa1[4]; u32x2 yq[8], vq[8], gq[8];
#pragma unroll
        for (int ks = 0; ks < 4; ++ks) { const int m0 = ks * 16 + lh * 8; ob[ks] = *(const bf16x8*)(zrow + m0); oa0[ks] = *(const bf16x8*)(srow + (size_t)lr * 64 + m0); oa1[ks] = *(const bf16x8*)(srow + (size_t)(32 + lr) * 64 + m0); }
#pragma unroll
        for (int q = 0; q < 8; ++q) { const int i0 = (q >> 2) * 32 + 8 * (q & 3) + 4 * lh; yq[q] = *(const u32x2*)(ylr + i0); vq[q] = *(const u32x2*)(vp + ml * D + h * 64 + i0); gq[q] = *(const u32x2*)(gg + ml * D + h * 64 + i0); }
        const float bn = bonus[ml * 16 + h];
        f32x16 d0 = zero16(), d1 = zero16();
#pragma unroll
        for (int ks = 0; ks < 4; ++ks) { d0 = __builtin_amdgcn_mfma_f32_32x32x16_bf16(oa0[ks], ob[ks], d0, 0, 0, 0); d1 = __builtin_amdgcn_mfma_f32_32x32x16_bf16(oa1[ks], ob[ks], d1, 0, 0, 0); }
        float y[32]; float s = 0.f;
#pragma unroll
        for (int itl = 0; itl < 2; ++itl)
#pragma unroll
            for (int rq = 0; rq < 4; ++rq) { const u32x2 q = yq[itl * 4 + rq];
                const float dd0 = itl ? d1[4 * rq] : d0[4 * rq], dd1 = itl ? d1[4 * rq + 1] : d0[4 * rq + 1], dd2 = itl ? d1[4 * rq + 2] : d0[4 * rq + 2], dd3 = itl ? d1[4 * rq + 3] : d0[4 * rq + 3];
                float* yy = y + itl * 16 + rq * 4; yy[0] = bflo(q.x) + dd0; yy[1] = bfhi(q.x) + dd1; yy[2] = bflo(q.y) + dd2; yy[3] = bfhi(q.y) + dd3; s += (yy[0] + yy[1]) + (yy[2] + yy[3]); }
        s += __shfl_xor(s, 32); const float mean = s * (1.f / 64.f); float s2 = 0.f;
#pragma unroll
        for (int e = 0; e < 32; ++e) { const float dlt = y[e] - mean; s2 += dlt * dlt; }
        s2 += __shfl_xor(s2, 32); const float rstd = __builtin_amdgcn_rsqf(s2 * (1.f / 64.f) + 64e-5f);
#pragma unroll
        for (int itl = 0; itl < 2; ++itl)
#pragma unroll
            for (int rq = 0; rq < 4; ++rq) { const int i0 = itl * 32 + 8 * rq + 4 * lh; const int cc = h * 64 + i0; const float* yy = y + itl * 16 + rq * 4;
                const f32x4 w4 = *(const LAS f32x4*)(LWs + cc), b4 = *(const LAS f32x4*)(LBs + cc); const u32x2 vv = vq[itl * 4 + rq], gv = gq[itl * 4 + rq];
                const float o0 = ((yy[0] - mean) * rstd * w4.x + b4.x + bn * bflo(vv.x)) * bflo(gv.x), o1 = ((yy[1] - mean) * rstd * w4.y + b4.y + bn * bfhi(vv.x)) * bfhi(gv.x);
                const float o2 = ((yy[2] - mean) * rstd * w4.z + b4.z + bn * bflo(vv.y)) * bflo(gv.y), o3 = ((yy[3] - mean) * rstd * w4.w + b4.w + bn * bfhi(vv.y)) * bfhi(gv.y);
                *(u32x2*)(ya + ml * D + cc) = (u32x2){cvt_pk_bf16(o0, o1), cvt_pk_bf16(o2, o3)}; }
    }
}

__device__ __forceinline__ void phase_route(const Ctx& C0, int it) {
    const Ctx C = launder(C0);
    const int l = it / NCH, c = it % NCH; const float* xs = C.out + (size_t)c * M * D; const float* g = C.inp(I_NORM_FFN) + (size_t)l * D; bf16* hn = (bf16*)(C.ws + WS_HN);
    const float* rgb = C.inp(I_RGRP_B) + (size_t)l * 4; const float* reb = C.inp(I_REXP_B) + (size_t)l * 32;
    unsigned* cnt = (unsigned*)(C.ws + WS_CTL) + CW_CNT + it * 64; int* tok = (int*)(C.ws + WS_TOK); float* wt = (float*)(C.ws + WS_TOK + 512 * 1024);
    const bf16* wrh = (const bf16*)(C.ws + WS_WSC + 512 * 1024); const bf16* wrl = (const bf16*)(C.ws + WS_WSC + 640 * 1024);
    const int lane = C.lane, fr = lane & 15, fq = lane >> 4;
    for (int rep15 = 0; rep15 < 1 + ((DUP_MASK >> 15) & 1); ++rep15)
    norm2_rows_i8(xs, g, (unsigned char*)hn, (float*)(C.ws + WS_HN + HNX_RS), C.gw, C.ngw, lane);
    LAS float* LG = (LAS float*)(C.lds + C.wave * 4096);
    LAS float* PX = (LAS float*)(C.lds + 32768) + (C.wave >> 1) * (64 * 13);
    const int half = C.wave & 1;
    for (int tbase = C.bid * 4; tbase < M / 16; tbase += C.G * 4) { const int task = tbase + (C.wave >> 1); const int ml = task * 16 + fr; const float* xr = xs + (size_t)ml * D + fq * 8;
        f32x4 acc[3]; acc[0] = acc[1] = acc[2] = (f32x4){0.f, 0.f, 0.f, 0.f}; float ss = 0.f;
#pragma unroll 4
        for (int ks = half * 16; ks < half * 16 + 16; ++ks) { const f32x4 xa = *(const f32x4*)(xr + ks * 32), xb = *(const f32x4*)(xr + ks * 32 + 4);
            ss += (xa.x * xa.x + xa.y * xa.y) + (xa.z * xa.z + xa.w * xa.w) + (xb.x * xb.x + xb.y * xb.y) + (xb.z * xb.z + xb.w * xb.w);
            u32x4 hq; hq.x = cvt_pk_bf16(xa.x, xa.y); hq.y = cvt_pk_bf16(xa.z, xa.w); hq.z = cvt_pk_bf16(xb.x, xb.y); hq.w = cvt_pk_bf16(xb.z, xb.w);
            u32x4 lq; lq.x = cvt_pk_bf16(xa.x - bflo(hq.x), xa.y - bfhi(hq.x)); lq.y = cvt_pk_bf16(xa.z - bflo(hq.y), xa.w - bfhi(hq.y));
            lq.z = cvt_pk_bf16(xb.x - bflo(hq.z), xb.y - bfhi(hq.z)); lq.w = cvt_pk_bf16(xb.z - bflo(hq.w), xb.w - bfhi(hq.w));
            const bf16x8 xh = __builtin_bit_cast(bf16x8, hq), xl = __builtin_bit_cast(bf16x8, lq);
#pragma unroll
            for (int nt = 0; nt < 3; ++nt) { const size_t wo = (size_t)(nt * 16 + fr) * D + ks * 32 + fq * 8;
                const bf16x8 wh = *(const bf16x8*)(wrh + wo), wl = *(const bf16x8*)(wrl + wo);
                acc[nt] = __builtin_amdgcn_mfma_f32_16x16x32_bf16(wh, xh, acc[nt], 0, 0, 0);
                acc[nt] = __builtin_amdgcn_mfma_f32_16x16x32_bf16(wl, xh, acc[nt], 0, 0, 0);
                acc[nt] = __builtin_amdgcn_mfma_f32_16x16x32_bf16(wh, xl, acc[nt], 0, 0, 0); } }
        if (half) {
#pragma unroll
            for (int nt = 0; nt < 3; ++nt)
#pragma unroll
                for (int i = 0; i < 4; ++i) PX[lane * 13 + nt * 4 + i] = acc[nt][i];
            PX[lane * 13 + 12] = ss; }
        __syncthreads();
        if (!half) {
#pragma unroll
            for (int nt = 0; nt < 3; ++nt)
#pragma unroll
                for (int i = 0; i < 4; ++i) acc[nt][i] += PX[lane * 13 + nt * 4 + i];
            ss += PX[lane * 13 + 12]; }
        ss += __shfl_xor(ss, 16); ss += __shfl_xor(ss, 32); const float rs = __builtin_amdgcn_rsqf(ss * (1.f / D) + 1e-6f);
#pragma unroll
        for (int nt = 0; nt < 3; ++nt)
#pragma unroll
            for (int i = 0; i < 4; ++i) LG[fr * 48 + nt * 16 + 4 * fq + i] = acc[nt][i] * rs;
        LDS_WAIT(); asm volatile("" ::: "memory");
        if (lane < 16 && !half) { const LAS float* lg = LG + lane * 48;
            float gl[4]; int gs = 0; float gm;
#pragma unroll
            for (int e = 0; e < 4; ++e) gl[e] = lg[e] + rgb[e];
            gm = gl[0];
#pragma unroll
            for (int e = 1; e < 4; ++e) if (gl[e] > gm) { gm = gl[e]; gs = e; }
            float den = 0.f;
#pragma unroll
            for (int e = 0; e < 4; ++e) den += __expf(gl[e] - gm);
            const float pg = 1.f / den;
            float el[8];
#pragma unroll
            for (int e = 0; e < 8; ++e) el[e] = lg[4 + gs * 8 + e] + reb[gs * 8 + e];
            int i1 = 0; float v1 = el[0];
#pragma unroll
            for (int e = 1; e < 8; ++e) if (el[e] > v1) { v1 = el[e]; i1 = e; }
            int i2 = -1; float v2 = -3.0e38f;
#pragma unroll
            for (int e = 0; e < 8; ++e) if (e != i1 && el[e] > v2) { v2 = el[e]; i2 = e; }
            const float ex = __expf(v2 - v1); const float w1 = pg / (1.f + ex), w2 = pg * ex / (1.f + ex);
            const int e1 = gs * 8 + i1, e2 = gs * 8 + i2;
            const unsigned s1 = atomicAdd(cnt + e1, 1u), s2 = atomicAdd(cnt + e2, 1u);
            const int mt = task * 16 + lane;
            tok[4 * mt] = e1; tok[4 * mt + 1] = (int)s1; tok[4 * mt + 2] = e2; tok[4 * mt + 3] = (int)s2; wt[2 * mt] = w1; wt[2 * mt + 1] = w2;
            int* rowmap = (int*)(C.ws + WS_R1 + R1_ROWMAP); rowmap[e1 * 16384 + (int)s1] = mt; rowmap[e2 * 16384 + (int)s2] = mt;
        }
        __syncthreads();
    }
}
__device__ __forceinline__ void moe_table(const Ctx& C, int it, LAS int* tb) {
    __syncthreads();
    int tl_ = C.tid; asm volatile("" : "+v"(tl_));
    if (C.tid < 64) { const unsigned* cnt = (const unsigned*)(C.ws + WS_CTL) + CW_CNT + it * 64;
        const unsigned cv = (C.tid < 32) ? __hip_atomic_load(cnt + tl_, __ATOMIC_RELAXED, __HIP_MEMORY_SCOPE_AGENT) : 0u; const int tiles = (int)((cv + 255u) >> 8); int x = tiles;
#pragma unroll
        for (int o = 1; o < 32; o <<= 1) { const int y = __shfl_up(x, o); if (C.lane >= o) x += y; }
        if (C.tid < 32) { tb[tl_] = x - tiles; tb[40 + tl_] = (int)cv; } if (C.tid == 31) tb[32] = x; }
    __syncthreads();
}
constexpr int NPH = 14;
__global__ void __launch_bounds__(512, 2) mk_fwd(Args args) {
    extern __shared__ __attribute__((aligned(16))) unsigned char lds_raw[];
    Ctx C; C.lds = (LAS unsigned char*)lds_raw; C.ws = args.ws; C.in = args.in; C.out = args.out;
    C.tid = threadIdx.x; C.lane = C.tid & 63; C.wave = __builtin_amdgcn_readfirstlane(C.tid >> 6); C.G = gridDim.x; C.bid = blockIdx.x; C.gw = C.bid * 8 + C.wave; C.ngw = C.G * 8;
    volatile LAS unsigned* MISC = (volatile LAS unsigned*)(C.lds + LDSCTL_OFF);
    LAS int* tb = (LAS int*)(C.lds + LDSCTL_OFF + 256);
    for (int u = C.tid; u < 64; u += 512) MISC[u] = 0u;
    __syncthreads();
    XcdBarrier bar; bar.bar = (unsigned*)(C.ws + WS_CTL) + CW_BAR; bar.x = 0; bar.st = nullptr;
#if MK_ONE_LAUNCH
    bar = xcd_barrier_post((unsigned*)(C.ws + WS_CTL) + CW_BAR, MISC + 8);
#define GRID_BAR() xcd_barrier(bar)
#else
#define GRID_BAR() do {} while (0)
#endif
    const int s_lo = args.s_lo, s_hi = args.s_hi;
    if (s_lo == 0) { phase_wmax(C); GRID_BAR(); }
#pragma unroll 1
    for (int it = 0; it <= NIT; ++it) {
        const int l = it / NCH, c = it % NCH; const int sb = it * NPH;
#define IN(k) (((PH_MASK >> (k)) & 1) && s_lo <= sb + (k) && sb + (k) < s_hi)
        if (IN(0)) for (int rep_ = 0; rep_ < 1 + ((DUP_MASK >> 0) & 1); ++rep_) { unsigned char* ws = C.ws; asm volatile("" : "+s"(ws)); ws = AS_GLOBAL(unsigned char, ws); if (it < NIT && c == 0) phase_convert(C, l, it == 0); phase_prep(C, it, tb); GRID_BAR(); }
        if (it == NIT) break;
        if (IN(1)) for (int rep_ = 0; rep_ < 1 + ((DUP_MASK >> 1) & 1); ++rep_) { unsigned char* ws = C.ws; asm volatile("" : "+s"(ws)); ws = AS_GLOBAL(unsigned char, ws); pg8::Gemm g{(const bf16*)(ws + WS_R1 + R1_HNX), (const bf16*)(ws + WS_WIN), D / 2, D / 2, D / 2, 0, nullptr, nullptr};   pg8::StaticOrder S; S.init(M, DBG_PROJ_N, C.G, C.bid);
            pg8::EpiProj E{(bf16*)(ws + WS_R2 + R2_ZA), (bf16*)(ws + WS_R1 + R1_ZB), (bf16*)(ws + WS_R1 + R1_ZC), (bf16*)(ws + WS_ZG), (bf16*)(ws + WS_VLO), C.inp(I_GATE_B) + (size_t)l * G_COLS, (const float*)(ws + WS_R1 + R1_HNX + HNX_RS), (const unsigned*)(ws + WS_CTL) + CW_WMAX + l * WIN_ROWS};
            pg8::gemm_phase<pg8::EpiProj, pg8::StaticOrder, false, true>(C.lds, g, S, E); GRID_BAR(); }
        if (IN(2)) for (int rep_ = 0; rep_ < 1 + ((DUP_MASK >> 2) & 1); ++rep_) { unsigned char* ws = C.ws; asm volatile("" : "+s"(ws)); ws = AS_GLOBAL(unsigned char, ws); sub_gmlp(C, l); sub_attn(C); sub_lora_prep(C, l); GRID_BAR(); }
        if (IN(3)) for (int rep_ = 0; rep_ < 1 + ((DUP_MASK >> 3) & 1); ++rep_) { unsigned char* ws = C.ws; asm volatile("" : "+s"(ws)); ws = AS_GLOBAL(unsigned char, ws); pg8::Gemm g{(const bf16*)(ws + WS_R1 + R1_ALORA), (const bf16*)(ws + WS_LORAB), LORA_K, LORA_K, (l == 0 ? 256 : LORA_K), 0, nullptr, nullptr};   pg8::StaticOrder S; S.init(M, l == 0 ? 3072 : 4096, C.G, C.bid);
            pg8::EpiLora EL{(bf16*)(ws + WS_R4 + R4_WPRE), (bf16*)(ws + WS_R4 + R4_APRE), (bf16*)(ws + WS_R4 + R4_G), (bf16*)(ws + WS_R4 + R4_VPRE)};
            pg8::gemm_phase(C.lds, g, S, EL); sub_yb_combine(C); GRID_BAR(); }
        if (IN(4)) for (int rep_ = 0; rep_ < 1 + ((DUP_MASK >> 4) & 1); ++rep_) { unsigned char* ws = C.ws; asm volatile("" : "+s"(ws)); ws = AS_GLOBAL(unsigned char, ws); }
        if (IN(5)) for (int rep_ = 0; rep_ < 1 + ((DUP_MASK >> 5) & 1); ++rep_) { unsigned char* ws = C.ws; asm volatile("" : "+s"(ws)); ws = AS_GLOBAL(unsigned char, ws); phase_chunkpre(C, l, c); GRID_BAR(); }
        if (IN(6)) for (int rep_ = 0; rep_ < 1 + ((DUP_MASK >> 6) & 1); ++rep_) { unsigned char* ws = C.ws; asm volatile("" : "+s"(ws)); ws = AS_GLOBAL(unsigned char, ws); phase_carry2(C); GRID_BAR(); }
        if (IN(7)) for (int rep_ = 0; rep_ < 1 + ((DUP_MASK >> 7) & 1); ++rep_) { unsigned char* ws = C.ws; asm volatile("" : "+s"(ws)); ws = AS_GLOBAL(unsigned char, ws); phase_post2(C, l); GRID_BAR(); }
        if (IN(8)) for (int rep_ = 0; rep_ < 1 + ((DUP_MASK >> 8) & 1); ++rep_) { unsigned char* ws = C.ws; asm volatile("" : "+s"(ws)); ws = AS_GLOBAL(unsigned char, ws); pg8::StaticOrder S; S.init(M, D, C.G, C.bid);
            pg8::Gemm ga{(const bf16*)(ws + WS_HN), (const bf16*)(ws + WS_PA), D, D, D, 0, nullptr, nullptr}; pg8::Gemm gb{(const bf16*)(ws + WS_YB), (const bf16*)(ws + WS_PB), 256, 256, 256, 0, nullptr, nullptr};
            pg8::Gemm gc{(const bf16*)(ws + WS_YC), (const bf16*)(ws + WS_PC), D, D, D, 0, nullptr, nullptr};
            pg8::EpiChainGate E{(const unsigned char*)(ws + WS_ZG), (bf16*)(ws + WS_R4 + R4_MERGED)}; pg8::gemm_chain3(C.lds, ga, gb, gc, S, E); GRID_BAR(); }
        if (IN(9)) for (int rep_ = 0; rep_ < 1 + ((DUP_MASK >> 9) & 1); ++rep_) { unsigned char* ws = C.ws; asm volatile("" : "+s"(ws)); ws = AS_GLOBAL(unsigned char, ws);
#ifdef DBG_WOUT_ZG
            pg8::Gemm g{(const bf16*)(ws + WS_ZG), (const bf16*)(ws + WS_WOUT), G_COLS, D, D, 0, nullptr, nullptr};
#else
            pg8::Gemm g{(const bf16*)(ws + WS_R4 + R4_MERGED), (const bf16*)(ws + WS_WOUT), D, D, D, 0, nullptr, nullptr};
#endif
            pg8::StaticOrder S; S.init(M, D, C.G, C.bid);
            pg8::EpiResid E{(l == 0 ? C.inp(I_X) : C.out) + (size_t)c * M * D, C.out + (size_t)c * M * D}; pg8::gemm_phase(C.lds, g, S, E); GRID_BAR(); }
        if (IN(10)) for (int rep_ = 0; rep_ < 1 + ((DUP_MASK >> 10) & 1); ++rep_) { unsigned char* ws = C.ws; asm volatile("" : "+s"(ws)); ws = AS_GLOBAL(unsigned char, ws); phase_route(C, it); GRID_BAR(); }
        if (IN(11)) for (int rep_ = 0; rep_ < 1 + ((DUP_MASK >> 11) & 1); ++rep_) { unsigned char* ws = C.ws; asm volatile("" : "+s"(ws)); ws = AS_GLOBAL(unsigned char, ws); }
        if (IN(12)) for (int rep_ = 0; rep_ < 1 + ((DUP_MASK >> 12) & 1); ++rep_) { unsigned char* ws = C.ws; asm volatile("" : "+s"(ws)); ws = AS_GLOBAL(unsigned char, ws); moe_table(C, it, tb); pg8::Gemm g{(const bf16*)(ws + WS_HN), (const bf16*)(ws + WS_W13), D / 2, D / 2, D / 2, (size_t)D * D / 2, (const int*)(ws + WS_R1 + R1_ROWMAP), tb};   pg8::MoeOrder S{tb, 4, C.G, C.bid};
            pg8::EpiSwiglu E{(bf16*)(ws + WS_R1 + R1_HID), (const float*)(ws + WS_HN + HNX_RS), (const int*)(ws + WS_R1 + R1_ROWMAP), tb, (const unsigned*)(ws + WS_CTL) + CW_WMAX13 + l * NEXP * 1024}; pg8::gemm_phase<pg8::EpiSwiglu, pg8::MoeOrder, true, true>(C.lds, g, S, E);
            if (it + 1 < NIT) {
                const int U = tb[32] * 4, rem = U % C.G; const int first = rem, nlow = C.G - rem;
                if (C.bid >= first) { const Ctx Cn = launder(C); mixer_norm(Cn, it + 1, (C.bid - first) * 8 + Cn.wave, nlow * 8); } }
            GRID_BAR(); }
        if (IN(13)) for (int rep_ = 0; rep_ < 1 + ((DUP_MASK >> 13) & 1); ++rep_) { unsigned char* ws = C.ws; asm volatile("" : "+s"(ws)); ws = AS_GLOBAL(unsigned char, ws); moe_table(C, it, tb); pg8::Gemm g{(const bf16*)(ws + WS_R1 + R1_HID), (const bf16*)(ws + WS_W2), EFF, EFF, EFF, (size_t)D * EFF, nullptr, nullptr}; pg8::MoeOrder S{tb, 4, C.G, C.bid};
            pg8::EpiBf16 E{(bf16*)(ws + WS_R1 + R1_YEXP), D, 0, 0}; pg8::gemm_phase(C.lds, g, S, E); GRID_BAR(); }
#undef IN
    }
}

extern "C" void kernel_launch(void* const* d_in, const int* in_sizes, int n_in, void* d_out, int out_size, void* d_ws, size_t ws_size, hipStream_t stream) {
    static int grid = 0;
    if (grid == 0) {
        if (n_in != 36 || out_size != NBATCH * T * D || ws_size < WS_END) { fprintf(stderr, "kernel_launch: unexpected shapes (n_in %d out %d ws %zu)\n", n_in, out_size, ws_size); grid = -1; return; }
        int dev = 0, cus = 0;
        if (hipGetDevice(&dev) != hipSuccess || hipDeviceGetAttribute(&cus, hipDeviceAttributeMultiprocessorCount, dev) != hipSuccess) { grid = -1; return; }
        if (hipFuncSetAttribute((const void*)mk_fwd, hipFuncAttributeMaxDynamicSharedMemorySize, LDS_BYTES) != hipSuccess) { grid = -1; return; }
        int per_cu = 0;
        if (hipOccupancyMaxActiveBlocksPerMultiprocessor(&per_cu, (const void*)mk_fwd, 512, LDS_BYTES) != hipSuccess || per_cu < 1) fprintf(stderr, "kernel_launch: occupancy query says %d\n", per_cu);
        (void)hipGetLastError();
        grid = cus;
    }
    if (grid < 0) return;
    (void)hipMemsetAsync((char*)d_ws + WS_CTL, 0, CTL_ZERO_BYTES, stream);
    Args a{};
    for (int i = 0; i < 36; ++i) a.in[i] = (const float*)d_in[i];
    a.out = (float*)d_out; a.ws = (unsigned char*)d_ws;
    const int total = NIT * NPH + 1;
#if MK_ONE_LAUNCH
    a.s_lo = 0; a.s_hi = total;
    hipLaunchKernelGGL(mk_fwd, dim3(grid), dim3(512), LDS_BYTES, stream, a);
#else
    for (int s = 0; s < total; ++s) { a.s_lo = s; a.s_hi = s + 1; hipLaunchKernelGGL(mk_fwd, dim3(grid), dim3(512), LDS_BYTES, stream, a); }
#endif
}
```

```cpp
#include <hip/hip_runtime.h>
#include <cstdint>
#include <cstdio>

#define DBG_PROJ_N (l == 0 ? IN_COLS : WIN_ROWS)
#ifndef DUP_MASK
#define DUP_MASK 0
#endif
#ifndef PH_MASK
#define PH_MASK 0xFFFF
#endif
#ifndef MK_ONE_LAUNCH
#define MK_ONE_LAUNCH 1
#endif

#define LAS __attribute__((address_space(3)))
#define GAS __attribute__((address_space(1)))
#define AS_GLOBAL(T, p) ({ GAS T* g_ = (GAS T*)(p); asm("" : "+s"(g_)); (T*)g_; })
typedef unsigned short bf16;
typedef unsigned u32;
typedef short bf16x8 __attribute__((ext_vector_type(8)));
typedef float f32x4 __attribute__((ext_vector_type(4)));
typedef float f32x2 __attribute__((ext_vector_type(2)));
typedef float f32x16 __attribute__((ext_vector_type(16)));
typedef unsigned u32x4 __attribute__((ext_vector_type(4)));
typedef unsigned u32x2 __attribute__((ext_vector_type(2)));
typedef int i32x4 __attribute__((ext_vector_type(4)));

constexpr int NBATCH = 8, T = 8192, D = 1024, NLAYER = 2;
constexpr int M = 2 * T;
constexpr int NCH = 4;
constexpr int NIT = NLAYER * NCH;
constexpr int A_COLS = 3328, B_COLS = 2304, C_COLS = 2048, G_COLS = 3072, IN_COLS = 10752;
constexpr int WIN_ROWS = 11008;
constexpr int LORA_K = 384, LORA_N = 4096;
constexpr int NEXP = 32, EFF = 512;
constexpr int SEGL = 256, NSEG = T / SEGL;
constexpr int MOE_MAXROWS = 40960;

constexpr size_t MiB = 1u << 20;
constexpr size_t WS_CTL = 0, CTL_ZERO_BYTES = 1 * MiB;
constexpr size_t WS_ROPE = 1 * MiB;
constexpr size_t WS_WSC = 3 * MiB;
constexpr size_t WS_WIN = 4 * MiB;
constexpr size_t WS_LORAB = 26 * MiB;
constexpr size_t WS_PA = 29 * MiB, WS_PB = 31 * MiB, WS_PC = 32 * MiB, WS_WOUT = 34 * MiB;
constexpr size_t WS_W13 = 36 * MiB;
constexpr size_t WS_W2 = 100 * MiB;
constexpr size_t WS_VFIRST = 132 * MiB;
constexpr size_t WS_HN = 260 * MiB;
constexpr size_t WS_VP = 292 * MiB;
constexpr size_t WS_YB = 324 * MiB;
constexpr size_t WS_YC = 332 * MiB;
constexpr size_t WS_VLO = 364 * MiB;
constexpr size_t WS_BONUS = 365 * MiB;
constexpr size_t WS_TOK = 366 * MiB;
constexpr size_t WS_LSE = 367 * MiB;
constexpr size_t WS_ZG = 368 * MiB;
constexpr size_t WS_R4 = 464 * MiB;
constexpr size_t WS_R2 = 592 * MiB;
constexpr size_t WS_R1 = 696 * MiB;
constexpr size_t WS_END = 1016 * MiB;
constexpr size_t R4_G = 0, R4_WPRE = 32 * MiB, R4_APRE = 64 * MiB, R4_VPRE = 96 * MiB;
constexpr size_t R4_SEGS = 32 * MiB, R4_SEGP = 64 * MiB;
constexpr size_t R4_MTMP = 0, R4_MERGED = 64 * MiB;
constexpr size_t R2_ZA = 0;
constexpr size_t R2_YLOC = 0, R2_Z = 32 * MiB, R2_SSTART = 64 * MiB;
constexpr size_t R1_ZB = 0, R1_ZC = 72 * MiB, R1_ALORA = 136 * MiB, R1_OG = 148 * MiB;
constexpr size_t R1_SCANIN = 0;
constexpr size_t R1_XG = 0, R1_HID = 80 * MiB, R1_YEXP = 120 * MiB, R1_ROWMAP = 300 * MiB, R1_HNX = 256 * MiB;
constexpr size_t R1_LW = 0, R1_AA = 64 * MiB, R1_BB = 96 * MiB, R1_KK = 128 * MiB, R1_RR = 160 * MiB;
constexpr size_t R1_MT = 192 * MiB, R1_NC = 224 * MiB;
constexpr size_t R1_YLOC = 0, R1_Q = 32 * MiB, R1_SST = 64 * MiB;
constexpr int CHK = 64, NCHK = T / CHK;
constexpr int CW_BAR = 4096;
constexpr int CW_CNT = 16384;
constexpr int CW_WMAX = 32768;
constexpr int CW_WMAX13 = 65536;
constexpr size_t HNX_RS = 16 * MiB;

constexpr int RING_BYTES = 131072;
constexpr int LDSCTL_OFF = RING_BYTES;
constexpr int LDS_BYTES = 147456;

__device__ __forceinline__ float bf2f(u32 v) { return __uint_as_float(v << 16); }
__device__ __forceinline__ float bflo(u32 v) { return __uint_as_float(v << 16); }
__device__ __forceinline__ float bfhi(u32 v) { return __uint_as_float(v & 0xffff0000u); }
typedef __bf16 bf16x2_t __attribute__((ext_vector_type(2)));
__device__ __forceinline__ u32 cvt_pk_bf16(float lo, float hi) { f32x2 v = {lo, hi}; bf16x2_t b = __builtin_convertvector(v, bf16x2_t); return __builtin_bit_cast(u32, b); }
__device__ __forceinline__ u32 f2bf(float f) { return cvt_pk_bf16(f, 0.f) & 0xffffu; }
__device__ __forceinline__ float wave_sum(float v) {
#pragma unroll
    for (int o = 1; o < 64; o <<= 1) v += __shfl_xor(v, o);
    return v;
}
__device__ __forceinline__ float sigmoidf_(float x) { return __builtin_amdgcn_rcpf(1.0f + __expf(-x)); }
#define LDS_WAIT() asm volatile("s_waitcnt lgkmcnt(0)" ::: "memory")
typedef short v4i16_t __attribute__((ext_vector_type(4)));
__device__ __forceinline__ u32x2 lds_tr16(const LAS bf16* p) { return __builtin_bit_cast(u32x2, __builtin_amdgcn_ds_read_tr16_b64_v4i16((LAS v4i16_t*)p)); }

namespace pg8 {
#define PG8_LAS __attribute__((address_space(3)))
constexpr int BM = 256, BK = 64, HALF = 128, HTB = HALF * BK * 2, STAGE_BYTES = 8 * HTB, NXCD = 8, WGM = 2;
__host__ __device__ __forceinline__ int lds_byte(int r, int c) { const int st = (r >> 4) * 2 + (c >> 5), rr = r & 15, cc = c & 31, ob = rr * 64 + cc * 2; return st * 1024 + (ob ^ (((ob >> 9) & 1) << 5)); }
__host__ __device__ __forceinline__ void stage_rc(int b, int& R, int& C) { const int st = b / 1024, sb = b % 1024, swz = sb ^ (((sb >> 9) & 1) << 5); R = (st >> 1) * 16 + swz / 64; C = (st & 1) * 32 + (swz % 64) / 2; }
__host__ __device__ __forceinline__ int perm32(int rho) { const int n = rho >> 4, i = rho & 15; return 8 * (i >> 2) + 4 * n + (i & 3); }

struct Unit { int pm, pn, e; };
struct Gemm { const bf16* A; const bf16* Bt; int lda, ldb, K; size_t b_estride; const int* rowmap; const LAS int* tb; };

struct StaticOrder {
    int nM, nN, nwg, G, c;
    __device__ void init(int Mr, int N, int G_, int c_) { nM = Mr / BM; nN = N / BM; nwg = nM * nN; G = G_; c = c_; }
    __device__ bool next(int i, Unit& u) const {
        const long L = (long)i * G + c; if (L >= nwg) return false;
        int wgid = (int)L; { const int q = nwg / NXCD, r = nwg % NXCD, xcd = wgid % NXCD, off = wgid / NXCD; wgid = (xcd < r ? xcd * (q + 1) : r * (q + 1) + (xcd - r) * q) + off; }
        const int nig = WGM * nN, gid = wgid / nig, fm = gid * WGM, gsz = (nM - fm) < WGM ? (nM - fm) : WGM;
        u.pm = fm + ((wgid % nig) % gsz); u.pn = (wgid % nig) / gsz; u.e = 0; return true;
    }
};
struct MoeOrder {
    const LAS int* tb; int nN, G, c;
    __device__ bool next(int i, Unit& u) const {
        const int L = i * G + c; const int total = tb[32] * nN; if (L >= total) return false;
        const int q = total / NXCD, r = total % NXCD, xcd = L % NXCD, off = L / NXCD; const int wg = (xcd < r ? xcd * (q + 1) : r * (q + 1) + (xcd - r) * q) + off;
        const int rt = wg / nN; u.pn = wg % nN; u.pm = rt; int e = 0;
#pragma unroll 1
        for (int k = 1; k < 32; ++k) e += (rt >= tb[k]) ? 1 : 0;
        u.e = e; return true;
    }
};

template <bool I8> struct AccSel { typedef f32x4 t; };
template <> struct AccSel<true> { typedef i32x4 t; };
template <class Epi, class Sched, bool GATHER = false, bool I8 = false>
__device__ __forceinline__ void gemm_phase(PG8_LAS unsigned char* lds, const Gemm g, const Sched& S, const Epi& E) {
    int tid_ = threadIdx.x; asm volatile("" : "+v"(tid_));
    const int tid = tid_, wid = __builtin_amdgcn_readfirstlane(tid >> 6), lane = tid & 63, wr = wid >> 2, wc = wid & 3, fr = lane & 15, fq = lane >> 4;
    const int K = g.K, nt = K / BK;
    unsigned voffA[2], voffB[2];
#pragma unroll
    for (int i = 0; i < 2; ++i) { int R, C; stage_rc(tid * 16 + i * 8192, R, C); const int Rb = (R & ~31) + perm32(R & 31);
        voffA[i] = (unsigned)(R * g.lda + C) * 2u; voffB[i] = (unsigned)(Rb * g.ldb + C) * 2u; }
#define PG8_GOFFS(u_, go_) do { if constexpr (GATHER) { const int e_ = (u_).e; const int ti_ = (u_).pm - g.tb[e_]; const int cn_ = g.tb[40 + e_]; \
        _Pragma("unroll") for (int h_ = 0; h_ < 2; ++h_) _Pragma("unroll") for (int i_ = 0; i_ < 2; ++i_) { int R_, C_; stage_rc(tid * 16 + i_ * 8192, R_, C_); const int sl_ = ti_ * 256 + h_ * 128 + R_; \
            const int tr_ = (sl_ < cn_) ? g.rowmap[e_ * 16384 + sl_] : 0; go_[h_][i_] = (unsigned)(tr_ * g.lda + C_) * 2u; } } } while (0)
    unsigned goC[2][2] = {{0u, 0u}, {0u, 0u}}, goN[2][2] = {{0u, 0u}, {0u, 0u}};
    const size_t kstep = (size_t)(BK * 2);
    const size_t hA = GATHER ? 0 : (size_t)HALF * g.lda * 2, hB = (size_t)HALF * g.ldb * 2;
    const size_t tA = 2 * hA, tB = 2 * hB;
    const unsigned ldsw = (unsigned)wid * 1024u;
    const int aoff = lds_byte(wr * 64 + fr, fq * 8), boff = lds_byte(wc * 32 + fr, fq * 8);
#define PG8_SA(b, h) (((b) * 2 + (h)) * HTB)
#define PG8_SB(b, h) ((4 + (b) * 2 + (h)) * HTB)
#define PG8_STAGE(bufoff, gbase, voff) do { _Pragma("unroll") for (int _i = 0; _i < 2; ++_i) \
        __builtin_amdgcn_global_load_lds((const unsigned*)((const char*)(gbase) + (voff)[_i]), (PG8_LAS unsigned*)(lds + (bufoff) + ldsw + _i * 8192), 16, 0, 0); } while (0)
#define PG8_LDA(dst, b, h) do { _Pragma("unroll") for (int m = 0; m < 4; ++m) _Pragma("unroll") for (int k = 0; k < 2; ++k) dst[m][k] = *(const PG8_LAS bf16x8*)(lds + PG8_SA(b, h) + aoff + m * 2048 + k * 1024); } while (0)
#define PG8_LDB(dst, b, h) do { _Pragma("unroll") for (int n = 0; n < 2; ++n) _Pragma("unroll") for (int k = 0; k < 2; ++k) dst[n][k] = *(const PG8_LAS bf16x8*)(lds + PG8_SB(b, h) + boff + n * 2048 + k * 1024); } while (0)
#define PG8_MMA(ai, bj, At, Bt) do { __builtin_amdgcn_s_setprio(1); _Pragma("unroll") for (int m = 0; m < 4; ++m) _Pragma("unroll") for (int n = 0; n < 2; ++n) _Pragma("unroll") for (int k = 0; k < 2; ++k) { \
        if constexpr (I8) acc[ai][bj][m][n] = __builtin_amdgcn_mfma_i32_16x16x64_i8(__builtin_bit_cast(i32x4, Bt[n][k]), __builtin_bit_cast(i32x4, At[m][k]), acc[ai][bj][m][n], 0, 0, 0); \
        else acc[ai][bj][m][n] = __builtin_amdgcn_mfma_f32_16x16x32_bf16(Bt[n][k], At[m][k], acc[ai][bj][m][n], 0, 0, 0); } __builtin_amdgcn_s_setprio(0); } while (0)
#define PG8_WAIT_V(n) asm volatile("s_waitcnt vmcnt(" #n ")" ::: "memory")
#define PG8_WAIT_L(n) asm volatile("s_waitcnt lgkmcnt(" #n ")" ::: "memory")
#define PG8_BAR __builtin_amdgcn_s_barrier()
#define PG8_SCHED __builtin_amdgcn_sched_barrier(0)
    Unit cur, nxt; int ui = 0;
    if (!S.next(0, cur)) return;
    typedef typename AccSel<I8>::t acc_t;
    acc_t acc[2][2][4][2];
#pragma unroll
    for (int a = 0; a < 2; ++a)
#pragma unroll
        for (int b = 0; b < 2; ++b)
#pragma unroll
            for (int m = 0; m < 4; ++m)
#pragma unroll
                for (int n = 0; n < 2; ++n) acc[a][b][m][n] = (acc_t){0, 0, 0, 0};
    bf16x8 At[4][2], B0[2][2], B1[2][2];
    const char* cA = (const char*)g.A + (GATHER ? 0 : (size_t)cur.pm * tA); const char* cB = (const char*)g.Bt + (size_t)cur.e * g.b_estride * 2 + (size_t)cur.pn * tB;
    PG8_GOFFS(cur, goC);
#define PG8_VA(cond_, h_) (GATHER ? ((cond_) ? goN[h_] : goC[h_]) : voffA)
    PG8_STAGE(PG8_SB(0, 0), cB, voffB); PG8_STAGE(PG8_SB(0, 1), cB + hB, voffB); PG8_STAGE(PG8_SA(0, 0), cA, PG8_VA(false, 0)); PG8_STAGE(PG8_SA(0, 1), cA + hA, PG8_VA(false, 1));
    if (wr == 1) PG8_BAR;
    PG8_WAIT_V(2); PG8_BAR;
    PG8_STAGE(PG8_SB(1, 0), cB + kstep, voffB); PG8_STAGE(PG8_SA(1, 0), cA + kstep, PG8_VA(false, 0)); PG8_STAGE(PG8_SB(1, 1), cB + hB + kstep, voffB);
    PG8_WAIT_V(6); PG8_BAR;
    for (;;) {
        const bool has_next = S.next(ui + 1, nxt);
        const char* nA = (has_next && !GATHER) ? (const char*)g.A + (size_t)nxt.pm * tA : cA;
        if (has_next) PG8_GOFFS(nxt, goN); else { goN[0][0] = goC[0][0]; goN[0][1] = goC[0][1]; goN[1][0] = goC[1][0]; goN[1][1] = goC[1][1]; }
        const char* nB = has_next ? (const char*)g.Bt + (size_t)nxt.e * g.b_estride * 2 + (size_t)nxt.pn * tB : cB;
#pragma unroll 1
        for (int t = 0; t < nt; t += 2) {
            const bool last = (t == nt - 2);
            const char* a1 = cA + (size_t)(t + 1) * kstep;
            const char* a2 = last ? nA : cA + (size_t)(t + 2) * kstep; const char* b2 = last ? nB : cB + (size_t)(t + 2) * kstep;
            const char* a3 = a2 + kstep; const char* b3 = b2 + kstep;
            PG8_LDB(B0, 0, 0); PG8_LDB(B1, 0, 1); PG8_SCHED; PG8_LDA(At, 0, 0); PG8_STAGE(PG8_SA(1, 1), a1 + hA, PG8_VA(false, 1));
            PG8_WAIT_V(8); PG8_WAIT_L(0); PG8_BAR; PG8_MMA(0, 0, At, B0); PG8_MMA(0, 1, At, B1); PG8_BAR; PG8_SCHED;
            PG8_LDA(At, 0, 1); PG8_STAGE(PG8_SB(0, 0), b2, voffB); PG8_STAGE(PG8_SB(0, 1), b2 + hB, voffB); PG8_STAGE(PG8_SA(0, 0), a2, PG8_VA(last, 0));
            PG8_WAIT_V(8); PG8_WAIT_L(0); PG8_BAR; PG8_MMA(1, 0, At, B0); PG8_MMA(1, 1, At, B1); PG8_BAR; PG8_SCHED;
            PG8_LDB(B0, 1, 0); PG8_LDB(B1, 1, 1); PG8_SCHED; PG8_LDA(At, 1, 0); PG8_STAGE(PG8_SA(0, 1), a2 + hA, PG8_VA(last, 1));
            PG8_WAIT_V(8); PG8_WAIT_L(0); PG8_BAR; PG8_MMA(0, 0, At, B0); PG8_MMA(0, 1, At, B1); PG8_BAR; PG8_SCHED;
            PG8_LDA(At, 1, 1); PG8_STAGE(PG8_SB(1, 0), b3, voffB); PG8_STAGE(PG8_SB(1, 1), b3 + hB, voffB); PG8_STAGE(PG8_SA(1, 0), a3, PG8_VA(last, 0));
            PG8_WAIT_V(8); PG8_WAIT_L(0); PG8_BAR; PG8_MMA(1, 0, At, B0); PG8_MMA(1, 1, At, B1); PG8_BAR; PG8_SCHED;
        }
        if (wr == 0) PG8_BAR;
        E(acc, cur, wr, wc, fr, fq);
        if (!has_next) break;
#pragma unroll
        for (int a = 0; a < 2; ++a)
#pragma unroll
            for (int b = 0; b < 2; ++b)
#pragma unroll
                for (int m = 0; m < 4; ++m)
#pragma unroll
                    for (int n = 0; n < 2; ++n) acc[a][b][m][n] = (acc_t){0, 0, 0, 0};
        cur = nxt; cA = nA; cB = nB; ++ui; goC[0][0] = goN[0][0]; goC[0][1] = goN[0][1]; goC[1][0] = goN[1][0]; goC[1][1] = goN[1][1];
        if (wr == 1) PG8_BAR;
    }
    PG8_WAIT_V(0);
    PG8_BAR;
#undef PG8_GOFFS
#undef PG8_VA
#undef PG8_SA
#undef PG8_SB
#undef PG8_STAGE
#undef PG8_LDA
#undef PG8_LDB
#undef PG8_MMA
#undef PG8_WAIT_V
#undef PG8_WAIT_L
#undef PG8_BAR
#undef PG8_SCHED
}

template <class Epi, class Sched>
__device__ __forceinline__ void gemm_chain3(PG8_LAS unsigned char* lds, const Gemm g0, const Gemm g1, const Gemm g2, const Sched& S, const Epi& E) {
    int tid_ = threadIdx.x; asm volatile("" : "+v"(tid_));
    const int tid = tid_, wid = __builtin_amdgcn_readfirstlane(tid >> 6), lane = tid & 63, wr = wid >> 2, wc = wid & 3, fr = lane & 15, fq = lane >> 4;
    int Rr[2], Cc[2], Rbb[2];
#pragma unroll
    for (int i = 0; i < 2; ++i) { int R, C; stage_rc(tid * 16 + i * 8192, R, C); Rr[i] = R; Cc[i] = C; Rbb[i] = (R & ~31) + perm32(R & 31); }
#define PG8_SEL(br_, f_) ((br_) == 0 ? g0.f_ : ((br_) == 1 ? g1.f_ : g2.f_))
#define PG8_VOFF(br_, va_, vb_) do { const int lda_ = PG8_SEL(br_, lda), ldb_ = PG8_SEL(br_, ldb); _Pragma("unroll") for (int i_ = 0; i_ < 2; ++i_) { \
        va_[i_] = (unsigned)(Rr[i_] * lda_ + Cc[i_]) * 2u; vb_[i_] = (unsigned)(Rbb[i_] * ldb_ + Cc[i_]) * 2u; } } while (0)
    const size_t kstep = (size_t)(BK * 2);
    const unsigned ldsw = (unsigned)wid * 1024u;
    const int aoff = lds_byte(wr * 64 + fr, fq * 8), boff = lds_byte(wc * 32 + fr, fq * 8);
#define PG8_SA(b, h) (((b) * 2 + (h)) * HTB)
#define PG8_SB(b, h) ((4 + (b) * 2 + (h)) * HTB)
#define PG8_STAGE(bufoff, gbase, voff) do { _Pragma("unroll") for (int _i = 0; _i < 2; ++_i) \
        __builtin_amdgcn_global_load_lds((const unsigned*)((const char*)(gbase) + (voff)[_i]), (PG8_LAS unsigned*)(lds + (bufoff) + ldsw + _i * 8192), 16, 0, 0); } while (0)
#define PG8_LDA(dst, b, h) do { _Pragma("unroll") for (int m = 0; m < 4; ++m) _Pragma("unroll") for (int k = 0; k < 2; ++k) dst[m][k] = *(const PG8_LAS bf16x8*)(lds + PG8_SA(b, h) + aoff + m * 2048 + k * 1024); } while (0)
#define PG8_LDB(dst, b, h) do { _Pragma("unroll") for (int n = 0; n < 2; ++n) _Pragma("unroll") for (int k = 0; k < 2; ++k) dst[n][k] = *(const PG8_LAS bf16x8*)(lds + PG8_SB(b, h) + boff + n * 2048 + k * 1024); } while (0)
#define PG8_MMA(ai, bj, At, Bt) do { __builtin_amdgcn_s_setprio(1); _Pragma("unroll") for (int m = 0; m < 4; ++m) _Pragma("unroll") for (int n = 0; n < 2; ++n) _Pragma("unroll") for (int k = 0; k < 2; ++k) \
        acc[ai][bj][m][n] = __builtin_amdgcn_mfma_f32_16x16x32_bf16(Bt[n][k], At[m][k], acc[ai][bj][m][n], 0, 0, 0); __builtin_amdgcn_s_setprio(0); } while (0)
#define PG8_WAIT_V(n) asm volatile("s_waitcnt vmcnt(" #n ")" ::: "memory")
#define PG8_WAIT_L(n) asm volatile("s_waitcnt lgkmcnt(" #n ")" ::: "memory")
#define PG8_BAR __builtin_amdgcn_s_barrier()
#define PG8_SCHED __builtin_amdgcn_sched_barrier(0)
    Unit cur, nxt; int ui = 0;
    if (!S.next(0, cur)) return;
    int brc = 0;
    f32x4 acc[2][2][4][2];
#pragma unroll
    for (int a = 0; a < 2; ++a)
#pragma unroll
        for (int b = 0; b < 2; ++b)
#pragma unroll
            for (int m = 0; m < 4; ++m)
#pragma unroll
                for (int n = 0; n < 2; ++n) acc[a][b][m][n] = (f32x4){0.f, 0.f, 0.f, 0.f};
    bf16x8 At[4][2], B0[2][2], B1[2][2];
    unsigned vAc[2], vBc[2], vAn[2], vBn[2];
    PG8_VOFF(0, vAc, vBc);
    size_t hAc = (size_t)HALF * g0.lda * 2, hBc = (size_t)HALF * g0.ldb * 2, hAn = hAc, hBn = hBc; int ntc = g0.K / BK;
    const char* cA = (const char*)g0.A + (size_t)cur.pm * 2 * hAc; const char* cB = (const char*)g0.Bt + (size_t)cur.pn * 2 * hBc;
    PG8_STAGE(PG8_SB(0, 0), cB, vBc); PG8_STAGE(PG8_SB(0, 1), cB + hBc, vBc); PG8_STAGE(PG8_SA(0, 0), cA, vAc); PG8_STAGE(PG8_SA(0, 1), cA + hAc, vAc);
    if (wr == 1) PG8_BAR;
    PG8_WAIT_V(2); PG8_BAR;
    PG8_STAGE(PG8_SB(1, 0), cB + kstep, vBc); PG8_STAGE(PG8_SA(1, 0), cA + kstep, vAc); PG8_STAGE(PG8_SB(1, 1), cB + hBc + kstep, vBc);
    PG8_WAIT_V(6); PG8_BAR;
    for (;;) {
        const int brn = (brc == 2) ? 0 : brc + 1; bool has_next = true;
        if (brc == 2) has_next = S.next(ui / 3 + 1, nxt); else nxt = cur;
        const char* nA = cA; const char* nB = cB;
        if (has_next) { PG8_VOFF(brn, vAn, vBn); hAn = (size_t)HALF * PG8_SEL(brn, lda) * 2; hBn = (size_t)HALF * PG8_SEL(brn, ldb) * 2;
            nA = (const char*)PG8_SEL(brn, A) + (size_t)nxt.pm * 2 * hAn; nB = (const char*)PG8_SEL(brn, Bt) + (size_t)nxt.pn * 2 * hBn; }
        else { vAn[0] = vAc[0]; vAn[1] = vAc[1]; vBn[0] = vBc[0]; vBn[1] = vBc[1]; hAn = hAc; hBn = hBc; }
#pragma unroll 1
        for (int t = 0; t < ntc; t += 2) {
            const bool last = (t == ntc - 2);
            const char* a1 = cA + (size_t)(t + 1) * kstep;
            const char* a2 = last ? nA : cA + (size_t)(t + 2) * kstep; const char* b2 = last ? nB : cB + (size_t)(t + 2) * kstep;
            const char* a3 = a2 + kstep; const char* b3 = b2 + kstep;
            const size_t hA2 = last ? hAn : hAc, hB2 = last ? hBn : hBc;
            PG8_LDB(B0, 0, 0); PG8_LDB(B1, 0, 1); PG8_SCHED; PG8_LDA(At, 0, 0); PG8_STAGE(PG8_SA(1, 1), a1 + hAc, vAc);
            PG8_WAIT_V(8); PG8_WAIT_L(0); PG8_BAR; PG8_MMA(0, 0, At, B0); PG8_MMA(0, 1, At, B1); PG8_BAR; PG8_SCHED;
            PG8_LDA(At, 0, 1); PG8_STAGE(PG8_SB(0, 0), b2, (last ? vBn : vBc)); PG8_STAGE(PG8_SB(0, 1), b2 + hB2, (last ? vBn : vBc)); PG8_STAGE(PG8_SA(0, 0), a2, (last ? vAn : vAc));
            PG8_WAIT_V(8); PG8_WAIT_L(0); PG8_BAR; PG8_MMA(1, 0, At, B0); PG8_MMA(1, 1, At, B1); PG8_BAR; PG8_SCHED;
            PG8_LDB(B0, 1, 0); PG8_LDB(B1, 1, 1); PG8_SCHED; PG8_LDA(At, 1, 0); PG8_STAGE(PG8_SA(0, 1), a2 + hA2, (last ? vAn : vAc));
            PG8_WAIT_V(8); PG8_WAIT_L(0); PG8_BAR; PG8_MMA(0, 0, At, B0); PG8_MMA(0, 1, At, B1); PG8_BAR; PG8_SCHED;
            PG8_LDA(At, 1, 1); PG8_STAGE(PG8_SB(1, 0), b3, (last ? vBn : vBc)); PG8_STAGE(PG8_SB(1, 1), b3 + hB2, (last ? vBn : vBc)); PG8_STAGE(PG8_SA(1, 0), a3, (last ? vAn : vAc));
            PG8_WAIT_V(8); PG8_WAIT_L(0); PG8_BAR; PG8_MMA(1, 0, At, B0); PG8_MMA(1, 1, At, B1); PG8_BAR; PG8_SCHED;
        }
        if (wr == 0) PG8_BAR;
        if (brc < 2) E.link(acc, cur, brc, wr, wc, fr, fq); else E.fin(acc, cur, wr, wc, fr, fq);
        if (!has_next) break;
        if (brc == 2) {
#pragma unroll
            for (int a = 0; a < 2; ++a)
#pragma unroll
                for (int b = 0; b < 2; ++b)
#pragma unroll
                    for (int m = 0; m < 4; ++m)
#pragma unroll
                        for (int n = 0; n < 2; ++n) acc[a][b][m][n] = (f32x4){0.f, 0.f, 0.f, 0.f}; }
        cur = nxt; cA = nA; cB = nB; ++ui; brc = brn; vAc[0] = vAn[0]; vAc[1] = vAn[1]; vBc[0] = vBn[0]; vBc[1] = vBn[1]; hAc = hAn; hBc = hBn; ntc = PG8_SEL(brc, K) / BK;
        if (wr == 1) PG8_BAR;
    }
    PG8_WAIT_V(0);
    PG8_BAR;
#undef PG8_SEL
#undef PG8_VOFF
#undef PG8_SA
#undef PG8_SB
#undef PG8_STAGE
#undef PG8_LDA
#undef PG8_LDB
#undef PG8_MMA
#undef PG8_WAIT_V
#undef PG8_WAIT_L
#undef PG8_BAR
#undef PG8_SCHED
}

__device__ __forceinline__ f32x2 gelu_pk(f32x2 v) {
    const f32x2 av = __builtin_elementwise_abs(v), d = av * 0.2316418882f + 1.0f;
    f32x2 t; t.x = __builtin_amdgcn_rcpf(d.x); t.y = __builtin_amdgcn_rcpf(d.y);
    f32x2 q = t * 0.5307027145f + (-0.7265760135f); q = q * t + 0.7107068705f; q = q * t + (-0.142248368f); q = q * t + 0.127414796f; q = q * t;
    const f32x2 s = (v * v) * (-0.72134752044f);
    f32x2 e; e.x = __builtin_amdgcn_exp2f(s.x); e.y = __builtin_amdgcn_exp2f(s.y);
    const f32x2 zero2 = {0.f, 0.f};
    return __builtin_elementwise_max(v, zero2) - av * (q * e);
}
__device__ __forceinline__ u32x4 pack8(f32x4 v0, f32x4 v1) { u32x4 w; w.x = cvt_pk_bf16(v0[0], v0[1]); w.y = cvt_pk_bf16(v0[2], v0[3]); w.z = cvt_pk_bf16(v1[0], v1[1]); w.w = cvt_pk_bf16(v1[2], v1[3]); return w; }

struct EpiBf16 {
    bf16* O; int ldc; int split_cols; size_t split_stride;
    __device__ __forceinline__ void operator()(const f32x4 (&acc)[2][2][4][2], const Unit& u, int wr, int wc, int fr, int fq) const {
        const int row0 = u.pm * BM + wr * 64 + fr; int colt = u.pn * BM; bf16* base = O;
        if (split_cols) { const int t = colt / split_cols; base += (size_t)t * split_stride; colt -= t * split_cols; }
        const int col0 = colt + wc * 32 + 8 * fq;
#pragma unroll
        for (int ai = 0; ai < 2; ++ai)
#pragma unroll
            for (int m = 0; m < 4; ++m) { bf16* rowp = base + (size_t)(row0 + ai * HALF + m * 16) * ldc + col0;
#pragma unroll
                for (int bj = 0; bj < 2; ++bj) *(u32x4*)(rowp + bj * HALF) = pack8(acc[ai][bj][m][0], acc[ai][bj][m][1]); }
    }
};
struct EpiProj {
    bf16 *za, *zb, *zc, *zg, *vlo; const float* gate_b; const float* rs; const unsigned* cmax;
    __device__ __forceinline__ void operator()(const i32x4 (&acc)[2][2][4][2], const Unit& u, int wr, int wc, int fr, int fq) const {
        const int row0 = u.pm * BM + wr * 64 + fr; const int pn = u.pn;
        bf16* base; int ld, ct, mode;
        if (pn < 13) { base = za; ld = A_COLS; ct = pn; mode = 0; }
        else if (pn < 22) { base = zb; ld = B_COLS; ct = pn - 13; mode = 0; }
        else if (pn < 30) { base = zc; ld = C_COLS; ct = pn - 22; mode = 1; }
        else if (pn < 42) { base = zg; ld = G_COLS; ct = pn - 30; mode = 2; }
        else { base = vlo; ld = 32; ct = 0; mode = 3; }
        const int col0 = ct * BM + wc * 32 + 8 * fq;
        f32x4 cs[2][2];
#pragma unroll
        for (int bj = 0; bj < 2; ++bj)
#pragma unroll
            for (int n = 0; n < 2; ++n) { const u32x4 b = *(const u32x4*)(cmax + pn * BM + wc * 32 + 8 * fq + bj * HALF + 4 * n);
                cs[bj][n] = (f32x4){__uint_as_float(b.x), __uint_as_float(b.y), __uint_as_float(b.z), __uint_as_float(b.w)} * (1.f / 127.f); }
        float rsv[2][4];
#pragma unroll
        for (int ai = 0; ai < 2; ++ai)
#pragma unroll
            for (int m = 0; m < 4; ++m) rsv[ai][m] = rs[row0 + ai * HALF + m * 16];
#define PG8_DQ(ai, bj, m, n, r) (__builtin_convertvector(acc[ai][bj][m][n], f32x4) * (cs[bj][n] * (r)))
        if (mode == 0) {
#pragma unroll
            for (int ai = 0; ai < 2; ++ai)
#pragma unroll
                for (int m = 0; m < 4; ++m) { const int row = row0 + ai * HALF + m * 16; const float r = rsv[ai][m]; bf16* rowp = base + (size_t)row * ld + col0;
#pragma unroll
                    for (int bj = 0; bj < 2; ++bj) *(u32x4*)(rowp + bj * HALF) = pack8(PG8_DQ(ai, bj, m, 0, r), PG8_DQ(ai, bj, m, 1, r)); }
        } else if (mode == 1) {
#pragma unroll
            for (int ai = 0; ai < 2; ++ai)
#pragma unroll
                for (int m = 0; m < 4; ++m) { const int row = row0 + ai * HALF + m * 16; const float r = rsv[ai][m]; bf16* rowp = base + (size_t)row * ld + col0;
#pragma unroll
                    for (int bj = 0; bj < 2; ++bj) { const f32x4 v0 = PG8_DQ(ai, bj, m, 0, r), v1 = PG8_DQ(ai, bj, m, 1, r);
                        const f32x2 a = gelu_pk((f32x2){v0[0], v0[1]}), b = gelu_pk((f32x2){v0[2], v0[3]}), c = gelu_pk((f32x2){v1[0], v1[1]}), d = gelu_pk((f32x2){v1[2], v1[3]});
                        *(u32x4*)(rowp + bj * HALF) = pack8((f32x4){a.x, a.y, b.x, b.y}, (f32x4){c.x, c.y, d.x, d.y}); } }
        } else if (mode == 2) {
            f32x4 bv[2][2];
#pragma unroll
            for (int bj = 0; bj < 2; ++bj)
#pragma unroll
                for (int n = 0; n < 2; ++n) bv[bj][n] = *(const f32x4*)(gate_b + col0 + bj * HALF + 4 * n);
#pragma unroll
            for (int ai = 0; ai < 2; ++ai)
#pragma unroll
                for (int m = 0; m < 4; ++m) { const int row = row0 + ai * HALF + m * 16; const float r = rsv[ai][m];
#pragma unroll
                    for (int bj = 0; bj < 2; ++bj) { f32x4 v0 = PG8_DQ(ai, bj, m, 0, r) + bv[bj][0], v1 = PG8_DQ(ai, bj, m, 1, r) + bv[bj][1];
                        const f32x4 one4 = {1.f, 1.f, 1.f, 1.f};
                        v0 = v0 * -1.44269504f; v1 = v1 * -1.44269504f;
#pragma unroll
                        for (int e = 0; e < 4; ++e) { v0[e] = __builtin_amdgcn_exp2f(v0[e]); v1[e] = __builtin_amdgcn_exp2f(v1[e]); }
                        v0 = v0 + one4; v1 = v1 + one4;
#pragma unroll
                        for (int e = 0; e < 4; ++e) { v0[e] = __builtin_amdgcn_rcpf(v0[e]); v1[e] = __builtin_amdgcn_rcpf(v1[e]); }
                        v0 = v0 * 255.f; v1 = v1 * 255.f;
#pragma unroll
                        for (int e = 0; e < 4; ++e) { v0[e] = __builtin_rintf(v0[e]); v1[e] = __builtin_rintf(v1[e]); }
                        v0 = __builtin_elementwise_max(v0, one4); v1 = __builtin_elementwise_max(v1, one4);
                        u32 w0 = 0u, w1 = 0u;
#pragma unroll
                        for (int e = 0; e < 4; ++e) { w0 = __builtin_amdgcn_cvt_pk_u8_f32(v0[e], e, w0); w1 = __builtin_amdgcn_cvt_pk_u8_f32(v1[e], e, w1); }
                        *(u32x2*)((unsigned char*)zg + (size_t)row * G_COLS + col0 + bj * HALF) = (u32x2){w0, w1}; } }
        } else {
            if (wc == 0) {
#pragma unroll
                for (int ai = 0; ai < 2; ++ai)
#pragma unroll
                    for (int m = 0; m < 4; ++m) { const int row = row0 + ai * HALF + m * 16; const float r = rsv[ai][m]; bf16* rowp = base + (size_t)row * 32 + 8 * fq;
                        *(u32x4*)(rowp) = pack8(PG8_DQ(ai, 0, m, 0, r), PG8_DQ(ai, 0, m, 1, r)); }
            }
        }
#undef PG8_DQ
    }
};
template <int MODE> struct EpiGate {
    const bf16* gate; bf16* tmp; bf16* merged;
    __device__ __forceinline__ void operator()(const f32x4 (&acc)[2][2][4][2], const Unit& u, int wr, int wc, int fr, int fq) const {
        const int row0 = u.pm * BM + wr * 64 + fr; const int col0 = u.pn * BM + wc * 32 + 8 * fq;
#pragma unroll
        for (int ai = 0; ai < 2; ++ai)
#pragma unroll
            for (int m = 0; m < 4; ++m) { const size_t row = (size_t)(row0 + ai * HALF + m * 16);
#pragma unroll
                for (int bj = 0; bj < 2; ++bj) { const int col = col0 + bj * HALF;
                    const u32x4 gq = *(const u32x4*)(gate + row * G_COLS + col);
                    f32x4 g0 = (f32x4){bflo(gq.x), bfhi(gq.x), bflo(gq.y), bfhi(gq.y)}, g1 = (f32x4){bflo(gq.z), bfhi(gq.z), bflo(gq.w), bfhi(gq.w)};
                    f32x4 v0 = acc[ai][bj][m][0] * g0, v1 = acc[ai][bj][m][1] * g1;
                    bf16* tp = tmp + row * D + col;
                    if (MODE != 0) { const u32x4 tq = *(const u32x4*)tp; v0 += (f32x4){bflo(tq.x), bfhi(tq.x), bflo(tq.y), bfhi(tq.y)}; v1 += (f32x4){bflo(tq.z), bfhi(tq.z), bflo(tq.w), bfhi(tq.w)}; }
                    if (MODE != 2) *(u32x4*)tp = pack8(v0, v1);
                    else *(u32x4*)(merged + row * D + col) = pack8(v0, v1); }
                asm volatile("" ::: "memory"); }
    }
};
struct EpiChainGate {
    const unsigned char* gate; bf16* merged;
    __device__ __forceinline__ void link(f32x4 (&acc)[2][2][4][2], const Unit& u, int br, int wr, int wc, int fr, int fq) const {
        const int row0 = u.pm * BM + wr * 64 + fr; const int col0 = u.pn * BM + wc * 32 + 8 * fq;
        u32x2 gav[2][4][2], gbv[2][4][2];
#pragma unroll
        for (int ai = 0; ai < 2; ++ai)
#pragma unroll
            for (int m = 0; m < 4; ++m)
#pragma unroll
                for (int bj = 0; bj < 2; ++bj) { const unsigned char* gp = gate + (size_t)(row0 + ai * HALF + m * 16) * G_COLS + br * 1024 + col0 + bj * HALF; gav[ai][m][bj] = *(const u32x2*)gp; gbv[ai][m][bj] = *(const u32x2*)(gp + 1024); }
#pragma unroll
        for (int ai = 0; ai < 2; ++ai)
#pragma unroll
            for (int m = 0; m < 4; ++m) {
#pragma unroll
                for (int bj = 0; bj < 2; ++bj) { const u32x2 ga = gav[ai][m][bj], gb = gbv[ai][m][bj];
#pragma unroll
                    for (int e = 0; e < 8; ++e) { const u32 wa = (e < 4) ? ga.x : ga.y, wb = (e < 4) ? gb.x : gb.y; const int sh = 8 * (e & 3);
                        const float r = (float)((wa >> sh) & 255u) * __builtin_amdgcn_rcpf((float)((wb >> sh) & 255u));
                        if (e < 4) acc[ai][bj][m][0][e] *= r; else acc[ai][bj][m][1][e - 4] *= r; } }
                asm volatile("" ::: "memory"); }
    }
    __device__ __forceinline__ void fin(const f32x4 (&acc)[2][2][4][2], const Unit& u, int wr, int wc, int fr, int fq) const {
        const int row0 = u.pm * BM + wr * 64 + fr; const int col0 = u.pn * BM + wc * 32 + 8 * fq;
        u32x2 gqv[2][4][2];
#pragma unroll
        for (int ai = 0; ai < 2; ++ai)
#pragma unroll
            for (int m = 0; m < 4; ++m)
#pragma unroll
                for (int bj = 0; bj < 2; ++bj) gqv[ai][m][bj] = *(const u32x2*)(gate + (size_t)(row0 + ai * HALF + m * 16) * G_COLS + 2048 + col0 + bj * HALF);
#pragma unroll
        for (int ai = 0; ai < 2; ++ai)
#pragma unroll
            for (int m = 0; m < 4; ++m) { const size_t row = (size_t)(row0 + ai * HALF + m * 16);
#pragma unroll
                for (int bj = 0; bj < 2; ++bj) { const int col = col0 + bj * HALF; const u32x2 gq = gqv[ai][m][bj]; f32x4 g0_, g1_;
#pragma unroll
                    for (int e = 0; e < 4; ++e) { g0_[e] = (float)((gq.x >> (8 * e)) & 255u) * (1.f / 255.f); g1_[e] = (float)((gq.y >> (8 * e)) & 255u) * (1.f / 255.f); }
                    *(u32x4*)(merged + row * D + col) = pack8(acc[ai][bj][m][0] * g0_, acc[ai][bj][m][1] * g1_); }
                asm volatile("" ::: "memory"); }
    }
};
struct EpiResid {
    const float* xin; float* xout;
    __device__ __forceinline__ void operator()(const f32x4 (&acc)[2][2][4][2], const Unit& u, int wr, int wc, int fr, int fq) const {
        const int row0 = u.pm * BM + wr * 64 + fr; const int col0 = u.pn * BM + wc * 32 + 8 * fq;
        f32x4 cur[4], nx[4];
#pragma unroll
        for (int bj = 0; bj < 2; ++bj) { const float* ip = xin + (size_t)row0 * D + col0 + bj * HALF; cur[2 * bj] = *(const f32x4*)ip; cur[2 * bj + 1] = *(const f32x4*)(ip + 4); }
#pragma unroll
        for (int rr = 0; rr < 8; ++rr) { const int ai = rr >> 2, m = rr & 3; const size_t off = (size_t)(row0 + ai * HALF + m * 16) * D + col0;
            if (rr < 7) { const int ai2 = (rr + 1) >> 2, m2 = (rr + 1) & 3; const size_t off2 = (size_t)(row0 + ai2 * HALF + m2 * 16) * D + col0;
#pragma unroll
                for (int bj = 0; bj < 2; ++bj) { const float* ip = xin + off2 + bj * HALF; nx[2 * bj] = *(const f32x4*)ip; nx[2 * bj + 1] = *(const f32x4*)(ip + 4); } }
            asm volatile("" ::: "memory");
#pragma unroll
            for (int bj = 0; bj < 2; ++bj) { float* op = xout + off + bj * HALF; *(f32x4*)op = cur[2 * bj] + acc[ai][bj][m][0]; *(f32x4*)(op + 4) = cur[2 * bj + 1] + acc[ai][bj][m][1]; }
            asm volatile("" ::: "memory");
#pragma unroll
            for (int q = 0; q < 4; ++q) cur[q] = nx[q]; }
    }
};
struct EpiSwiglu {
    bf16* hid; const float* rs; const int* rowmap; const LAS int* tb; const unsigned* cmax;
    __device__ __forceinline__ void operator()(const i32x4 (&acc)[2][2][4][2], const Unit& u, int wr, int wc, int fr, int fq) const {
        const int row0 = u.pm * BM + wr * 64 + fr; const int col0 = u.pn * HALF + wc * 32 + 8 * fq;
        const int e = u.e, slot0 = (u.pm - tb[e]) * BM + wr * 64 + fr, cn = tb[40 + e];
        f32x4 cs[2][2];
#pragma unroll
        for (int bj = 0; bj < 2; ++bj)
#pragma unroll
            for (int n = 0; n < 2; ++n) { const u32x4 b = *(const u32x4*)(cmax + e * 1024 + u.pn * BM + bj * HALF + wc * 32 + 8 * fq + 4 * n);
                cs[bj][n] = (f32x4){__uint_as_float(b.x), __uint_as_float(b.y), __uint_as_float(b.z), __uint_as_float(b.w)} * (1.f / 127.f); }
        float rsv[2][4]; int tk[2][4];
#pragma unroll
        for (int ai = 0; ai < 2; ++ai)
#pragma unroll
            for (int m = 0; m < 4; ++m) { const int slot = slot0 + ai * HALF + m * 16; tk[ai][m] = (slot < cn) ? rowmap[e * 16384 + slot] : -1; }
#pragma unroll
        for (int ai = 0; ai < 2; ++ai)
#pragma unroll
            for (int m = 0; m < 4; ++m) rsv[ai][m] = (tk[ai][m] >= 0) ? rs[tk[ai][m]] : 0.f;
#pragma unroll
        for (int ai = 0; ai < 2; ++ai)
#pragma unroll
            for (int m = 0; m < 4; ++m) { bf16* rowp = hid + (size_t)(row0 + ai * HALF + m * 16) * EFF + col0;
                const float r = rsv[ai][m];
                const f32x4 a0 = __builtin_convertvector(acc[ai][0][m][0], f32x4) * (cs[0][0] * r), a1 = __builtin_convertvector(acc[ai][0][m][1], f32x4) * (cs[0][1] * r);
                const f32x4 b0 = __builtin_convertvector(acc[ai][1][m][0], f32x4) * (cs[1][0] * r), b1 = __builtin_convertvector(acc[ai][1][m][1], f32x4) * (cs[1][1] * r);
                f32x4 h0, h1;
#pragma unroll
                for (int q = 0; q < 4; ++q) { h0[q] = a0[q] * sigmoidf_(a0[q]) * b0[q]; h1[q] = a1[q] * sigmoidf_(a1[q]) * b1[q]; }
                *(u32x4*)rowp = pack8(h0, h1); }
    }
};
struct EpiLora { bf16* w; bf16* a; bf16* g; bf16* v;
    __device__ __forceinline__ void operator()(const f32x4 (&acc)[2][2][4][2], const Unit& u, int wr, int wc, int fr, int fq) const {
        const int sec = u.pn >> 2; bf16* base = sec == 0 ? w : (sec == 1 ? a : (sec == 2 ? g : v)); Unit u2 = u; u2.pn = u.pn & 3;
        EpiBf16 e{base, D, 0, 0}; e(acc, u2, wr, wc, fr, fq); } };
}

#define XB_TMO      128
#define XB_XCNT(j)  (256  + 64 * (j))
#define XB_XSUB(j)  (1280 + 64 * (j))
#define XB_XGEN(j)  (2304 + 64 * (j))
#define XB_TOP      3328
#define XB_TOPGEN   3392
#define XCD_BAR_WORDS 3456
#define XB_SPIN_CAP (1u << 22)
__device__ __forceinline__ unsigned xb_ld(unsigned* p)              { return __hip_atomic_load(p, __ATOMIC_RELAXED, __HIP_MEMORY_SCOPE_AGENT); }
__device__ __forceinline__ unsigned xb_add(unsigned* p, unsigned v) { return __hip_atomic_fetch_add(p, v, __ATOMIC_RELAXED, __HIP_MEMORY_SCOPE_AGENT); }
__device__ __forceinline__ unsigned xb_xcc_id() { return (unsigned)__builtin_amdgcn_s_getreg((3 << 11) | 20) & 0xFu; }
#define XB_SPIN(cond, bar) do { unsigned _sp = 0; while (cond) { __builtin_amdgcn_s_sleep(1); \
    if ((++_sp & 255u) == 0u) { if (xb_ld(&(bar)[XB_TMO])) break; if (_sp > XB_SPIN_CAP) { atomicAdd(&(bar)[XB_TMO], 1u); break; } } } } while (0)
struct XcdBarrier { unsigned* bar; unsigned x; volatile LAS unsigned* st; };
__device__ __forceinline__ XcdBarrier xcd_barrier_post(unsigned* bar, volatile LAS unsigned* st) {
    XcdBarrier b; b.bar = bar; b.x = xb_xcc_id(); b.st = st;
    if (threadIdx.x == 0) (void)xb_add(&bar[XB_XCNT(b.x)], 1u);
    return b;
}
__device__ __forceinline__ void xcd_barrier_complete(unsigned* bar, unsigned x, unsigned& nloc, unsigned& nx) {
    const unsigned G = gridDim.x * gridDim.y * gridDim.z;
    unsigned sum, cnt, mine, sp = 0u;
    for (;;) {
        sum = 0u; cnt = 0u; mine = 0u;
#pragma unroll
        for (unsigned j = 0; j < 16; ++j) { const unsigned c = xb_ld(&bar[XB_XCNT(j)]); sum += c; cnt += (c > 0u) ? 1u : 0u; mine = (j == x) ? c : mine; }
        if (sum == G) break;
        __builtin_amdgcn_s_sleep(1);
        if ((++sp & 255u) == 0u) { if (xb_ld(&bar[XB_TMO])) break; if (sp > XB_SPIN_CAP) { atomicAdd(&bar[XB_TMO], 1u); break; } }
    }
    nloc = mine > 0u ? mine : 1u; nx = cnt > 0u ? cnt : 1u;
}
__device__ __forceinline__ void xcd_barrier(const XcdBarrier& b) {
    asm volatile("s_waitcnt vmcnt(0)" ::: "memory");
    __syncthreads();
    if (threadIdx.x == 0) {
        unsigned* bar = b.bar;
        __builtin_amdgcn_s_waitcnt(0);
        unsigned nloc = b.st[0], nx = b.st[1];
        if (nloc == 0u) { xcd_barrier_complete(bar, b.x, nloc, nx); b.st[0] = nloc; b.st[1] = nx; }
        const unsigned old = xb_add(&bar[XB_XSUB(b.x)], 1u);
        const unsigned gen = old / nloc;
        if (old + 1u == (gen + 1u) * nloc) {
            __builtin_amdgcn_fence(__ATOMIC_RELEASE, "agent");
            asm volatile("s_waitcnt vmcnt(0)" ::: "memory");
            const unsigned og = xb_add(&bar[XB_TOP], 1u);
            const unsigned tg = og / nx;
            if (og + 1u == (tg + 1u) * nx) xb_add(&bar[XB_TOPGEN], 1u);
            else XB_SPIN(xb_ld(&bar[XB_TOPGEN]) == tg, bar);
            __builtin_amdgcn_fence(__ATOMIC_ACQUIRE, "agent");
            xb_add(&bar[XB_XGEN(b.x)], 1u);
            asm volatile("s_waitcnt vmcnt(0)" ::: "memory");
        } else {
            XB_SPIN(xb_ld(&bar[XB_XGEN(b.x)]) == gen, bar);
            __builtin_amdgcn_fence(__ATOMIC_ACQUIRE, "agent");
            asm volatile("s_waitcnt vmcnt(0)" ::: "memory");
        }
    }
    __syncthreads();
}

struct Args { const float* in[36]; float* out; unsigned char* ws; int s_lo, s_hi; };
enum { I_X = 0, I_NORM_MIX, I_W_IN, I_MU_A, I_W_DECAY0, I_W_DECAY2, I_A0, I_A2, I_G2, I_K_K, I_K_A, I_R_K, I_LNX_W, I_LNX_B, I_VRES_MU, I_VRES_W1, I_VRES_W2, I_VRES_B,
       I_SGU_LN_W, I_SGU_LN_B, I_SGU_WS, I_SGU_BS, I_GATE_B, I_W_PA, I_W_PB, I_W_PC, I_W_OUT, I_NORM_FFN, I_RGRP, I_RGRP_B, I_REXP, I_REXP_B, I_MOE_W1, I_MOE_W3, I_MOE_W2, I_NORM_FINAL };

struct Ctx {
    LAS unsigned char* lds; unsigned char* ws; const float* const* in; float* out;
    int tid, lane, wave, G, bid, gw, ngw;
    __device__ __forceinline__ const float* inp(int k) const { return AS_GLOBAL(const float, in[k]); }
};
__device__ __forceinline__ Ctx launder(const Ctx& C0) {
    Ctx C = C0; asm volatile("" : "+v"(C.tid), "+v"(C.lane)); asm volatile("" : "+s"(C.wave), "+s"(C.bid), "+s"(C.gw), "+s"(C.ws)); C.ws = AS_GLOBAL(unsigned char, C.ws); C.out = AS_GLOBAL(float, C.out); return C;
}

__device__ __forceinline__ void tr_item(const float* W, int N, int k0, int n0, bf16* WT, int ldk, int drow0, LAS float* scr, int lane) {
    float wv_[32];
#pragma unroll
    for (int i = 0; i < 32; ++i) { const int kk = 2 * i + (lane >> 5); wv_[i] = W[(size_t)(k0 + kk) * N + n0 + (lane & 31)]; }
#pragma unroll
    for (int i = 0; i < 32; ++i) { const int kk = 2 * i + (lane >> 5); scr[kk * 33 + (lane & 31)] = wv_[i]; }
    LDS_WAIT(); asm volatile("" ::: "memory");
    const int c = lane & 7;
#pragma unroll
    for (int j = 0; j < 4; ++j) { const int n = (lane >> 3) + 8 * j; const LAS float* s = scr + (8 * c) * 33 + n;
        u32x4 o; o.x = cvt_pk_bf16(s[0 * 33], s[1 * 33]); o.y = cvt_pk_bf16(s[2 * 33], s[3 * 33]); o.z = cvt_pk_bf16(s[4 * 33], s[5 * 33]); o.w = cvt_pk_bf16(s[6 * 33], s[7 * 33]);
        *(u32x4*)(WT + (size_t)(drow0 + n) * ldk + k0 + 8 * c) = o; }
    LDS_WAIT(); asm volatile("" ::: "memory");
}

__device__ __forceinline__ void tr_item_i8(const float* W, int N, int k0, int n0, unsigned char* WT, int ldkb, int drow0, const unsigned* cmax, LAS float* scr, int lane) {
    float wv_[32];
    const float sc = 127.f / fmaxf(__uint_as_float(cmax[drow0 + (lane & 31)]), 1e-30f);
#pragma unroll
    for (int i = 0; i < 32; ++i) { const int kk = 2 * i + (lane >> 5); wv_[i] = W[(size_t)(k0 + kk) * N + n0 + (lane & 31)]; }
#pragma unroll
    for (int i = 0; i < 32; ++i) { const int kk = 2 * i + (lane >> 5); scr[kk * 33 + (lane & 31)] = __builtin_rintf(wv_[i] * sc); }
    LDS_WAIT(); asm volatile("" ::: "memory");
    const int c = lane & 7;
#pragma unroll
    for (int j = 0; j < 4; ++j) { const int n = (lane >> 3) + 8 * j; const LAS float* s = scr + (8 * c) * 33 + n; u32 q[8];
#pragma unroll
        for (int e = 0; e < 8; ++e) q[e] = (u32)(int)s[e * 33] & 255u;
        *(u32x2*)(WT + (size_t)(drow0 + n) * ldkb + k0 + 8 * c) = (u32x2){q[0] | (q[1] << 8) | (q[2] << 16) | (q[3] << 24), q[4] | (q[5] << 8) | (q[6] << 16) | (q[7] << 24)}; }
    LDS_WAIT(); asm volatile("" ::: "memory");
}
__device__ __forceinline__ void phase_wmax(const Ctx& C0) {
    const Ctx C = launder(C0);
    unsigned* cm = (unsigned*)(C.ws + WS_CTL) + CW_WMAX;
    const int gt = C.bid * 512 + C.tid, ngt = C.G * 512;
    constexpr int NF4 = IN_COLS / 4;
    for (int i = gt; i < NLAYER * 32 * NF4; i += ngt) { const int n4 = i % NF4, kb = (i / NF4) % 32, l = i / (NF4 * 32);
        const float* p = C.inp(I_W_IN) + ((size_t)l * D + kb * 32) * IN_COLS + n4 * 4; f32x4 m = {0.f, 0.f, 0.f, 0.f};
#pragma unroll 8
        for (int k = 0; k < 32; ++k) { const f32x4 v = *(const f32x4*)(p + (size_t)k * IN_COLS); m = __builtin_elementwise_max(m, __builtin_elementwise_abs(v)); }
        unsigned* d = cm + l * WIN_ROWS + n4 * 4;
#pragma unroll
        for (int e = 0; e < 4; ++e) __hip_atomic_fetch_max(d + e, __float_as_uint(m[e]), __ATOMIC_RELAXED, __HIP_MEMORY_SCOPE_AGENT); }
    for (int i = gt; i < 32 * 8; i += ngt) { const int n4 = i % 8, kb = i / 8;
        const float* p = C.inp(I_VRES_W1) + (size_t)(kb * 32) * 32 + n4 * 4; f32x4 m = {0.f, 0.f, 0.f, 0.f};
#pragma unroll 8
        for (int k = 0; k < 32; ++k) { const f32x4 v = *(const f32x4*)(p + (size_t)k * 32); m = __builtin_elementwise_max(m, __builtin_elementwise_abs(v)); }
        unsigned* d = cm + WIN_ROWS + IN_COLS + n4 * 4;
#pragma unroll
        for (int e = 0; e < 4; ++e) __hip_atomic_fetch_max(d + e, __float_as_uint(m[e]), __ATOMIC_RELAXED, __HIP_MEMORY_SCOPE_AGENT); }
    unsigned* cm13 = (unsigned*)(C.ws + WS_CTL) + CW_WMAX13; const float* w1_ = C.inp(I_MOE_W1); const float* w3_ = C.inp(I_MOE_W3);
    for (int i = gt; i < NLAYER * NEXP * 2 * 16 * 128; i += ngt) { const int n4 = i % 128, kb = (i / 128) % 16, sel = (i / 2048) % 2, le = i / 4096;
        const float* p = (sel ? w3_ : w1_) + ((size_t)le * D + kb * 64) * EFF + n4 * 4; f32x4 m = {0.f, 0.f, 0.f, 0.f};
#pragma unroll 8
        for (int k = 0; k < 64; ++k) { const f32x4 v = *(const f32x4*)(p + (size_t)k * EFF); m = __builtin_elementwise_max(m, __builtin_elementwise_abs(v)); }
        const int n = n4 * 4; unsigned* d = cm13 + le * 1024 + (n / 128) * 256 + (n % 128) + sel * 128;
#pragma unroll
        for (int e = 0; e < 4; ++e) __hip_atomic_fetch_max(d + e, __float_as_uint(m[e]), __ATOMIC_RELAXED, __HIP_MEMORY_SCOPE_AGENT); }
}

__device__ __forceinline__ void phase_convert(const Ctx& C0, int l, bool first) {
    const Ctx C = launder(C0);
    LAS float* scr = (LAS float*)(C.lds + C.wave * 16384);
    unsigned char* ws = C.ws;
    constexpr int I_WIN = 16 * 336, I_VR = 16, I_SQ = 16 * 32, I_PB = 4 * 32, I_E13 = 256 * 32, I_E2 = 256 * 32;
    constexpr int NIT_ = I_WIN + I_VR + 3 * I_SQ + I_PB + 2 * I_E13 + I_E2;
    for (int it = C.gw; it < NIT_; it += C.ngw) {
        int r = it;
        if (r < I_WIN) { tr_item_i8(C.inp(I_W_IN) + (size_t)l * D * IN_COLS, IN_COLS, (r / 336) * 64, (r % 336) * 32, ws + WS_WIN, D, (r % 336) * 32, (const unsigned*)(ws + WS_CTL) + CW_WMAX + l * WIN_ROWS, scr, C.lane); continue; } r -= I_WIN;
        if (r < I_VR) { if (l == 1) tr_item_i8(C.inp(I_VRES_W1), 32, r * 64, 0, ws + WS_WIN, D, IN_COLS, (const unsigned*)(ws + WS_CTL) + CW_WMAX + WIN_ROWS, scr, C.lane); continue; } r -= I_VR;
        if (r < I_SQ) { tr_item(C.inp(I_W_PA) + (size_t)l * D * D, D, (r / 32) * 64, (r % 32) * 32, (bf16*)(ws + WS_PA), D, (r % 32) * 32, scr, C.lane); continue; } r -= I_SQ;
        if (r < I_SQ) { tr_item(C.inp(I_W_PC) + (size_t)l * D * D, D, (r / 32) * 64, (r % 32) * 32, (bf16*)(ws + WS_PC), D, (r % 32) * 32, scr, C.lane); continue; } r -= I_SQ;
        if (r < I_SQ) { tr_item(C.inp(I_W_OUT) + (size_t)l * D * D, D, (r / 32) * 64, (r % 32) * 32, (bf16*)(ws + WS_WOUT), D, (r % 32) * 32, scr, C.lane); continue; } r -= I_SQ;
        if (r < I_PB) { tr_item(C.inp(I_W_PB) + (size_t)l * 256 * D, D, (r / 32) * 64, (r % 32) * 32, (bf16*)(ws + WS_PB), 256, (r % 32) * 32, scr, C.lane); continue; } r -= I_PB;
        if (r < 2 * I_E13) { const int sel = r / I_E13; r -= sel * I_E13; const int e = r / 256, q = r % 256, kb = q / 16, nb = q % 16, n0 = nb * 32;
            tr_item_i8(C.inp(sel ? I_MOE_W3 : I_MOE_W1) + ((size_t)l * NEXP + e) * D * EFF, EFF, kb * 64, n0, ws + WS_W13 + (size_t)e * D * D, D, (n0 / 128) * 256 + (n0 % 128) + sel * 128, (const unsigned*)(ws + WS_CTL) + CW_WMAX13 + (l * NEXP + e) * 1024, scr, C.lane); continue; }
        r -= 2 * I_E13;
        { const int e = r / 256, q = r % 256, kb = q / 32, nb = q % 32;
            tr_item(C.inp(I_MOE_W2) + ((size_t)l * NEXP + e) * EFF * D, D, kb * 64, nb * 32, (bf16*)(ws + WS_W2) + (size_t)e * D * EFF, EFF, nb * 32, scr, C.lane); }
    }
    const int gt = C.bid * 512 + C.tid, ngt = C.G * 512;
    if (l == 1) { u32 zz_ = 0u; asm volatile("" : "+v"(zz_));
        for (int i = gt; i < 224 * 64; i += ngt) *(u32x4*)(ws + WS_WIN + (size_t)(10784 + i / 64) * D + (i % 64) * 16) = (u32x4){zz_, zz_, zz_, zz_}; }
    for (int i = gt; i < LORA_N * (LORA_K / 8); i += ngt) {
        const int n = i % LORA_N, k8 = i / LORA_N, sec = n >> 10, nn = n & 1023; float v[8];
#pragma unroll
        for (int e = 0; e < 8; ++e) { const int k = k8 * 8 + e; float x = 0.f;
            if (sec == 0) { if (k < 64) x = C.inp(I_W_DECAY2)[((size_t)l * 64 + k) * D + nn]; }
            else if (sec == 1) { if (k >= 64 && k < 128) x = C.inp(I_A2)[((size_t)l * 64 + (k - 64)) * D + nn]; }
            else if (sec == 2) { if (k >= 128 && k < 256) x = C.inp(I_G2)[((size_t)l * 128 + (k - 128)) * D + nn]; }
            else { if (l == 1 && k >= 256 && k < 288) x = C.inp(I_VRES_W2)[(size_t)(k - 256) * D + nn]; }
            v[e] = x; }
        u32x4 o; o.x = cvt_pk_bf16(v[0], v[1]); o.y = cvt_pk_bf16(v[2], v[3]); o.z = cvt_pk_bf16(v[4], v[5]); o.w = cvt_pk_bf16(v[6], v[7]);
        *(u32x4*)((bf16*)(ws + WS_LORAB) + (size_t)n * LORA_K + k8 * 8) = o;
    }
    for (int i = gt; i < 8 * 128 * 16; i += ngt) { const int s8 = i & 15, t = (i >> 4) & 127, g = i >> 11; const float* src = C.inp(I_SGU_WS) + (((size_t)l * 8 + g) * 128 + t) * 128 + s8 * 8; float v[8];
#pragma unroll
        for (int e = 0; e < 8; ++e) v[e] = (s8 * 8 + e <= t) ? src[e] : 0.f;
        u32x4 o; o.x = cvt_pk_bf16(v[0], v[1]); o.y = cvt_pk_bf16(v[2], v[3]); o.z = cvt_pk_bf16(v[4], v[5]); o.w = cvt_pk_bf16(v[6], v[7]);
        *(u32x4*)((bf16*)(ws + WS_WSC) + (size_t)i * 8) = o; }
    for (int i = gt; i < 48 * (D / 8); i += ngt) { const int e = i / (D / 8), k8 = i % (D / 8); u32 hi[4], lo[4]; float h2[8], l2[8];
#pragma unroll
        for (int q = 0; q < 8; ++q) { const int k = k8 * 8 + q; float w = 0.f;
            if (e < 4) w = C.inp(I_RGRP)[((size_t)l * D + k) * 4 + e]; else if (e < 36) w = C.inp(I_REXP)[((size_t)l * D + k) * 32 + (e - 4)];
            w *= C.inp(I_NORM_FFN)[(size_t)l * D + k];
            const float wh = bf2f(f2bf(w)); h2[q] = wh; l2[q] = w - wh; }
#pragma unroll
        for (int q = 0; q < 4; ++q) { hi[q] = cvt_pk_bf16(h2[2 * q], h2[2 * q + 1]); lo[q] = cvt_pk_bf16(l2[2 * q], l2[2 * q + 1]); }
        *(u32x4*)((bf16*)(ws + WS_WSC + 512 * 1024) + (size_t)e * D + k8 * 8) = (u32x4){hi[0], hi[1], hi[2], hi[3]};
        *(u32x4*)((bf16*)(ws + WS_WSC + 640 * 1024) + (size_t)e * D + k8 * 8) = (u32x4){lo[0], lo[1], lo[2], lo[3]}; }
    if (first) for (int i = gt; i < T * 32; i += ngt) { const int t = i >> 5, f = i & 31;
        double invd = 1.0; for (int q = 0; q < f; ++q) invd *= 0.74989420933245582;
        const float inv = (float)invd;
        const float ang = (float)t * inv;
        double rev = (double)ang * 0.15915494309189535; rev -= __builtin_rint(rev);
        const float rv = (float)rev;
        ((f32x2*)(ws + WS_ROPE))[i] = (f32x2){__builtin_amdgcn_cosf(rv), __builtin_amdgcn_sinf(rv)}; }
}

__device__ __forceinline__ void row_load(const float* p, int lane, f32x4 (&v)[4]) {
#pragma unroll
    for (int j = 0; j < 4; ++j) v[j] = ((const f32x4*)p)[lane + 64 * j];
}
__device__ __forceinline__ float row_ss(const f32x4 (&v)[4]) {
    float s = 0.f;
#pragma unroll
    for (int j = 0; j < 4; ++j) s += (v[j].x * v[j].x + v[j].y * v[j].y) + (v[j].z * v[j].z + v[j].w * v[j].w);
    return wave_sum(s);
}
__device__ __forceinline__ void norm2_rows(const float* xsrc, const float* g, bf16* out, int gw, int ngw, int lane) {
    f32x4 gv[4];
#pragma unroll
    for (int j = 0; j < 4; ++j) gv[j] = ((const f32x4*)g)[lane + 64 * j];
    for (int ml = gw; ml < M; ml += 2 * ngw) { const int m2 = ml + ngw; const bool has2 = m2 < M; const int mb = has2 ? m2 : ml;
        f32x4 va[4], vb[4]; row_load(xsrc + (size_t)ml * D, lane, va); row_load(xsrc + (size_t)mb * D, lane, vb);
        const float ra = __builtin_amdgcn_rsqf(row_ss(va) * (1.f / D) + 1e-6f), rb = __builtin_amdgcn_rsqf(row_ss(vb) * (1.f / D) + 1e-6f);
#pragma unroll
        for (int j = 0; j < 4; ++j) { const f32x4 oa = va[j] * ra * gv[j]; ((u32x2*)(out + (size_t)ml * D))[lane + 64 * j] = (u32x2){cvt_pk_bf16(oa.x, oa.y), cvt_pk_bf16(oa.z, oa.w)}; }
        if (has2) {
#pragma unroll
            for (int j = 0; j < 4; ++j) { const f32x4 ob = vb[j] * rb * gv[j]; ((u32x2*)(out + (size_t)m2 * D))[lane + 64 * j] = (u32x2){cvt_pk_bf16(ob.x, ob.y), cvt_pk_bf16(ob.z, ob.w)}; } } }
}
__device__ __forceinline__ float wave_max(float v) {
#pragma unroll
    for (int o = 1; o < 64; o <<= 1) v = fmaxf(v, __shfl_xor(v, o));
    return v;
}
__device__ __forceinline__ void norm_q8_store(f32x4 (&v)[4], const f32x4 (&gv)[4], float r, unsigned char* orow, float* rsp, int lane) {
    float mx = 0.f;
#pragma unroll
    for (int j = 0; j < 4; ++j) { v[j] = v[j] * r * gv[j]; const f32x4 a = __builtin_elementwise_abs(v[j]); mx = fmaxf(mx, fmaxf(fmaxf(a.x, a.y), fmaxf(a.z, a.w))); }
    mx = fmaxf(wave_max(mx), 1e-20f);
    const float sc = 127.f / mx;
#pragma unroll
    for (int j = 0; j < 4; ++j) { const u32 q0 = (u32)(int)__builtin_rintf(v[j].x * sc) & 255u, q1 = (u32)(int)__builtin_rintf(v[j].y * sc) & 255u, q2 = (u32)(int)__builtin_rintf(v[j].z * sc) & 255u, q3 = (u32)(int)__builtin_rintf(v[j].w * sc);
        ((u32*)orow)[lane + 64 * j] = q0 | (q1 << 8) | (q2 << 16) | (q3 << 24); }
    if (lane == 0) *rsp = mx * (1.f / 127.f);
}
__device__ __forceinline__ void norm2_rows_i8(const float* xsrc, const float* g, unsigned char* out8, float* rs, int gw, int ngw, int lane) {
    f32x4 gv[4];
#pragma unroll
    for (int j = 0; j < 4; ++j) gv[j] = ((const f32x4*)g)[lane + 64 * j];
    for (int ml = gw; ml < M; ml += 2 * ngw) { const int m2 = ml + ngw; const bool has2 = m2 < M; const int mb = has2 ? m2 : ml;
        f32x4 va[4], vb[4]; row_load(xsrc + (size_t)ml * D, lane, va); row_load(xsrc + (size_t)mb * D, lane, vb);
        const float ra = __builtin_amdgcn_rsqf(row_ss(va) * (1.f / D) + 1e-6f), rb = __builtin_amdgcn_rsqf(row_ss(vb) * (1.f / D) + 1e-6f);
        norm_q8_store(va, gv, ra, out8 + (size_t)ml * D, rs + ml, lane);
        if (has2) norm_q8_store(vb, gv, rb, out8 + (size_t)m2 * D, rs + m2, lane); }
}
__device__ __forceinline__ void row_add_moe(const Ctx& C, int ml, f32x4 (&v)[4], const LAS int* tb) {
#ifdef DBG_NOMOE
    return;
#endif
    const int* tk = (const int*)(C.ws + WS_TOK) + 4 * ml; const float* wt = (const float*)(C.ws + WS_TOK + 512 * 1024) + 2 * ml;
    const int d0 = tb[tk[0]] * 256 + tk[1], d1 = tb[tk[2]] * 256 + tk[3]; const float w0 = wt[0], w1 = wt[1];
    const bf16* y0 = (const bf16*)(C.ws + WS_R1 + R1_YEXP) + (size_t)d0 * D; const bf16* y1 = (const bf16*)(C.ws + WS_R1 + R1_YEXP) + (size_t)d1 * D;
#pragma unroll
    for (int j = 0; j < 4; ++j) { const u32x2 a = ((const u32x2*)y0)[C.lane + 64 * j], b = ((const u32x2*)y1)[C.lane + 64 * j];
        v[j].x += w0 * bflo(a.x) + w1 * bflo(b.x); v[j].y += w0 * bfhi(a.x) + w1 * bfhi(b.x); v[j].z += w0 * bflo(a.y) + w1 * bflo(b.y); v[j].w += w0 * bfhi(a.y) + w1 * bfhi(b.y); }
}

__device__ __forceinline__ void mixer_norm(const Ctx& C, int it, int widx, int nw) {
    const int l = it / NCH, c = it % NCH;
    norm2_rows_i8((l == 0 ? C.inp(I_X) : C.out) + (size_t)c * M * D, C.inp(I_NORM_MIX) + (size_t)l * D, C.ws + WS_R1 + R1_HNX, (float*)(C.ws + WS_R1 + R1_HNX + HNX_RS), widx, nw, C.lane);
}
__device__ __forceinline__ void moe_table(const Ctx& C, int it, LAS int* tb);
__device__ __forceinline__ void phase_prep(const Ctx& C0, int it, LAS int* tb) {
    const Ctx C = launder(C0);
    if (it > 0) moe_table(C, it - 1, tb);
    const int l = it / NCH, c = it % NCH;
    if (it > 0) {
        const int pl = (it - 1) / NCH, pc = (it - 1) % NCH; const float* nf = C.inp(I_NORM_FINAL);
        const int* tkb = (const int*)(C.ws + WS_TOK); const float* wtb = (const float*)(C.ws + WS_TOK + 512 * 1024); const bf16* yex = (const bf16*)(C.ws + WS_R1 + R1_YEXP);
        int t0 = 0, t1 = 0, t2 = 0, t3 = 0; float w0 = 0.f, w1 = 0.f;
        if (C.gw < M) { const int* tk = tkb + 4 * C.gw; t0 = tk[0]; t1 = tk[1]; t2 = tk[2]; t3 = tk[3]; w0 = wtb[2 * C.gw]; w1 = wtb[2 * C.gw + 1]; }
        for (int ml = C.gw; ml < M; ml += C.ngw) { float* xr = C.out + ((size_t)pc * M + ml) * D; f32x4 v[4];
            const int d0 = tb[t0] * 256 + t1, d1 = tb[t2] * 256 + t3; const float cw0 = w0, cw1 = w1;
            { const int mn = (ml + C.ngw < M) ? ml + C.ngw : ml; const int* tk = tkb + 4 * mn; t0 = tk[0]; t1 = tk[1]; t2 = tk[2]; t3 = tk[3]; w0 = wtb[2 * mn]; w1 = wtb[2 * mn + 1]; }
            row_load(xr, C.lane, v);
            { const bf16* y0 = yex + (size_t)d0 * D; const bf16* y1 = yex + (size_t)d1 * D;
#pragma unroll
              for (int j = 0; j < 4; ++j) { const u32x2 a = ((const u32x2*)y0)[C.lane + 64 * j], b = ((const u32x2*)y1)[C.lane + 64 * j];
                  v[j].x += cw0 * bflo(a.x) + cw1 * bflo(b.x); v[j].y += cw0 * bfhi(a.x) + cw1 * bfhi(b.x); v[j].z += cw0 * bflo(a.y) + cw1 * bflo(b.y); v[j].w += cw0 * bfhi(a.y) + cw1 * bfhi(b.y); } }
            if (pl == 1) { const float rs = __builtin_amdgcn_rsqf(row_ss(v) * (1.f / D) + 1e-6f);
#pragma unroll
                for (int j = 0; j < 4; ++j) v[j] = v[j] * rs * ((const f32x4*)nf)[C.lane + 64 * j]; }
#pragma unroll
            for (int j = 0; j < 4; ++j) ((f32x4*)xr)[C.lane + 64 * j] = v[j]; }
    }
    if (it == 0) mixer_norm(C, 0, C.gw, C.ngw);
}

__device__ __forceinline__ void sub_lora_prep(const Ctx& C0, int l) {
    const Ctx C = launder(C0);
    const bf16* za = (const bf16*)(C.ws + WS_R2 + R2_ZA); const bf16* vlo = (const bf16*)(C.ws + WS_VLO); bf16* al = (bf16*)(C.ws + WS_R1 + R1_ALORA);
    const float* mu = C.inp(I_MU_A) + (size_t)l * A_COLS + 3072; const float* vmu = C.inp(I_VRES_MU);
    const int gt = C.bid * 512 + C.tid, ngt = C.G * 512;
    for (int i = gt; i < M * 48; i += ngt) { const int ml = i / 48, k8 = i % 48; const int t = ml & (T - 1); float v[8];
        if (k8 < 32) { const u32x4 cur = *(const u32x4*)(za + (size_t)ml * A_COLS + 3072 + k8 * 8); u32x4 prv = (u32x4){0u, 0u, 0u, 0u};
            if (t > 0) prv = *(const u32x4*)(za + (size_t)(ml - 1) * A_COLS + 3072 + k8 * 8);
            const u32 cw[4] = {cur.x, cur.y, cur.z, cur.w}, pw[4] = {prv.x, prv.y, prv.z, prv.w};
#pragma unroll
            for (int e = 0; e < 8; ++e) { const float zc = (e & 1) ? bfhi(cw[e >> 1]) : bflo(cw[e >> 1]), zp = (e & 1) ? bfhi(pw[e >> 1]) : bflo(pw[e >> 1]);
                float x = zc + (zp - zc) * mu[k8 * 8 + e];
                if (k8 < 8) x = 1.f - 2.f * __builtin_amdgcn_rcpf(__expf(2.f * x) + 1.f);
                else if (k8 >= 16) x = sigmoidf_(x);
                v[e] = x; }
        } else if (k8 < 36 && l == 1) { const int c8 = k8 - 32; const u32x4 cur = *(const u32x4*)(vlo + (size_t)ml * 32 + c8 * 8); u32x4 prv = (u32x4){0u, 0u, 0u, 0u};
            if (t > 0) prv = *(const u32x4*)(vlo + (size_t)(ml - 1) * 32 + c8 * 8);
            const u32 cw[4] = {cur.x, cur.y, cur.z, cur.w}, pw[4] = {prv.x, prv.y, prv.z, prv.w};
#pragma unroll
            for (int e = 0; e < 8; ++e) { const float zc = (e & 1) ? bfhi(cw[e >> 1]) : bflo(cw[e >> 1]), zp = (e & 1) ? bfhi(pw[e >> 1]) : bflo(pw[e >> 1]);
                v[e] = zc + (zp - zc) * vmu[c8 * 8 + e]; }
        } else {
#pragma unroll
            for (int e = 0; e < 8; ++e) v[e] = 0.f;
        }
        u32x4 o; o.x = cvt_pk_bf16(v[0], v[1]); o.y = cvt_pk_bf16(v[2], v[3]); o.z = cvt_pk_bf16(v[4], v[5]); o.w = cvt_pk_bf16(v[6], v[7]);
        *(u32x4*)(al + (size_t)ml * LORA_K + k8 * 8) = o; }
}

__device__ __forceinline__ void sub_gmlp(const Ctx& C0, int l) {
    const Ctx C = launder(C0);
    const bf16* zc = (const bf16*)(C.ws + WS_R1 + R1_ZC); bf16* yc = (bf16*)(C.ws + WS_YC); const bf16* wsc = (const bf16*)(C.ws + WS_WSC);
    const float* lnw = C.inp(I_SGU_LN_W) + (size_t)l * D; const float* lnb = C.inp(I_SGU_LN_B) + (size_t)l * D; const float* bs = C.inp(I_SGU_BS) + (size_t)l * 8 * 128;
    LAS bf16* VT = (LAS bf16*)C.lds;
    LAS float* ST = (LAS float*)(C.lds + 40960);
    const int lane = C.lane, w = C.wave;
    for (int u = C.bid; u < 256; u += C.G) {
        const int nloc = u >> 1, gq = u & 1; const int r0 = nloc * 128;
#pragma unroll 1
        for (int tb4 = 0; tb4 < 4; ++tb4) { u32x4 ra[4], rb4[4]; float s1[4], s2[4];
#pragma unroll
            for (int q4 = 0; q4 < 4; ++q4) { const bf16* vr = zc + (size_t)(r0 + 16 * w + 4 * tb4 + q4) * C_COLS + 1024; ra[q4] = ((const u32x4*)vr)[lane]; rb4[q4] = ((const u32x4*)vr)[lane + 64]; }
#pragma unroll
            for (int q4 = 0; q4 < 4; ++q4) { const u32 q[8] = {ra[q4].x, ra[q4].y, ra[q4].z, ra[q4].w, rb4[q4].x, rb4[q4].y, rb4[q4].z, rb4[q4].w}; float a = 0.f, b = 0.f;
#pragma unroll
                for (int e = 0; e < 8; ++e) { const float x0 = bflo(q[e]), x1 = bfhi(q[e]); a += x0 + x1; b += x0 * x0 + x1 * x1; }
                s1[q4] = a; s2[q4] = b; }
#pragma unroll
            for (int o = 1; o < 64; o <<= 1) {
#pragma unroll
                for (int q4 = 0; q4 < 4; ++q4) { const float t1 = __shfl_xor(s1[q4], o), t2 = __shfl_xor(s2[q4], o); s1[q4] += t1; s2[q4] += t2; } }
            if (lane == 0) {
#pragma unroll
                for (int q4 = 0; q4 < 4; ++q4) { const int tk = 16 * w + 4 * tb4 + q4; const float mean = s1[q4] * (1.f / 1024.f); const float var = fmaxf(s2[q4] * (1.f / 1024.f) - mean * mean, 0.f);
                    ST[2 * tk] = mean; ST[2 * tk + 1] = __builtin_amdgcn_rsqf(var + 1e-5f); } } }
        __syncthreads();
        u32x4 gr[4];
#define GM_ISSUE(g_) do { _Pragma("unroll") for (int p_ = 0; p_ < 4; ++p_) { const int idx_ = C.tid + 512 * p_; gr[p_] = *(const u32x4*)(zc + (size_t)(r0 + (idx_ >> 4)) * C_COLS + 1024 + (g_) * 128 + (idx_ & 15) * 8); } } while (0)
        GM_ISSUE(gq * 4);
        for (int gi = 0; gi < 4; ++gi) { const int g = gq * 4 + gi;
#pragma unroll
            for (int p = 0; p < 4; ++p) { const int idx = C.tid + 512 * p; const int tk = idx >> 4, c8 = idx & 15;
                const u32 q[4] = {gr[p].x, gr[p].y, gr[p].z, gr[p].w};
                const float mean = ST[2 * tk], rstd = ST[2 * tk + 1];
#pragma unroll
                for (int e = 0; e < 8; ++e) { const int cc = c8 * 8 + e; const float x = (e & 1) ? bfhi(q[e >> 1]) : bflo(q[e >> 1]);
                    const float y = (x - mean) * rstd * lnw[g * 128 + cc] + lnb[g * 128 + cc];
                    VT[cc * 136 + ((((tk >> 3) + c8) & 15) << 3) + (tk & 7)] = (bf16)f2bf(y); } }
            asm volatile("" ::: "memory");
            if (gi < 3) GM_ISSUE(g + 1);
            __syncthreads();
            const int ct = w & 3, th = w >> 2;
#pragma unroll 1
            for (int tq = 0; tq < 2; ++tq) { const int tau = 2 * th + tq; f32x16 acc;
#pragma unroll
                for (int e = 0; e < 16; ++e) acc[e] = 0.f;
                const int nks = 2 * tau + 2; const int crow = ct * 32 + (lane & 31); const bf16* wrow = wsc + ((size_t)g * 128 + tau * 32 + (lane & 31)) * 128 + (lane >> 5) * 8;
                bf16x8 bb[8];
#pragma unroll
                for (int ks = 0; ks < 8; ++ks) if (ks < nks) bb[ks] = *(const bf16x8*)(wrow + ks * 16);
#pragma unroll
                for (int ks = 0; ks < 8; ++ks) if (ks < nks) { const int s0 = ks * 16 + (lane >> 5) * 8;
                    const bf16x8 a = *(const LAS bf16x8*)(VT + crow * 136 + ((((s0 >> 3) + (crow >> 3)) & 15) << 3));
                    acc = __builtin_amdgcn_mfma_f32_32x32x16_bf16(a, bb[ks], acc, 0, 0, 0); }
                const int tk = tau * 32 + (lane & 31); const float bsv = bs[g * 128 + tk];
                const bf16* ur = zc + (size_t)(r0 + tk) * C_COLS + g * 128 + ct * 32; bf16* yr = yc + (size_t)(r0 + tk) * D + g * 128 + ct * 32;
#pragma unroll
                for (int rq = 0; rq < 4; ++rq) { const int cb = 8 * rq + 4 * (lane >> 5); const u32x2 uu = *(const u32x2*)(ur + cb);
                    const float o0 = bflo(uu.x) * (acc[4 * rq + 0] + bsv), o1 = bfhi(uu.x) * (acc[4 * rq + 1] + bsv), o2 = bflo(uu.y) * (acc[4 * rq + 2] + bsv), o3 = bfhi(uu.y) * (acc[4 * rq + 3] + bsv);
                    *(u32x2*)(yr + cb) = (u32x2){cvt_pk_bf16(o0, o1), cvt_pk_bf16(o2, o3)}; } }
            __syncthreads();
        }
    }
}

__device__ __forceinline__ void sub_attn(const Ctx& C0) {
    const Ctx C = launder(C0);
    const bf16* zb = (const bf16*)(C.ws + WS_R1 + R1_ZB); bf16* og = (bf16*)(C.ws + WS_R1 + R1_OG); float* lse = (float*)(C.ws + WS_LSE); const f32x2* rope = (const f32x2*)(C.ws + WS_ROPE);
    LAS bf16* Qs = (LAS bf16*)C.lds;
    LAS bf16* Ks = (LAS bf16*)(C.lds + 18432);
    LAS bf16* Vs = (LAS bf16*)(C.lds + 18432 + 36864);
    const int lane = C.lane, w = C.wave, fr = lane & 15, fq = lane >> 4;
    u32x4 rqa, rqb, rka[2], rkb[2], rv[4];
#define AT_DECODE(u_, bl_, hd_, gi_, d_, r_, n_) const int bl_ = (u_) / 768, rem_##bl_ = (u_) % 768, hd_ = rem_##bl_ / 64, blk_##bl_ = rem_##bl_ % 64; \
        const int gi_ = hd_ >> 2, d_ = (gi_ == 0) ? 1 : (gi_ == 1 ? 4 : 16), nb_##bl_ = 64 / d_, r_ = blk_##bl_ / nb_##bl_, n_ = blk_##bl_ % nb_##bl_
#define AT_ISSUE(u_) do { AT_DECODE(u_, xbl, xhd, xgi, xd, xr, xn); const int rb_ = xbl * T; const u32x4 z4_ = (u32x4){0u, 0u, 0u, 0u}; \
        { const int row_ = C.tid >> 2, c0_ = (C.tid & 3) * 8; const int t_ = (128 * xn + row_) * xd + xr; const bf16* s_ = zb + (size_t)(rb_ + t_) * B_COLS + xhd * 64; rqa = *(const u32x4*)(s_ + c0_); rqb = *(const u32x4*)(s_ + 32 + c0_); } \
        _Pragma("unroll") for (int p_ = 0; p_ < 2; ++p_) { const int row_ = (C.tid >> 2) + 128 * p_, c0_ = (C.tid & 3) * 8; const int ms_ = 128 * (xn - 1) + row_; rka[p_] = z4_; rkb[p_] = z4_; \
            if (ms_ >= 0) { const int t_ = ms_ * xd + xr; const bf16* s_ = zb + (size_t)(rb_ + t_) * B_COLS + 768 + xhd * 64; rka[p_] = *(const u32x4*)(s_ + c0_); rkb[p_] = *(const u32x4*)(s_ + 32 + c0_); } } \
        _Pragma("unroll") for (int p_ = 0; p_ < 4; ++p_) { const int idx_ = C.tid + 512 * p_; const int row_ = idx_ >> 3, c8_ = idx_ & 7; const int ms_ = 128 * (xn - 1) + row_; rv[p_] = z4_; \
            if (ms_ >= 0) { const int t_ = ms_ * xd + xr; rv[p_] = *(const u32x4*)(zb + (size_t)(rb_ + t_) * B_COLS + 1536 + xhd * 64 + c8_ * 8); } } } while (0)
    if (C.bid < 1536) AT_ISSUE(C.bid);
    for (int u = C.bid; u < 1536; u += C.G) {
        AT_DECODE(u, bl, hd, gi, d, r, n);
        const int rowbase = bl * T;
        { const int row = C.tid >> 2, c0 = (C.tid & 3) * 8; const int t = (128 * n + row) * d + r;
            const u32 qa[4] = {rqa.x, rqa.y, rqa.z, rqa.w}, qb[4] = {rqb.x, rqb.y, rqb.z, rqb.w}; float o1[8], o2[8];
#pragma unroll
            for (int e = 0; e < 8; ++e) { const f32x2 cs = rope[t * 32 + c0 + e]; const float z1 = (e & 1) ? bfhi(qa[e >> 1]) : bflo(qa[e >> 1]), z2 = (e & 1) ? bfhi(qb[e >> 1]) : bflo(qb[e >> 1]);
                o1[e] = (z1 * cs.x - z2 * cs.y) * 0.125f; o2[e] = (z1 * cs.y + z2 * cs.x) * 0.125f; }
            *(LAS u32x4*)(Qs + row * 72 + c0) = (u32x4){cvt_pk_bf16(o1[0], o1[1]), cvt_pk_bf16(o1[2], o1[3]), cvt_pk_bf16(o1[4], o1[5]), cvt_pk_bf16(o1[6], o1[7])};
            *(LAS u32x4*)(Qs + row * 72 + 32 + c0) = (u32x4){cvt_pk_bf16(o2[0], o2[1]), cvt_pk_bf16(o2[2], o2[3]), cvt_pk_bf16(o2[4], o2[5]), cvt_pk_bf16(o2[6], o2[7])}; }
#pragma unroll
        for (int p = 0; p < 2; ++p) { const int row = (C.tid >> 2) + 128 * p, c0 = (C.tid & 3) * 8; const int ms = 128 * (n - 1) + row; u32x4 oa = (u32x4){0u, 0u, 0u, 0u}, ob = oa;
            if (ms >= 0) { const int t = ms * d + r;
                const u32 qa[4] = {rka[p].x, rka[p].y, rka[p].z, rka[p].w}, qb[4] = {rkb[p].x, rkb[p].y, rkb[p].z, rkb[p].w}; float o1[8], o2[8];
#pragma unroll
                for (int e = 0; e < 8; ++e) { const f32x2 cs = rope[t * 32 + c0 + e]; const float z1 = (e & 1) ? bfhi(qa[e >> 1]) : bflo(qa[e >> 1]), z2 = (e & 1) ? bfhi(qb[e >> 1]) : bflo(qb[e >> 1]);
                    o1[e] = z1 * cs.x - z2 * cs.y; o2[e] = z1 * cs.y + z2 * cs.x; }
                oa = (u32x4){cvt_pk_bf16(o1[0], o1[1]), cvt_pk_bf16(o1[2], o1[3]), cvt_pk_bf16(o1[4], o1[5]), cvt_pk_bf16(o1[6], o1[7])};
                ob = (u32x4){cvt_pk_bf16(o2[0], o2[1]), cvt_pk_bf16(o2[2], o2[3]), cvt_pk_bf16(o2[4], o2[5]), cvt_pk_bf16(o2[6], o2[7])}; }
            *(LAS u32x4*)(Ks + row * 72 + c0) = oa; *(LAS u32x4*)(Ks + row * 72 + 32 + c0) = ob; }
#pragma unroll
        for (int p = 0; p < 4; ++p) { const int idx = C.tid + 512 * p; const int row = idx >> 3, c8 = idx & 7;
            *(LAS u32x4*)(Vs + row * 72 + c8 * 8) = rv[p]; }
        asm volatile("" ::: "memory");
        if (u + C.G < 1536) AT_ISSUE(u + C.G);
        __syncthreads();
        f32x4 sc[9];
        { const bf16x8 q0 = *(const LAS bf16x8*)(Qs + (16 * w + fr) * 72 + fq * 8), q1 = *(const LAS bf16x8*)(Qs + (16 * w + fr) * 72 + 32 + fq * 8);
#pragma unroll
            for (int ti = 0; ti < 9; ++ti) { const int kr = 16 * w + 16 * ti + fr;
                const bf16x8 k0 = *(const LAS bf16x8*)(Ks + kr * 72 + fq * 8), k1 = *(const LAS bf16x8*)(Ks + kr * 72 + 32 + fq * 8);
                f32x4 a = (f32x4){0.f, 0.f, 0.f, 0.f};
                a = __builtin_amdgcn_mfma_f32_16x16x32_bf16(k0, q0, a, 0, 0, 0); a = __builtin_amdgcn_mfma_f32_16x16x32_bf16(k1, q1, a, 0, 0, 0); sc[ti] = a; } }
        float mx = -3.0e38f;
#pragma unroll
        for (int ti = 0; ti < 9; ++ti)
#pragma unroll
            for (int e = 0; e < 4; ++e) { const int rel = 16 * ti + 4 * fq + e; const bool ok = (rel >= fr) && (rel <= fr + 128) && (n > 0 || (16 * w + rel) >= 128);
                sc[ti][e] = ok ? sc[ti][e] : -3.0e38f; mx = fmaxf(mx, sc[ti][e]); }
        mx = fmaxf(mx, __shfl_xor(mx, 16)); mx = fmaxf(mx, __shfl_xor(mx, 32));
        float sum = 0.f;
#pragma unroll
        for (int ti = 0; ti < 9; ++ti)
#pragma unroll
            for (int e = 0; e < 4; ++e) { const float p = __expf(sc[ti][e] - mx); sc[ti][e] = p; sum += p; }
        sum += __shfl_xor(sum, 16); sum += __shfl_xor(sum, 32);
        f32x4 oacc[4];
#pragma unroll
        for (int ct = 0; ct < 4; ++ct) oacc[ct] = (f32x4){0.f, 0.f, 0.f, 0.f};
#pragma unroll
        for (int kp = 0; kp < 5; ++kp) { const int t0 = 2 * kp, t1 = (2 * kp + 1 < 9) ? 2 * kp + 1 : 8;
            u32x4 pw; pw.x = cvt_pk_bf16(sc[t0][0], sc[t0][1]); pw.y = cvt_pk_bf16(sc[t0][2], sc[t0][3]);
            if (2 * kp + 1 < 9) { pw.z = cvt_pk_bf16(sc[t1][0], sc[t1][1]); pw.w = cvt_pk_bf16(sc[t1][2], sc[t1][3]); } else { pw.z = 0u; pw.w = 0u; }
            const bf16x8 pb = __builtin_bit_cast(bf16x8, pw);
            const int k0 = 16 * w + 16 * t0 + 4 * fq, k1 = 16 * w + 16 * t1 + 4 * fq;
#pragma unroll
            for (int ct = 0; ct < 4; ++ct) {
                const u32x2 va = lds_tr16(Vs + (k0 + (fr >> 2)) * 72 + ct * 16 + 4 * (fr & 3)), vb = lds_tr16(Vs + (k1 + (fr >> 2)) * 72 + ct * 16 + 4 * (fr & 3));
                const bf16x8 av = __builtin_bit_cast(bf16x8, (u32x4){va.x, va.y, vb.x, vb.y});
                oacc[ct] = __builtin_amdgcn_mfma_f32_16x16x32_bf16(av, pb, oacc[ct], 0, 0, 0); } }
        { const float inv = __builtin_amdgcn_rcpf(sum); const int t = (128 * n + 16 * w + fr) * d + r; const size_t ml = (size_t)(rowbase + t);
            bf16* orow = og + ((size_t)gi * M + ml) * 256 + (hd & 3) * 64;
#pragma unroll
            for (int ct = 0; ct < 4; ++ct) *(u32x2*)(orow + ct * 16 + 4 * fq) = (u32x2){cvt_pk_bf16(oacc[ct][0] * inv, oacc[ct][1] * inv), cvt_pk_bf16(oacc[ct][2] * inv, oacc[ct][3] * inv)};
            if (fq == 0) lse[((size_t)gi * M + ml) * 4 + (hd & 3)] = mx + __logf(sum); }
        __syncthreads();
    }
}

__device__ __forceinline__ void sub_yb_combine(const Ctx& C0) {
    const Ctx C = launder(C0);
    const bf16* og = (const bf16*)(C.ws + WS_R1 + R1_OG); const float* lse = (const float*)(C.ws + WS_LSE); bf16* yb = (bf16*)(C.ws + WS_YB);
    const int gt = C.bid * 512 + C.tid, ngt = C.G * 512;
    for (int i = gt; i < M * 32; i += ngt) { const int ml = i >> 5, c8 = i & 31, hp = c8 >> 3;
        const float l0 = lse[((size_t)0 * M + ml) * 4 + hp], l1 = lse[((size_t)1 * M + ml) * 4 + hp], l2 = lse[((size_t)2 * M + ml) * 4 + hp];
        const float mx = fmaxf(l0, fmaxf(l1, l2)); float w0 = __expf(l0 - mx), w1 = __expf(l1 - mx), w2 = __expf(l2 - mx); const float inv = __builtin_amdgcn_rcpf(w0 + w1 + w2); w0 *= inv; w1 *= inv; w2 *= inv;
        const u32x4 a = *(const u32x4*)(og + ((size_t)0 * M + ml) * 256 + c8 * 8), b = *(const u32x4*)(og + ((size_t)1 * M + ml) * 256 + c8 * 8), c = *(const u32x4*)(og + ((size_t)2 * M + ml) * 256 + c8 * 8);
        const u32 qa[4] = {a.x, a.y, a.z, a.w}, qb[4] = {b.x, b.y, b.z, b.w}, qc[4] = {c.x, c.y, c.z, c.w}; u32 o[4];
#pragma unroll
        for (int e = 0; e < 4; ++e) o[e] = cvt_pk_bf16(w0 * bflo(qa[e]) + w1 * bflo(qb[e]) + w2 * bflo(qc[e]), w0 * bfhi(qa[e]) + w1 * bfhi(qb[e]) + w2 * bfhi(qc[e]));
        *(u32x4*)(yb + (size_t)ml * 256 + c8 * 8) = (u32x4){o[0], o[1], o[2], o[3]}; }
}

__device__ __forceinline__ void ld8(const bf16* p, float (&v)[8]) { const u32x4 a = *(const u32x4*)p; v[0] = bflo(a.x); v[1] = bfhi(a.x); v[2] = bflo(a.y); v[3] = bfhi(a.y); v[4] = bflo(a.z); v[5] = bfhi(a.z); v[6] = bflo(a.w); v[7] = bfhi(a.w); }
__device__ __forceinline__ void ldl8(const LAS float* p, float (&v)[8]) { const f32x4 a = *(const LAS f32x4*)p, b = *(const LAS f32x4*)(p + 4); v[0] = a.x; v[1] = a.y; v[2] = a.z; v[3] = a.w; v[4] = b.x; v[5] = b.y; v[6] = b.z; v[7] = b.w; }
__device__ __forceinline__ void ldf8(const float* p, float (&v)[8]) { const f32x4 a = *(const f32x4*)p, b = *(const f32x4*)(p + 4); v[0] = a.x; v[1] = a.y; v[2] = a.z; v[3] = a.w; v[4] = b.x; v[5] = b.y; v[6] = b.z; v[7] = b.w; }
constexpr int TS = 9216;
template <int KS, bool SW1, bool SW2>
__device__ __forceinline__ f32x16 mm_tile(const LAS bf16* t1, int r1, const LAS bf16* t2, int r2, f32x16 acc, int lane) {
    const int row1 = r1 + (lane & 31), row2 = r2 + (lane & 31), hb = lane >> 5;
    const LAS bf16* p1 = t1 + row1 * 72; const LAS bf16* p2 = t2 + row2 * 72; const int s1 = SW1 ? (row1 >> 3) : 0, s2 = SW2 ? (row2 >> 3) : 0;
#pragma unroll
    for (int ks = 0; ks < KS; ++ks) { const int cb = 2 * ks + hb;
        acc = __builtin_amdgcn_mfma_f32_32x32x16_bf16(*(const LAS bf16x8*)(p1 + ((cb + s1) & 7) * 8), *(const LAS bf16x8*)(p2 + ((cb + s2) & 7) * 8), acc, 0, 0, 0); }
    return acc;
}
__device__ __forceinline__ f32x16 zero16() { f32x16 a;
#pragma unroll
    for (int e = 0; e < 16; ++e) a[e] = 0.f;
    return a; }

__device__ __forceinline__ void phase_chunkpre(const Ctx& C0, int l, int c) {
    const Ctx C = launder(C0);
    LAS unsigned char* L = C.lds;
    LAS bf16* sA = (LAS bf16*)(L + 0 * TS);  LAS bf16* sR = (LAS bf16*)(L + 1 * TS);  LAS bf16* sB = (LAS bf16*)(L + 2 * TS);  LAS bf16* sK = (LAS bf16*)(L + 3 * TS);
    LAS bf16* sBhT = (LAS bf16*)(L + 4 * TS); LAS bf16* sKhT = (LAS bf16*)(L + 5 * TS); LAS bf16* sVT = (LAS bf16*)(L + 6 * TS); LAS bf16* sAT = (LAS bf16*)(L + 7 * TS);
    LAS bf16* sUT = (LAS bf16*)(L + 8 * TS); LAS bf16* sAab = (LAS bf16*)(L + 9 * TS);
    LAS bf16* sPT = (LAS bf16*)(L + 0 * TS);
    LAS bf16* sAak = (LAS bf16*)(L + 10 * TS); LAS bf16* sArb = (LAS bf16*)(L + 11 * TS); LAS bf16* sArk = (LAS bf16*)(L + 12 * TS);
    LAS float* TOT = (LAS float*)(L + 13 * TS);
    LAS bf16* TBB = (LAS bf16*)(L + 13 * TS + 2048);
    LAS float* WC = (LAS float*)(L + 13 * TS + 2048 + 4352);
    LAS float* PAR = (LAS float*)(L + 13 * TS + 2048 + 4352 + 256);
    LAS bf16* sZT = sB;
    const int tid = C.tid, w = C.wave;
    const bf16* ZAg = (const bf16*)(C.ws + WS_R2 + R2_ZA); const bf16* WPg = (const bf16*)(C.ws + WS_R4 + R4_WPRE); const bf16* APg = (const bf16*)(C.ws + WS_R4 + R4_APRE); const bf16* VRg = (const bf16*)(C.ws + WS_R4 + R4_VPRE);
    bf16* VFg = (bf16*)(C.ws + WS_VFIRST) + (size_t)c * M * D; bf16* VPg = (bf16*)(C.ws + WS_VP); float* BNg = (float*)(C.ws + WS_BONUS);
    bf16* YLg = (bf16*)(C.ws + WS_R1 + R1_YLOC); bf16* Qg = (bf16*)(C.ws + WS_R1 + R1_Q); bf16* MTg = (bf16*)(C.ws + WS_R1 + R1_MT); bf16* NCg = (bf16*)(C.ws + WS_R1 + R1_NC);
    const float* mu = C.inp(I_MU_A) + (size_t)l * A_COLS;
    u32x4 qr, qk, qv, qrp, qkp, qvp, qw, qa, qvr, qvf;
#define CP_ISSUE(u_) do { const int bh_ = (u_) / NCHK, ck_ = (u_) % NCHK; const size_t row_ = (size_t)(bh_ >> 4) * T + ck_ * CHK + (tid >> 3); const int chn_ = (bh_ & 15) * 64 + (tid & 7) * 8; \
        const bf16* z_ = ZAg + row_ * A_COLS + chn_; const bool hp_ = (ck_ * CHK + (tid >> 3)) > 0; const u32x4 zero_ = (u32x4){0u, 0u, 0u, 0u}; \
        qr = *(const u32x4*)z_; qk = *(const u32x4*)(z_ + 1024); qv = *(const u32x4*)(z_ + 2048); \
        qrp = hp_ ? *(const u32x4*)(z_ - A_COLS) : zero_; qkp = hp_ ? *(const u32x4*)(z_ - A_COLS + 1024) : zero_; qvp = hp_ ? *(const u32x4*)(z_ - A_COLS + 2048) : zero_; \
        qw = *(const u32x4*)(WPg + row_ * D + chn_); qa = *(const u32x4*)(APg + row_ * D + chn_); \
        if (l == 1) { qvr = *(const u32x4*)(VRg + row_ * D + chn_); qvf = *(const u32x4*)(VFg + row_ * D + chn_); } } while (0)
#define CP_UNPK(v_, q_) do { v_[0] = bflo(q_.x); v_[1] = bfhi(q_.x); v_[2] = bflo(q_.y); v_[3] = bfhi(q_.y); v_[4] = bflo(q_.z); v_[5] = bfhi(q_.z); v_[6] = bflo(q_.w); v_[7] = bfhi(q_.w); } while (0)
    qvr = qvf = (u32x4){0u, 0u, 0u, 0u};
    const int UPB = (32 * NCHK + C.G - 1) / C.G; const int u_lo = C.bid * UPB, u_hi = (u_lo + UPB < 32 * NCHK) ? u_lo + UPB : 32 * NCHK;
    if (u_lo < u_hi) CP_ISSUE(u_lo);
    int par_bh = -1;
#pragma unroll 1
    for (int unit = u_lo; unit < u_hi; ++unit) {
        const int bh = unit / NCHK, ck = unit % NCHK, bl = bh >> 4, h = bh & 15; const size_t row0 = (size_t)bl * T + ck * CHK;
        int lane = C.lane; asm volatile("" : "+v"(lane));
        if (bh != par_bh) { par_bh = bh; __syncthreads();
            for (int i = tid; i < 9 * 64; i += 512) { const int k9 = i >> 6, jj = i & 63, chn = h * 64 + jj; float v;
                if (k9 < 3) v = mu[k9 * 1024 + chn]; else if (k9 == 3) v = C.inp(I_W_DECAY0)[(size_t)l * D + chn]; else if (k9 == 4) v = C.inp(I_A0)[(size_t)l * D + chn];
                else if (k9 == 5) v = C.inp(I_K_K)[(size_t)l * D + chn]; else if (k9 == 6) v = C.inp(I_K_A)[(size_t)l * D + chn]; else if (k9 == 7) v = C.inp(I_R_K)[(size_t)l * D + chn];
                else v = (l == 1) ? C.inp(I_VRES_B)[chn] : 0.f;
                PAR[i] = v; }
            __syncthreads(); }
        { const int t = tid >> 3, o = tid & 7, j0 = o * 8; const int ch = h * 64 + j0; const size_t row = row0 + t;
          float lw[8], av[8], bv[8], kv[8], rv[8], vv[8], Lc[8];
          { float tmp[8], p[8], kk[8], aa[8];
            CP_UNPK(rv, qr); CP_UNPK(tmp, qrp); ldl8(PAR + 0 * 64 + j0, p);
#pragma unroll
            for (int e = 0; e < 8; ++e) rv[e] = rv[e] + (tmp[e] - rv[e]) * p[e];
            CP_UNPK(kv, qk); CP_UNPK(tmp, qkp); ldl8(PAR + 1 * 64 + j0, p);
#pragma unroll
            for (int e = 0; e < 8; ++e) kv[e] = kv[e] + (tmp[e] - kv[e]) * p[e];
            CP_UNPK(vv, qv); CP_UNPK(tmp, qvp); ldl8(PAR + 2 * 64 + j0, p);
#pragma unroll
            for (int e = 0; e < 8; ++e) vv[e] = vv[e] + (tmp[e] - vv[e]) * p[e];
            if (l == 0) { *(u32x4*)(VFg + row * D + ch) = (u32x4){cvt_pk_bf16(vv[0], vv[1]), cvt_pk_bf16(vv[2], vv[3]), cvt_pk_bf16(vv[4], vv[5]), cvt_pk_bf16(vv[6], vv[7])}; }
            else { float vf[8], vb[8]; CP_UNPK(vf, qvf); CP_UNPK(tmp, qvr); ldl8(PAR + 8 * 64 + j0, vb);
#pragma unroll
                for (int e = 0; e < 8; ++e) vv[e] = vv[e] + (vf[e] - vv[e]) * sigmoidf_(vb[e] + tmp[e]); }
            const u32x4 vpk = (u32x4){cvt_pk_bf16(vv[0], vv[1]), cvt_pk_bf16(vv[2], vv[3]), cvt_pk_bf16(vv[4], vv[5]), cvt_pk_bf16(vv[6], vv[7])};
            *(u32x4*)(VPg + row * D + ch) = vpk; CP_UNPK(vv, vpk);
            CP_UNPK(tmp, qw); ldl8(PAR + 3 * 64 + j0, p);
#pragma unroll
            for (int e = 0; e < 8; ++e) { const float x = -(p[e] + tmp[e]); const float sp = fmaxf(x, 0.f) + __logf(1.f + __expf(-fabsf(x))); lw[e] = -__expf(-sp - 0.5f); }
            CP_UNPK(tmp, qa); ldl8(PAR + 4 * 64 + j0, p);
#pragma unroll
            for (int e = 0; e < 8; ++e) aa[e] = sigmoidf_(p[e] + tmp[e]);
            ldl8(PAR + 5 * 64 + j0, p); float ss = 0.f;
#pragma unroll
            for (int e = 0; e < 8; ++e) { kk[e] = kv[e] * p[e]; ss += kk[e] * kk[e]; }
            ss += __shfl_xor(ss, 1); ss += __shfl_xor(ss, 2); ss += __shfl_xor(ss, 4);
            const float kn = 1.0f / fmaxf(sqrtf(ss), 1e-12f);
            ldl8(PAR + 6 * 64 + j0, p); ldl8(PAR + 7 * 64 + j0, tmp); float bs = 0.f;
#pragma unroll
            for (int e = 0; e < 8; ++e) { kk[e] *= kn; kv[e] = kv[e] * (1.f + (aa[e] - 1.f) * p[e]); bs += rv[e] * kv[e] * tmp[e]; av[e] = -kk[e]; bv[e] = kk[e] * aa[e]; }
            bs += __shfl_xor(bs, 1); bs += __shfl_xor(bs, 2); bs += __shfl_xor(bs, 4);
            if (o == 0) BNg[row * 16 + h] = bs;
          }
#pragma unroll
          for (int e = 0; e < 8; ++e) { float x = lw[e]; float y;
              y = __shfl_up(x, 8); if (lane >= 8) x += y; y = __shfl_up(x, 16); if (lane >= 16) x += y; y = __shfl_up(x, 32); if (lane >= 32) x += y; Lc[e] = x; }
          if (lane >= 56) {
#pragma unroll
              for (int e = 0; e < 8; ++e) TOT[w * 64 + j0 + e] = Lc[e]; }
          __syncthreads();
          float LC[8];
#pragma unroll
          for (int e = 0; e < 8; ++e) { float off = 0.f, tot = 0.f;
#pragma unroll
              for (int q = 0; q < 8; ++q) { const float x = TOT[q * 64 + j0 + e]; tot += x; off += (q < w) ? x : 0.f; }
              Lc[e] += off; LC[e] = tot; }
          float ta[8], tr[8], tb[8], tk[8], hb[8], hk[8];
#pragma unroll
          for (int e = 0; e < 8; ++e) { const float eL = __expf(Lc[e]), emL = __expf(-Lc[e]), eLm = __expf(Lc[e] - lw[e]), eh = __expf(LC[e] - Lc[e]);
              ta[e] = av[e] * eLm; tr[e] = rv[e] * eL; tb[e] = bv[e] * emL; tk[e] = kv[e] * emL; hb[e] = bv[e] * eh; hk[e] = kv[e] * eh; }
          *(LAS u32x4*)(sA + t * 72 + j0) = (u32x4){cvt_pk_bf16(ta[0], ta[1]), cvt_pk_bf16(ta[2], ta[3]), cvt_pk_bf16(ta[4], ta[5]), cvt_pk_bf16(ta[6], ta[7])};
          *(LAS u32x4*)(sR + t * 72 + j0) = (u32x4){cvt_pk_bf16(tr[0], tr[1]), cvt_pk_bf16(tr[2], tr[3]), cvt_pk_bf16(tr[4], tr[5]), cvt_pk_bf16(tr[6], tr[7])};
          *(LAS u32x4*)(sB + t * 72 + j0) = (u32x4){cvt_pk_bf16(tb[0], tb[1]), cvt_pk_bf16(tb[2], tb[3]), cvt_pk_bf16(tb[4], tb[5]), cvt_pk_bf16(tb[6], tb[7])};
          *(LAS u32x4*)(sK + t * 72 + j0) = (u32x4){cvt_pk_bf16(tk[0], tk[1]), cvt_pk_bf16(tk[2], tk[3]), cvt_pk_bf16(tk[4], tk[5]), cvt_pk_bf16(tk[6], tk[7])};
#pragma unroll
          for (int e = 0; e < 8; ++e) { const int ad = (j0 + e) * 72 + ((((t >> 3) + o) & 7) << 3) + (t & 7); sAT[ad] = (bf16)f2bf(ta[e]); sBhT[ad] = (bf16)f2bf(hb[e]); sKhT[ad] = (bf16)f2bf(hk[e]); sVT[ad] = (bf16)f2bf(vv[e]); }
          if (t == 0) {
#pragma unroll
              for (int e = 0; e < 8; ++e) WC[j0 + e] = __expf(LC[e]); }
          asm volatile("" ::: "memory");
          if (unit + 1 < u_hi) CP_ISSUE(unit + 1);
        }
        __syncthreads();
        { const int mq = w >> 1, tt = w & 1; const LAS bf16* o1b = (mq & 1) ? sK : sB; const LAS bf16* o2b = (mq & 2) ? sR : sA; const bool incl = (mq & 2) != 0;
          LAS bf16* dst = (mq == 0) ? sAab : ((mq == 1) ? sAak : (mq == 2 ? sArb : sArk));
#pragma unroll
          for (int mt = 0; mt < 2; ++mt) { f32x16 acc = zero16();
              if (mt <= tt) acc = mm_tile<4, false, false>(o1b, mt * 32, o2b, tt * 32, acc, lane);
              const int tg = tt * 32 + (lane & 31);
#pragma unroll
              for (int rq = 0; rq < 4; ++rq) { const int tau0 = mt * 32 + 8 * rq + 4 * (lane >> 5); float v4[4];
#pragma unroll
                  for (int e = 0; e < 4; ++e) { const int tau = tau0 + e; const bool keep = incl ? (tau <= tg) : (tau < tg); v4[e] = keep ? acc[4 * rq + e] : 0.f; }
                  *(LAS u32x2*)(dst + tg * 72 + tau0) = (u32x2){cvt_pk_bf16(v4[0], v4[1]), cvt_pk_bf16(v4[2], v4[3])}; } } }
        __syncthreads();
        if (w < 4) { if (lane < 16) { const int b0 = 16 * w; float tc[16];
#pragma unroll
            for (int r = 0; r < 16; ++r) tc[r] = (r == lane) ? 1.f : 0.f;
#pragma unroll
            for (int q = 0; q < 15; ++q) { const float tq = tc[q];
#pragma unroll
                for (int r = q + 1; r < 16; ++r) tc[r] += bf2f(sAab[(b0 + r) * 72 + b0 + q]) * tq; }
#pragma unroll
            for (int r = 0; r < 16; ++r) TBB[(w * 16 + r) * 16 + lane] = (bf16)f2bf(tc[r]); } }
        else { const int tt = w & 1, itl = (w >> 1) & 1; f32x16 acc = zero16();
            acc = mm_tile<4, false, true>(sAak, tt * 32, sVT, itl * 32, acc, lane);
            const int i = itl * 32 + (lane & 31);
#pragma unroll
            for (int rq = 0; rq < 4; ++rq) { const int t0 = tt * 32 + 8 * rq + 4 * (lane >> 5);
                *(LAS u32x2*)(sZT + i * 72 + t0) = (u32x2){cvt_pk_bf16(acc[4 * rq], acc[4 * rq + 1]), cvt_pk_bf16(acc[4 * rq + 2], acc[4 * rq + 3])}; } }
        __syncthreads();
        { const int fr = lane & 15, fq = lane >> 4; LAS bf16* xt = ((w < 4) ? sUT : sPT) + ((w & 3) * 16) * 72;
          const int zr = (w & 3) * 16 + fr;
          { u32 zz_ = 0u; asm volatile("" : "+v"(zz_)); const u32x4 z4 = (u32x4){zz_, zz_, zz_, zz_};
            *(LAS u32x4*)(xt + (lane >> 2) * 72 + (lane & 3) * 16) = z4; *(LAS u32x4*)(xt + (lane >> 2) * 72 + (lane & 3) * 16 + 8) = z4; }
          LDS_WAIT();
#pragma unroll
          for (int b = 0; b < 4; ++b) { const int t0 = 16 * b + 4 * fq;
              u32x2 zq;
              if (w < 4) zq = *(const LAS u32x2*)(sZT + zr * 72 + t0); else zq = *(const LAS u32x2*)(sAT + zr * 72 + ((((t0 >> 3) + (zr >> 3)) & 7) << 3) + (t0 & 7));
              f32x4 acc = (f32x4){bflo(zq.x), bfhi(zq.x), bflo(zq.y), bfhi(zq.y)};
              if (b > 0) {
#pragma unroll
                  for (int ks = 0; ks < (b + 1) / 2; ++ks) { const bf16x8 oa = *(const LAS bf16x8*)(sAab + (16 * b + fr) * 72 + 32 * ks + 8 * fq), ox = *(const LAS bf16x8*)(xt + fr * 72 + 32 * ks + 8 * fq);
                      acc = __builtin_amdgcn_mfma_f32_16x16x32_bf16(oa, ox, acc, 0, 0, 0); } }
              const u32x2 tq = *(const LAS u32x2*)(TBB + (b * 16 + fr) * 16 + 4 * fq);
              const bf16x8 ot = __builtin_bit_cast(bf16x8, (u32x4){tq.x, tq.y, 0u, 0u}), ow = __builtin_bit_cast(bf16x8, (u32x4){cvt_pk_bf16(acc[0], acc[1]), cvt_pk_bf16(acc[2], acc[3]), 0u, 0u});
              const f32x4 xb = __builtin_amdgcn_mfma_f32_16x16x32_bf16(ot, ow, (f32x4){0.f, 0.f, 0.f, 0.f}, 0, 0, 0);
              *(LAS u32x2*)(xt + fr * 72 + t0) = (u32x2){cvt_pk_bf16(xb[0], xb[1]), cvt_pk_bf16(xb[2], xb[3])};
              LDS_WAIT(); asm volatile("" ::: "memory"); } }
        __syncthreads();
        { const int mt = (w >> 1) & 1, nt = w & 1, ln = lane & 31, lh = lane >> 5;
          if (w < 4) {
              { f32x16 acc = zero16();
                acc = mm_tile<4, false, false>(sUT, mt * 32, sArb, nt * 32, acc, lane); acc = mm_tile<4, true, false>(sVT, mt * 32, sArk, nt * 32, acc, lane);
                bf16* yr = YLg + (row0 + nt * 32 + ln) * D + h * 64 + mt * 32;
#pragma unroll
                for (int rq = 0; rq < 4; ++rq) *(u32x2*)(yr + 8 * rq + 4 * lh) = (u32x2){cvt_pk_bf16(acc[4 * rq], acc[4 * rq + 1]), cvt_pk_bf16(acc[4 * rq + 2], acc[4 * rq + 3])}; }
              { f32x16 acc = zero16();
                acc = mm_tile<4, false, false>(sPT, mt * 32, sArb, nt * 32, acc, lane);
                const int tl = nt * 32 + ln; bf16* qr_ = Qg + (row0 + tl) * D + h * 64 + mt * 32;
#pragma unroll
                for (int rq = 0; rq < 4; ++rq) { const int m0 = mt * 32 + 8 * rq + 4 * lh; const u32x2 rr = *(const LAS u32x2*)(sR + tl * 72 + m0);
                    *(u32x2*)(qr_ + 8 * rq + 4 * lh) = (u32x2){cvt_pk_bf16(acc[4 * rq] + bflo(rr.x), acc[4 * rq + 1] + bfhi(rr.x)), cvt_pk_bf16(acc[4 * rq + 2] + bflo(rr.y), acc[4 * rq + 3] + bfhi(rr.y))}; } }
          } else {
              { f32x16 acc = zero16();
                acc = mm_tile<4, true, false>(sBhT, mt * 32, sUT, nt * 32, acc, lane); acc = mm_tile<4, true, true>(sKhT, mt * 32, sVT, nt * 32, acc, lane);
                const int i_ = nt * 32 + ln;
#pragma unroll
                for (int rq = 0; rq < 4; ++rq) { const int j0_ = mt * 32 + 8 * rq + 4 * lh;
                    bf16* np = NCg + ((((size_t)unit * 4 + (i_ >> 4)) * 64 + (i_ & 15) + 16 * ((j0_ & 15) >> 2)) * 4 + (j0_ >> 4)) * 4;
                    *(u32x2*)np = (u32x2){cvt_pk_bf16(acc[4 * rq], acc[4 * rq + 1]), cvt_pk_bf16(acc[4 * rq + 2], acc[4 * rq + 3])}; } }
              { f32x16 acc = zero16();
                acc = mm_tile<4, false, true>(sPT, mt * 32, sBhT, nt * 32, acc, lane);
                const int j = nt * 32 + ln; const float wc = WC[j];
#pragma unroll
                for (int rq = 0; rq < 4; ++rq) { const int m0 = mt * 32 + 8 * rq + 4 * lh; float v4[4];
#pragma unroll
                    for (int e = 0; e < 4; ++e) v4[e] = acc[4 * rq + e] + ((m0 + e == j) ? wc : 0.f);
                    bf16* mp = MTg + ((((size_t)unit * 8 + 2 * (j >> 4) + (m0 >> 5)) * 64 + (j & 15) + 16 * ((m0 & 15) >> 2)) * 2 + ((m0 >> 4) & 1)) * 4;
                    *(u32x2*)mp = (u32x2){cvt_pk_bf16(v4[0], v4[1]), cvt_pk_bf16(v4[2], v4[3])}; } }
          } }
        __syncthreads();
    }
}

struct CarryBuf { u32x4 m[8]; u32x4 n[2]; };
__device__ __forceinline__ void carry_load(CarryBuf& B, const bf16* MTg, const bf16* NCg, size_t unit, int slab, int lane) {
    const bf16* mb = MTg + unit * 4096; const bf16* nb = NCg + (unit * 4 + slab) * 1024; const unsigned vm = (unsigned)lane * 16u, vm2 = vm + 4096u, vn = (unsigned)lane * 32u;
    asm volatile("global_load_dwordx4 %0, %1, %2" : "=v"(B.m[0]) : "v"(vm), "s"(mb) : "memory");
    asm volatile("global_load_dwordx4 %0, %1, %2 offset:1024" : "=v"(B.m[1]) : "v"(vm), "s"(mb) : "memory");
    asm volatile("global_load_dwordx4 %0, %1, %2 offset:2048" : "=v"(B.m[2]) : "v"(vm), "s"(mb) : "memory");
    asm volatile("global_load_dwordx4 %0, %1, %2 offset:3072" : "=v"(B.m[3]) : "v"(vm), "s"(mb) : "memory");
    asm volatile("global_load_dwordx4 %0, %1, %2" : "=v"(B.m[4]) : "v"(vm2), "s"(mb) : "memory");
    asm volatile("global_load_dwordx4 %0, %1, %2 offset:1024" : "=v"(B.m[5]) : "v"(vm2), "s"(mb) : "memory");
    asm volatile("global_load_dwordx4 %0, %1, %2 offset:2048" : "=v"(B.m[6]) : "v"(vm2), "s"(mb) : "memory");
    asm volatile("global_load_dwordx4 %0, %1, %2 offset:3072" : "=v"(B.m[7]) : "v"(vm2), "s"(mb) : "memory");
    asm volatile("global_load_dwordx4 %0, %1, %2" : "=v"(B.n[0]) : "v"(vn), "s"(nb) : "memory");
    asm volatile("global_load_dwordx4 %0, %1, %2 offset:16" : "=v"(B.n[1]) : "v"(vn), "s"(nb) : "memory");
}
#define CARRY_WAIT(B, N) asm volatile("s_waitcnt vmcnt(" #N ")" : "+v"(B.m[0]), "+v"(B.m[1]), "+v"(B.m[2]), "+v"(B.m[3]), "+v"(B.m[4]), "+v"(B.m[5]), "+v"(B.m[6]), "+v"(B.m[7]), "+v"(B.n[0]), "+v"(B.n[1]) :: "memory")
__device__ __forceinline__ void carry_step(f32x4 (&acc)[4], const CarryBuf& B, bf16* sp) {
    u32 pk[4][2];
#pragma unroll
    for (int jt = 0; jt < 4; ++jt) { pk[jt][0] = cvt_pk_bf16(acc[jt][0], acc[jt][1]); pk[jt][1] = cvt_pk_bf16(acc[jt][2], acc[jt][3]); }
#pragma unroll
    for (int jt = 0; jt < 4; ++jt) *(GAS u32x2*)(sp + jt * 16) = (u32x2){pk[jt][0], pk[jt][1]};
    const bf16x8 sb0 = __builtin_bit_cast(bf16x8, (u32x4){pk[0][0], pk[0][1], pk[1][0], pk[1][1]}), sb1 = __builtin_bit_cast(bf16x8, (u32x4){pk[2][0], pk[2][1], pk[3][0], pk[3][1]});
    const u32 nw[8] = {B.n[0].x, B.n[0].y, B.n[0].z, B.n[0].w, B.n[1].x, B.n[1].y, B.n[1].z, B.n[1].w};
#pragma unroll
    for (int jt = 0; jt < 4; ++jt) { f32x4 a = (f32x4){bflo(nw[2 * jt]), bfhi(nw[2 * jt]), bflo(nw[2 * jt + 1]), bfhi(nw[2 * jt + 1])};
        a = __builtin_amdgcn_mfma_f32_16x16x32_bf16(__builtin_bit_cast(bf16x8, B.m[2 * jt]), sb0, a, 0, 0, 0);
        a = __builtin_amdgcn_mfma_f32_16x16x32_bf16(__builtin_bit_cast(bf16x8, B.m[2 * jt + 1]), sb1, a, 0, 0, 0);
        acc[jt] = a; }
}
__device__ __forceinline__ void phase_carry2(const Ctx& C0) {
    const Ctx C = launder(C0);
    const bf16* MTg = (const bf16*)(C.ws + WS_R1 + R1_MT); const bf16* NCg = (const bf16*)(C.ws + WS_R1 + R1_NC); bf16* sst = (bf16*)(C.ws + WS_R1 + R1_SST);
    const int lane = C.lane, fr = lane & 15, fq = lane >> 4;
    if (C.wave != 0) return;
    for (int task = C.bid; task < 128; task += C.G) { const int bh = task >> 2, slab = task & 3; const size_t u0 = (size_t)bh * NCHK;
        f32x4 acc[4]; acc[0] = acc[1] = acc[2] = acc[3] = (f32x4){0.f, 0.f, 0.f, 0.f};
        CarryBuf B0, B1, B2, B3;
        asm volatile("s_waitcnt vmcnt(0)" ::: "memory");
        carry_load(B0, MTg, NCg, u0, slab, lane); carry_load(B1, MTg, NCg, u0 + 1, slab, lane); carry_load(B2, MTg, NCg, u0 + 2, slab, lane); carry_load(B3, MTg, NCg, u0 + 3, slab, lane);
        bf16* sp = sst + (u0 * 64 + slab * 16 + fr) * 64 + 4 * fq;
        CARRY_WAIT(B0, 30); carry_step(acc, B0, sp + (size_t)0 * 4096); carry_load(B0, MTg, NCg, u0 + 4, slab, lane);
        CARRY_WAIT(B1, 34); carry_step(acc, B1, sp + (size_t)1 * 4096); carry_load(B1, MTg, NCg, u0 + 5, slab, lane);
        CARRY_WAIT(B2, 38); carry_step(acc, B2, sp + (size_t)2 * 4096); carry_load(B2, MTg, NCg, u0 + 6, slab, lane);
        CARRY_WAIT(B3, 42); carry_step(acc, B3, sp + (size_t)3 * 4096); carry_load(B3, MTg, NCg, u0 + 7, slab, lane);
#pragma unroll 1
        for (int c = 4; c < NCHK; c += 4) {
            const size_t un = u0 + ((c + 4 < NCHK) ? c + 4 : c);
            CARRY_WAIT(B0, 42); carry_step(acc, B0, sp + (size_t)(c + 0) * 4096); carry_load(B0, MTg, NCg, un + 0, slab, lane);
            CARRY_WAIT(B1, 42); carry_step(acc, B1, sp + (size_t)(c + 1) * 4096); carry_load(B1, MTg, NCg, un + 1, slab, lane);
            CARRY_WAIT(B2, 42); carry_step(acc, B2, sp + (size_t)(c + 2) * 4096); carry_load(B2, MTg, NCg, un + 2, slab, lane);
            CARRY_WAIT(B3, 42); carry_step(acc, B3, sp + (size_t)(c + 3) * 4096); carry_load(B3, MTg, NCg, un + 3, slab, lane);
        }
        asm volatile("s_waitcnt vmcnt(0)" ::: "memory");
    }
}

__device__ __forceinline__ void phase_post2(const Ctx& C0, int l) {
    const Ctx C = launder(C0);
    const bf16* yl = (const bf16*)(C.ws + WS_R1 + R1_YLOC); const bf16* zz = (const bf16*)(C.ws + WS_R1 + R1_Q); const bf16* sst = (const bf16*)(C.ws + WS_R1 + R1_SST);
    const bf16* vp = (const bf16*)(C.ws + WS_VP); const bf16* gg = (const bf16*)(C.ws + WS_R4 + R4_G); const float* bonus = (const float*)(C.ws + WS_BONUS); bf16* ya = (bf16*)(C.ws + WS_HN);
    LAS float* LWs = (LAS float*)C.lds; LAS float* LBs = LWs + 1024;
    for (int i = C.tid; i < 1024; i += 512) { LWs[i] = C.inp(I_LNX_W)[(size_t)l * D + i]; LBs[i] = C.inp(I_LNX_B)[(size_t)l * D + i]; }
    __syncthreads();
    const int lane = C.lane, lr = lane & 31, lh = lane >> 5;
    for (int task = C.gw; task < 8192; task += C.ngw) { const int unit = task >> 1, sub = task & 1; const int bh = unit / NCHK, ck = unit % NCHK, bl = bh >> 4, h = bh & 15;
        const size_t ml = (size_t)bl * T + ck * CHK + sub * 32 + lr;
        const bf16* srow = sst + (size_t)unit * 4096; const bf16* zrow = zz + ml * D + h * 64; const bf16* ylr = yl + ml * D + h * 64;
        bf16x8 ob[4], oa0[4], oa1[4]; u32x2 yq[8], vq[8], gq[8];
#pragma unroll
        for (int ks = 0; ks < 4; ++ks) { const int m0 = ks * 16 + lh * 8; ob[ks] = *(const bf16x8*)(zrow + m0); oa0[ks] = *(const bf16x8*)(srow + (size_t)lr * 64 + m0); oa1[ks] = *(const bf16x8*)(srow + (size_t)(32 + lr) * 64 + m0); }
#pragma unroll
        for (int q = 0; q < 8; ++q) { const int i0 = (q >> 2) * 32 + 8 * (q & 3) + 4 * lh; yq[q] = *(const u32x2*)(ylr + i0); vq[q] = *(const u32x2*)(vp + ml * D + h * 64 + i0); gq[q] = *(const u32x2*)(gg + ml * D + h * 64 + i0); }
        const float bn = bonus[ml * 16 + h];
        f32x16 d0 = zero16(), d1 = zero16();
#pragma unroll
        for (int ks = 0; ks < 4; ++ks) { d0 = __builtin_amdgcn_mfma_f32_32x32x16_bf16(oa0[ks], ob[ks], d0, 0, 0, 0); d1 = __builtin_amdgcn_mfma_f32_32x32x16_bf16(oa1[ks], ob[ks], d1, 0, 0, 0); }
        float y[32]; float s = 0.f;
#pragma unroll
        for (int itl = 0; itl < 2; ++itl)
#pragma unroll
            for (int rq = 0; rq < 4; ++rq) { const u32x2 q = yq[itl * 4 + rq];
                const float dd0 = itl ? d1[4 * rq] : d0[4 * rq], dd1 = itl ? d1[4 * rq + 1] : d0[4 * rq + 1], dd2 = itl ? d1[4 * rq + 2] : d0[4 * rq + 2], dd3 = itl ? d1[4 * rq + 3] : d0[4 * rq + 3];
                float* yy = y + itl * 16 + rq * 4; yy[0] = bflo(q.x) + dd0; yy[1] = bfhi(q.x) + dd1; yy[2] = bflo(q.y) + dd2; yy[3] = bfhi(q.y) + dd3; s += (yy[0] + yy[1]) + (yy[2] + yy[3]); }
        s += __shfl_xor(s, 32); const float mean = s * (1.f / 64.f); float s2 = 0.f;
#pragma unroll
        for (int e = 0; e < 32; ++e) { const float dlt = y[e] - mean; s2 += dlt * dlt; }
        s2 += __shfl_xor(s2, 32); const float rstd = __builtin_amdgcn_rsqf(s2 * (1.f / 64.f) + 64e-5f);
#pragma unroll
        for (int itl = 0; itl < 2; ++itl)
#pragma unroll
            for (int rq = 0; rq < 4; ++rq) { const int i0 = itl * 32 + 8 * rq + 4 * lh; const int cc = h * 64 + i0; const float* yy = y + itl * 16 + rq * 4;
                const f32x4 w4 = *(const LAS f32x4*)(LWs + cc), b4 = *(const LAS f32x4*)(LBs + cc); const u32x2 vv = vq[itl * 4 + rq], gv = gq[itl * 4 + rq];
                const float o0 = ((yy[0] - mean) * rstd * w4.x + b4.x + bn * bflo(vv.x)) * bflo(gv.x), o1 = ((yy[1] - mean) * rstd * w4.y + b4.y + bn * bfhi(vv.x)) * bfhi(gv.x);
                const float o2 = ((yy[2] - mean) * rstd * w4.z + b4.z + bn * bflo(vv.y)) * bflo(gv.y), o3 = ((yy[3] - mean) * rstd * w4.w + b4.w + bn * bfhi(vv.y)) * bfhi(gv.y);
                *(u32x2*)(ya + ml * D + cc) = (u32x2){cvt_pk_bf16(o0, o1), cvt_pk_bf16(o2, o3)}; }
    }
}

__device__ __forceinline__ void phase_route(const Ctx& C0, int it) {
    const Ctx C = launder(C0);
    const int l = it / NCH, c = it % NCH; const float* xs = C.out + (size_t)c * M * D; const float* g = C.inp(I_NORM_FFN) + (size_t)l * D; bf16* hn = (bf16*)(C.ws + WS_HN);
    const float* rgb = C.inp(I_RGRP_B) + (size_t)l * 4; const float* reb = C.inp(I_REXP_B) + (size_t)l * 32;
    unsigned* cnt = (unsigned*)(C.ws + WS_CTL) + CW_CNT + it * 64; int* tok = (int*)(C.ws + WS_TOK); float* wt = (float*)(C.ws + WS_TOK + 512 * 1024);
    const bf16* wrh = (const bf16*)(C.ws + WS_WSC + 512 * 1024); const bf16* wrl = (const bf16*)(C.ws + WS_WSC + 640 * 1024);
    const int lane = C.lane, fr = lane & 15, fq = lane >> 4;
    for (int rep15 = 0; rep15 < 1 + ((DUP_MASK >> 15) & 1); ++rep15)
    norm2_rows_i8(xs, g, (unsigned char*)hn, (float*)(C.ws + WS_HN + HNX_RS), C.gw, C.ngw, lane);
    LAS float* LG = (LAS float*)(C.lds + C.wave * 4096);
    LAS float* PX = (LAS float*)(C.lds + 32768) + (C.wave >> 1) * (64 * 13);
    const int half = C.wave & 1;
    for (int tbase = C.bid * 4; tbase < M / 16; tbase += C.G * 4) { const int task = tbase + (C.wave >> 1); const int ml = task * 16 + fr; const float* xr = xs + (size_t)ml * D + fq * 8;
        f32x4 acc[3]; acc[0] = acc[1] = acc[2] = (f32x4){0.f, 0.f, 0.f, 0.f}; float ss = 0.f;
#pragma unroll 4
        for (int ks = half * 16; ks < half * 16 + 16; ++ks) { const f32x4 xa = *(const f32x4*)(xr + ks * 32), xb = *(const f32x4*)(xr + ks * 32 + 4);
            ss += (xa.x * xa.x + xa.y * xa.y) + (xa.z * xa.z + xa.w * xa.w) + (xb.x * xb.x + xb.y * xb.y) + (xb.z * xb.z + xb.w * xb.w);
            u32x4 hq; hq.x = cvt_pk_bf16(xa.x, xa.y); hq.y = cvt_pk_bf16(xa.z, xa.w); hq.z = cvt_pk_bf16(xb.x, xb.y); hq.w = cvt_pk_bf16(xb.z, xb.w);
            u32x4 lq; lq.x = cvt_pk_bf16(xa.x - bflo(hq.x), xa.y - bfhi(hq.x)); lq.y = cvt_pk_bf16(xa.z - bflo(hq.y), xa.w - bfhi(hq.y));
            lq.z = cvt_pk_bf16(xb.x - bflo(hq.z), xb.y - bfhi(hq.z)); lq.w = cvt_pk_bf16(xb.z - bflo(hq.w), xb.w - bfhi(hq.w));
            const bf16x8 xh = __builtin_bit_cast(bf16x8, hq), xl = __builtin_bit_cast(bf16x8, lq);
#pragma unroll
            for (int nt = 0; nt < 3; ++nt) { const size_t wo = (size_t)(nt * 16 + fr) * D + ks * 32 + fq * 8;
                const bf16x8 wh = *(const bf16x8*)(wrh + wo), wl = *(const bf16x8*)(wrl + wo);
                acc[nt] = __builtin_amdgcn_mfma_f32_16x16x32_bf16(wh, xh, acc[nt], 0, 0, 0);
                acc[nt] = __builtin_amdgcn_mfma_f32_16x16x32_bf16(wl, xh, acc[nt], 0, 0, 0);
                acc[nt] = __builtin_amdgcn_mfma_f32_16x16x32_bf16(wh, xl, acc[nt], 0, 0, 0); } }
        if (half) {
#pragma unroll
            for (int nt = 0; nt < 3; ++nt)
#pragma unroll
                for (int i = 0; i < 4; ++i) PX[lane * 13 + nt * 4 + i] = acc[nt][i];
            PX[lane * 13 + 12] = ss; }
        __syncthreads();
        if (!half) {
#pragma unroll
            for (int nt = 0; nt < 3; ++nt)
#pragma unroll
                for (int i = 0; i < 4; ++i) acc[nt][i] += PX[lane * 13 + nt * 4 + i];
            ss += PX[lane * 13 + 12]; }
        ss += __shfl_xor(ss, 16); ss += __shfl_xor(ss, 32); const float rs = __builtin_amdgcn_rsqf(ss * (1.f / D) + 1e-6f);
#pragma unroll
        for (int nt = 0; nt < 3; ++nt)
#pragma unroll
            for (int i = 0; i < 4; ++i) LG[fr * 48 + nt * 16 + 4 * fq + i] = acc[nt][i] * rs;
        LDS_WAIT(); asm volatile("" ::: "memory");
        if (lane < 16 && !half) { const LAS float* lg = LG + lane * 48;
            float gl[4]; int gs = 0; float gm;
#pragma unroll
            for (int e = 0; e < 4; ++e) gl[e] = lg[e] + rgb[e];
            gm = gl[0];
#pragma unroll
            for (int e = 1; e < 4; ++e) if (gl[e] > gm) { gm = gl[e]; gs = e; }
            float den = 0.f;
#pragma unroll
            for (int e = 0; e < 4; ++e) den += __expf(gl[e] - gm);
            const float pg = 1.f / den;
            float el[8];
#pragma unroll
            for (int e = 0; e < 8; ++e) el[e] = lg[4 + gs * 8 + e] + reb[gs * 8 + e];
            int i1 = 0; float v1 = el[0];
#pragma unroll
            for (int e = 1; e < 8; ++e) if (el[e] > v1) { v1 = el[e]; i1 = e; }
            int i2 = -1; float v2 = -3.0e38f;
#pragma unroll
            for (int e = 0; e < 8; ++e) if (e != i1 && el[e] > v2) { v2 = el[e]; i2 = e; }
            const float ex = __expf(v2 - v1); const float w1 = pg / (1.f + ex), w2 = pg * ex / (1.f + ex);
            const int e1 = gs * 8 + i1, e2 = gs * 8 + i2;
            const unsigned s1 = atomicAdd(cnt + e1, 1u), s2 = atomicAdd(cnt + e2, 1u);
            const int mt = task * 16 + lane;
            tok[4 * mt] = e1; tok[4 * mt + 1] = (int)s1; tok[4 * mt + 2] = e2; tok[4 * mt + 3] = (int)s2; wt[2 * mt] = w1; wt[2 * mt + 1] = w2;
            int* rowmap = (int*)(C.ws + WS_R1 + R1_ROWMAP); rowmap[e1 * 16384 + (int)s1] = mt; rowmap[e2 * 16384 + (int)s2] = mt;
        }
        __syncthreads();
    }
}
__device__ __forceinline__ void moe_table(const Ctx& C, int it, LAS int* tb) {
    __syncthreads();
    int tl_ = C.tid; asm volatile("" : "+v"(tl_));
    if (C.tid < 64) { const unsigned* cnt = (const unsigned*)(C.ws + WS_CTL) + CW_CNT + it * 64;
        const unsigned cv = (C.tid < 32) ? __hip_atomic_load(cnt + tl_, __ATOMIC_RELAXED, __HIP_MEMORY_SCOPE_AGENT) : 0u; const int tiles = (int)((cv + 255u) >> 8); int x = tiles;
#pragma unroll
        for (int o = 1; o < 32; o <<= 1) { const int y = __shfl_up(x, o); if (C.lane >= o) x += y; }
        if (C.tid < 32) { tb[tl_] = x - tiles; tb[40 + tl_] = (int)cv; } if (C.tid == 31) tb[32] = x; }
    __syncthreads();
}
constexpr int NPH = 14;
__global__ void __launch_bounds__(512, 2) mk_fwd(Args args) {
    extern __shared__ __attribute__((aligned(16))) unsigned char lds_raw[];
    Ctx C; C.lds = (LAS unsigned char*)lds_raw; C.ws = args.ws; C.in = args.in; C.out = args.out;
    C.tid = threadIdx.x; C.lane = C.tid & 63; C.wave = __builtin_amdgcn_readfirstlane(C.tid >> 6); C.G = gridDim.x; C.bid = blockIdx.x; C.gw = C.bid * 8 + C.wave; C.ngw = C.G * 8;
    volatile LAS unsigned* MISC = (volatile LAS unsigned*)(C.lds + LDSCTL_OFF);
    LAS int* tb = (LAS int*)(C.lds + LDSCTL_OFF + 256);
    for (int u = C.tid; u < 64; u += 512) MISC[u] = 0u;
    __syncthreads();
    XcdBarrier bar; bar.bar = (unsigned*)(C.ws + WS_CTL) + CW_BAR; bar.x = 0; bar.st = nullptr;
#if MK_ONE_LAUNCH
    bar = xcd_barrier_post((unsigned*)(C.ws + WS_CTL) + CW_BAR, MISC + 8);
#define GRID_BAR() xcd_barrier(bar)
#else
#define GRID_BAR() do {} while (0)
#endif
    const int s_lo = args.s_lo, s_hi = args.s_hi;
    if (s_lo == 0) { phase_wmax(C); GRID_BAR(); }
#pragma unroll 1
    for (int it = 0; it <= NIT; ++it) {
        const int l = it / NCH, c = it % NCH; const int sb = it * NPH;
#define IN(k) (((PH_MASK >> (k)) & 1) && s_lo <= sb + (k) && sb + (k) < s_hi)
        if (IN(0)) for (int rep_ = 0; rep_ < 1 + ((DUP_MASK >> 0) & 1); ++rep_) { unsigned char* ws = C.ws; asm volatile("" : "+s"(ws)); ws = AS_GLOBAL(unsigned char, ws); if (it < NIT && c == 0) phase_convert(C, l, it == 0); phase_prep(C, it, tb); GRID_BAR(); }
        if (it == NIT) break;
        if (IN(1)) for (int rep_ = 0; rep_ < 1 + ((DUP_MASK >> 1) & 1); ++rep_) { unsigned char* ws = C.ws; asm volatile("" : "+s"(ws)); ws = AS_GLOBAL(unsigned char, ws); pg8::Gemm g{(const bf16*)(ws + WS_R1 + R1_HNX), (const bf16*)(ws + WS_WIN), D / 2, D / 2, D / 2, 0, nullptr, nullptr};   pg8::StaticOrder S; S.init(M, DBG_PROJ_N, C.G, C.bid);
            pg8::EpiProj E{(bf16*)(ws + WS_R2 + R2_ZA), (bf16*)(ws + WS_R1 + R1_ZB), (bf16*)(ws + WS_R1 + R1_ZC), (bf16*)(ws + WS_ZG), (bf16*)(ws + WS_VLO), C.inp(I_GATE_B) + (size_t)l * G_COLS, (const float*)(ws + WS_R1 + R1_HNX + HNX_RS), (const unsigned*)(ws + WS_CTL) + CW_WMAX + l * WIN_ROWS};
            pg8::gemm_phase<pg8::EpiProj, pg8::StaticOrder, false, true>(C.lds, g, S, E); GRID_BAR(); }
        if (IN(2)) for (int rep_ = 0; rep_ < 1 + ((DUP_MASK >> 2) & 1); ++rep_) { unsigned char* ws = C.ws; asm volatile("" : "+s"(ws)); ws = AS_GLOBAL(unsigned char, ws); sub_gmlp(C, l); sub_attn(C); sub_lora_prep(C, l); GRID_BAR(); }
        if (IN(3)) for (int rep_ = 0; rep_ < 1 + ((DUP_MASK >> 3) & 1); ++rep_) { unsigned char* ws = C.ws; asm volatile("" : "+s"(ws)); ws = AS_GLOBAL(unsigned char, ws); pg8::Gemm g{(const bf16*)(ws + WS_R1 + R1_ALORA), (const bf16*)(ws + WS_LORAB), LORA_K, LORA_K, (l == 0 ? 256 : LORA_K), 0, nullptr, nullptr};   pg8::StaticOrder S; S.init(M, l == 0 ? 3072 : 4096, C.G, C.bid);
            pg8::EpiLora EL{(bf16*)(ws + WS_R4 + R4_WPRE), (bf16*)(ws + WS_R4 + R4_APRE), (bf16*)(ws + WS_R4 + R4_G), (bf16*)(ws + WS_R4 + R4_VPRE)};
            pg8::gemm_phase(C.lds, g, S, EL); sub_yb_combine(C); GRID_BAR(); }
        if (IN(4)) for (int rep_ = 0; rep_ < 1 + ((DUP_MASK >> 4) & 1); ++rep_) { unsigned char* ws = C.ws; asm volatile("" : "+s"(ws)); ws = AS_GLOBAL(unsigned char, ws); }
        if (IN(5)) for (int rep_ = 0; rep_ < 1 + ((DUP_MASK >> 5) & 1); ++rep_) { unsigned char* ws = C.ws; asm volatile("" : "+s"(ws)); ws = AS_GLOBAL(unsigned char, ws); phase_chunkpre(C, l, c); GRID_BAR(); }
        if (IN(6)) for (int rep_ = 0; rep_ < 1 + ((DUP_MASK >> 6) & 1); ++rep_) { unsigned char* ws = C.ws; asm volatile("" : "+s"(ws)); ws = AS_GLOBAL(unsigned char, ws); phase_carry2(C); GRID_BAR(); }
        if (IN(7)) for (int rep_ = 0; rep_ < 1 + ((DUP_MASK >> 7) & 1); ++rep_) { unsigned char* ws = C.ws; asm volatile("" : "+s"(ws)); ws = AS_GLOBAL(unsigned char, ws); phase_post2(C, l); GRID_BAR(); }
        if (IN(8)) for (int rep_ = 0; rep_ < 1 + ((DUP_MASK >> 8) & 1); ++rep_) { unsigned char* ws = C.ws; asm volatile("" : "+s"(ws)); ws = AS_GLOBAL(unsigned char, ws); pg8::StaticOrder S; S.init(M, D, C.G, C.bid);
            pg8::Gemm ga{(const bf16*)(ws + WS_HN), (const bf16*)(ws + WS_PA), D, D, D, 0, nullptr, nullptr}; pg8::Gemm gb{(const bf16*)(ws + WS_YB), (const bf16*)(ws + WS_PB), 256, 256, 256, 0, nullptr, nullptr};
            pg8::Gemm gc{(const bf16*)(ws + WS_YC), (const bf16*)(ws + WS_PC), D, D, D, 0, nullptr, nullptr};
            pg8::EpiChainGate E{(const unsigned char*)(ws + WS_ZG), (bf16*)(ws + WS_R4 + R4_MERGED)}; pg8::gemm_chain3(C.lds, ga, gb, gc, S, E); GRID_BAR(); }
        if (IN(9)) for (int rep_ = 0; rep_ < 1 + ((DUP_MASK >> 9) & 1); ++rep_) { unsigned char* ws = C.ws; asm volatile("" : "+s"(ws)); ws = AS_GLOBAL(unsigned char, ws);
#ifdef DBG_WOUT_ZG
            pg8::Gemm g{(const bf16*)(ws + WS_ZG), (const bf16*)(ws + WS_WOUT), G_COLS, D, D, 0, nullptr, nullptr};
#else
            pg8::Gemm g{(const bf16*)(ws + WS_R4 + R4_MERGED), (const bf16*)(ws + WS_WOUT), D, D, D, 0, nullptr, nullptr};
#endif
            pg8::StaticOrder S; S.init(M, D, C.G, C.bid);
            pg8::EpiResid E{(l == 0 ? C.inp(I_X) : C.out) + (size_t)c * M * D, C.out + (size_t)c * M * D}; pg8::gemm_phase(C.lds, g, S, E); GRID_BAR(); }
        if (IN(10)) for (int rep_ = 0; rep_ < 1 + ((DUP_MASK >> 10) & 1); ++rep_) { unsigned char* ws = C.ws; asm volatile("" : "+s"(ws)); ws = AS_GLOBAL(unsigned char, ws); phase_route(C, it); GRID_BAR(); }
        if (IN(11)) for (int rep_ = 0; rep_ < 1 + ((DUP_MASK >> 11) & 1); ++rep_) { unsigned char* ws = C.ws; asm volatile("" : "+s"(ws)); ws = AS_GLOBAL(unsigned char, ws); }
        if (IN(12)) for (int rep_ = 0; rep_ < 1 + ((DUP_MASK >> 12) & 1); ++rep_) { unsigned char* ws = C.ws; asm volatile("" : "+s"(ws)); ws = AS_GLOBAL(unsigned char, ws); moe_table(C, it, tb); pg8::Gemm g{(const bf16*)(ws + WS_HN), (const bf16*)(ws + WS_W13), D / 2, D / 2, D / 2, (size_t)D * D / 2, (const int*)(ws + WS_R1 + R1_ROWMAP), tb};   pg8::MoeOrder S{tb, 4, C.G, C.bid};
            pg8::EpiSwiglu E{(bf16*)(ws + WS_R1 + R1_HID), (const float*)(ws + WS_HN + HNX_RS), (const int*)(ws + WS_R1 + R1_ROWMAP), tb, (const unsigned*)(ws + WS_CTL) + CW_WMAX13 + l * NEXP * 1024}; pg8::gemm_phase<pg8::EpiSwiglu, pg8::MoeOrder, true, true>(C.lds, g, S, E);
            if (it + 1 < NIT) {
                const int U = tb[32] * 4, rem = U % C.G; const int first = rem, nlow = C.G - rem;
                if (C.bid >= first) { const Ctx Cn = launder(C); mixer_norm(Cn, it + 1, (C.bid - first) * 8 + Cn.wave, nlow * 8); } }
            GRID_BAR(); }
        if (IN(13)) for (int rep_ = 0; rep_ < 1 + ((DUP_MASK >> 13) & 1); ++rep_) { unsigned char* ws = C.ws; asm volatile("" : "+s"(ws)); ws = AS_GLOBAL(unsigned char, ws); moe_table(C, it, tb); pg8::Gemm g{(const bf16*)(ws + WS_R1 + R1_HID), (const bf16*)(ws + WS_W2), EFF, EFF, EFF, (size_t)D * EFF, nullptr, nullptr}; pg8::MoeOrder S{tb, 4, C.G, C.bid};
            pg8::EpiBf16 E{(bf16*)(ws + WS_R1 + R1_YEXP), D, 0, 0}; pg8::gemm_phase(C.lds, g, S, E); GRID_BAR(); }
#undef IN
    }
}

extern "C" void kernel_launch(void* const* d_in, const int* in_sizes, int n_in, void* d_out, int out_size, void* d_ws, size_t ws_size, hipStream_t stream) {
    static int grid = 0;
    if (grid == 0) {
        if (n_in != 36 || out_size != NBATCH * T * D || ws_size < WS_END) { fprintf(stderr, "kernel_launch: unexpected shapes (n_in %d out %d ws %zu)\n", n_in, out_size, ws_size); grid = -1; return; }
        int dev = 0, cus = 0;
        if (hipGetDevice(&dev) != hipSuccess || hipDeviceGetAttribute(&cus, hipDeviceAttributeMultiprocessorCount, dev) != hipSuccess) { grid = -1; return; }
        if (hipFuncSetAttribute((const void*)mk_fwd, hipFuncAttributeMaxDynamicSharedMemorySize, LDS_BYTES) != hipSuccess) { grid = -1; return; }
        int per_cu = 0;
        if (hipOccupancyMaxActiveBlocksPerMultiprocessor(&per_cu, (const void*)mk_fwd, 512, LDS_BYTES) != hipSuccess || per_cu < 1) fprintf(stderr, "kernel_launch: occupancy query says %d\n", per_cu);
        (void)hipGetLastError();
        grid = cus;
    }
    if (grid < 0) return;
    (void)hipMemsetAsync((char*)d_ws + WS_CTL, 0, CTL_ZERO_BYTES, stream);
    Args a{};
    for (int i = 0; i < 36; ++i) a.in[i] = (const float*)d_in[i];
    a.out = (float*)d_out; a.ws = (unsigned char*)d_ws;
    const int total = NIT * NPH + 1;
#if MK_ONE_LAUNCH
    a.s_lo = 0; a.s_hi = total;
    hipLaunchKernelGGL(mk_fwd, dim3(grid), dim3(512), LDS_BYTES, stream, a);
#else
    for (int s = 0; s < total; ++s) { a.s_lo = s; a.s_hi = s + 1; hipLaunchKernelGGL(mk_fwd, dim3(grid), dim3(512), LDS_BYTES, stream, a); }
#endif
}
```

```cpp
#include <hip/hip_runtime.h>
#include <cstdint>
#include <cstdio>

#define DBG_PROJ_N (l == 0 ? IN_COLS : WIN_ROWS)
#ifndef DUP_MASK
#define DUP_MASK 0
#endif
#ifndef PH_MASK
#define PH_MASK 0xFFFF
#endif
#ifndef MK_ONE_LAUNCH
#define MK_ONE_LAUNCH 1
#endif

#define LAS __attribute__((address_space(3)))
#define GAS __attribute__((address_space(1)))
#define AS_GLOBAL(T, p) ({ GAS T* g_ = (GAS T*)(p); asm("" : "+s"(g_)); (T*)g_; })
typedef unsigned short bf16;
typedef unsigned u32;
typedef short bf16x8 __attribute__((ext_vector_type(8)));
typedef float f32x4 __attribute__((ext_vector_type(4)));
typedef float f32x2 __attribute__((ext_vector_type(2)));
typedef float f32x16 __attribute__((ext_vector_type(16)));
typedef unsigned u32x4 __attribute__((ext_vector_type(4)));
typedef unsigned u32x2 __attribute__((ext_vector_type(2)));
typedef int i32x4 __attribute__((ext_vector_type(4)));

constexpr int NBATCH = 8, T = 8192, D = 1024, NLAYER = 2;
constexpr int M = 2 * T;
constexpr int NCH = 4;
constexpr int NIT = NLAYER * NCH;
constexpr int A_COLS = 3328, B_COLS = 2304, C_COLS = 2048, G_COLS = 3072, IN_COLS = 10752;
constexpr int WIN_ROWS = 11008;
constexpr int LORA_K = 384, LORA_N = 4096;
constexpr int NEXP = 32, EFF = 512;
constexpr int SEGL = 256, NSEG = T / SEGL;
constexpr int MOE_MAXROWS = 40960;

constexpr size_t MiB = 1u << 20;
constexpr size_t WS_CTL = 0, CTL_ZERO_BYTES = 1 * MiB;
constexpr size_t WS_ROPE = 1 * MiB;
constexpr size_t WS_WSC = 3 * MiB;
constexpr size_t WS_WIN = 4 * MiB;
constexpr size_t WS_LORAB = 26 * MiB;
constexpr size_t WS_PA = 29 * MiB, WS_PB = 31 * MiB, WS_PC = 32 * MiB, WS_WOUT = 34 * MiB;
constexpr size_t WS_W13 = 36 * MiB;
constexpr size_t WS_W2 = 100 * MiB;
constexpr size_t WS_VFIRST = 132 * MiB;
constexpr size_t WS_HN = 260 * MiB;
constexpr size_t WS_VP = 292 * MiB;
constexpr size_t WS_YB = 324 * MiB;
constexpr size_t WS_YC = 332 * MiB;
constexpr size_t WS_VLO = 364 * MiB;
constexpr size_t WS_BONUS = 365 * MiB;
constexpr size_t WS_TOK = 366 * MiB;
constexpr size_t WS_LSE = 367 * MiB;
constexpr size_t WS_ZG = 368 * MiB;
constexpr size_t WS_R4 = 464 * MiB;
constexpr size_t WS_R2 = 592 * MiB;
constexpr size_t WS_R1 = 696 * MiB;
constexpr size_t WS_END = 1016 * MiB;
constexpr size_t R4_G = 0, R4_WPRE = 32 * MiB, R4_APRE = 64 * MiB, R4_VPRE = 96 * MiB;
constexpr size_t R4_SEGS = 32 * MiB, R4_SEGP = 64 * MiB;
constexpr size_t R4_MTMP = 0, R4_MERGED = 64 * MiB;
constexpr size_t R2_ZA = 0;
constexpr size_t R2_YLOC = 0, R2_Z = 32 * MiB, R2_SSTART = 64 * MiB;
constexpr size_t R1_ZB = 0, R1_ZC = 72 * MiB, R1_ALORA = 136 * MiB, R1_OG = 148 * MiB;
constexpr size_t R1_SCANIN = 0;
constexpr size_t R1_XG = 0, R1_HID = 80 * MiB, R1_YEXP = 120 * MiB, R1_ROWMAP = 300 * MiB, R1_HNX = 256 * MiB;
constexpr size_t R1_LW = 0, R1_AA = 64 * MiB, R1_BB = 96 * MiB, R1_KK = 128 * MiB, R1_RR = 160 * MiB;
constexpr size_t R1_MT = 192 * MiB, R1_NC = 224 * MiB;
constexpr size_t R1_YLOC = 0, R1_Q = 32 * MiB, R1_SST = 64 * MiB;
constexpr int CHK = 64, NCHK = T / CHK;
constexpr int CW_BAR = 4096;
constexpr int CW_CNT = 16384;
constexpr int CW_WMAX = 32768;
constexpr int CW_WMAX13 = 65536;
constexpr size_t HNX_RS = 16 * MiB;

constexpr int RING_BYTES = 131072;
constexpr int LDSCTL_OFF = RING_BYTES;
constexpr int LDS_BYTES = 147456;

__device__ __forceinline__ float bf2f(u32 v) { return __uint_as_float(v << 16); }
__device__ __forceinline__ float bflo(u32 v) { return __uint_as_float(v << 16); }
__device__ __forceinline__ float bfhi(u32 v) { return __uint_as_float(v & 0xffff0000u); }
typedef __bf16 bf16x2_t __attribute__((ext_vector_type(2)));
__device__ __forceinline__ u32 cvt_pk_bf16(float lo, float hi) { f32x2 v = {lo, hi}; bf16x2_t b = __builtin_convertvector(v, bf16x2_t); return __builtin_bit_cast(u32, b); }
__device__ __forceinline__ u32 f2bf(float f) { return cvt_pk_bf16(f, 0.f) & 0xffffu; }
__device__ __forceinline__ float wave_sum(float v) {
#pragma unroll
    for (int o = 1; o < 64; o <<= 1) v += __shfl_xor(v, o);
    return v;
}
__device__ __forceinline__ float sigmoidf_(float x) { return __builtin_amdgcn_rcpf(1.0f + __expf(-x)); }
#define LDS_WAIT() asm volatile("s_waitcnt lgkmcnt(0)" ::: "memory")
typedef short v4i16_t __attribute__((ext_vector_type(4)));
__device__ __forceinline__ u32x2 lds_tr16(const LAS bf16* p) { return __builtin_bit_cast(u32x2, __builtin_amdgcn_ds_read_tr16_b64_v4i16((LAS v4i16_t*)p)); }

namespace pg8 {
#define PG8_LAS __attribute__((address_space(3)))
constexpr int BM = 256, BK = 64, HALF = 128, HTB = HALF * BK * 2, STAGE_BYTES = 8 * HTB, NXCD = 8, WGM = 4;
__host__ __device__ __forceinline__ int lds_byte(int r, int c) { const int st = (r >> 4) * 2 + (c >> 5), rr = r & 15, cc = c & 31, ob = rr * 64 + cc * 2; return st * 1024 + (ob ^ (((ob >> 9) & 1) << 5)); }
__host__ __device__ __forceinline__ void stage_rc(int b, int& R, int& C) { const int st = b / 1024, sb = b % 1024, swz = sb ^ (((sb >> 9) & 1) << 5); R = (st >> 1) * 16 + swz / 64; C = (st & 1) * 32 + (swz % 64) / 2; }
__host__ __device__ __forceinline__ int perm32(int rho) { const int n = rho >> 4, i = rho & 15; return 8 * (i >> 2) + 4 * n + (i & 3); }

struct Unit { int pm, pn, e; };
struct Gemm { const bf16* A; const bf16* Bt; int lda, ldb, K; size_t b_estride; const int* rowmap; const LAS int* tb; };

struct StaticOrder {
    int nM, nN, nwg, G, c;
    __device__ void init(int Mr, int N, int G_, int c_) { nM = Mr / BM; nN = N / BM; nwg = nM * nN; G = G_; c = c_; }
    __device__ bool next(int i, Unit& u) const {
        const long L = (long)i * G + c; if (L >= nwg) return false;
        int wgid = (int)L; { const int q = nwg / NXCD, r = nwg % NXCD, xcd = wgid % NXCD, off = wgid / NXCD; wgid = (xcd < r ? xcd * (q + 1) : r * (q + 1) + (xcd - r) * q) + off; }
        const int nig = WGM * nN, gid = wgid / nig, fm = gid * WGM, gsz = (nM - fm) < WGM ? (nM - fm) : WGM;
        u.pm = fm + ((wgid % nig) % gsz); u.pn = (wgid % nig) / gsz; u.e = 0; return true;
    }
};
struct MoeOrder {
    const LAS int* tb; int nN, G, c;
    __device__ bool next(int i, Unit& u) const {
        const int L = i * G + c; const int total = tb[32] * nN; if (L >= total) return false;
        const int q = total / NXCD, r = total % NXCD, xcd = L % NXCD, off = L / NXCD; const int wg = (xcd < r ? xcd * (q + 1) : r * (q + 1) + (xcd - r) * q) + off;
        const int rt = wg / nN; u.pn = wg % nN; u.pm = rt; int e = 0;
#pragma unroll 1
        for (int k = 1; k < 32; ++k) e += (rt >= tb[k]) ? 1 : 0;
        u.e = e; return true;
    }
};

template <bool I8> struct AccSel { typedef f32x4 t; };
template <> struct AccSel<true> { typedef i32x4 t; };
template <class Epi, class Sched, bool GATHER = false, bool I8 = false>
__device__ __forceinline__ void gemm_phase(PG8_LAS unsigned char* lds, const Gemm g, const Sched& S, const Epi& E) {
    int tid_ = threadIdx.x; asm volatile("" : "+v"(tid_));
    const int tid = tid_, wid = __builtin_amdgcn_readfirstlane(tid >> 6), lane = tid & 63, wr = wid >> 2, wc = wid & 3, fr = lane & 15, fq = lane >> 4;
    const int K = g.K, nt = K / BK;
    unsigned voffA[2], voffB[2];
#pragma unroll
    for (int i = 0; i < 2; ++i) { int R, C; stage_rc(tid * 16 + i * 8192, R, C); const int Rb = (R & ~31) + perm32(R & 31);
        voffA[i] = (unsigned)(R * g.lda + C) * 2u; voffB[i] = (unsigned)(Rb * g.ldb + C) * 2u; }
#define PG8_GOFFS(u_, go_) do { if constexpr (GATHER) { const int e_ = (u_).e; const int ti_ = (u_).pm - g.tb[e_]; const int cn_ = g.tb[40 + e_]; \
        _Pragma("unroll") for (int h_ = 0; h_ < 2; ++h_) _Pragma("unroll") for (int i_ = 0; i_ < 2; ++i_) { int R_, C_; stage_rc(tid * 16 + i_ * 8192, R_, C_); const int sl_ = ti_ * 256 + h_ * 128 + R_; \
            const int tr_ = (sl_ < cn_) ? g.rowmap[e_ * 16384 + sl_] : 0; go_[h_][i_] = (unsigned)(tr_ * g.lda + C_) * 2u; } } } while (0)
    unsigned goC[2][2] = {{0u, 0u}, {0u, 0u}}, goN[2][2] = {{0u, 0u}, {0u, 0u}};
    const size_t kstep = (size_t)(BK * 2);
    const size_t hA = GATHER ? 0 : (size_t)HALF * g.lda * 2, hB = (size_t)HALF * g.ldb * 2;
    const size_t tA = 2 * hA, tB = 2 * hB;
    const unsigned ldsw = (unsigned)wid * 1024u;
    const int aoff = lds_byte(wr * 64 + fr, fq * 8), boff = lds_byte(wc * 32 + fr, fq * 8);
#define PG8_SA(b, h) (((b) * 2 + (h)) * HTB)
#define PG8_SB(b, h) ((4 + (b) * 2 + (h)) * HTB)
#define PG8_STAGE(bufoff, gbase, voff) do { _Pragma("unroll") for (int _i = 0; _i < 2; ++_i) \
        __builtin_amdgcn_global_load_lds((const unsigned*)((const char*)(gbase) + (voff)[_i]), (PG8_LAS unsigned*)(lds + (bufoff) + ldsw + _i * 8192), 16, 0, 0); } while (0)
#define PG8_LDA(dst, b, h) do { _Pragma("unroll") for (int m = 0; m < 4; ++m) _Pragma("unroll") for (int k = 0; k < 2; ++k) dst[m][k] = *(const PG8_LAS bf16x8*)(lds + PG8_SA(b, h) + aoff + m * 2048 + k * 1024); } while (0)
#define PG8_LDB(dst, b, h) do { _Pragma("unroll") for (int n = 0; n < 2; ++n) _Pragma("unroll") for (int k = 0; k < 2; ++k) dst[n][k] = *(const PG8_LAS bf16x8*)(lds + PG8_SB(b, h) + boff + n * 2048 + k * 1024); } while (0)
#define PG8_MMA(ai, bj, At, Bt) do { __builtin_amdgcn_s_setprio(1); _Pragma("unroll") for (int m = 0; m < 4; ++m) _Pragma("unroll") for (int n = 0; n < 2; ++n) _Pragma("unroll") for (int k = 0; k < 2; ++k) { \
        if constexpr (I8) acc[ai][bj][m][n] = __builtin_amdgcn_mfma_i32_16x16x64_i8(__builtin_bit_cast(i32x4, Bt[n][k]), __builtin_bit_cast(i32x4, At[m][k]), acc[ai][bj][m][n], 0, 0, 0); \
        else acc[ai][bj][m][n] = __builtin_amdgcn_mfma_f32_16x16x32_bf16(Bt[n][k], At[m][k], acc[ai][bj][m][n], 0, 0, 0); } __builtin_amdgcn_s_setprio(0); } while (0)
#define PG8_WAIT_V(n) asm volatile("s_waitcnt vmcnt(" #n ")" ::: "memory")
#define PG8_WAIT_L(n) asm volatile("s_waitcnt lgkmcnt(" #n ")" ::: "memory")
#define PG8_BAR __builtin_amdgcn_s_barrier()
#define PG8_SCHED __builtin_amdgcn_sched_barrier(0)
    Unit cur, nxt; int ui = 0;
    if (!S.next(0, cur)) return;
    typedef typename AccSel<I8>::t acc_t;
    acc_t acc[2][2][4][2];
#pragma unroll
    for (int a = 0; a < 2; ++a)
#pragma unroll
        for (int b = 0; b < 2; ++b)
#pragma unroll
            for (int m = 0; m < 4; ++m)
#pragma unroll
                for (int n = 0; n < 2; ++n) acc[a][b][m][n] = (acc_t){0, 0, 0, 0};
    bf16x8 At[4][2], B0[2][2], B1[2][2];
    const char* cA = (const char*)g.A + (GATHER ? 0 : (size_t)cur.pm * tA); const char* cB = (const char*)g.Bt + (size_t)cur.e * g.b_estride * 2 + (size_t)cur.pn * tB;
    PG8_GOFFS(cur, goC);
#define PG8_VA(cond_, h_) (GATHER ? ((cond_) ? goN[h_] : goC[h_]) : voffA)
    PG8_STAGE(PG8_SB(0, 0), cB, voffB); PG8_STAGE(PG8_SB(0, 1), cB + hB, voffB); PG8_STAGE(PG8_SA(0, 0), cA, PG8_VA(false, 0)); PG8_STAGE(PG8_SA(0, 1), cA + hA, PG8_VA(false, 1));
    if (wr == 1) PG8_BAR;
    PG8_WAIT_V(2); PG8_BAR;
    PG8_STAGE(PG8_SB(1, 0), cB + kstep, voffB); PG8_STAGE(PG8_SA(1, 0), cA + kstep, PG8_VA(false, 0)); PG8_STAGE(PG8_SB(1, 1), cB + hB + kstep, voffB);
    PG8_WAIT_V(6); PG8_BAR;
    for (;;) {
        const bool has_next = S.next(ui + 1, nxt);
        const char* nA = (has_next && !GATHER) ? (const char*)g.A + (size_t)nxt.pm * tA : cA;
        if (has_next) PG8_GOFFS(nxt, goN); else { goN[0][0] = goC[0][0]; goN[0][1] = goC[0][1]; goN[1][0] = goC[1][0]; goN[1][1] = goC[1][1]; }
        const char* nB = has_next ? (const char*)g.Bt + (size_t)nxt.e * g.b_estride * 2 + (size_t)nxt.pn * tB : cB;
#pragma unroll 1
        for (int t = 0; t < nt; t += 2) {
            const bool last = (t == nt - 2);
            const char* a1 = cA + (size_t)(t + 1) * kstep;
            const char* a2 = last ? nA : cA + (size_t)(t + 2) * kstep; const char* b2 = last ? nB : cB + (size_t)(t + 2) * kstep;
            const char* a3 = a2 + kstep; const char* b3 = b2 + kstep;
            PG8_LDB(B0, 0, 0); PG8_LDB(B1, 0, 1); PG8_SCHED; PG8_LDA(At, 0, 0); PG8_STAGE(PG8_SA(1, 1), a1 + hA, PG8_VA(false, 1));
            PG8_WAIT_V(8); PG8_WAIT_L(0); PG8_BAR; PG8_MMA(0, 0, At, B0); PG8_MMA(0, 1, At, B1); PG8_BAR; PG8_SCHED;
            PG8_LDA(At, 0, 1); PG8_STAGE(PG8_SB(0, 0), b2, voffB); PG8_STAGE(PG8_SB(0, 1), b2 + hB, voffB); PG8_STAGE(PG8_SA(0, 0), a2, PG8_VA(last, 0));
            PG8_WAIT_V(8); PG8_WAIT_L(0); PG8_BAR; PG8_MMA(1, 0, At, B0); PG8_MMA(1, 1, At, B1); PG8_BAR; PG8_SCHED;
            PG8_LDB(B0, 1, 0); PG8_LDB(B1, 1, 1); PG8_SCHED; PG8_LDA(At, 1, 0); PG8_STAGE(PG8_SA(0, 1), a2 + hA, PG8_VA(last, 1));
            PG8_WAIT_V(8); PG8_WAIT_L(0); PG8_BAR; PG8_MMA(0, 0, At, B0); PG8_MMA(0, 1, At, B1); PG8_BAR; PG8_SCHED;
            PG8_LDA(At, 1, 1); PG8_STAGE(PG8_SB(1, 0), b3, voffB); PG8_STAGE(PG8_SB(1, 1), b3 + hB, voffB); PG8_STAGE(PG8_SA(1, 0), a3, PG8_VA(last, 0));
            PG8_WAIT_V(8); PG8_WAIT_L(0); PG8_BAR; PG8_MMA(1, 0, At, B0); PG8_MMA(1, 1, At, B1); PG8_BAR; PG8_SCHED;
        }
        if (wr == 0) PG8_BAR;
        E(acc, cur, wr, wc, fr, fq);
        if (!has_next) break;
#pragma unroll
        for (int a = 0; a < 2; ++a)
#pragma unroll
            for (int b = 0; b < 2; ++b)
#pragma unroll
                for (int m = 0; m < 4; ++m)
#pragma unroll
                    for (int n = 0; n < 2; ++n) acc[a][b][m][n] = (acc_t){0, 0, 0, 0};
        cur = nxt; cA = nA; cB = nB; ++ui; goC[0][0] = goN[0][0]; goC[0][1] = goN[0][1]; goC[1][0] = goN[1][0]; goC[1][1] = goN[1][1];
        if (wr == 1) PG8_BAR;
    }
    PG8_WAIT_V(0);
    PG8_BAR;
#undef PG8_GOFFS
#undef PG8_VA
#undef PG8_SA
#undef PG8_SB
#undef PG8_STAGE
#undef PG8_LDA
#undef PG8_LDB
#undef PG8_MMA
#undef PG8_WAIT_V
#undef PG8_WAIT_L
#undef PG8_BAR
#undef PG8_SCHED
}

template <class Epi, class Sched>
__device__ __forceinline__ void gemm_chain3(PG8_LAS unsigned char* lds, const Gemm g0, const Gemm g1, const Gemm g2, const Sched& S, const Epi& E) {
    int tid_ = threadIdx.x; asm volatile("" : "+v"(tid_));
    const int tid = tid_, wid = __builtin_amdgcn_readfirstlane(tid >> 6), lane = tid & 63, wr = wid >> 2, wc = wid & 3, fr = lane & 15, fq = lane >> 4;
    int Rr[2], Cc[2], Rbb[2];
#pragma unroll
    for (int i = 0; i < 2; ++i) { int R, C; stage_rc(tid * 16 + i * 8192, R, C); Rr[i] = R; Cc[i] = C; Rbb[i] = (R & ~31) + perm32(R & 31); }
#define PG8_SEL(br_, f_) ((br_) == 0 ? g0.f_ : ((br_) == 1 ? g1.f_ : g2.f_))
#define PG8_VOFF(br_, va_, vb_) do { const int lda_ = PG8_SEL(br_, lda), ldb_ = PG8_SEL(br_, ldb); _Pragma("unroll") for (int i_ = 0; i_ < 2; ++i_) { \
        va_[i_] = (unsigned)(Rr[i_] * lda_ + Cc[i_]) * 2u; vb_[i_] = (unsigned)(Rbb[i_] * ldb_ + Cc[i_]) * 2u; } } while (0)
    const size_t kstep = (size_t)(BK * 2);
    const unsigned ldsw = (unsigned)wid * 1024u;
    const int aoff = lds_byte(wr * 64 + fr, fq * 8), boff = lds_byte(wc * 32 + fr, fq * 8);
#define PG8_SA(b, h) (((b) * 2 + (h)) * HTB)
#define PG8_SB(b, h) ((4 + (b) * 2 + (h)) * HTB)
#define PG8_STAGE(bufoff, gbase, voff) do { _Pragma("unroll") for (int _i = 0; _i < 2; ++_i) \
        __builtin_amdgcn_global_load_lds((const unsigned*)((const char*)(gbase) + (voff)[_i]), (PG8_LAS unsigned*)(lds + (bufoff) + ldsw + _i * 8192), 16, 0, 0); } while (0)
#define PG8_LDA(dst, b, h) do { _Pragma("unroll") for (int m = 0; m < 4; ++m) _Pragma("unroll") for (int k = 0; k < 2; ++k) dst[m][k] = *(const PG8_LAS bf16x8*)(lds + PG8_SA(b, h) + aoff + m * 2048 + k * 1024); } while (0)
#define PG8_LDB(dst, b, h) do { _Pragma("unroll") for (int n = 0; n < 2; ++n) _Pragma("unroll") for (int k = 0; k < 2; ++k) dst[n][k] = *(const PG8_LAS bf16x8*)(lds + PG8_SB(b, h) + boff + n * 2048 + k * 1024); } while (0)
#define PG8_MMA(ai, bj, At, Bt) do { __builtin_amdgcn_s_setprio(1); _Pragma("unroll") for (int m = 0; m < 4; ++m) _Pragma("unroll") for (int n = 0; n < 2; ++n) _Pragma("unroll") for (int k = 0; k < 2; ++k) \
        acc[ai][bj][m][n] = __builtin_amdgcn_mfma_f32_16x16x32_bf16(Bt[n][k], At[m][k], acc[ai][bj][m][n], 0, 0, 0); __builtin_amdgcn_s_setprio(0); } while (0)
#define PG8_WAIT_V(n) asm volatile("s_waitcnt vmcnt(" #n ")" ::: "memory")
#define PG8_WAIT_L(n) asm volatile("s_waitcnt lgkmcnt(" #n ")" ::: "memory")
#define PG8_BAR __builtin_amdgcn_s_barrier()
#define PG8_SCHED __builtin_amdgcn_sched_barrier(0)
    Unit cur, nxt; int ui = 0;
    if (!S.next(0, cur)) return;
    int brc = 0;
    f32x4 acc[2][2][4][2];
#pragma unroll
    for (int a = 0; a < 2; ++a)
#pragma unroll
        for (int b = 0; b < 2; ++b)
#pragma unroll
            for (int m = 0; m < 4; ++m)
#pragma unroll
                for (int n = 0; n < 2; ++n) acc[a][b][m][n] = (f32x4){0.f, 0.f, 0.f, 0.f};
    bf16x8 At[4][2], B0[2][2], B1[2][2];
    unsigned vAc[2], vBc[2], vAn[2], vBn[2];
    PG8_VOFF(0, vAc, vBc);
    size_t hAc = (size_t)HALF * g0.lda * 2, hBc = (size_t)HALF * g0.ldb * 2, hAn = hAc, hBn = hBc; int ntc = g0.K / BK;
    const char* cA = (const char*)g0.A + (size_t)cur.pm * 2 * hAc; const char* cB = (const char*)g0.Bt + (size_t)cur.pn * 2 * hBc;
    PG8_STAGE(PG8_SB(0, 0), cB, vBc); PG8_STAGE(PG8_SB(0, 1), cB + hBc, vBc); PG8_STAGE(PG8_SA(0, 0), cA, vAc); PG8_STAGE(PG8_SA(0, 1), cA + hAc, vAc);
    if (wr == 1) PG8_BAR;
    PG8_WAIT_V(2); PG8_BAR;
    PG8_STAGE(PG8_SB(1, 0), cB + kstep, vBc); PG8_STAGE(PG8_SA(1, 0), cA + kstep, vAc); PG8_STAGE(PG8_SB(1, 1), cB + hBc + kstep, vBc);
    PG8_WAIT_V(6); PG8_BAR;
    for (;;) {
        const int brn = (brc == 2) ? 0 : brc + 1; bool has_next = true;
        if (brc == 2) has_next = S.next(ui / 3 + 1, nxt); else nxt = cur;
        const char* nA = cA; const char* nB = cB;
        if (has_next) { PG8_VOFF(brn, vAn, vBn); hAn = (size_t)HALF * PG8_SEL(brn, lda) * 2; hBn = (size_t)HALF * PG8_SEL(brn, ldb) * 2;
            nA = (const char*)PG8_SEL(brn, A) + (size_t)nxt.pm * 2 * hAn; nB = (const char*)PG8_SEL(brn, Bt) + (size_t)nxt.pn * 2 * hBn; }
        else { vAn[0] = vAc[0]; vAn[1] = vAc[1]; vBn[0] = vBc[0]; vBn[1] = vBc[1]; hAn = hAc; hBn = hBc; }
#pragma unroll 1
        for (int t = 0; t < ntc; t += 2) {
            const bool last = (t == ntc - 2);
            const char* a1 = cA + (size_t)(t + 1) * kstep;
            const char* a2 = last ? nA : cA + (size_t)(t + 2) * kstep; const char* b2 = last ? nB : cB + (size_t)(t + 2) * kstep;
            const char* a3 = a2 + kstep; const char* b3 = b2 + kstep;
            const size_t hA2 = last ? hAn : hAc, hB2 = last ? hBn : hBc;
            PG8_LDB(B0, 0, 0); PG8_LDB(B1, 0, 1); PG8_SCHED; PG8_LDA(At, 0, 0); PG8_STAGE(PG8_SA(1, 1), a1 + hAc, vAc);
            PG8_WAIT_V(8); PG8_WAIT_L(0); PG8_BAR; PG8_MMA(0, 0, At, B0); PG8_MMA(0, 1, At, B1); PG8_BAR; PG8_SCHED;
            PG8_LDA(At, 0, 1); PG8_STAGE(PG8_SB(0, 0), b2, (last ? vBn : vBc)); PG8_STAGE(PG8_SB(0, 1), b2 + hB2, (last ? vBn : vBc)); PG8_STAGE(PG8_SA(0, 0), a2, (last ? vAn : vAc));
            PG8_WAIT_V(8); PG8_WAIT_L(0); PG8_BAR; PG8_MMA(1, 0, At, B0); PG8_MMA(1, 1, At, B1); PG8_BAR; PG8_SCHED;
            PG8_LDB(B0, 1, 0); PG8_LDB(B1, 1, 1); PG8_SCHED; PG8_LDA(At, 1, 0); PG8_STAGE(PG8_SA(0, 1), a2 + hA2, (last ? vAn : vAc));
            PG8_WAIT_V(8); PG8_WAIT_L(0); PG8_BAR; PG8_MMA(0, 0, At, B0); PG8_MMA(0, 1, At, B1); PG8_BAR; PG8_SCHED;
            PG8_LDA(At, 1, 1); PG8_STAGE(PG8_SB(1, 0), b3, (last ? vBn : vBc)); PG8_STAGE(PG8_SB(1, 1), b3 + hB2, (last ? vBn : vBc)); PG8_STAGE(PG8_SA(1, 0), a3, (last ? vAn : vAc));
            PG8_WAIT_V(8); PG8_WAIT_L(0); PG8_BAR; PG8_MMA(1, 0, At, B0); PG8_MMA(1, 1, At, B1); PG8_BAR; PG8_SCHED;
        }
        if (wr == 0) PG8_BAR;
        if (brc < 2) E.link(acc, cur, brc, wr, wc, fr, fq); else E.fin(acc, cur, wr, wc, fr, fq);
        if (!has_next) break;
        if (brc == 2) {
#pragma unroll
            for (int a = 0; a < 2; ++a)
#pragma unroll
                for (int b = 0; b < 2; ++b)
#pragma unroll
                    for (int m = 0; m < 4; ++m)
#pragma unroll
                        for (int n = 0; n < 2; ++n) acc[a][b][m][n] = (f32x4){0.f, 0.f, 0.f, 0.f}; }
        cur = nxt; cA = nA; cB = nB; ++ui; brc = brn; vAc[0] = vAn[0]; vAc[1] = vAn[1]; vBc[0] = vBn[0]; vBc[1] = vBn[1]; hAc = hAn; hBc = hBn; ntc = PG8_SEL(brc, K) / BK;
        if (wr == 1) PG8_BAR;
    }
    PG8_WAIT_V(0);
    PG8_BAR;
#undef PG8_SEL
#undef PG8_VOFF
#undef PG8_SA
#undef PG8_SB
#undef PG8_STAGE
#undef PG8_LDA
#undef PG8_LDB
#undef PG8_MMA
#undef PG8_WAIT_V
#undef PG8_WAIT_L
#undef PG8_BAR
#undef PG8_SCHED
}

__device__ __forceinline__ f32x2 gelu_pk(f32x2 v) {
    const f32x2 av = __builtin_elementwise_abs(v), d = av * 0.2316418882f + 1.0f;
    f32x2 t; t.x = __builtin_amdgcn_rcpf(d.x); t.y = __builtin_amdgcn_rcpf(d.y);
    f32x2 q = t * 0.5307027145f + (-0.7265760135f); q = q * t + 0.7107068705f; q = q * t + (-0.142248368f); q = q * t + 0.127414796f; q = q * t;
    const f32x2 s = (v * v) * (-0.72134752044f);
    f32x2 e; e.x = __builtin_amdgcn_exp2f(s.x); e.y = __builtin_amdgcn_exp2f(s.y);
    const f32x2 zero2 = {0.f, 0.f};
    return __builtin_elementwise_max(v, zero2) - av * (q * e);
}
__device__ __forceinline__ u32x4 pack8(f32x4 v0, f32x4 v1) { u32x4 w; w.x = cvt_pk_bf16(v0[0], v0[1]); w.y = cvt_pk_bf16(v0[2], v0[3]); w.z = cvt_pk_bf16(v1[0], v1[1]); w.w = cvt_pk_bf16(v1[2], v1[3]); return w; }

struct EpiBf16 {
    bf16* O; int ldc; int split_cols; size_t split_stride;
    __device__ __forceinline__ void operator()(const f32x4 (&acc)[2][2][4][2], const Unit& u, int wr, int wc, int fr, int fq) const {
        const int row0 = u.pm * BM + wr * 64 + fr; int colt = u.pn * BM; bf16* base = O;
        if (split_cols) { const int t = colt / split_cols; base += (size_t)t * split_stride; colt -= t * split_cols; }
        const int col0 = colt + wc * 32 + 8 * fq;
#pragma unroll
        for (int ai = 0; ai < 2; ++ai)
#pragma unroll
            for (int m = 0; m < 4; ++m) { bf16* rowp = base + (size_t)(row0 + ai * HALF + m * 16) * ldc + col0;
#pragma unroll
                for (int bj = 0; bj < 2; ++bj) *(u32x4*)(rowp + bj * HALF) = pack8(acc[ai][bj][m][0], acc[ai][bj][m][1]); }
    }
};
struct EpiProj {
    bf16 *za, *zb, *zc, *zg, *vlo; const float* gate_b; const float* rs; const unsigned* cmax;
    __device__ __forceinline__ void operator()(const i32x4 (&acc)[2][2][4][2], const Unit& u, int wr, int wc, int fr, int fq) const {
        const int row0 = u.pm * BM + wr * 64 + fr; const int pn = u.pn;
        bf16* base; int ld, ct, mode;
        if (pn < 13) { base = za; ld = A_COLS; ct = pn; mode = 0; }
        else if (pn < 22) { base = zb; ld = B_COLS; ct = pn - 13; mode = 0; }
        else if (pn < 30) { base = zc; ld = C_COLS; ct = pn - 22; mode = 1; }
        else if (pn < 42) { base = zg; ld = G_COLS; ct = pn - 30; mode = 2; }
        else { base = vlo; ld = 32; ct = 0; mode = 3; }
        const int col0 = ct * BM + wc * 32 + 8 * fq;
        f32x4 cs[2][2];
#pragma unroll
        for (int bj = 0; bj < 2; ++bj)
#pragma unroll
            for (int n = 0; n < 2; ++n) { const u32x4 b = *(const u32x4*)(cmax + pn * BM + wc * 32 + 8 * fq + bj * HALF + 4 * n);
                cs[bj][n] = (f32x4){__uint_as_float(b.x), __uint_as_float(b.y), __uint_as_float(b.z), __uint_as_float(b.w)} * (1.f / 127.f); }
        float rsv[2][4];
#pragma unroll
        for (int ai = 0; ai < 2; ++ai)
#pragma unroll
            for (int m = 0; m < 4; ++m) rsv[ai][m] = rs[row0 + ai * HALF + m * 16];
#define PG8_DQ(ai, bj, m, n, r) (__builtin_convertvector(acc[ai][bj][m][n], f32x4) * (cs[bj][n] * (r)))
        if (mode == 0) {
#pragma unroll
            for (int ai = 0; ai < 2; ++ai)
#pragma unroll
                for (int m = 0; m < 4; ++m) { const int row = row0 + ai * HALF + m * 16; const float r = rsv[ai][m]; bf16* rowp = base + (size_t)row * ld + col0;
#pragma unroll
                    for (int bj = 0; bj < 2; ++bj) *(u32x4*)(rowp + bj * HALF) = pack8(PG8_DQ(ai, bj, m, 0, r), PG8_DQ(ai, bj, m, 1, r)); }
        } else if (mode == 1) {
#pragma unroll
            for (int ai = 0; ai < 2; ++ai)
#pragma unroll
                for (int m = 0; m < 4; ++m) { const int row = row0 + ai * HALF + m * 16; const float r = rsv[ai][m]; bf16* rowp = base + (size_t)row * ld + col0;
#pragma unroll
                    for (int bj = 0; bj < 2; ++bj) { const f32x4 v0 = PG8_DQ(ai, bj, m, 0, r), v1 = PG8_DQ(ai, bj, m, 1, r);
                        const f32x2 a = gelu_pk((f32x2){v0[0], v0[1]}), b = gelu_pk((f32x2){v0[2], v0[3]}), c = gelu_pk((f32x2){v1[0], v1[1]}), d = gelu_pk((f32x2){v1[2], v1[3]});
                        *(u32x4*)(rowp + bj * HALF) = pack8((f32x4){a.x, a.y, b.x, b.y}, (f32x4){c.x, c.y, d.x, d.y}); } }
        } else if (mode == 2) {
            f32x4 bv[2][2];
#pragma unroll
            for (int bj = 0; bj < 2; ++bj)
#pragma unroll
                for (int n = 0; n < 2; ++n) bv[bj][n] = *(const f32x4*)(gate_b + col0 + bj * HALF + 4 * n);
#pragma unroll
            for (int ai = 0; ai < 2; ++ai)
#pragma unroll
                for (int m = 0; m < 4; ++m) { const int row = row0 + ai * HALF + m * 16; const float r = rsv[ai][m];
#pragma unroll
                    for (int bj = 0; bj < 2; ++bj) { f32x4 v0 = PG8_DQ(ai, bj, m, 0, r) + bv[bj][0], v1 = PG8_DQ(ai, bj, m, 1, r) + bv[bj][1];
                        const f32x4 one4 = {1.f, 1.f, 1.f, 1.f};
                        v0 = v0 * -1.44269504f; v1 = v1 * -1.44269504f;
#pragma unroll
                        for (int e = 0; e < 4; ++e) { v0[e] = __builtin_amdgcn_exp2f(v0[e]); v1[e] = __builtin_amdgcn_exp2f(v1[e]); }
                        v0 = v0 + one4; v1 = v1 + one4;
#pragma unroll
                        for (int e = 0; e < 4; ++e) { v0[e] = __builtin_amdgcn_rcpf(v0[e]); v1[e] = __builtin_amdgcn_rcpf(v1[e]); }
                        v0 = v0 * 255.f; v1 = v1 * 255.f;
#pragma unroll
                        for (int e = 0; e < 4; ++e) { v0[e] = __builtin_rintf(v0[e]); v1[e] = __builtin_rintf(v1[e]); }
                        v0 = __builtin_elementwise_max(v0, one4); v1 = __builtin_elementwise_max(v1, one4);
                        u32 w0 = 0u, w1 = 0u;
#pragma unroll
                        for (int e = 0; e < 4; ++e) { w0 = __builtin_amdgcn_cvt_pk_u8_f32(v0[e], e, w0); w1 = __builtin_amdgcn_cvt_pk_u8_f32(v1[e], e, w1); }
                        *(u32x2*)((unsigned char*)zg + (size_t)row * G_COLS + col0 + bj * HALF) = (u32x2){w0, w1}; } }
        } else {
            if (wc == 0) {
#pragma unroll
                for (int ai = 0; ai < 2; ++ai)
#pragma unroll
                    for (int m = 0; m < 4; ++m) { const int row = row0 + ai * HALF + m * 16; const float r = rsv[ai][m]; bf16* rowp = base + (size_t)row * 32 + 8 * fq;
                        *(u32x4*)(rowp) = pack8(PG8_DQ(ai, 0, m, 0, r), PG8_DQ(ai, 0, m, 1, r)); }
            }
        }
#undef PG8_DQ
    }
};
template <int MODE> struct EpiGate {
    const bf16* gate; bf16* tmp; bf16* merged;
    __device__ __forceinline__ void operator()(const f32x4 (&acc)[2][2][4][2], const Unit& u, int wr, int wc, int fr, int fq) const {
        const int row0 = u.pm * BM + wr * 64 + fr; const int col0 = u.pn * BM + wc * 32 + 8 * fq;
#pragma unroll
        for (int ai = 0; ai < 2; ++ai)
#pragma unroll
            for (int m = 0; m < 4; ++m) { const size_t row = (size_t)(row0 + ai * HALF + m * 16);
#pragma unroll
                for (int bj = 0; bj < 2; ++bj) { const int col = col0 + bj * HALF;
                    const u32x4 gq = *(const u32x4*)(gate + row * G_COLS + col);
                    f32x4 g0 = (f32x4){bflo(gq.x), bfhi(gq.x), bflo(gq.y), bfhi(gq.y)}, g1 = (f32x4){bflo(gq.z), bfhi(gq.z), bflo(gq.w), bfhi(gq.w)};
                    f32x4 v0 = acc[ai][bj][m][0] * g0, v1 = acc[ai][bj][m][1] * g1;
                    bf16* tp = tmp + row * D + col;
                    if (MODE != 0) { const u32x4 tq = *(const u32x4*)tp; v0 += (f32x4){bflo(tq.x), bfhi(tq.x), bflo(tq.y), bfhi(tq.y)}; v1 += (f32x4){bflo(tq.z), bfhi(tq.z), bflo(tq.w), bfhi(tq.w)}; }
                    if (MODE != 2) *(u32x4*)tp = pack8(v0, v1);
                    else *(u32x4*)(merged + row * D + col) = pack8(v0, v1); }
                asm volatile("" ::: "memory"); }
    }
};
struct EpiChainGate {
    const unsigned char* gate; bf16* merged;
    __device__ __forceinline__ void link(f32x4 (&acc)[2][2][4][2], const Unit& u, int br, int wr, int wc, int fr, int fq) const {
        const int row0 = u.pm * BM + wr * 64 + fr; const int col0 = u.pn * BM + wc * 32 + 8 * fq;
        u32x2 gav[2][4][2], gbv[2][4][2];
#pragma unroll
        for (int ai = 0; ai < 2; ++ai)
#pragma unroll
            for (int m = 0; m < 4; ++m)
#pragma unroll
                for (int bj = 0; bj < 2; ++bj) { const unsigned char* gp = gate + (size_t)(row0 + ai * HALF + m * 16) * G_COLS + br * 1024 + col0 + bj * HALF; gav[ai][m][bj] = *(const u32x2*)gp; gbv[ai][m][bj] = *(const u32x2*)(gp + 1024); }
#pragma unroll
        for (int ai = 0; ai < 2; ++ai)
#pragma unroll
            for (int m = 0; m < 4; ++m) {
#pragma unroll
                for (int bj = 0; bj < 2; ++bj) { const u32x2 ga = gav[ai][m][bj], gb = gbv[ai][m][bj];
#pragma unroll
                    for (int e = 0; e < 8; ++e) { const u32 wa = (e < 4) ? ga.x : ga.y, wb = (e < 4) ? gb.x : gb.y; const int sh = 8 * (e & 3);
                        const float r = (float)((wa >> sh) & 255u) * __builtin_amdgcn_rcpf((float)((wb >> sh) & 255u));
                        if (e < 4) acc[ai][bj][m][0][e] *= r; else acc[ai][bj][m][1][e - 4] *= r; } }
                asm volatile("" ::: "memory"); }
    }
    __device__ __forceinline__ void fin(const f32x4 (&acc)[2][2][4][2], const Unit& u, int wr, int wc, int fr, int fq) const {
        const int row0 = u.pm * BM + wr * 64 + fr; const int col0 = u.pn * BM + wc * 32 + 8 * fq;
        u32x2 gqv[2][4][2];
#pragma unroll
        for (int ai = 0; ai < 2; ++ai)
#pragma unroll
            for (int m = 0; m < 4; ++m)
#pragma unroll
                for (int bj = 0; bj < 2; ++bj) gqv[ai][m][bj] = *(const u32x2*)(gate + (size_t)(row0 + ai * HALF + m * 16) * G_COLS + 2048 + col0 + bj * HALF);
#pragma unroll
        for (int ai = 0; ai < 2; ++ai)
#pragma unroll
            for (int m = 0; m < 4; ++m) { const size_t row = (size_t)(row0 + ai * HALF + m * 16);
#pragma unroll
                for (int bj = 0; bj < 2; ++bj) { const int col = col0 + bj * HALF; const u32x2 gq = gqv[ai][m][bj]; f32x4 g0_, g1_;
#pragma unroll
                    for (int e = 0; e < 4; ++e) { g0_[e] = (float)((gq.x >> (8 * e)) & 255u) * (1.f / 255.f); g1_[e] = (float)((gq.y >> (8 * e)) & 255u) * (1.f / 255.f); }
                    *(u32x4*)(merged + row * D + col) = pack8(acc[ai][bj][m][0] * g0_, acc[ai][bj][m][1] * g1_); }
                asm volatile("" ::: "memory"); }
    }
};
struct EpiResid {
    const float* xin; float* xout;
    __device__ __forceinline__ void operator()(const f32x4 (&acc)[2][2][4][2], const Unit& u, int wr, int wc, int fr, int fq) const {
        const int row0 = u.pm * BM + wr * 64 + fr; const int col0 = u.pn * BM + wc * 32 + 8 * fq;
        f32x4 cur[4], nx[4];
#pragma unroll
        for (int bj = 0; bj < 2; ++bj) { const float* ip = xin + (size_t)row0 * D + col0 + bj * HALF; cur[2 * bj] = *(const f32x4*)ip; cur[2 * bj + 1] = *(const f32x4*)(ip + 4); }
#pragma unroll
        for (int rr = 0; rr < 8; ++rr) { const int ai = rr >> 2, m = rr & 3; const size_t off = (size_t)(row0 + ai * HALF + m * 16) * D + col0;
            if (rr < 7) { const int ai2 = (rr + 1) >> 2, m2 = (rr + 1) & 3; const size_t off2 = (size_t)(row0 + ai2 * HALF + m2 * 16) * D + col0;
#pragma unroll
                for (int bj = 0; bj < 2; ++bj) { const float* ip = xin + off2 + bj * HALF; nx[2 * bj] = *(const f32x4*)ip; nx[2 * bj + 1] = *(const f32x4*)(ip + 4); } }
            asm volatile("" ::: "memory");
#pragma unroll
            for (int bj = 0; bj < 2; ++bj) { float* op = xout + off + bj * HALF; *(f32x4*)op = cur[2 * bj] + acc[ai][bj][m][0]; *(f32x4*)(op + 4) = cur[2 * bj + 1] + acc[ai][bj][m][1]; }
            asm volatile("" ::: "memory");
#pragma unroll
            for (int q = 0; q < 4; ++q) cur[q] = nx[q]; }
    }
};
struct EpiSwiglu {
    bf16* hid; const float* rs; const int* rowmap; const LAS int* tb; const unsigned* cmax;
    __device__ __forceinline__ void operator()(const i32x4 (&acc)[2][2][4][2], const Unit& u, int wr, int wc, int fr, int fq) const {
        const int row0 = u.pm * BM + wr * 64 + fr; const int col0 = u.pn * HALF + wc * 32 + 8 * fq;
        const int e = u.e, slot0 = (u.pm - tb[e]) * BM + wr * 64 + fr, cn = tb[40 + e];
        f32x4 cs[2][2];
#pragma unroll
        for (int bj = 0; bj < 2; ++bj)
#pragma unroll
            for (int n = 0; n < 2; ++n) { const u32x4 b = *(const u32x4*)(cmax + e * 1024 + u.pn * BM + bj * HALF + wc * 32 + 8 * fq + 4 * n);
                cs[bj][n] = (f32x4){__uint_as_float(b.x), __uint_as_float(b.y), __uint_as_float(b.z), __uint_as_float(b.w)} * (1.f / 127.f); }
        float rsv[2][4]; int tk[2][4];
#pragma unroll
        for (int ai = 0; ai < 2; ++ai)
#pragma unroll
            for (int m = 0; m < 4; ++m) { const int slot = slot0 + ai * HALF + m * 16; tk[ai][m] = (slot < cn) ? rowmap[e * 16384 + slot] : -1; }
#pragma unroll
        for (int ai = 0; ai < 2; ++ai)
#pragma unroll
            for (int m = 0; m < 4; ++m) rsv[ai][m] = (tk[ai][m] >= 0) ? rs[tk[ai][m]] : 0.f;
#pragma unroll
        for (int ai = 0; ai < 2; ++ai)
#pragma unroll
            for (int m = 0; m < 4; ++m) { bf16* rowp = hid + (size_t)(row0 + ai * HALF + m * 16) * EFF + col0;
                const float r = rsv[ai][m];
                const f32x4 a0 = __builtin_convertvector(acc[ai][0][m][0], f32x4) * (cs[0][0] * r), a1 = __builtin_convertvector(acc[ai][0][m][1], f32x4) * (cs[0][1] * r);
                const f32x4 b0 = __builtin_convertvector(acc[ai][1][m][0], f32x4) * (cs[1][0] * r), b1 = __builtin_convertvector(acc[ai][1][m][1], f32x4) * (cs[1][1] * r);
                f32x4 h0, h1;
#pragma unroll
                for (int q = 0; q < 4; ++q) { h0[q] = a0[q] * sigmoidf_(a0[q]) * b0[q]; h1[q] = a1[q] * sigmoidf_(a1[q]) * b1[q]; }
                *(u32x4*)rowp = pack8(h0, h1); }
    }
};
struct EpiLora { bf16* w; bf16* a; bf16* g; bf16* v;
    __device__ __forceinline__ void operator()(const f32x4 (&acc)[2][2][4][2], const Unit& u, int wr, int wc, int fr, int fq) const {
        const int sec = u.pn >> 2; bf16* base = sec == 0 ? w : (sec == 1 ? a : (sec == 2 ? g : v)); Unit u2 = u; u2.pn = u.pn & 3;
        EpiBf16 e{base, D, 0, 0}; e(acc, u2, wr, wc, fr, fq); } };
}

#define XB_TMO      128
#define XB_XCNT(j)  (256  + 64 * (j))
#define XB_XSUB(j)  (1280 + 64 * (j))
#define XB_XGEN(j)  (2304 + 64 * (j))
#define XB_TOP      3328
#define XB_TOPGEN   3392
#define XCD_BAR_WORDS 3456
#define XB_SPIN_CAP (1u << 22)
__device__ __forceinline__ unsigned xb_ld(unsigned* p)              { return __hip_atomic_load(p, __ATOMIC_RELAXED, __HIP_MEMORY_SCOPE_AGENT); }
__device__ __forceinline__ unsigned xb_add(unsigned* p, unsigned v) { return __hip_atomic_fetch_add(p, v, __ATOMIC_RELAXED, __HIP_MEMORY_SCOPE_AGENT); }
__device__ __forceinline__ unsigned xb_xcc_id() { return (unsigned)__builtin_amdgcn_s_getreg((3 << 11) | 20) & 0xFu; }
#define XB_SPIN(cond, bar) do { unsigned _sp = 0; while (cond) { __builtin_amdgcn_s_sleep(1); \
    if ((++_sp & 255u) == 0u) { if (xb_ld(&(bar)[XB_TMO])) break; if (_sp > XB_SPIN_CAP) { atomicAdd(&(bar)[XB_TMO], 1u); break; } } } } while (0)
struct XcdBarrier { unsigned* bar; unsigned x; volatile LAS unsigned* st; };
__device__ __forceinline__ XcdBarrier xcd_barrier_post(unsigned* bar, volatile LAS unsigned* st) {
    XcdBarrier b; b.bar = bar; b.x = xb_xcc_id(); b.st = st;
    if (threadIdx.x == 0) (void)xb_add(&bar[XB_XCNT(b.x)], 1u);
    return b;
}
__device__ __forceinline__ void xcd_barrier_complete(unsigned* bar, unsigned x, unsigned& nloc, unsigned& nx) {
    const unsigned G = gridDim.x * gridDim.y * gridDim.z;
    unsigned sum, cnt, mine, sp = 0u;
    for (;;) {
        sum = 0u; cnt = 0u; mine = 0u;
#pragma unroll
        for (unsigned j = 0; j < 16; ++j) { const unsigned c = xb_ld(&bar[XB_XCNT(j)]); sum += c; cnt += (c > 0u) ? 1u : 0u; mine = (j == x) ? c : mine; }
        if (sum == G) break;
        __builtin_amdgcn_s_sleep(1);
        if ((++sp & 255u) == 0u) { if (xb_ld(&bar[XB_TMO])) break; if (sp > XB_SPIN_CAP) { atomicAdd(&bar[XB_TMO], 1u); break; } }
    }
    nloc = mine > 0u ? mine : 1u; nx = cnt > 0u ? cnt : 1u;
}
__device__ __forceinline__ void xcd_barrier(const XcdBarrier& b) {
    asm volatile("s_waitcnt vmcnt(0)" ::: "memory");
    __syncthreads();
    if (threadIdx.x == 0) {
        unsigned* bar = b.bar;
        __builtin_amdgcn_s_waitcnt(0);
        unsigned nloc = b.st[0], nx = b.st[1];
        if (nloc == 0u) { xcd_barrier_complete(bar, b.x, nloc, nx); b.st[0] = nloc; b.st[1] = nx; }
        const unsigned old = xb_add(&bar[XB_XSUB(b.x)], 1u);
        const unsigned gen = old / nloc;
        if (old + 1u == (gen + 1u) * nloc) {
            __builtin_amdgcn_fence(__ATOMIC_RELEASE, "agent");
            asm volatile("s_waitcnt vmcnt(0)" ::: "memory");
            const unsigned og = xb_add(&bar[XB_TOP], 1u);
            const unsigned tg = og / nx;
            if (og + 1u == (tg + 1u) * nx) xb_add(&bar[XB_TOPGEN], 1u);
            else XB_SPIN(xb_ld(&bar[XB_TOPGEN]) == tg, bar);
            __builtin_amdgcn_fence(__ATOMIC_ACQUIRE, "agent");
            xb_add(&bar[XB_XGEN(b.x)], 1u);
            asm volatile("s_waitcnt vmcnt(0)" ::: "memory");
        } else {
            XB_SPIN(xb_ld(&bar[XB_XGEN(b.x)]) == gen, bar);
            __builtin_amdgcn_fence(__ATOMIC_ACQUIRE, "agent");
            asm volatile("s_waitcnt vmcnt(0)" ::: "memory");
        }
    }
    __syncthreads();
}

struct Args { const float* in[36]; float* out; unsigned char* ws; int s_lo, s_hi; };
enum { I_X = 0, I_NORM_MIX, I_W_IN, I_MU_A, I_W_DECAY0, I_W_DECAY2, I_A0, I_A2, I_G2, I_K_K, I_K_A, I_R_K, I_LNX_W, I_LNX_B, I_VRES_MU, I_VRES_W1, I_VRES_W2, I_VRES_B,
       I_SGU_LN_W, I_SGU_LN_B, I_SGU_WS, I_SGU_BS, I_GATE_B, I_W_PA, I_W_PB, I_W_PC, I_W_OUT, I_NORM_FFN, I_RGRP, I_RGRP_B, I_REXP, I_REXP_B, I_MOE_W1, I_MOE_W3, I_MOE_W2, I_NORM_FINAL };

struct Ctx {
    LAS unsigned char* lds; unsigned char* ws; const float* const* in; float* out;
    int tid, lane, wave, G, bid, gw, ngw;
    __device__ __forceinline__ const float* inp(int k) const { return AS_GLOBAL(const float, in[k]); }
};
__device__ __forceinline__ Ctx launder(const Ctx& C0) {
    Ctx C = C0; asm volatile("" : "+v"(C.tid), "+v"(C.lane)); asm volatile("" : "+s"(C.wave), "+s"(C.bid), "+s"(C.gw), "+s"(C.ws)); C.ws = AS_GLOBAL(unsigned char, C.ws); C.out = AS_GLOBAL(float, C.out); return C;
}

__device__ __forceinline__ void tr_item(const float* W, int N, int k0, int n0, bf16* WT, int ldk, int drow0, LAS float* scr, int lane) {
    float wv_[32];
#pragma unroll
    for (int i = 0; i < 32; ++i) { const int kk = 2 * i + (lane >> 5); wv_[i] = W[(size_t)(k0 + kk) * N + n0 + (lane & 31)]; }
#pragma unroll
    for (int i = 0; i < 32; ++i) { const int kk = 2 * i + (lane >> 5); scr[kk * 33 + (lane & 31)] = wv_[i]; }
    LDS_WAIT(); asm volatile("" ::: "memory");
    const int c = lane & 7;
#pragma unroll
    for (int j = 0; j < 4; ++j) { const int n = (lane >> 3) + 8 * j; const LAS float* s = scr + (8 * c) * 33 + n;
        u32x4 o; o.x = cvt_pk_bf16(s[0 * 33], s[1 * 33]); o.y = cvt_pk_bf16(s[2 * 33], s[3 * 33]); o.z = cvt_pk_bf16(s[4 * 33], s[5 * 33]); o.w = cvt_pk_bf16(s[6 * 33], s[7 * 33]);
        *(u32x4*)(WT + (size_t)(drow0 + n) * ldk + k0 + 8 * c) = o; }
    LDS_WAIT(); asm volatile("" ::: "memory");
}

__device__ __forceinline__ void tr_item_i8(const float* W, int N, int k0, int n0, unsigned char* WT, int ldkb, int drow0, const unsigned* cmax, LAS float* scr, int lane) {
    float wv_[32];
    const float sc = 127.f / fmaxf(__uint_as_float(cmax[drow0 + (lane & 31)]), 1e-30f);
#pragma unroll
    for (int i = 0; i < 32; ++i) { const int kk = 2 * i + (lane >> 5); wv_[i] = W[(size_t)(k0 + kk) * N + n0 + (lane & 31)]; }
#pragma unroll
    for (int i = 0; i < 32; ++i) { const int kk = 2 * i + (lane >> 5); scr[kk * 33 + (lane & 31)] = __builtin_rintf(wv_[i] * sc); }
    LDS_WAIT(); asm volatile("" ::: "memory");
    const int c = lane & 7;
#pragma unroll
    for (int j = 0; j < 4; ++j) { const int n = (lane >> 3) + 8 * j; const LAS float* s = scr + (8 * c) * 33 + n; u32 q[8];
#pragma unroll
        for (int e = 0; e < 8; ++e) q[e] = (u32)(int)s[e * 33] & 255u;
        *(u32x2*)(WT + (size_t)(drow0 + n) * ldkb + k0 + 8 * c) = (u32x2){q[0] | (q[1] << 8) | (q[2] << 16) | (q[3] << 24), q[4] | (q[5] << 8) | (q[6] << 16) | (q[7] << 24)}; }
    LDS_WAIT(); asm volatile("" ::: "memory");
}
__device__ __forceinline__ void phase_wmax(const Ctx& C0) {
    const Ctx C = launder(C0);
    unsigned* cm = (unsigned*)(C.ws + WS_CTL) + CW_WMAX;
    const int gt = C.bid * 512 + C.tid, ngt = C.G * 512;
    constexpr int NF4 = IN_COLS / 4;
    for (int i = gt; i < NLAYER * 32 * NF4; i += ngt) { const int n4 = i % NF4, kb = (i / NF4) % 32, l = i / (NF4 * 32);
        const float* p = C.inp(I_W_IN) + ((size_t)l * D + kb * 32) * IN_COLS + n4 * 4; f32x4 m = {0.f, 0.f, 0.f, 0.f};
#pragma unroll 8
        for (int k = 0; k < 32; ++k) { const f32x4 v = *(const f32x4*)(p + (size_t)k * IN_COLS); m = __builtin_elementwise_max(m, __builtin_elementwise_abs(v)); }
        unsigned* d = cm + l * WIN_ROWS + n4 * 4;
#pragma unroll
        for (int e = 0; e < 4; ++e) __hip_atomic_fetch_max(d + e, __float_as_uint(m[e]), __ATOMIC_RELAXED, __HIP_MEMORY_SCOPE_AGENT); }
    for (int i = gt; i < 32 * 8; i += ngt) { const int n4 = i % 8, kb = i / 8;
        const float* p = C.inp(I_VRES_W1) + (size_t)(kb * 32) * 32 + n4 * 4; f32x4 m = {0.f, 0.f, 0.f, 0.f};
#pragma unroll 8
        for (int k = 0; k < 32; ++k) { const f32x4 v = *(const f32x4*)(p + (size_t)k * 32); m = __builtin_elementwise_max(m, __builtin_elementwise_abs(v)); }
        unsigned* d = cm + WIN_ROWS + IN_COLS + n4 * 4;
#pragma unroll
        for (int e = 0; e < 4; ++e) __hip_atomic_fetch_max(d + e, __float_as_uint(m[e]), __ATOMIC_RELAXED, __HIP_MEMORY_SCOPE_AGENT); }
    unsigned* cm13 = (unsigned*)(C.ws + WS_CTL) + CW_WMAX13; const float* w1_ = C.inp(I_MOE_W1); const float* w3_ = C.inp(I_MOE_W3);
    for (int i = gt; i < NLAYER * NEXP * 2 * 16 * 128; i += ngt) { const int n4 = i % 128, kb = (i / 128) % 16, sel = (i / 2048) % 2, le = i / 4096;
        const float* p = (sel ? w3_ : w1_) + ((size_t)le * D + kb * 64) * EFF + n4 * 4; f32x4 m = {0.f, 0.f, 0.f, 0.f};
#pragma unroll 8
        for (int k = 0; k < 64; ++k) { const f32x4 v = *(const f32x4*)(p + (size_t)k * EFF); m = __builtin_elementwise_max(m, __builtin_elementwise_abs(v)); }
        const int n = n4 * 4; unsigned* d = cm13 + le * 1024 + (n / 128) * 256 + (n % 128) + sel * 128;
#pragma unroll
        for (int e = 0; e < 4; ++e) __hip_atomic_fetch_max(d + e, __float_as_uint(m[e]), __ATOMIC_RELAXED, __HIP_MEMORY_SCOPE_AGENT); }
}

__device__ __forceinline__ void phase_convert(const Ctx& C0, int l, bool first) {
    const Ctx C = launder(C0);
    LAS float* scr = (LAS float*)(C.lds + C.wave * 16384);
    unsigned char* ws = C.ws;
    constexpr int I_WIN = 16 * 336, I_VR = 16, I_SQ = 16 * 32, I_PB = 4 * 32, I_E13 = 256 * 32, I_E2 = 256 * 32;
    constexpr int NIT_ = I_WIN + I_VR + 3 * I_SQ + I_PB + 2 * I_E13 + I_E2;
    for (int it = C.gw; it < NIT_; it += C.ngw) {
        int r = it;
        if (r < I_WIN) { tr_item_i8(C.inp(I_W_IN) + (size_t)l * D * IN_COLS, IN_COLS, (r / 336) * 64, (r % 336) * 32, ws + WS_WIN, D, (r % 336) * 32, (const unsigned*)(ws + WS_CTL) + CW_WMAX + l * WIN_ROWS, scr, C.lane); continue; } r -= I_WIN;
        if (r < I_VR) { if (l == 1) tr_item_i8(C.inp(I_VRES_W1), 32, r * 64, 0, ws + WS_WIN, D, IN_COLS, (const unsigned*)(ws + WS_CTL) + CW_WMAX + WIN_ROWS, scr, C.lane); continue; } r -= I_VR;
        if (r < I_SQ) { tr_item(C.inp(I_W_PA) + (size_t)l * D * D, D, (r / 32) * 64, (r % 32) * 32, (bf16*)(ws + WS_PA), D, (r % 32) * 32, scr, C.lane); continue; } r -= I_SQ;
        if (r < I_SQ) { tr_item(C.inp(I_W_PC) + (size_t)l * D * D, D, (r / 32) * 64, (r % 32) * 32, (bf16*)(ws + WS_PC), D, (r % 32) * 32, scr, C.lane); continue; } r -= I_SQ;
        if (r < I_SQ) { tr_item(C.inp(I_W_OUT) + (size_t)l * D * D, D, (r / 32) * 64, (r % 32) * 32, (bf16*)(ws + WS_WOUT), D, (r % 32) * 32, scr, C.lane); continue; } r -= I_SQ;
        if (r < I_PB) { tr_item(C.inp(I_W_PB) + (size_t)l * 256 * D, D, (r / 32) * 64, (r % 32) * 32, (bf16*)(ws + WS_PB), 256, (r % 32) * 32, scr, C.lane); continue; } r -= I_PB;
        if (r < 2 * I_E13) { const int sel = r / I_E13; r -= sel * I_E13; const int e = r / 256, q = r % 256, kb = q / 16, nb = q % 16, n0 = nb * 32;
            tr_item_i8(C.inp(sel ? I_MOE_W3 : I_MOE_W1) + ((size_t)l * NEXP + e) * D * EFF, EFF, kb * 64, n0, ws + WS_W13 + (size_t)e * D * D, D, (n0 / 128) * 256 + (n0 % 128) + sel * 128, (const unsigned*)(ws + WS_CTL) + CW_WMAX13 + (l * NEXP + e) * 1024, scr, C.lane); continue; }
        r -= 2 * I_E13;
        { const int e = r / 256, q = r % 256, kb = q / 32, nb = q % 32;
            tr_item(C.inp(I_MOE_W2) + ((size_t)l * NEXP + e) * EFF * D, D, kb * 64, nb * 32, (bf16*)(ws + WS_W2) + (size_t)e * D * EFF, EFF, nb * 32, scr, C.lane); }
    }
    const int gt = C.bid * 512 + C.tid, ngt = C.G * 512;
    if (l == 1) { u32 zz_ = 0u; asm volatile("" : "+v"(zz_));
        for (int i = gt; i < 224 * 64; i += ngt) *(u32x4*)(ws + WS_WIN + (size_t)(10784 + i / 64) * D + (i % 64) * 16) = (u32x4){zz_, zz_, zz_, zz_}; }
    for (int i = gt; i < LORA_N * (LORA_K / 8); i += ngt) {
        const int n = i % LORA_N, k8 = i / LORA_N, sec = n >> 10, nn = n & 1023; float v[8];
#pragma unroll
        for (int e = 0; e < 8; ++e) { const int k = k8 * 8 + e; float x = 0.f;
            if (sec == 0) { if (k < 64) x = C.inp(I_W_DECAY2)[((size_t)l * 64 + k) * D + nn]; }
            else if (sec == 1) { if (k >= 64 && k < 128) x = C.inp(I_A2)[((size_t)l * 64 + (k - 64)) * D + nn]; }
            else if (sec == 2) { if (k >= 128 && k < 256) x = C.inp(I_G2)[((size_t)l * 128 + (k - 128)) * D + nn]; }
            else { if (l == 1 && k >= 256 && k < 288) x = C.inp(I_VRES_W2)[(size_t)(k - 256) * D + nn]; }
            v[e] = x; }
        u32x4 o; o.x = cvt_pk_bf16(v[0], v[1]); o.y = cvt_pk_bf16(v[2], v[3]); o.z = cvt_pk_bf16(v[4], v[5]); o.w = cvt_pk_bf16(v[6], v[7]);
        *(u32x4*)((bf16*)(ws + WS_LORAB) + (size_t)n * LORA_K + k8 * 8) = o;
    }
    for (int i = gt; i < 8 * 128 * 16; i += ngt) { const int s8 = i & 15, t = (i >> 4) & 127, g = i >> 11; const float* src = C.inp(I_SGU_WS) + (((size_t)l * 8 + g) * 128 + t) * 128 + s8 * 8; float v[8];
#pragma unroll
        for (int e = 0; e < 8; ++e) v[e] = (s8 * 8 + e <= t) ? src[e] : 0.f;
        u32x4 o; o.x = cvt_pk_bf16(v[0], v[1]); o.y = cvt_pk_bf16(v[2], v[3]); o.z = cvt_pk_bf16(v[4], v[5]); o.w = cvt_pk_bf16(v[6], v[7]);
        *(u32x4*)((bf16*)(ws + WS_WSC) + (size_t)i * 8) = o; }
    for (int i = gt; i < 48 * (D / 8); i += ngt) { const int e = i / (D / 8), k8 = i % (D / 8); u32 hi[4], lo[4]; float h2[8], l2[8];
#pragma unroll
        for (int q = 0; q < 8; ++q) { const int k = k8 * 8 + q; float w = 0.f;
            if (e < 4) w = C.inp(I_RGRP)[((size_t)l * D + k) * 4 + e]; else if (e < 36) w = C.inp(I_REXP)[((size_t)l * D + k) * 32 + (e - 4)];
            w *= C.inp(I_NORM_FFN)[(size_t)l * D + k];
            const float wh = bf2f(f2bf(w)); h2[q] = wh; l2[q] = w - wh; }
#pragma unroll
        for (int q = 0; q < 4; ++q) { hi[q] = cvt_pk_bf16(h2[2 * q], h2[2 * q + 1]); lo[q] = cvt_pk_bf16(l2[2 * q], l2[2 * q + 1]); }
        *(u32x4*)((bf16*)(ws + WS_WSC + 512 * 1024) + (size_t)e * D + k8 * 8) = (u32x4){hi[0], hi[1], hi[2], hi[3]};
        *(u32x4*)((bf16*)(ws + WS_WSC + 640 * 1024) + (size_t)e * D + k8 * 8) = (u32x4){lo[0], lo[1], lo[2], lo[3]}; }
    if (first) for (int i = gt; i < T * 32; i += ngt) { const int t = i >> 5, f = i & 31;
        double invd = 1.0; for (int q = 0; q < f; ++q) invd *= 0.74989420933245582;
        const float inv = (float)invd;
        const float ang = (float)t * inv;
        double rev = (double)ang * 0.15915494309189535; rev -= __builtin_rint(rev);
        const float rv = (float)rev;
        ((f32x2*)(ws + WS_ROPE))[i] = (f32x2){__builtin_amdgcn_cosf(rv), __builtin_amdgcn_sinf(rv)}; }
}

__device__ __forceinline__ void row_load(const float* p, int lane, f32x4 (&v)[4]) {
#pragma unroll
    for (int j = 0; j < 4; ++j) v[j] = ((const f32x4*)p)[lane + 64 * j];
}
__device__ __forceinline__ float row_ss(const f32x4 (&v)[4]) {
    float s = 0.f;
#pragma unroll
    for (int j = 0; j < 4; ++j) s += (v[j].x * v[j].x + v[j].y * v[j].y) + (v[j].z * v[j].z + v[j].w * v[j].w);
    return wave_sum(s);
}
__device__ __forceinline__ void norm2_rows(const float* xsrc, const float* g, bf16* out, int gw, int ngw, int lane) {
    f32x4 gv[4];
#pragma unroll
    for (int j = 0; j < 4; ++j) gv[j] = ((const f32x4*)g)[lane + 64 * j];
    for (int ml = gw; ml < M; ml += 2 * ngw) { const int m2 = ml + ngw; const bool has2 = m2 < M; const int mb = has2 ? m2 : ml;
        f32x4 va[4], vb[4]; row_load(xsrc + (size_t)ml * D, lane, va); row_load(xsrc + (size_t)mb * D, lane, vb);
        const float ra = __builtin_amdgcn_rsqf(row_ss(va) * (1.f / D) + 1e-6f), rb = __builtin_amdgcn_rsqf(row_ss(vb) * (1.f / D) + 1e-6f);
#pragma unroll
        for (int j = 0; j < 4; ++j) { const f32x4 oa = va[j] * ra * gv[j]; ((u32x2*)(out + (size_t)ml * D))[lane + 64 * j] = (u32x2){cvt_pk_bf16(oa.x, oa.y), cvt_pk_bf16(oa.z, oa.w)}; }
        if (has2) {
#pragma unroll
            for (int j = 0; j < 4; ++j) { const f32x4 ob = vb[j] * rb * gv[j]; ((u32x2*)(out + (size_t)m2 * D))[lane + 64 * j] = (u32x2){cvt_pk_bf16(ob.x, ob.y), cvt_pk_bf16(ob.z, ob.w)}; } } }
}
__device__ __forceinline__ float wave_max(float v) {
#pragma unroll
    for (int o = 1; o < 64; o <<= 1) v = fmaxf(v, __shfl_xor(v, o));
    return v;
}
__device__ __forceinline__ void norm_q8_store(f32x4 (&v)[4], const f32x4 (&gv)[4], float r, unsigned char* orow, float* rsp, int lane) {
    float mx = 0.f;
#pragma unroll
    for (int j = 0; j < 4; ++j) { v[j] = v[j] * r * gv[j]; const f32x4 a = __builtin_elementwise_abs(v[j]); mx = fmaxf(mx, fmaxf(fmaxf(a.x, a.y), fmaxf(a.z, a.w))); }
    mx = fmaxf(wave_max(mx), 1e-20f);
    const float sc = 127.f / mx;
#pragma unroll
    for (int j = 0; j < 4; ++j) { const u32 q0 = (u32)(int)__builtin_rintf(v[j].x * sc) & 255u, q1 = (u32)(int)__builtin_rintf(v[j].y * sc) & 255u, q2 = (u32)(int)__builtin_rintf(v[j].z * sc) & 255u, q3 = (u32)(int)__builtin_rintf(v[j].w * sc);
        ((u32*)orow)[lane + 64 * j] = q0 | (q1 << 8) | (q2 << 16) | (q3 << 24); }
    if (lane == 0) *rsp = mx * (1.f / 127.f);
}
__device__ __forceinline__ void norm2_rows_i8(const float* xsrc, const float* g, unsigned char* out8, float* rs, int gw, int ngw, int lane) {
    f32x4 gv[4];
#pragma unroll
    for (int j = 0; j < 4; ++j) gv[j] = ((const f32x4*)g)[lane + 64 * j];
    for (int ml = gw; ml < M; ml += 2 * ngw) { const int m2 = ml + ngw; const bool has2 = m2 < M; const int mb = has2 ? m2 : ml;
        f32x4 va[4], vb[4]; row_load(xsrc + (size_t)ml * D, lane, va); row_load(xsrc + (size_t)mb * D, lane, vb);
        const float ra = __builtin_amdgcn_rsqf(row_ss(va) * (1.f / D) + 1e-6f), rb = __builtin_amdgcn_rsqf(row_ss(vb) * (1.f / D) + 1e-6f);
        norm_q8_store(va, gv, ra, out8 + (size_t)ml * D, rs + ml, lane);
        if (has2) norm_q8_store(vb, gv, rb, out8 + (size_t)m2 * D, rs + m2, lane); }
}
__device__ __forceinline__ void row_add_moe(const Ctx& C, int ml, f32x4 (&v)[4], const LAS int* tb) {
#ifdef DBG_NOMOE
    return;
#endif
    const int* tk = (const int*)(C.ws + WS_TOK) + 4 * ml; const float* wt = (const float*)(C.ws + WS_TOK + 512 * 1024) + 2 * ml;
    const int d0 = tb[tk[0]] * 256 + tk[1], d1 = tb[tk[2]] * 256 + tk[3]; const float w0 = wt[0], w1 = wt[1];
    const bf16* y0 = (const bf16*)(C.ws + WS_R1 + R1_YEXP) + (size_t)d0 * D; const bf16* y1 = (const bf16*)(C.ws + WS_R1 + R1_YEXP) + (size_t)d1 * D;
#pragma unroll
    for (int j = 0; j < 4; ++j) { const u32x2 a = ((const u32x2*)y0)[C.lane + 64 * j], b = ((const u32x2*)y1)[C.lane + 64 * j];
        v[j].x += w0 * bflo(a.x) + w1 * bflo(b.x); v[j].y += w0 * bfhi(a.x) + w1 * bfhi(b.x); v[j].z += w0 * bflo(a.y) + w1 * bflo(b.y); v[j].w += w0 * bfhi(a.y) + w1 * bfhi(b.y); }
}

__device__ __forceinline__ void mixer_norm(const Ctx& C, int it, int widx, int nw) {
    const int l = it / NCH, c = it % NCH;
    norm2_rows_i8((l == 0 ? C.inp(I_X) : C.out) + (size_t)c * M * D, C.inp(I_NORM_MIX) + (size_t)l * D, C.ws + WS_R1 + R1_HNX, (float*)(C.ws + WS_R1 + R1_HNX + HNX_RS), widx, nw, C.lane);
}
__device__ __forceinline__ void moe_table(const Ctx& C, int it, LAS int* tb);
__device__ __forceinline__ void phase_prep(const Ctx& C0, int it, LAS int* tb) {
    const Ctx C = launder(C0);
    if (it > 0) moe_table(C, it - 1, tb);
    const int l = it / NCH, c = it % NCH;
    if (it > 0) {
        const int pl = (it - 1) / NCH, pc = (it - 1) % NCH; const float* nf = C.inp(I_NORM_FINAL);
        const int* tkb = (const int*)(C.ws + WS_TOK); const float* wtb = (const float*)(C.ws + WS_TOK + 512 * 1024); const bf16* yex = (const bf16*)(C.ws + WS_R1 + R1_YEXP);
        int t0 = 0, t1 = 0, t2 = 0, t3 = 0; float w0 = 0.f, w1 = 0.f;
        if (C.gw < M) { const int* tk = tkb + 4 * C.gw; t0 = tk[0]; t1 = tk[1]; t2 = tk[2]; t3 = tk[3]; w0 = wtb[2 * C.gw]; w1 = wtb[2 * C.gw + 1]; }
        for (int ml = C.gw; ml < M; ml += C.ngw) { float* xr = C.out + ((size_t)pc * M + ml) * D; f32x4 v[4];
            const int d0 = tb[t0] * 256 + t1, d1 = tb[t2] * 256 + t3; const float cw0 = w0, cw1 = w1;
            { const int mn = (ml + C.ngw < M) ? ml + C.ngw : ml; const int* tk = tkb + 4 * mn; t0 = tk[0]; t1 = tk[1]; t2 = tk[2]; t3 = tk[3]; w0 = wtb[2 * mn]; w1 = wtb[2 * mn + 1]; }
            row_load(xr, C.lane, v);
            { const bf16* y0 = yex + (size_t)d0 * D; const bf16* y1 = yex + (size_t)d1 * D;
#pragma unroll
              for (int j = 0; j < 4; ++j) { const u32x2 a = ((const u32x2*)y0)[C.lane + 64 * j], b = ((const u32x2*)y1)[C.lane + 64 * j];
                  v[j].x += cw0 * bflo(a.x) + cw1 * bflo(b.x); v[j].y += cw0 * bfhi(a.x) + cw1 * bfhi(b.x); v[j].z += cw0 * bflo(a.y) + cw1 * bflo(b.y); v[j].w += cw0 * bfhi(a.y) + cw1 * bfhi(b.y); } }
            if (pl == 1) { const float rs = __builtin_amdgcn_rsqf(row_ss(v) * (1.f / D) + 1e-6f);
#pragma unroll
                for (int j = 0; j < 4; ++j) v[j] = v[j] * rs * ((const f32x4*)nf)[C.lane + 64 * j]; }
#pragma unroll
            for (int j = 0; j < 4; ++j) ((f32x4*)xr)[C.lane + 64 * j] = v[j]; }
    }
    if (it == 0) mixer_norm(C, 0, C.gw, C.ngw);
}

__device__ __forceinline__ void sub_lora_prep(const Ctx& C0, int l) {
    const Ctx C = launder(C0);
    const bf16* za = (const bf16*)(C.ws + WS_R2 + R2_ZA); const bf16* vlo = (const bf16*)(C.ws + WS_VLO); bf16* al = (bf16*)(C.ws + WS_R1 + R1_ALORA);
    const float* mu = C.inp(I_MU_A) + (size_t)l * A_COLS + 3072; const float* vmu = C.inp(I_VRES_MU);
    const int gt = C.bid * 512 + C.tid, ngt = C.G * 512;
    for (int i = gt; i < M * 48; i += ngt) { const int ml = i / 48, k8 = i % 48; const int t = ml & (T - 1); float v[8];
        if (k8 < 32) { const u32x4 cur = *(const u32x4*)(za + (size_t)ml * A_COLS + 3072 + k8 * 8); u32x4 prv = (u32x4){0u, 0u, 0u, 0u};
            if (t > 0) prv = *(const u32x4*)(za + (size_t)(ml - 1) * A_COLS + 3072 + k8 * 8);
            const u32 cw[4] = {cur.x, cur.y, cur.z, cur.w}, pw[4] = {prv.x, prv.y, prv.z, prv.w};
#pragma unroll
            for (int e = 0; e < 8; ++e) { const float zc = (e & 1) ? bfhi(cw[e >> 1]) : bflo(cw[e >> 1]), zp = (e & 1) ? bfhi(pw[e >> 1]) : bflo(pw[e >> 1]);
                float x = zc + (zp - zc) * mu[k8 * 8 + e];
                if (k8 < 8) x = 1.f - 2.f * __builtin_amdgcn_rcpf(__expf(2.f * x) + 1.f);
                else if (k8 >= 16) x = sigmoidf_(x);
                v[e] = x; }
        } else if (k8 < 36 && l == 1) { const int c8 = k8 - 32; const u32x4 cur = *(const u32x4*)(vlo + (size_t)ml * 32 + c8 * 8); u32x4 prv = (u32x4){0u, 0u, 0u, 0u};
            if (t > 0) prv = *(const u32x4*)(vlo + (size_t)(ml - 1) * 32 + c8 * 8);
            const u32 cw[4] = {cur.x, cur.y, cur.z, cur.w}, pw[4] = {prv.x, prv.y, prv.z, prv.w};
#pragma unroll
            for (int e = 0; e < 8; ++e) { const float zc = (e & 1) ? bfhi(cw[e >> 1]) : bflo(cw[e >> 1]), zp = (e & 1) ? bfhi(pw[e >> 1]) : bflo(pw[e >> 1]);
                v[e] = zc + (zp - zc) * vmu[c8 * 8 + e]; }
        } else {
#pragma unroll
            for (int e = 0; e < 8; ++e) v[e] = 0.f;
        }
        u32x4 o; o.x = cvt_pk_bf16(v[0], v[1]); o.y = cvt_pk_bf16(v[2], v[3]); o.z = cvt_pk_bf16(v[4], v[5]); o.w = cvt_pk_bf16(v[6], v[7]);
        *(u32x4*)(al + (size_t)ml * LORA_K + k8 * 8) = o; }
}

__device__ __forceinline__ void sub_gmlp(const Ctx& C0, int l) {
    const Ctx C = launder(C0);
    const bf16* zc = (const bf16*)(C.ws + WS_R1 + R1_ZC); bf16* yc = (bf16*)(C.ws + WS_YC); const bf16* wsc = (const bf16*)(C.ws + WS_WSC);
    const float* lnw = C.inp(I_SGU_LN_W) + (size_t)l * D; const float* lnb = C.inp(I_SGU_LN_B) + (size_t)l * D; const float* bs = C.inp(I_SGU_BS) + (size_t)l * 8 * 128;
    LAS bf16* VT = (LAS bf16*)C.lds;
    LAS float* ST = (LAS float*)(C.lds + 40960);
    const int lane = C.lane, w = C.wave;
    for (int u = C.bid; u < 256; u += C.G) {
        const int nloc = u >> 1, gq = u & 1; const int r0 = nloc * 128;
#pragma unroll 1
        for (int tb4 = 0; tb4 < 4; ++tb4) { u32x4 ra[4], rb4[4]; float s1[4], s2[4];
#pragma unroll
            for (int q4 = 0; q4 < 4; ++q4) { const bf16* vr = zc + (size_t)(r0 + 16 * w + 4 * tb4 + q4) * C_COLS + 1024; ra[q4] = ((const u32x4*)vr)[lane]; rb4[q4] = ((const u32x4*)vr)[lane + 64]; }
#pragma unroll
            for (int q4 = 0; q4 < 4; ++q4) { const u32 q[8] = {ra[q4].x, ra[q4].y, ra[q4].z, ra[q4].w, rb4[q4].x, rb4[q4].y, rb4[q4].z, rb4[q4].w}; float a = 0.f, b = 0.f;
#pragma unroll
                for (int e = 0; e < 8; ++e) { const float x0 = bflo(q[e]), x1 = bfhi(q[e]); a += x0 + x1; b += x0 * x0 + x1 * x1; }
                s1[q4] = a; s2[q4] = b; }
#pragma unroll
            for (int o = 1; o < 64; o <<= 1) {
#pragma unroll
                for (int q4 = 0; q4 < 4; ++q4) { const float t1 = __shfl_xor(s1[q4], o), t2 = __shfl_xor(s2[q4], o); s1[q4] += t1; s2[q4] += t2; } }
            if (lane == 0) {
#pragma unroll
                for (int q4 = 0; q4 < 4; ++q4) { const int tk = 16 * w + 4 * tb4 + q4; const float mean = s1[q4] * (1.f / 1024.f); const float var = fmaxf(s2[q4] * (1.f / 1024.f) - mean * mean, 0.f);
                    ST[2 * tk] = mean; ST[2 * tk + 1] = __builtin_amdgcn_rsqf(var + 1e-5f); } } }
        __syncthreads();
        u32x4 gr[4];
#define GM_ISSUE(g_) do { _Pragma("unroll") for (int p_ = 0; p_ < 4; ++p_) { const int idx_ = C.tid + 512 * p_; gr[p_] = *(const u32x4*)(zc + (size_t)(r0 + (idx_ >> 4)) * C_COLS + 1024 + (g_) * 128 + (idx_ & 15) * 8); } } while (0)
        GM_ISSUE(gq * 4);
        for (int gi = 0; gi < 4; ++gi) { const int g = gq * 4 + gi;
#pragma unroll
            for (int p = 0; p < 4; ++p) { const int idx = C.tid + 512 * p; const int tk = idx >> 4, c8 = idx & 15;
                const u32 q[4] = {gr[p].x, gr[p].y, gr[p].z, gr[p].w};
                const float mean = ST[2 * tk], rstd = ST[2 * tk + 1];
#pragma unroll
                for (int e = 0; e < 8; ++e) { const int cc = c8 * 8 + e; const float x = (e & 1) ? bfhi(q[e >> 1]) : bflo(q[e >> 1]);
                    const float y = (x - mean) * rstd * lnw[g * 128 + cc] + lnb[g * 128 + cc];
                    VT[cc * 136 + ((((tk >> 3) + c8) & 15) << 3) + (tk & 7)] = (bf16)f2bf(y); } }
            asm volatile("" ::: "memory");
            if (gi < 3) GM_ISSUE(g + 1);
            __syncthreads();
            const int ct = w & 3, th = w >> 2;
#pragma unroll 1
            for (int tq = 0; tq < 2; ++tq) { const int tau = 2 * th + tq; f32x16 acc;
#pragma unroll
                for (int e = 0; e < 16; ++e) acc[e] = 0.f;
                const int nks = 2 * tau + 2; const int crow = ct * 32 + (lane & 31); const bf16* wrow = wsc + ((size_t)g * 128 + tau * 32 + (lane & 31)) * 128 + (lane >> 5) * 8;
                bf16x8 bb[8];
#pragma unroll
                for (int ks = 0; ks < 8; ++ks) if (ks < nks) bb[ks] = *(const bf16x8*)(wrow + ks * 16);
#pragma unroll
                for (int ks = 0; ks < 8; ++ks) if (ks < nks) { const int s0 = ks * 16 + (lane >> 5) * 8;
                    const bf16x8 a = *(const LAS bf16x8*)(VT + crow * 136 + ((((s0 >> 3) + (crow >> 3)) & 15) << 3));
                    acc = __builtin_amdgcn_mfma_f32_32x32x16_bf16(a, bb[ks], acc, 0, 0, 0); }
                const int tk = tau * 32 + (lane & 31); const float bsv = bs[g * 128 + tk];
                const bf16* ur = zc + (size_t)(r0 + tk) * C_COLS + g * 128 + ct * 32; bf16* yr = yc + (size_t)(r0 + tk) * D + g * 128 + ct * 32;
#pragma unroll
                for (int rq = 0; rq < 4; ++rq) { const int cb = 8 * rq + 4 * (lane >> 5); const u32x2 uu = *(const u32x2*)(ur + cb);
                    const float o0 = bflo(uu.x) * (acc[4 * rq + 0] + bsv), o1 = bfhi(uu.x) * (acc[4 * rq + 1] + bsv), o2 = bflo(uu.y) * (acc[4 * rq + 2] + bsv), o3 = bfhi(uu.y) * (acc[4 * rq + 3] + bsv);
                    *(u32x2*)(yr + cb) = (u32x2){cvt_pk_bf16(o0, o1), cvt_pk_bf16(o2, o3)}; } }
            __syncthreads();
        }
    }
}

__device__ __forceinline__ void sub_attn(const Ctx& C0) {
    const Ctx C = launder(C0);
    const bf16* zb = (const bf16*)(C.ws + WS_R1 + R1_ZB); bf16* og = (bf16*)(C.ws + WS_R1 + R1_OG); float* lse = (float*)(C.ws + WS_LSE); const f32x2* rope = (const f32x2*)(C.ws + WS_ROPE);
    LAS bf16* Qs = (LAS bf16*)C.lds;
    LAS bf16* Ks = (LAS bf16*)(C.lds + 18432);
    LAS bf16* Vs = (LAS bf16*)(C.lds + 18432 + 36864);
    const int lane = C.lane, w = C.wave, fr = lane & 15, fq = lane >> 4;
    u32x4 rqa, rqb, rka[2], rkb[2], rv[4];
#define AT_DECODE(u_, bl_, hd_, gi_, d_, r_, n_) const int bl_ = (u_) / 768, rem_##bl_ = (u_) % 768, hd_ = rem_##bl_ / 64, blk_##bl_ = rem_##bl_ % 64; \
        const int gi_ = hd_ >> 2, d_ = (gi_ == 0) ? 1 : (gi_ == 1 ? 4 : 16), nb_##bl_ = 64 / d_, r_ = blk_##bl_ / nb_##bl_, n_ = blk_##bl_ % nb_##bl_
#define AT_ISSUE(u_) do { AT_DECODE(u_, xbl, xhd, xgi, xd, xr, xn); const int rb_ = xbl * T; const u32x4 z4_ = (u32x4){0u, 0u, 0u, 0u}; \
        { const int row_ = C.tid >> 2, c0_ = (C.tid & 3) * 8; const int t_ = (128 * xn + row_) * xd + xr; const bf16* s_ = zb + (size_t)(rb_ + t_) * B_COLS + xhd * 64; rqa = *(const u32x4*)(s_ + c0_); rqb = *(const u32x4*)(s_ + 32 + c0_); } \
        _Pragma("unroll") for (int p_ = 0; p_ < 2; ++p_) { const int row_ = (C.tid >> 2) + 128 * p_, c0_ = (C.tid & 3) * 8; const int ms_ = 128 * (xn - 1) + row_; rka[p_] = z4_; rkb[p_] = z4_; \
            if (ms_ >= 0) { const int t_ = ms_ * xd + xr; const bf16* s_ = zb + (size_t)(rb_ + t_) * B_COLS + 768 + xhd * 64; rka[p_] = *(const u32x4*)(s_ + c0_); rkb[p_] = *(const u32x4*)(s_ + 32 + c0_); } } \
        _Pragma("unroll") for (int p_ = 0; p_ < 4; ++p_) { const int idx_ = C.tid + 512 * p_; const int row_ = idx_ >> 3, c8_ = idx_ & 7; const int ms_ = 128 * (xn - 1) + row_; rv[p_] = z4_; \
            if (ms_ >= 0) { const int t_ = ms_ * xd + xr; rv[p_] = *(const u32x4*)(zb + (size_t)(rb_ + t_) * B_COLS + 1536 + xhd * 64 + c8_ * 8); } } } while (0)
    if (C.bid < 1536) AT_ISSUE(C.bid);
    for (int u = C.bid; u < 1536; u += C.G) {
        AT_DECODE(u, bl, hd, gi, d, r, n);
        const int rowbase = bl * T;
        { const int row = C.tid >> 2, c0 = (C.tid & 3) * 8; const int t = (128 * n + row) * d + r;
            const u32 qa[4] = {rqa.x, rqa.y, rqa.z, rqa.w}, qb[4] = {rqb.x, rqb.y, rqb.z, rqb.w}; float o1[8], o2[8];
#pragma unroll
            for (int e = 0; e < 8; ++e) { const f32x2 cs = rope[t * 32 + c0 + e]; const float z1 = (e & 1) ? bfhi(qa[e >> 1]) : bflo(qa[e >> 1]), z2 = (e & 1) ? bfhi(qb[e >> 1]) : bflo(qb[e >> 1]);
                o1[e] = (z1 * cs.x - z2 * cs.y) * 0.125f; o2[e] = (z1 * cs.y + z2 * cs.x) * 0.125f; }
            *(LAS u32x4*)(Qs + row * 72 + c0) = (u32x4){cvt_pk_bf16(o1[0], o1[1]), cvt_pk_bf16(o1[2], o1[3]), cvt_pk_bf16(o1[4], o1[5]), cvt_pk_bf16(o1[6], o1[7])};
            *(LAS u32x4*)(Qs + row * 72 + 32 + c0) = (u32x4){cvt_pk_bf16(o2[0], o2[1]), cvt_pk_bf16(o2[2], o2[3]), cvt_pk_bf16(o2[4], o2[5]), cvt_pk_bf16(o2[6], o2[7])}; }
#pragma unroll
        for (int p = 0; p < 2; ++p) { const int row = (C.tid >> 2) + 128 * p, c0 = (C.tid & 3) * 8; const int ms = 128 * (n - 1) + row; u32x4 oa = (u32x4){0u, 0u, 0u, 0u}, ob = oa;
            if (ms >= 0) { const int t = ms * d + r;
                const u32 qa[4] = {rka[p].x, rka[p].y, rka[p].z, rka[p].w}, qb[4] = {rkb[p].x, rkb[p].y, rkb[p].z, rkb[p].w}; float o1[8], o2[8];
#pragma unroll
                for (int e = 0; e < 8; ++e) { const f32x2 cs = rope[t * 32 + c0 + e]; const float z1 = (e & 1) ? bfhi(qa[e >> 1]) : bflo(qa[e >> 1]), z2 = (e & 1) ? bfhi(qb[e >> 1]) : bflo(qb[e >> 1]);
                    o1[e] = z1 * cs.x - z2 * cs.y; o2[e] = z1 * cs.y + z2 * cs.x; }
                oa = (u32x4){cvt_pk_bf16(o1[0], o1[1]), cvt_pk_bf16(o1[2], o1[3]), cvt_pk_bf16(o1[4], o1[5]), cvt_pk_bf16(o1[6], o1[7])};
                ob = (u32x4){cvt_pk_bf16(o2[0], o2[1]), cvt_pk_bf16(o2[2], o2[3]), cvt_pk_bf16(o2[4], o2[5]), cvt_pk_bf16(o2[6], o2[7])}; }
            *(LAS u32x4*)(Ks + row * 72 + c0) = oa; *(LAS u32x4*)(Ks + row * 72 + 32 + c0) = ob; }
#pragma unroll
        for (int p = 0; p < 4; ++p) { const int idx = C.tid + 512 * p; const int row = idx >> 3, c8 = idx & 7;
            *(LAS u32x4*)(Vs + row * 72 + c8 * 8) = rv[p]; }
        asm volatile("" ::: "memory");
        if (u + C.G < 1536) AT_ISSUE(u + C.G);
        __syncthreads();
        f32x4 sc[9];
        { const bf16x8 q0 = *(const LAS bf16x8*)(Qs + (16 * w + fr) * 72 + fq * 8), q1 = *(const LAS bf16x8*)(Qs + (16 * w + fr) * 72 + 32 + fq * 8);
#pragma unroll
            for (int ti = 0; ti < 9; ++ti) { const int kr = 16 * w + 16 * ti + fr;
                const bf16x8 k0 = *(const LAS bf16x8*)(Ks + kr * 72 + fq * 8), k1 = *(const LAS bf16x8*)(Ks + kr * 72 + 32 + fq * 8);
                f32x4 a = (f32x4){0.f, 0.f, 0.f, 0.f};
                a = __builtin_amdgcn_mfma_f32_16x16x32_bf16(k0, q0, a, 0, 0, 0); a = __builtin_amdgcn_mfma_f32_16x16x32_bf16(k1, q1, a, 0, 0, 0); sc[ti] = a; } }
        float mx = -3.0e38f;
#pragma unroll
        for (int ti = 0; ti < 9; ++ti)
#pragma unroll
            for (int e = 0; e < 4; ++e) { const int rel = 16 * ti + 4 * fq + e; const bool ok = (rel >= fr) && (rel <= fr + 128) && (n > 0 || (16 * w + rel) >= 128);
                sc[ti][e] = ok ? sc[ti][e] : -3.0e38f; mx = fmaxf(mx, sc[ti][e]); }
        mx = fmaxf(mx, __shfl_xor(mx, 16)); mx = fmaxf(mx, __shfl_xor(mx, 32));
        float sum = 0.f;
#pragma unroll
        for (int ti = 0; ti < 9; ++ti)
#pragma unroll
            for (int e = 0; e < 4; ++e) { const float p = __expf(sc[ti][e] - mx); sc[ti][e] = p; sum += p; }
        sum += __shfl_xor(sum, 16); sum += __shfl_xor(sum, 32);
        f32x4 oacc[4];
#pragma unroll
        for (int ct = 0; ct < 4; ++ct) oacc[ct] = (f32x4){0.f, 0.f, 0.f, 0.f};
#pragma unroll
        for (int kp = 0; kp < 5; ++kp) { const int t0 = 2 * kp, t1 = (2 * kp + 1 < 9) ? 2 * kp + 1 : 8;
            u32x4 pw; pw.x = cvt_pk_bf16(sc[t0][0], sc[t0][1]); pw.y = cvt_pk_bf16(sc[t0][2], sc[t0][3]);
            if (2 * kp + 1 < 9) { pw.z = cvt_pk_bf16(sc[t1][0], sc[t1][1]); pw.w = cvt_pk_bf16(sc[t1][2], sc[t1][3]); } else { pw.z = 0u; pw.w = 0u; }
            const bf16x8 pb = __builtin_bit_cast(bf16x8, pw);
            const int k0 = 16 * w + 16 * t0 + 4 * fq, k1 = 16 * w + 16 * t1 + 4 * fq;
#pragma unroll
            for (int ct = 0; ct < 4; ++ct) {
                const u32x2 va = lds_tr16(Vs + (k0 + (fr >> 2)) * 72 + ct * 16 + 4 * (fr & 3)), vb = lds_tr16(Vs + (k1 + (fr >> 2)) * 72 + ct * 16 + 4 * (fr & 3));
                const bf16x8 av = __builtin_bit_cast(bf16x8, (u32x4){va.x, va.y, vb.x, vb.y});
                oacc[ct] = __builtin_amdgcn_mfma_f32_16x16x32_bf16(av, pb, oacc[ct], 0, 0, 0); } }
        { const float inv = __builtin_amdgcn_rcpf(sum); const int t = (128 * n + 16 * w + fr) * d + r; const size_t ml = (size_t)(rowbase + t);
            bf16* orow = og + ((size_t)gi * M + ml) * 256 + (hd & 3) * 64;
#pragma unroll
            for (int ct = 0; ct < 4; ++ct) *(u32x2*)(orow + ct * 16 + 4 * fq) = (u32x2){cvt_pk_bf16(oacc[ct][0] * inv, oacc[ct][1] * inv), cvt_pk_bf16(oacc[ct][2] * inv, oacc[ct][3] * inv)};
            if (fq == 0) lse[((size_t)gi * M + ml) * 4 + (hd & 3)] = mx + __logf(sum); }
        __syncthreads();
    }
}

__device__ __forceinline__ void sub_yb_combine(const Ctx& C0) {
    const Ctx C = launder(C0);
    const bf16* og = (const bf16*)(C.ws + WS_R1 + R1_OG); const float* lse = (const float*)(C.ws + WS_LSE); bf16* yb = (bf16*)(C.ws + WS_YB);
    const int gt = C.bid * 512 + C.tid, ngt = C.G * 512;
    for (int i = gt; i < M * 32; i += ngt) { const int ml = i >> 5, c8 = i & 31, hp = c8 >> 3;
        const float l0 = lse[((size_t)0 * M + ml) * 4 + hp], l1 = lse[((size_t)1 * M + ml) * 4 + hp], l2 = lse[((size_t)2 * M + ml) * 4 + hp];
        const float mx = fmaxf(l0, fmaxf(l1, l2)); float w0 = __expf(l0 - mx), w1 = __expf(l1 - mx), w2 = __expf(l2 - mx); const float inv = __builtin_amdgcn_rcpf(w0 + w1 + w2); w0 *= inv; w1 *= inv; w2 *= inv;
        const u32x4 a = *(const u32x4*)(og + ((size_t)0 * M + ml) * 256 + c8 * 8), b = *(const u32x4*)(og + ((size_t)1 * M + ml) * 256 + c8 * 8), c = *(const u32x4*)(og + ((size_t)2 * M + ml) * 256 + c8 * 8);
        const u32 qa[4] = {a.x, a.y, a.z, a.w}, qb[4] = {b.x, b.y, b.z, b.w}, qc[4] = {c.x, c.y, c.z, c.w}; u32 o[4];
#pragma unroll
        for (int e = 0; e < 4; ++e) o[e] = cvt_pk_bf16(w0 * bflo(qa[e]) + w1 * bflo(qb[e]) + w2 * bflo(qc[e]), w0 * bfhi(qa[e]) + w1 * bfhi(qb[e]) + w2 * bfhi(qc[e]));
        *(u32x4*)(yb + (size_t)ml * 256 + c8 * 8) = (u32x4){o[0], o[1], o[2], o[3]}; }
}

__device__ __forceinline__ void ld8(const bf16* p, float (&v)[8]) { const u32x4 a = *(const u32x4*)p; v[0] = bflo(a.x); v[1] = bfhi(a.x); v[2] = bflo(a.y); v[3] = bfhi(a.y); v[4] = bflo(a.z); v[5] = bfhi(a.z); v[6] = bflo(a.w); v[7] = bfhi(a.w); }
__device__ __forceinline__ void ldl8(const LAS float* p, float (&v)[8]) { const f32x4 a = *(const LAS f32x4*)p, b = *(const LAS f32x4*)(p + 4); v[0] = a.x; v[1] = a.y; v[2] = a.z; v[3] = a.w; v[4] = b.x; v[5] = b.y; v[6] = b.z; v[7] = b.w; }
__device__ __forceinline__ void ldf8(const float* p, float (&v)[8]) { const f32x4 a = *(const f32x4*)p, b = *(const f32x4*)(p + 4); v[0] = a.x; v[1] = a.y; v[2] = a.z; v[3] = a.w; v[4] = b.x; v[5] = b.y; v[6] = b.z; v[7] = b.w; }
constexpr int TS = 9216;
template <int KS, bool SW1, bool SW2>
__device__ __forceinline__ f32x16 mm_tile(const LAS bf16* t1, int r1, const LAS bf16* t2, int r2, f32x16 acc, int lane) {
    const int row1 = r1 + (lane & 31), row2 = r2 + (lane & 31), hb = lane >> 5;
    const LAS bf16* p1 = t1 + row1 * 72; const LAS bf16* p2 = t2 + row2 * 72; const int s1 = SW1 ? (row1 >> 3) : 0, s2 = SW2 ? (row2 >> 3) : 0;
#pragma unroll
    for (int ks = 0; ks < KS; ++ks) { const int cb = 2 * ks + hb;
        acc = __builtin_amdgcn_mfma_f32_32x32x16_bf16(*(const LAS bf16x8*)(p1 + ((cb + s1) & 7) * 8), *(const LAS bf16x8*)(p2 + ((cb + s2) & 7) * 8), acc, 0, 0, 0); }
    return acc;
}
__device__ __forceinline__ f32x16 zero16() { f32x16 a;
#pragma unroll
    for (int e = 0; e < 16; ++e) a[e] = 0.f;
    return a; }

__device__ __forceinline__ void phase_chunkpre(const Ctx& C0, int l, int c) {
    const Ctx C = launder(C0);
    LAS unsigned char* L = C.lds;
    LAS bf16* sA = (LAS bf16*)(L + 0 * TS);  LAS bf16* sR = (LAS bf16*)(L + 1 * TS);  LAS bf16* sB = (LAS bf16*)(L + 2 * TS);  LAS bf16* sK = (LAS bf16*)(L + 3 * TS);
    LAS bf16* sBhT = (LAS bf16*)(L + 4 * TS); LAS bf16* sKhT = (LAS bf16*)(L + 5 * TS); LAS bf16* sVT = (LAS bf16*)(L + 6 * TS); LAS bf16* sAT = (LAS bf16*)(L + 7 * TS);
    LAS bf16* sUT = (LAS bf16*)(L + 8 * TS); LAS bf16* sAab = (LAS bf16*)(L + 9 * TS);
    LAS bf16* sPT = (LAS bf16*)(L + 0 * TS);
    LAS bf16* sAak = (LAS bf16*)(L + 10 * TS); LAS bf16* sArb = (LAS bf16*)(L + 11 * TS); LAS bf16* sArk = (LAS bf16*)(L + 12 * TS);
    LAS float* TOT = (LAS float*)(L + 13 * TS);
    LAS bf16* TBB = (LAS bf16*)(L + 13 * TS + 2048);
    LAS float* WC = (LAS float*)(L + 13 * TS + 2048 + 4352);
    LAS float* PAR = (LAS float*)(L + 13 * TS + 2048 + 4352 + 256);
    LAS bf16* sZT = sB;
    const int tid = C.tid, w = C.wave;
    const bf16* ZAg = (const bf16*)(C.ws + WS_R2 + R2_ZA); const bf16* WPg = (const bf16*)(C.ws + WS_R4 + R4_WPRE); const bf16* APg = (const bf16*)(C.ws + WS_R4 + R4_APRE); const bf16* VRg = (const bf16*)(C.ws + WS_R4 + R4_VPRE);
    bf16* VFg = (bf16*)(C.ws + WS_VFIRST) + (size_t)c * M * D; bf16* VPg = (bf16*)(C.ws + WS_VP); float* BNg = (float*)(C.ws + WS_BONUS);
    bf16* YLg = (bf16*)(C.ws + WS_R1 + R1_YLOC); bf16* Qg = (bf16*)(C.ws + WS_R1 + R1_Q); bf16* MTg = (bf16*)(C.ws + WS_R1 + R1_MT); bf16* NCg = (bf16*)(C.ws + WS_R1 + R1_NC);
    const float* mu = C.inp(I_MU_A) + (size_t)l * A_COLS;
    u32x4 qr, qk, qv, qrp, qkp, qvp, qw, qa, qvr, qvf;
#define CP_ISSUE(u_) do { const int bh_ = (u_) / NCHK, ck_ = (u_) % NCHK; const size_t row_ = (size_t)(bh_ >> 4) * T + ck_ * CHK + (tid >> 3); const int chn_ = (bh_ & 15) * 64 + (tid & 7) * 8; \
        const bf16* z_ = ZAg + row_ * A_COLS + chn_; const bool hp_ = (ck_ * CHK + (tid >> 3)) > 0; const u32x4 zero_ = (u32x4){0u, 0u, 0u, 0u}; \
        qr = *(const u32x4*)z_; qk = *(const u32x4*)(z_ + 1024); qv = *(const u32x4*)(z_ + 2048); \
        qrp = hp_ ? *(const u32x4*)(z_ - A_COLS) : zero_; qkp = hp_ ? *(const u32x4*)(z_ - A_COLS + 1024) : zero_; qvp = hp_ ? *(const u32x4*)(z_ - A_COLS + 2048) : zero_; \
        qw = *(const u32x4*)(WPg + row_ * D + chn_); qa = *(const u32x4*)(APg + row_ * D + chn_); \
        if (l == 1) { qvr = *(const u32x4*)(VRg + row_ * D + chn_); qvf = *(const u32x4*)(VFg + row_ * D + chn_); } } while (0)
#define CP_UNPK(v_, q_) do { v_[0] = bflo(q_.x); v_[1] = bfhi(q_.x); v_[2] = bflo(q_.y); v_[3] = bfhi(q_.y); v_[4] = bflo(q_.z); v_[5] = bfhi(q_.z); v_[6] = bflo(q_.w); v_[7] = bfhi(q_.w); } while (0)
    qvr = qvf = (u32x4){0u, 0u, 0u, 0u};
    const int UPB = (32 * NCHK + C.G - 1) / C.G; const int u_lo = C.bid * UPB, u_hi = (u_lo + UPB < 32 * NCHK) ? u_lo + UPB : 32 * NCHK;
    if (u_lo < u_hi) CP_ISSUE(u_lo);
    int par_bh = -1;
#pragma unroll 1
    for (int unit = u_lo; unit < u_hi; ++unit) {
        const int bh = unit / NCHK, ck = unit % NCHK, bl = bh >> 4, h = bh & 15; const size_t row0 = (size_t)bl * T + ck * CHK;
        int lane = C.lane; asm volatile("" : "+v"(lane));
        if (bh != par_bh) { par_bh = bh; __syncthreads();
            for (int i = tid; i < 9 * 64; i += 512) { const int k9 = i >> 6, jj = i & 63, chn = h * 64 + jj; float v;
                if (k9 < 3) v = mu[k9 * 1024 + chn]; else if (k9 == 3) v = C.inp(I_W_DECAY0)[(size_t)l * D + chn]; else if (k9 == 4) v = C.inp(I_A0)[(size_t)l * D + chn];
                else if (k9 == 5) v = C.inp(I_K_K)[(size_t)l * D + chn]; else if (k9 == 6) v = C.inp(I_K_A)[(size_t)l * D + chn]; else if (k9 == 7) v = C.inp(I_R_K)[(size_t)l * D + chn];
                else v = (l == 1) ? C.inp(I_VRES_B)[chn] : 0.f;
                PAR[i] = v; }
            __syncthreads(); }
        { const int t = tid >> 3, o = tid & 7, j0 = o * 8; const int ch = h * 64 + j0; const size_t row = row0 + t;
          float lw[8], av[8], bv[8], kv[8], rv[8], vv[8], Lc[8];
          { float tmp[8], p[8], kk[8], aa[8];
            CP_UNPK(rv, qr); CP_UNPK(tmp, qrp); ldl8(PAR + 0 * 64 + j0, p);
#pragma unroll
            for (int e = 0; e < 8; ++e) rv[e] = rv[e] + (tmp[e] - rv[e]) * p[e];
            CP_UNPK(kv, qk); CP_UNPK(tmp, qkp); ldl8(PAR + 1 * 64 + j0, p);
#pragma unroll
            for (int e = 0; e < 8; ++e) kv[e] = kv[e] + (tmp[e] - kv[e]) * p[e];
            CP_UNPK(vv, qv); CP_UNPK(tmp, qvp); ldl8(PAR + 2 * 64 + j0, p);
#pragma unroll
            for (int e = 0; e < 8; ++e) vv[e] = vv[e] + (tmp[e] - vv[e]) * p[e];
            if (l == 0) { *(u32x4*)(VFg + row * D + ch) = (u32x4){cvt_pk_bf16(vv[0], vv[1]), cvt_pk_bf16(vv[2], vv[3]), cvt_pk_bf16(vv[4], vv[5]), cvt_pk_bf16(vv[6], vv[7])}; }
            else { float vf[8], vb[8]; CP_UNPK(vf, qvf); CP_UNPK(tmp, qvr); ldl8(PAR + 8 * 64 + j0, vb);
#pragma unroll
                for (int e = 0; e < 8; ++e) vv[e] = vv[e] + (vf[e] - vv[e]) * sigmoidf_(vb[e] + tmp[e]); }
            const u32x4 vpk = (u32x4){cvt_pk_bf16(vv[0], vv[1]), cvt_pk_bf16(vv[2], vv[3]), cvt_pk_bf16(vv[4], vv[5]), cvt_pk_bf16(vv[6], vv[7])};
            *(u32x4*)(VPg + row * D + ch) = vpk; CP_UNPK(vv, vpk);
            CP_UNPK(tmp, qw); ldl8(PAR + 3 * 64 + j0, p);
#pragma unroll
            for (int e = 0; e < 8; ++e) { const float x = -(p[e] + tmp[e]); const float sp = fmaxf(x, 0.f) + __logf(1.f + __expf(-fabsf(x))); lw[e] = -__expf(-sp - 0.5f); }
            CP_UNPK(tmp, qa); ldl8(PAR + 4 * 64 + j0, p);
#pragma unroll
            for (int e = 0; e < 8; ++e) aa[e] = sigmoidf_(p[e] + tmp[e]);
            ldl8(PAR + 5 * 64 + j0, p); float ss = 0.f;
#pragma unroll
            for (int e = 0; e < 8; ++e) { kk[e] = kv[e] * p[e]; ss += kk[e] * kk[e]; }
            ss += __shfl_xor(ss, 1); ss += __shfl_xor(ss, 2); ss += __shfl_xor(ss, 4);
            const float kn = 1.0f / fmaxf(sqrtf(ss), 1e-12f);
            ldl8(PAR + 6 * 64 + j0, p); ldl8(PAR + 7 * 64 + j0, tmp); float bs = 0.f;
#pragma unroll
            for (int e = 0; e < 8; ++e) { kk[e] *= kn; kv[e] = kv[e] * (1.f + (aa[e] - 1.f) * p[e]); bs += rv[e] * kv[e] * tmp[e]; av[e] = -kk[e]; bv[e] = kk[e] * aa[e]; }
            bs += __shfl_xor(bs, 1); bs += __shfl_xor(bs, 2); bs += __shfl_xor(bs, 4);
            if (o == 0) BNg[row * 16 + h] = bs;
          }
#pragma unroll
          for (int e = 0; e < 8; ++e) { float x = lw[e]; float y;
              y = __shfl_up(x, 8); if (lane >= 8) x += y; y = __shfl_up(x, 16); if (lane >= 16) x += y; y = __shfl_up(x, 32); if (lane >= 32) x += y; Lc[e] = x; }
          if (lane >= 56) {
#pragma unroll
              for (int e = 0; e < 8; ++e) TOT[w * 64 + j0 + e] = Lc[e]; }
          __syncthreads();
          float LC[8];
#pragma unroll
          for (int e = 0; e < 8; ++e) { float off = 0.f, tot = 0.f;
#pragma unroll
              for (int q = 0; q < 8; ++q) { const float x = TOT[q * 64 + j0 + e]; tot += x; off += (q < w) ? x : 0.f; }
              Lc[e] += off; LC[e] = tot; }
          float ta[8], tr[8], tb[8], tk[8], hb[8], hk[8];
#pragma unroll
          for (int e = 0; e < 8; ++e) { const float eL = __expf(Lc[e]), emL = __expf(-Lc[e]), eLm = __expf(Lc[e] - lw[e]), eh = __expf(LC[e] - Lc[e]);
              ta[e] = av[e] * eLm; tr[e] = rv[e] * eL; tb[e] = bv[e] * emL; tk[e] = kv[e] * emL; hb[e] = bv[e] * eh; hk[e] = kv[e] * eh; }
          *(LAS u32x4*)(sA + t * 72 + j0) = (u32x4){cvt_pk_bf16(ta[0], ta[1]), cvt_pk_bf16(ta[2], ta[3]), cvt_pk_bf16(ta[4], ta[5]), cvt_pk_bf16(ta[6], ta[7])};
          *(LAS u32x4*)(sR + t * 72 + j0) = (u32x4){cvt_pk_bf16(tr[0], tr[1]), cvt_pk_bf16(tr[2], tr[3]), cvt_pk_bf16(tr[4], tr[5]), cvt_pk_bf16(tr[6], tr[7])};
          *(LAS u32x4*)(sB + t * 72 + j0) = (u32x4){cvt_pk_bf16(tb[0], tb[1]), cvt_pk_bf16(tb[2], tb[3]), cvt_pk_bf16(tb[4], tb[5]), cvt_pk_bf16(tb[6], tb[7])};
          *(LAS u32x4*)(sK + t * 72 + j0) = (u32x4){cvt_pk_bf16(tk[0], tk[1]), cvt_pk_bf16(tk[2], tk[3]), cvt_pk_bf16(tk[4], tk[5]), cvt_pk_bf16(tk[6], tk[7])};
#pragma unroll
          for (int e = 0; e < 8; ++e) { const int ad = (j0 + e) * 72 + ((((t >> 3) + o) & 7) << 3) + (t & 7); sAT[ad] = (bf16)f2bf(ta[e]); sBhT[ad] = (bf16)f2bf(hb[e]); sKhT[ad] = (bf16)f2bf(hk[e]); sVT[ad] = (bf16)f2bf(vv[e]); }
          if (t == 0) {
#pragma unroll
              for (int e = 0; e < 8; ++e) WC[j0 + e] = __expf(LC[e]); }
          asm volatile("" ::: "memory");
          if (unit + 1 < u_hi) CP_ISSUE(unit + 1);
        }
        __syncthreads();
        { const int mq = w >> 1, tt = w & 1; const LAS bf16* o1b = (mq & 1) ? sK : sB; const LAS bf16* o2b = (mq & 2) ? sR : sA; const bool incl = (mq & 2) != 0;
          LAS bf16* dst = (mq == 0) ? sAab : ((mq == 1) ? sAak : (mq == 2 ? sArb : sArk));
#pragma unroll
          for (int mt = 0; mt < 2; ++mt) { f32x16 acc = zero16();
              if (mt <= tt) acc = mm_tile<4, false, false>(o1b, mt * 32, o2b, tt * 32, acc, lane);
              const int tg = tt * 32 + (lane & 31);
#pragma unroll
              for (int rq = 0; rq < 4; ++rq) { const int tau0 = mt * 32 + 8 * rq + 4 * (lane >> 5); float v4[4];
#pragma unroll
                  for (int e = 0; e < 4; ++e) { const int tau = tau0 + e; const bool keep = incl ? (tau <= tg) : (tau < tg); v4[e] = keep ? acc[4 * rq + e] : 0.f; }
                  *(LAS u32x2*)(dst + tg * 72 + tau0) = (u32x2){cvt_pk_bf16(v4[0], v4[1]), cvt_pk_bf16(v4[2], v4[3])}; } } }
        __syncthreads();
        if (w < 4) { if (lane < 16) { const int b0 = 16 * w; float tc[16];
#pragma unroll
            for (int r = 0; r < 16; ++r) tc[r] = (r == lane) ? 1.f : 0.f;
#pragma unroll
            for (int q = 0; q < 15; ++q) { const float tq = tc[q];
#pragma unroll
                for (int r = q + 1; r < 16; ++r) tc[r] += bf2f(sAab[(b0 + r) * 72 + b0 + q]) * tq; }
#pragma unroll
            for (int r = 0; r < 16; ++r) TBB[(w * 16 + r) * 16 + lane] = (bf16)f2bf(tc[r]); } }
        else { const int tt = w & 1, itl = (w >> 1) & 1; f32x16 acc = zero16();
            acc = mm_tile<4, false, true>(sAak, tt * 32, sVT, itl * 32, acc, lane);
            const int i = itl * 32 + (lane & 31);
#pragma unroll
            for (int rq = 0; rq < 4; ++rq) { const int t0 = tt * 32 + 8 * rq + 4 * (lane >> 5);
                *(LAS u32x2*)(sZT + i * 72 + t0) = (u32x2){cvt_pk_bf16(acc[4 * rq], acc[4 * rq + 1]), cvt_pk_bf16(acc[4 * rq + 2], acc[4 * rq + 3])}; } }
        __syncthreads();
        { const int fr = lane & 15, fq = lane >> 4; LAS bf16* xt = ((w < 4) ? sUT : sPT) + ((w & 3) * 16) * 72;
          const int zr = (w & 3) * 16 + fr;
          { u32 zz_ = 0u; asm volatile("" : "+v"(zz_)); const u32x4 z4 = (u32x4){zz_, zz_, zz_, zz_};
            *(LAS u32x4*)(xt + (lane >> 2) * 72 + (lane & 3) * 16) = z4; *(LAS u32x4*)(xt + (lane >> 2) * 72 + (lane & 3) * 16 + 8) = z4; }
          LDS_WAIT();
#pragma unroll
          for (int b = 0; b < 4; ++b) { const int t0 = 16 * b + 4 * fq;
              u32x2 zq;
              if (w < 4) zq = *(const LAS u32x2*)(sZT + zr * 72 + t0); else zq = *(const LAS u32x2*)(sAT + zr * 72 + ((((t0 >> 3) + (zr >> 3)) & 7) << 3) + (t0 & 7));
              f32x4 acc = (f32x4){bflo(zq.x), bfhi(zq.x), bflo(zq.y), bfhi(zq.y)};
              if (b > 0) {
#pragma unroll
                  for (int ks = 0; ks < (b + 1) / 2; ++ks) { const bf16x8 oa = *(const LAS bf16x8*)(sAab + (16 * b + fr) * 72 + 32 * ks + 8 * fq), ox = *(const LAS bf16x8*)(xt + fr * 72 + 32 * ks + 8 * fq);
                      acc = __builtin_amdgcn_mfma_f32_16x16x32_bf16(oa, ox, acc, 0, 0, 0); } }
              const u32x2 tq = *(const LAS u32x2*)(TBB + (b * 16 + fr) * 16 + 4 * fq);
              const bf16x8 ot = __builtin_bit_cast(bf16x8, (u32x4){tq.x, tq.y, 0u, 0u}), ow = __builtin_bit_cast(bf16x8, (u32x4){cvt_pk_bf16(acc[0], acc[1]), cvt_pk_bf16(acc[2], acc[3]), 0u, 0u});
              const f32x4 xb = __builtin_amdgcn_mfma_f32_16x16x32_bf16(ot, ow, (f32x4){0.f, 0.f, 0.f, 0.f}, 0, 0, 0);
              *(LAS u32x2*)(xt + fr * 72 + t0) = (u32x2){cvt_pk_bf16(xb[0], xb[1]), cvt_pk_bf16(xb[2], xb[3])};
              LDS_WAIT(); asm volatile("" ::: "memory"); } }
        __syncthreads();
        { const int mt = (w >> 1) & 1, nt = w & 1, ln = lane & 31, lh = lane >> 5;
          if (w < 4) {
              { f32x16 acc = zero16();
                acc = mm_tile<4, false, false>(sUT, mt * 32, sArb, nt * 32, acc, lane); acc = mm_tile<4, true, false>(sVT, mt * 32, sArk, nt * 32, acc, lane);
                bf16* yr = YLg + (row0 + nt * 32 + ln) * D + h * 64 + mt * 32;
#pragma unroll
                for (int rq = 0; rq < 4; ++rq) *(u32x2*)(yr + 8 * rq + 4 * lh) = (u32x2){cvt_pk_bf16(acc[4 * rq], acc[4 * rq + 1]), cvt_pk_bf16(acc[4 * rq + 2], acc[4 * rq + 3])}; }
              { f32x16 acc = zero16();
                acc = mm_tile<4, false, false>(sPT, mt * 32, sArb, nt * 32, acc, lane);
                const int tl = nt * 32 + ln; bf16* qr_ = Qg + (row0 + tl) * D + h * 64 + mt * 32;
#pragma unroll
                for (int rq = 0; rq < 4; ++rq) { const int m0 = mt * 32 + 8 * rq + 4 * lh; const u32x2 rr = *(const LAS u32x2*)(sR + tl * 72 + m0);
                    *(u32x2*)(qr_ + 8 * rq + 4 * lh) = (u32x2){cvt_pk_bf16(acc[4 * rq] + bflo(rr.x), acc[4 * rq + 1] + bfhi(rr.x)), cvt_pk_bf16(acc[4 * rq + 2] + bflo(rr.y), acc[4 * rq + 3] + bfhi(rr.y))}; } }
          } else {
              { f32x16 acc = zero16();
                acc = mm_tile<4, true, false>(sBhT, mt * 32, sUT, nt * 32, acc, lane); acc = mm_tile<4, true, true>(sKhT, mt * 32, sVT, nt * 32, acc, lane);
                const int i_ = nt * 32 + ln;
#pragma unroll
                for (int rq = 0; rq < 4; ++rq) { const int j0_ = mt * 32 + 8 * rq + 4 * lh;
                    bf16* np = NCg + ((((size_t)unit * 4 + (i_ >> 4)) * 64 + (i_ & 15) + 16 * ((j0_ & 15) >> 2)) * 4 + (j0_ >> 4)) * 4;
                    *(u32x2*)np = (u32x2){cvt_pk_bf16(acc[4 * rq], acc[4 * rq + 1]), cvt_pk_bf16(acc[4 * rq + 2], acc[4 * rq + 3])}; } }
              { f32x16 acc = zero16();
                acc = mm_tile<4, false, true>(sPT, mt * 32, sBhT, nt * 32, acc, lane);
                const int j = nt * 32 + ln; const float wc = WC[j];
#pragma unroll
                for (int rq = 0; rq < 4; ++rq) { const int m0 = mt * 32 + 8 * rq + 4 * lh; float v4[4];
#pragma unroll
                    for (int e = 0; e < 4; ++e) v4[e] = acc[4 * rq + e] + ((m0 + e == j) ? wc : 0.f);
                    bf16* mp = MTg + ((((size_t)unit * 8 + 2 * (j >> 4) + (m0 >> 5)) * 64 + (j & 15) + 16 * ((m0 & 15) >> 2)) * 2 + ((m0 >> 4) & 1)) * 4;
                    *(u32x2*)mp = (u32x2){cvt_pk_bf16(v4[0], v4[1]), cvt_pk_bf16(v4[2], v4[3])}; } }
          } }
        __syncthreads();
    }
}

struct CarryBuf { u32x4 m[8]; u32x4 n[2]; };
__device__ __forceinline__ void carry_load(CarryBuf& B, const bf16* MTg, const bf16* NCg, size_t unit, int slab, int lane) {
    const bf16* mb = MTg + unit * 4096; const bf16* nb = NCg + (unit * 4 + slab) * 1024; const unsigned vm = (unsigned)lane * 16u, vm2 = vm + 4096u, vn = (unsigned)lane * 32u;
    asm volatile("global_load_dwordx4 %0, %1, %2" : "=v"(B.m[0]) : "v"(vm), "s"(mb) : "memory");
    asm volatile("global_load_dwordx4 %0, %1, %2 offset:1024" : "=v"(B.m[1]) : "v"(vm), "s"(mb) : "memory");
    asm volatile("global_load_dwordx4 %0, %1, %2 offset:2048" : "=v"(B.m[2]) : "v"(vm), "s"(mb) : "memory");
    asm volatile("global_load_dwordx4 %0, %1, %2 offset:3072" : "=v"(B.m[3]) : "v"(vm), "s"(mb) : "memory");
    asm volatile("global_load_dwordx4 %0, %1, %2" : "=v"(B.m[4]) : "v"(vm2), "s"(mb) : "memory");
    asm volatile("global_load_dwordx4 %0, %1, %2 offset:1024" : "=v"(B.m[5]) : "v"(vm2), "s"(mb) : "memory");
    asm volatile("global_load_dwordx4 %0, %1, %2 offset:2048" : "=v"(B.m[6]) : "v"(vm2), "s"(mb) : "memory");
    asm volatile("global_load_dwordx4 %0, %1, %2 offset:3072" : "=v"(B.m[7]) : "v"(vm2), "s"(mb) : "memory");
    asm volatile("global_load_dwordx4 %0, %1, %2" : "=v"(B.n[0]) : "v"(vn), "s"(nb) : "memory");
    asm volatile("global_load_dwordx4 %0, %1, %2 offset:16" : "=v"(B.n[1]) : "v"(vn), "s"(nb) : "memory");
}
#define CARRY_WAIT(B, N) asm volatile("s_waitcnt vmcnt(" #N ")" : "+v"(B.m[0]), "+v"(B.m[1]), "+v"(B.m[2]), "+v"(B.m[3]), "+v"(B.m[4]), "+v"(B.m[5]), "+v"(B.m[6]), "+v"(B.m[7]), "+v"(B.n[0]), "+v"(B.n[1]) :: "memory")
__device__ __forceinline__ void carry_step(f32x4 (&acc)[4], const CarryBuf& B, bf16* sp) {
    u32 pk[4][2];
#pragma unroll
    for (int jt = 0; jt < 4; ++jt) { pk[jt][0] = cvt_pk_bf16(acc[jt][0], acc[jt][1]); pk[jt][1] = cvt_pk_bf16(acc[jt][2], acc[jt][3]); }
#pragma unroll
    for (int jt = 0; jt < 4; ++jt) *(GAS u32x2*)(sp + jt * 16) = (u32x2){pk[jt][0], pk[jt][1]};
    const bf16x8 sb0 = __builtin_bit_cast(bf16x8, (u32x4){pk[0][0], pk[0][1], pk[1][0], pk[1][1]}), sb1 = __builtin_bit_cast(bf16x8, (u32x4){pk[2][0], pk[2][1], pk[3][0], pk[3][1]});
    const u32 nw[8] = {B.n[0].x, B.n[0].y, B.n[0].z, B.n[0].w, B.n[1].x, B.n[1].y, B.n[1].z, B.n[1].w};
#pragma unroll
    for (int jt = 0; jt < 4; ++jt) { f32x4 a = (f32x4){bflo(nw[2 * jt]), bfhi(nw[2 * jt]), bflo(nw[2 * jt + 1]), bfhi(nw[2 * jt + 1])};
        a = __builtin_amdgcn_mfma_f32_16x16x32_bf16(__builtin_bit_cast(bf16x8, B.m[2 * jt]), sb0, a, 0, 0, 0);
        a = __builtin_amdgcn_mfma_f32_16x16x32_bf16(__builtin_bit_cast(bf16x8, B.m[2 * jt + 1]), sb1, a, 0, 0, 0);
        acc[jt] = a; }
}
__device__ __forceinline__ void phase_carry2(const Ctx& C0) {
    const Ctx C = launder(C0);
    const bf16* MTg = (const bf16*)(C.ws + WS_R1 + R1_MT); const bf16* NCg = (const bf16*)(C.ws + WS_R1 + R1_NC); bf16* sst = (bf16*)(C.ws + WS_R1 + R1_SST);
    const int lane = C.lane, fr = lane & 15, fq = lane >> 4;
    if (C.wave != 0) return;
    for (int task = C.bid; task < 128; task += C.G) { const int bh = task >> 2, slab = task & 3; const size_t u0 = (size_t)bh * NCHK;
        f32x4 acc[4]; acc[0] = acc[1] = acc[2] = acc[3] = (f32x4){0.f, 0.f, 0.f, 0.f};
        CarryBuf B0, B1, B2, B3;
        asm volatile("s_waitcnt vmcnt(0)" ::: "memory");
        carry_load(B0, MTg, NCg, u0, slab, lane); carry_load(B1, MTg, NCg, u0 + 1, slab, lane); carry_load(B2, MTg, NCg, u0 + 2, slab, lane); carry_load(B3, MTg, NCg, u0 + 3, slab, lane);
        bf16* sp = sst + (u0 * 64 + slab * 16 + fr) * 64 + 4 * fq;
        CARRY_WAIT(B0, 30); carry_step(acc, B0, sp + (size_t)0 * 4096); carry_load(B0, MTg, NCg, u0 + 4, slab, lane);
        CARRY_WAIT(B1, 34); carry_step(acc, B1, sp + (size_t)1 * 4096); carry_load(B1, MTg, NCg, u0 + 5, slab, lane);
        CARRY_WAIT(B2, 38); carry_step(acc, B2, sp + (size_t)2 * 4096); carry_load(B2, MTg, NCg, u0 + 6, slab, lane);
        CARRY_WAIT(B3, 42); carry_step(acc, B3, sp + (size_t)3 * 4096); carry_load(B3, MTg, NCg, u0 + 7, slab, lane);
#pragma unroll 1
        for (int c = 4; c < NCHK; c += 4) {
            const size_t un = u0 + ((c + 4 < NCHK) ? c + 4 : c);
            CARRY_WAIT(B0, 42); carry_step(acc, B0, sp + (size_t)(c + 0) * 4096); carry_load(B0, MTg, NCg, un + 0, slab, lane);
            CARRY_WAIT(B1, 42); carry_step(acc, B1, sp + (size_t)(c + 1) * 4096); carry_load(B1, MTg, NCg, un + 1, slab, lane);
            CARRY_WAIT(B2, 42); carry_step(acc, B2, sp + (size_t)(c + 2) * 4096); carry_load(B2, MTg, NCg, un + 2, slab, lane);
            CARRY_WAIT(B3, 42); carry_step(acc, B3, sp + (size_t)(c + 3) * 4096); carry_load(B3, MTg, NCg, un + 3, slab, lane);
        }
        asm volatile("s_waitcnt vmcnt(0)" ::: "memory");
    }
}

__device__ __forceinline__ void phase_post2(const Ctx& C0, int l) {
    const Ctx C = launder(C0);
    const bf16* yl = (const bf16*)(C.ws + WS_R1 + R1_YLOC); const bf16* zz = (const bf16*)(C.ws + WS_R1 + R1_Q); const bf16* sst = (const bf16*)(C.ws + WS_R1 + R1_SST);
    const bf16* vp = (const bf16*)(C.ws + WS_VP); const bf16* gg = (const bf16*)(C.ws + WS_R4 + R4_G); const float* bonus = (const float*)(C.ws + WS_BONUS); bf16* ya = (bf16*)(C.ws + WS_HN);
    LAS float* LWs = (LAS float*)C.lds; LAS float* LBs = LWs + 1024;
    for (int i = C.tid; i < 1024; i += 512) { LWs[i] = C.inp(I_LNX_W)[(size_t)l * D + i]; LBs[i] = C.inp(I_LNX_B)[(size_t)l * D + i]; }
    __syncthreads();
    const int lane = C.lane, lr = lane & 31, lh = lane >> 5;
    for (int task = C.gw; task < 8192; task += C.ngw) { const int unit = task >> 1, sub = task & 1; const int bh = unit / NCHK, ck = unit % NCHK, bl = bh >> 4, h = bh & 15;
        const size_t ml = (size_t)bl * T + ck * CHK + sub * 32 + lr;
        const bf16* srow = sst + (size_t)unit * 4096; const bf16* zrow = zz + ml * D + h * 64; const bf16* ylr = yl + ml * D + h * 64;
        bf16x8 ob[4], oa0[4], oa1[4]; u32x2 yq[8], vq[8], gq[8];
#pragma unroll
        for (int ks = 0; ks < 4; ++ks) { const int m0 = ks * 16 + lh * 8; ob[ks] = *(const bf16x8*)(zrow + m0); oa0[ks] = *(const bf16x8*)(srow + (size_t)lr * 64 + m0); oa1[ks] = *(const bf16x8*)(srow + (size_t)(32 + lr) * 64 + m0); }
#pragma unroll
        for (int q = 0; q < 8; ++q) { const int i0 = (q >> 2) * 32 + 8 * (q & 3) + 4 * lh; yq[q] = *(const u32x2*)(ylr + i0); vq[q] = *(const u32x2*)(vp + ml * D + h * 64 + i0); gq[q] = *(const u32x2*)(gg + ml * D + h * 64 + i0); }
        const float bn = bonus[ml * 16 + h];
        f32x16 d0 = zero16(), d1 = zero16();
#pragma unroll
        for (int ks = 0; ks < 4; ++ks) { d0 = __builtin_amdgcn_mfma_f32_32x32x16_bf16(oa0[ks], ob[ks], d0, 0, 0, 0); d1 = __builtin_amdgcn_mfma_f32_32x32x16_bf16(oa1[ks], ob[ks], d1, 0, 0, 0); }
        float y[32]; float s = 0.f;
#pragma unroll
        for (int itl = 0; itl < 2; ++itl)
#pragma unroll
            for (int rq = 0; rq < 4; ++rq) { const u32x2 q = yq[itl * 4 + rq];
                const float dd0 = itl ? d1[4 * rq] : d0[4 * rq], dd1 = itl ? d1[4 * rq + 1] : d0[4 * rq + 1], dd2 = itl ? d1[4 * rq + 2] : d0[4 * rq + 2], dd3 = itl ? d1[4 * rq + 3] : d0[4 * rq + 3];
                float* yy = y + itl * 16 + rq * 4; yy[0] = bflo(q.x) + dd0; yy[1] = bfhi(q.x) + dd1; yy[2] = bflo(q.y) + dd2; yy[3] = bfhi(q.y) + dd3; s += (yy[0] + yy[1]) + (yy[2] + yy[3]); }
        s += __shfl_xor(s, 32); const float mean = s * (1.f / 64.f); float s2 = 0.f;
#pragma unroll
        for (int e = 0; e < 32; ++e) { const float dlt = y[e] - mean; s2 += dlt * dlt; }
        s2 += __shfl_xor(s2, 32); const float rstd = __builtin_amdgcn_rsqf(s2 * (1.f / 64.f) + 64e-5f);
#pragma unroll
        for (int itl = 0; itl < 2; ++itl)
#pragma unroll
            for (int rq = 0; rq < 4; ++rq) { const int i0 = itl * 32 + 8 * rq + 4 * lh; const int cc = h * 64 + i0; const float* yy = y + itl * 16 + rq * 4;
                const f32x4 w4 = *(const LAS f32x4*)(LWs + cc), b4 = *(const LAS f32x4*)(LBs + cc); const u32x2 vv = vq[itl * 4 + rq], gv = gq[itl * 4 + rq];
                const float o0 = ((yy[0] - mean) * rstd * w4.x + b4.x + bn * bflo(vv.x)) * bflo(gv.x), o1 = ((yy[1] - mean) * rstd * w4.y + b4.y + bn * bfhi(vv.x)) * bfhi(gv.x);
                const float o2 = ((yy[2] - mean) * rstd * w4.z + b4.z + bn * bflo(vv.y)) * bflo(gv.y), o3 = ((yy[3] - mean) * rstd * w4.w + b4.w + bn * bfhi(vv.y)) * bfhi(gv.y);
                *(u32x2*)(ya + ml * D + cc) = (u32x2){cvt_pk_bf16(o0, o1), cvt_pk_bf16(o2, o3)}; }
    }
}

__device__ __forceinline__ void phase_route(const Ctx& C0, int it) {
    const Ctx C = launder(C0);
    const int l = it / NCH, c = it % NCH; const float* xs = C.out + (size_t)c * M * D; const float* g = C.inp(I_NORM_FFN) + (size_t)l * D; bf16* hn = (bf16*)(C.ws + WS_HN);
    const float* rgb = C.inp(I_RGRP_B) + (size_t)l * 4; const float* reb = C.inp(I_REXP_B) + (size_t)l * 32;
    unsigned* cnt = (unsigned*)(C.ws + WS_CTL) + CW_CNT + it * 64; int* tok = (int*)(C.ws + WS_TOK); float* wt = (float*)(C.ws + WS_TOK + 512 * 1024);
    const bf16* wrh = (const bf16*)(C.ws + WS_WSC + 512 * 1024); const bf16* wrl = (const bf16*)(C.ws + WS_WSC + 640 * 1024);
    const int lane = C.lane, fr = lane & 15, fq = lane >> 4;
    for (int rep15 = 0; rep15 < 1 + ((DUP_MASK >> 15) & 1); ++rep15)
    norm2_rows_i8(xs, g, (unsigned char*)hn, (float*)(C.ws + WS_HN + HNX_RS), C.gw, C.ngw, lane);
    LAS float* LG = (LAS float*)(C.lds + C.wave * 4096);
    LAS float* PX = (LAS float*)(C.lds + 32768) + (C.wave >> 1) * (64 * 13);
    const int half = C.wave & 1;
    for (int tbase = C.bid * 4; tbase < M / 16; tbase += C.G * 4) { const int task = tbase + (C.wave >> 1); const int ml = task * 16 + fr; const float* xr = xs + (size_t)ml * D + fq * 8;
        f32x4 acc[3]; acc[0] = acc[1] = acc[2] = (f32x4){0.f, 0.f, 0.f, 0.f}; float ss = 0.f;
#pragma unroll 4
        for (int ks = half * 16; ks < half * 16 + 16; ++ks) { const f32x4 xa = *(const f32x4*)(xr + ks * 32), xb = *(const f32x4*)(xr + ks * 32 + 4);
            ss += (xa.x * xa.x + xa.y * xa.y) + (xa.z * xa.z + xa.w * xa.w) + (xb.x * xb.x + xb.y * xb.y) + (xb.z * xb.z + xb.w * xb.w);
            u32x4 hq; hq.x = cvt_pk_bf16(xa.x, xa.y); hq.y = cvt_pk_bf16(xa.z, xa.w); hq.z = cvt_pk_bf16(xb.x, xb.y); hq.w = cvt_pk_bf16(xb.z, xb.w);
            u32x4 lq; lq.x = cvt_pk_bf16(xa.x - bflo(hq.x), xa.y - bfhi(hq.x)); lq.y = cvt_pk_bf16(xa.z - bflo(hq.y), xa.w - bfhi(hq.y));
            lq.z = cvt_pk_bf16(xb.x - bflo(hq.z), xb.y - bfhi(hq.z)); lq.w = cvt_pk_bf16(xb.z - bflo(hq.w), xb.w - bfhi(hq.w));
            const bf16x8 xh = __builtin_bit_cast(bf16x8, hq), xl = __builtin_bit_cast(bf16x8, lq);
#pragma unroll
            for (int nt = 0; nt < 3; ++nt) { const size_t wo = (size_t)(nt * 16 + fr) * D + ks * 32 + fq * 8;
                const bf16x8 wh = *(const bf16x8*)(wrh + wo), wl = *(const bf16x8*)(wrl + wo);
                acc[nt] = __builtin_amdgcn_mfma_f32_16x16x32_bf16(wh, xh, acc[nt], 0, 0, 0);
                acc[nt] = __builtin_amdgcn_mfma_f32_16x16x32_bf16(wl, xh, acc[nt], 0, 0, 0);
                acc[nt] = __builtin_amdgcn_mfma_f32_16x16x32_bf16(wh, xl, acc[nt], 0, 0, 0); } }
        if (half) {
#pragma unroll
            for (int nt = 0; nt < 3; ++nt)
#pragma unroll
                for (int i = 0; i < 4; ++i) PX[lane * 13 + nt * 4 + i] = acc[nt][i];
            PX[lane * 13 + 12] = ss; }
        __syncthreads();
        if (!half) {
#pragma unroll
            for (int nt = 0; nt < 3; ++nt)
#pragma unroll
                for (int i = 0; i < 4; ++i) acc[nt][i] += PX[lane * 13 + nt * 4 + i];
            ss += PX[lane * 13 + 12]; }
        ss += __shfl_xor(ss, 16); ss += __shfl_xor(ss, 32); const float rs = __builtin_amdgcn_rsqf(ss * (1.f / D) + 1e-6f);
#pragma unroll
        for (int nt = 0; nt < 3; ++nt)
#pragma unroll
            for (int i = 0; i < 4; ++i) LG[fr * 48 + nt * 16 + 4 * fq + i] = acc[nt][i] * rs;
        LDS_WAIT(); asm volatile("" ::: "memory");
        if (lane < 16 && !half) { const LAS float* lg = LG + lane * 48;
            float gl[4]; int gs = 0; float gm;
#pragma unroll
            for (int e = 0; e < 4; ++e) gl[e] = lg[e] + rgb[e];
            gm = gl[0];
#pragma unroll
            for (int e = 1; e < 4; ++e) if (gl[e] > gm) { gm = gl[e]; gs = e; }
            float den = 0.f;
#pragma unroll
            for (int e = 0; e < 4; ++e) den += __expf(gl[e] - gm);
            const float pg = 1.f / den;
            float el[8];
#pragma unroll
            for (int e = 0; e < 8; ++e) el[e] = lg[4 + gs * 8 + e] + reb[gs * 8 + e];
            int i1 = 0; float v1 = el[0];
#pragma unroll
            for (int e = 1; e < 8; ++e) if (el[e] > v1) { v1 = el[e]; i1 = e; }
            int i2 = -1; float v2 = -3.0e38f;
#pragma unroll
            for (int e = 0; e < 8; ++e) if (e != i1 && el[e] > v2) { v2 = el[e]; i2 = e; }
            const float ex = __expf(v2 - v1); const float w1 = pg / (1.f + ex), w2 = pg * ex / (1.f + ex);
            const int e1 = gs * 8 + i1, e2 = gs * 8 + i2;
            const unsigned s1 = atomicAdd(cnt + e1, 1u), s2 = atomicAdd(cnt + e2, 1u);
            const int mt = task * 16 + lane;
            tok[4 * mt] = e1; tok[4 * mt + 1] = (int)s1; tok[4 * mt + 2] = e2; tok[4 * mt + 3] = (int)s2; wt[2 * mt] = w1; wt[2 * mt + 1] = w2;
            int* rowmap = (int*)(C.ws + WS_R1 + R1_ROWMAP); rowmap[e1 * 16384 + (int)s1] = mt; rowmap[e2 * 16384 + (int)s2] = mt;
        }
        __syncthreads();
    }
}
__device__ __forceinline__ void moe_table(const Ctx& C, int it, LAS int* tb) {
    __syncthreads();
    int tl_ = C.tid; asm volatile("" : "+v"(tl_));
    if (C.tid < 64) { const unsigned* cnt = (const unsigned*)(C.ws + WS_CTL) + CW_CNT + it * 64;
        const unsigned cv = (C.tid < 32) ? __hip_atomic_load(cnt + tl_, __ATOMIC_RELAXED, __HIP_MEMORY_SCOPE_AGENT) : 0u; const int tiles = (int)((cv + 255u) >> 8); int x = tiles;
#pragma unroll
        for (int o = 1; o < 32; o <<= 1) { const int y = __shfl_up(x, o); if (C.lane >= o) x += y; }
        if (C.tid < 32) { tb[tl_] = x - tiles; tb[40 + tl_] = (int)cv; } if (C.tid == 31) tb[32] = x; }
    __syncthreads();
}
constexpr int NPH = 14;
__global__ void __launch_bounds__(512, 2) mk_fwd(Args args) {
    extern __shared__ __attribute__((aligned(16))) unsigned char lds_raw[];
    Ctx C; C.lds = (LAS unsigned char*)lds_raw; C.ws = args.ws; C.in = args.in; C.out = args.out;
    C.tid = threadIdx.x; C.lane = C.tid & 63; C.wave = __builtin_amdgcn_readfirstlane(C.tid >> 6); C.G = gridDim.x; C.bid = blockIdx.x; C.gw = C.bid * 8 + C.wave; C.ngw = C.G * 8;
    volatile LAS unsigned* MISC = (volatile LAS unsigned*)(C.lds + LDSCTL_OFF);
    LAS int* tb = (LAS int*)(C.lds + LDSCTL_OFF + 256);
    for (int u = C.tid; u < 64; u += 512) MISC[u] = 0u;
    __syncthreads();
    XcdBarrier bar; bar.bar = (unsigned*)(C.ws + WS_CTL) + CW_BAR; bar.x = 0; bar.st = nullptr;
#if MK_ONE_LAUNCH
    bar = xcd_barrier_post((unsigned*)(C.ws + WS_CTL) + CW_BAR, MISC + 8);
#define GRID_BAR() xcd_barrier(bar)
#else
#define GRID_BAR() do {} while (0)
#endif
    const int s_lo = args.s_lo, s_hi = args.s_hi;
    if (s_lo == 0) { phase_wmax(C); GRID_BAR(); }
#pragma unroll 1
    for (int it = 0; it <= NIT; ++it) {
        const int l = it / NCH, c = it % NCH; const int sb = it * NPH;
#define IN(k) (((PH_MASK >> (k)) & 1) && s_lo <= sb + (k) && sb + (k) < s_hi)
        if (IN(0)) for (int rep_ = 0; rep_ < 1 + ((DUP_MASK >> 0) & 1); ++rep_) { unsigned char* ws = C.ws; asm volatile("" : "+s"(ws)); ws = AS_GLOBAL(unsigned char, ws); if (it < NIT && c == 0) phase_convert(C, l, it == 0); phase_prep(C, it, tb); GRID_BAR(); }
        if (it == NIT) break;
        if (IN(1)) for (int rep_ = 0; rep_ < 1 + ((DUP_MASK >> 1) & 1); ++rep_) { unsigned char* ws = C.ws; asm volatile("" : "+s"(ws)); ws = AS_GLOBAL(unsigned char, ws); pg8::Gemm g{(const bf16*)(ws + WS_R1 + R1_HNX), (const bf16*)(ws + WS_WIN), D / 2, D / 2, D / 2, 0, nullptr, nullptr};   pg8::StaticOrder S; S.init(M, DBG_PROJ_N, C.G, C.bid);
            pg8::EpiProj E{(bf16*)(ws + WS_R2 + R2_ZA), (bf16*)(ws + WS_R1 + R1_ZB), (bf16*)(ws + WS_R1 + R1_ZC), (bf16*)(ws + WS_ZG), (bf16*)(ws + WS_VLO), C.inp(I_GATE_B) + (size_t)l * G_COLS, (const float*)(ws + WS_R1 + R1_HNX + HNX_RS), (const unsigned*)(ws + WS_CTL) + CW_WMAX + l * WIN_ROWS};
            pg8::gemm_phase<pg8::EpiProj, pg8::StaticOrder, false, true>(C.lds, g, S, E); GRID_BAR(); }
        if (IN(2)) for (int rep_ = 0; rep_ < 1 + ((DUP_MASK >> 2) & 1); ++rep_) { unsigned char* ws = C.ws; asm volatile("" : "+s"(ws)); ws = AS_GLOBAL(unsigned char, ws); sub_gmlp(C, l); sub_attn(C); sub_lora_prep(C, l); GRID_BAR(); }
        if (IN(3)) for (int rep_ = 0; rep_ < 1 + ((DUP_MASK >> 3) & 1); ++rep_) { unsigned char* ws = C.ws; asm volatile("" : "+s"(ws)); ws = AS_GLOBAL(unsigned char, ws); pg8::Gemm g{(const bf16*)(ws + WS_R1 + R1_ALORA), (const bf16*)(ws + WS_LORAB), LORA_K, LORA_K, (l == 0 ? 256 : LORA_K), 0, nullptr, nullptr};   pg8::StaticOrder S; S.init(M, l == 0 ? 3072 : 4096, C.G, C.bid);
            pg8::EpiLora EL{(bf16*)(ws + WS_R4 + R4_WPRE), (bf16*)(ws + WS_R4 + R4_APRE), (bf16*)(ws + WS_R4 + R4_G), (bf16*)(ws + WS_R4 + R4_VPRE)};
            pg8::gemm_phase(C.lds, g, S, EL); sub_yb_combine(C); GRID_BAR(); }
        if (IN(4)) for (int rep_ = 0; rep_ < 1 + ((DUP_MASK >> 4) & 1); ++rep_) { unsigned char* ws = C.ws; asm volatile("" : "+s"(ws)); ws = AS_GLOBAL(unsigned char, ws); }
        if (IN(5)) for (int rep_ = 0; rep_ < 1 + ((DUP_MASK >> 5) & 1); ++rep_) { unsigned char* ws = C.ws; asm volatile("" : "+s"(ws)); ws = AS_GLOBAL(unsigned char, ws); phase_chunkpre(C, l, c); GRID_BAR(); }
        if (IN(6)) for (int rep_ = 0; rep_ < 1 + ((DUP_MASK >> 6) & 1); ++rep_) { unsigned char* ws = C.ws; asm volatile("" : "+s"(ws)); ws = AS_GLOBAL(unsigned char, ws); phase_carry2(C); GRID_BAR(); }
        if (IN(7)) for (int rep_ = 0; rep_ < 1 + ((DUP_MASK >> 7) & 1); ++rep_) { unsigned char* ws = C.ws; asm volatile("" : "+s"(ws)); ws = AS_GLOBAL(unsigned char, ws); phase_post2(C, l); GRID_BAR(); }
        if (IN(8)) for (int rep_ = 0; rep_ < 1 + ((DUP_MASK >> 8) & 1); ++rep_) { unsigned char* ws = C.ws; asm volatile("" : "+s"(ws)); ws = AS_GLOBAL(unsigned char, ws); pg8::StaticOrder S; S.init(M, D, C.G, C.bid);
            pg8::Gemm ga{(const bf16*)(ws + WS_HN), (const bf16*)(ws + WS_PA), D, D, D, 0, nullptr, nullptr}; pg8::Gemm gb{(const bf16*)(ws + WS_YB), (const bf16*)(ws + WS_PB), 256, 256, 256, 0, nullptr, nullptr};
            pg8::Gemm gc{(const bf16*)(ws + WS_YC), (const bf16*)(ws + WS_PC), D, D, D, 0, nullptr, nullptr};
            pg8::EpiChainGate E{(const unsigned char*)(ws + WS_ZG), (bf16*)(ws + WS_R4 + R4_MERGED)}; pg8::gemm_chain3(C.lds, ga, gb, gc, S, E); GRID_BAR(); }
        if (IN(9)) for (int rep_ = 0; rep_ < 1 + ((DUP_MASK >> 9) & 1); ++rep_) { unsigned char* ws = C.ws; asm volatile("" : "+s"(ws)); ws = AS_GLOBAL(unsigned char, ws);
#ifdef DBG_WOUT_ZG
            pg8::Gemm g{(const bf16*)(ws + WS_ZG), (const bf16*)(ws + WS_WOUT), G_COLS, D, D, 0, nullptr, nullptr};
#else
            pg8::Gemm g{(const bf16*)(ws + WS_R4 + R4_MERGED), (const bf16*)(ws + WS_WOUT), D, D, D, 0, nullptr, nullptr};
#endif
            pg8::StaticOrder S; S.init(M, D, C.G, C.bid);
            pg8::EpiResid E{(l == 0 ? C.inp(I_X) : C.out) + (size_t)c * M * D, C.out + (size_t)c * M * D}; pg8::gemm_phase(C.lds, g, S, E); GRID_BAR(); }
        if (IN(10)) for (int rep_ = 0; rep_ < 1 + ((DUP_MASK >> 10) & 1); ++rep_) { unsigned char* ws = C.ws; asm volatile("" : "+s"(ws)); ws = AS_GLOBAL(unsigned char, ws); phase_route(C, it); GRID_BAR(); }
        if (IN(11)) for (int rep_ = 0; rep_ < 1 + ((DUP_MASK >> 11) & 1); ++rep_) { unsigned char* ws = C.ws; asm volatile("" : "+s"(ws)); ws = AS_GLOBAL(unsigned char, ws); }
        if (IN(12)) for (int rep_ = 0; rep_ < 1 + ((DUP_MASK >> 12) & 1); ++rep_) { unsigned char* ws = C.ws; asm volatile("" : "+s"(ws)); ws = AS_GLOBAL(unsigned char, ws); moe_table(C, it, tb); pg8::Gemm g{(const bf16*)(ws + WS_HN), (const bf16*)(ws + WS_W13), D / 2, D / 2, D / 2, (size_t)D * D / 2, (const int*)(ws + WS_R1 + R1_ROWMAP), tb};   pg8::MoeOrder S{tb, 4, C.G, C.bid};
            pg8::EpiSwiglu E{(bf16*)(ws + WS_R1 + R1_HID), (const float*)(ws + WS_HN + HNX_RS), (const int*)(ws + WS_R1 + R1_ROWMAP), tb, (const unsigned*)(ws + WS_CTL) + CW_WMAX13 + l * NEXP * 1024}; pg8::gemm_phase<pg8::EpiSwiglu, pg8::MoeOrder, true, true>(C.lds, g, S, E);
            if (it + 1 < NIT) {
                const int U = tb[32] * 4, rem = U % C.G; const int first = rem, nlow = C.G - rem;
                if (C.bid >= first) { const Ctx Cn = launder(C); mixer_norm(Cn, it + 1, (C.bid - first) * 8 + Cn.wave, nlow * 8); } }
            GRID_BAR(); }
        if (IN(13)) for (int rep_ = 0; rep_ < 1 + ((DUP_MASK >> 13) & 1); ++rep_) { unsigned char* ws = C.ws; asm volatile("" : "+s"(ws)); ws = AS_GLOBAL(unsigned char, ws); moe_table(C, it, tb); pg8::Gemm g{(const bf16*)(ws + WS_R1 + R1_HID), (const bf16*)(ws + WS_W2), EFF, EFF, EFF, (size_t)D * EFF, nullptr, nullptr}; pg8::MoeOrder S{tb, 4, C.G, C.bid};
            pg8::EpiBf16 E{(bf16*)(ws + WS_R1 + R1_YEXP), D, 0, 0}; pg8::gemm_phase(C.lds, g, S, E); GRID_BAR(); }
#undef IN
    }
}

extern "C" void kernel_launch(void* const* d_in, const int* in_sizes, int n_in, void* d_out, int out_size, void* d_ws, size_t ws_size, hipStream_t stream) {
    static int grid = 0;
    if (grid == 0) {
        if (n_in != 36 || out_size != NBATCH * T * D || ws_size < WS_END) { fprintf(stderr, "kernel_launch: unexpected shapes (n_in %d out %d ws %zu)\n", n_in, out_size, ws_size); grid = -1; return; }
        int dev = 0, cus = 0;
        if (hipGetDevice(&dev) != hipSuccess || hipDeviceGetAttribute(&cus, hipDeviceAttributeMultiprocessorCount, dev) != hipSuccess) { grid = -1; return; }
        if (hipFuncSetAttribute((const void*)mk_fwd, hipFuncAttributeMaxDynamicSharedMemorySize, LDS_BYTES) != hipSuccess) { grid = -1; return; }
        int per_cu = 0;
        if (hipOccupancyMaxActiveBlocksPerMultiprocessor(&per_cu, (const void*)mk_fwd, 512, LDS_BYTES) != hipSuccess || per_cu < 1) fprintf(stderr, "kernel_launch: occupancy query says %d\n", per_cu);
        (void)hipGetLastError();
        grid = cus;
    }
    if (grid < 0) return;
    (void)hipMemsetAsync((char*)d_ws + WS_CTL, 0, CTL_ZERO_BYTES, stream);
    Args a{};
    for (int i = 0; i < 36; ++i) a.in[i] = (const float*)d_in[i];
    a.out = (float*)d_out; a.ws = (unsigned char*)d_ws;
    const int total = NIT * NPH + 1;
#if MK_ONE_LAUNCH
    a.s_lo = 0; a.s_hi = total;
    hipLaunchKernelGGL(mk_fwd, dim3(grid), dim3(512), LDS_BYTES, stream, a);
#else
    for (int s = 0; s < total; ++s) { a.s_lo = s; a.s_hi = s + 1; hipLaunchKernelGGL(mk_fwd, dim3(grid), dim3(512), LDS_BYTES, stream, a); }
#endif
}
```

```cpp
#include <hip/hip_runtime.h>
#include <cstdint>
#include <cstdio>

#define DBG_PROJ_N (l == 0 ? IN_COLS : WIN_ROWS)
#ifndef DUP_MASK
#define DUP_MASK 0
#endif
#ifndef PH_MASK
#define PH_MASK 0xFFFF
#endif
#ifndef MK_ONE_LAUNCH
#define MK_ONE_LAUNCH 1
#endif

#define LAS __attribute__((address_space(3)))
#define GAS __attribute__((address_space(1)))
#define AS_GLOBAL(T, p) ({ GAS T* g_ = (GAS T*)(p); asm("" : "+s"(g_)); (T*)g_; })
typedef unsigned short bf16;
typedef unsigned u32;
typedef short bf16x8 __attribute__((ext_vector_type(8)));
typedef float f32x4 __attribute__((ext_vector_type(4)));
typedef float f32x2 __attribute__((ext_vector_type(2)));
typedef float f32x16 __attribute__((ext_vector_type(16)));
typedef unsigned u32x4 __attribute__((ext_vector_type(4)));
typedef unsigned u32x2 __attribute__((ext_vector_type(2)));
typedef int i32x4 __attribute__((ext_vector_type(4)));

constexpr int NBATCH = 8, T = 8192, D = 1024, NLAYER = 2;
constexpr int M = 2 * T;
constexpr int NCH = 4;
constexpr int NIT = NLAYER * NCH;
constexpr int A_COLS = 3328, B_COLS = 2304, C_COLS = 2048, G_COLS = 3072, IN_COLS = 10752;
constexpr int WIN_ROWS = 11008;
constexpr int LORA_K = 384, LORA_N = 4096;
constexpr int NEXP = 32, EFF = 512;
constexpr int SEGL = 256, NSEG = T / SEGL;
constexpr int MOE_MAXROWS = 40960;

constexpr size_t MiB = 1u << 20;
constexpr size_t WS_CTL = 0, CTL_ZERO_BYTES = 1 * MiB;
constexpr size_t WS_ROPE = 1 * MiB;
constexpr size_t WS_WSC = 3 * MiB;
constexpr size_t WS_WIN = 4 * MiB;
constexpr size_t WS_LORAB = 26 * MiB;
constexpr size_t WS_PA = 29 * MiB, WS_PB = 31 * MiB, WS_PC = 32 * MiB, WS_WOUT = 34 * MiB;
constexpr size_t WS_W13 = 36 * MiB;
constexpr size_t WS_W2 = 100 * MiB;
constexpr size_t WS_VFIRST = 132 * MiB;
constexpr size_t WS_HN = 260 * MiB;
constexpr size_t WS_VP = 292 * MiB;
constexpr size_t WS_YB = 324 * MiB;
constexpr size_t WS_YC = 332 * MiB;
constexpr size_t WS_VLO = 364 * MiB;
constexpr size_t WS_BONUS = 365 * MiB;
constexpr size_t WS_TOK = 366 * MiB;
constexpr size_t WS_LSE = 367 * MiB;
constexpr size_t WS_ZG = 368 * MiB;
constexpr size_t WS_R4 = 464 * MiB;
constexpr size_t WS_R2 = 592 * MiB;
constexpr size_t WS_R1 = 696 * MiB;
constexpr size_t WS_END = 1016 * MiB;
constexpr size_t R4_G = 0, R4_WPRE = 32 * MiB, R4_APRE = 64 * MiB, R4_VPRE = 96 * MiB;
constexpr size_t R4_SEGS = 32 * MiB, R4_SEGP = 64 * MiB;
constexpr size_t R4_MTMP = 0, R4_MERGED = 64 * MiB;
constexpr size_t R2_ZA = 0;
constexpr size_t R2_YLOC = 0, R2_Z = 32 * MiB, R2_SSTART = 64 * MiB;
constexpr size_t R1_ZB = 0, R1_ZC = 72 * MiB, R1_ALORA = 136 * MiB, R1_OG = 148 * MiB;
constexpr size_t R1_SCANIN = 0;
constexpr size_t R1_XG = 0, R1_HID = 80 * MiB, R1_YEXP = 120 * MiB, R1_ROWMAP = 300 * MiB, R1_HNX = 256 * MiB;
constexpr size_t R1_LW = 0, R1_AA = 64 * MiB, R1_BB = 96 * MiB, R1_KK = 128 * MiB, R1_RR = 160 * MiB;
constexpr size_t R1_MT = 192 * MiB, R1_NC = 224 * MiB;
constexpr size_t R1_YLOC = 0, R1_Q = 32 * MiB, R1_SST = 64 * MiB;
constexpr int CHK = 64, NCHK = T / CHK;
constexpr int CW_BAR = 4096;
constexpr int CW_CNT = 16384;
constexpr int CW_WMAX = 32768;
constexpr int CW_WMAX13 = 65536;
constexpr size_t HNX_RS = 16 * MiB;

constexpr int RING_BYTES = 131072;
constexpr int LDSCTL_OFF = RING_BYTES;
constexpr int LDS_BYTES = 147456;

__device__ __forceinline__ float bf2f(u32 v) { return __uint_as_float(v << 16); }
__device__ __forceinline__ float bflo(u32 v) { return __uint_as_float(v << 16); }
__device__ __forceinline__ float bfhi(u32 v) { return __uint_as_float(v & 0xffff0000u); }
typedef __bf16 bf16x2_t __attribute__((ext_vector_type(2)));
__device__ __forceinline__ u32 cvt_pk_bf16(float lo, float hi) { f32x2 v = {lo, hi}; bf16x2_t b = __builtin_convertvector(v, bf16x2_t); return __builtin_bit_cast(u32, b); }
__device__ __forceinline__ u32 f2bf(float f) { return cvt_pk_bf16(f, 0.f) & 0xffffu; }
__device__ __forceinline__ float wave_sum(float v) {
#pragma unroll
    for (int o = 1; o < 64; o <<= 1) v += __shfl_xor(v, o);
    return v;
}
__device__ __forceinline__ float sigmoidf_(float x) { return __builtin_amdgcn_rcpf(1.0f + __expf(-x)); }
#define LDS_WAIT() asm volatile("s_waitcnt lgkmcnt(0)" ::: "memory")
typedef short v4i16_t __attribute__((ext_vector_type(4)));
__device__ __forceinline__ u32x2 lds_tr16(const LAS bf16* p) { return __builtin_bit_cast(u32x2, __builtin_amdgcn_ds_read_tr16_b64_v4i16((LAS v4i16_t*)p)); }

namespace pg8 {
#define PG8_LAS __attribute__((address_space(3)))
constexpr int BM = 256, BK = 64, HALF = 128, HTB = HALF * BK * 2, STAGE_BYTES = 8 * HTB, NXCD = 8, WGM = 4;
__host__ __device__ __forceinline__ int lds_byte(int r, int c) { const int st = (r >> 4) * 2 + (c >> 5), rr = r & 15, cc = c & 31, ob = rr * 64 + cc * 2; return st * 1024 + (ob ^ (((ob >> 9) & 1) << 5)); }
__host__ __device__ __forceinline__ void stage_rc(int b, int& R, int& C) { const int st = b / 1024, sb = b % 1024, swz = sb ^ (((sb >> 9) & 1) << 5); R = (st >> 1) * 16 + swz / 64; C = (st & 1) * 32 + (swz % 64) / 2; }
__host__ __device__ __forceinline__ int perm32(int rho) { const int n = rho >> 4, i = rho & 15; return 8 * (i >> 2) + 4 * n + (i & 3); }

struct Unit { int pm, pn, e; };
struct Gemm { const bf16* A; const bf16* Bt; int lda, ldb, K; size_t b_estride; const int* rowmap; const LAS int* tb; };

struct StaticOrder {
    int nM, nN, nwg, G, c;
    __device__ void init(int Mr, int N, int G_, int c_) { nM = Mr / BM; nN = N / BM; nwg = nM * nN; G = G_; c = c_; }
    __device__ bool next(int i, Unit& u) const {
        const long L = (long)i * G + c; if (L >= nwg) return false;
        int wgid = (int)L; { const int q = nwg / NXCD, r = nwg % NXCD, xcd = wgid % NXCD, off = wgid / NXCD; wgid = (xcd < r ? xcd * (q + 1) : r * (q + 1) + (xcd - r) * q) + off; }
        const int nig = WGM * nN, gid = wgid / nig, fm = gid * WGM, gsz = (nM - fm) < WGM ? (nM - fm) : WGM;
        u.pm = fm + ((wgid % nig) % gsz); u.pn = (wgid % nig) / gsz; u.e = 0; return true;
    }
};
struct MoeOrder {
    const LAS int* tb; int nN, G, c;
    __device__ bool next(int i, Unit& u) const {
        const int L = i * G + c; const int total = tb[32] * nN; if (L >= total) return false;
        const int q = total / NXCD, r = total % NXCD, xcd = L % NXCD, off = L / NXCD; const int wg = (xcd < r ? xcd * (q + 1) : r * (q + 1) + (xcd - r) * q) + off;
        const int rt = wg / nN; u.pn = wg % nN; u.pm = rt; int e = 0;
#pragma unroll 1
        for (int k = 1; k < 32; ++k) e += (rt >= tb[k]) ? 1 : 0;
        u.e = e; return true;
    }
};

template <bool I8> struct AccSel { typedef f32x4 t; };
template <> struct AccSel<true> { typedef i32x4 t; };
template <class Epi, class Sched, bool GATHER = false, bool I8 = false>
__device__ __forceinline__ void gemm_phase(PG8_LAS unsigned char* lds, const Gemm g, const Sched& S, const Epi& E) {
    int tid_ = threadIdx.x; asm volatile("" : "+v"(tid_));
    const int tid = tid_, wid = __builtin_amdgcn_readfirstlane(tid >> 6), lane = tid & 63, wr = wid >> 2, wc = wid & 3, fr = lane & 15, fq = lane >> 4;
    const int K = g.K, nt = K / BK;
    unsigned voffA[2], voffB[2];
#pragma unroll
    for (int i = 0; i < 2; ++i) { int R, C; stage_rc(tid * 16 + i * 8192, R, C); const int Rb = (R & ~31) + perm32(R & 31);
        voffA[i] = (unsigned)(R * g.lda + C) * 2u; voffB[i] = (unsigned)(Rb * g.ldb + C) * 2u; }
#define PG8_GOFFS(u_, go_) do { if constexpr (GATHER) { const int e_ = (u_).e; const int ti_ = (u_).pm - g.tb[e_]; const int cn_ = g.tb[40 + e_]; \
        _Pragma("unroll") for (int h_ = 0; h_ < 2; ++h_) _Pragma("unroll") for (int i_ = 0; i_ < 2; ++i_) { int R_, C_; stage_rc(tid * 16 + i_ * 8192, R_, C_); const int sl_ = ti_ * 256 + h_ * 128 + R_; \
            const int tr_ = (sl_ < cn_) ? g.rowmap[e_ * 16384 + sl_] : 0; go_[h_][i_] = (unsigned)(tr_ * g.lda + C_) * 2u; } } } while (0)
    unsigned goC[2][2] = {{0u, 0u}, {0u, 0u}}, goN[2][2] = {{0u, 0u}, {0u, 0u}};
    const size_t kstep = (size_t)(BK * 2);
    const size_t hA = GATHER ? 0 : (size_t)HALF * g.lda * 2, hB = (size_t)HALF * g.ldb * 2;
    const size_t tA = 2 * hA, tB = 2 * hB;
    const unsigned ldsw = (unsigned)wid * 1024u;
    const int aoff = lds_byte(wr * 64 + fr, fq * 8), boff = lds_byte(wc * 32 + fr, fq * 8);
#define PG8_SA(b, h) (((b) * 2 + (h)) * HTB)
#define PG8_SB(b, h) ((4 + (b) * 2 + (h)) * HTB)
#define PG8_STAGE(bufoff, gbase, voff) do { _Pragma("unroll") for (int _i = 0; _i < 2; ++_i) \
        __builtin_amdgcn_global_load_lds((const unsigned*)((const char*)(gbase) + (voff)[_i]), (PG8_LAS unsigned*)(lds + (bufoff) + ldsw + _i * 8192), 16, 0, 0); } while (0)
#define PG8_LDA(dst, b, h) do { _Pragma("unroll") for (int m = 0; m < 4; ++m) _Pragma("unroll") for (int k = 0; k < 2; ++k) dst[m][k] = *(const PG8_LAS bf16x8*)(lds + PG8_SA(b, h) + aoff + m * 2048 + k * 1024); } while (0)
#define PG8_LDB(dst, b, h) do { _Pragma("unroll") for (int n = 0; n < 2; ++n) _Pragma("unroll") for (int k = 0; k < 2; ++k) dst[n][k] = *(const PG8_LAS bf16x8*)(lds + PG8_SB(b, h) + boff + n * 2048 + k * 1024); } while (0)
#define PG8_MMA(ai, bj, At, Bt) do { __builtin_amdgcn_s_setprio(1); _Pragma("unroll") for (int m = 0; m < 4; ++m) _Pragma("unroll") for (int n = 0; n < 2; ++n) _Pragma("unroll") for (int k = 0; k < 2; ++k) { \
        if constexpr (I8) acc[ai][bj][m][n] = __builtin_amdgcn_mfma_i32_16x16x64_i8(__builtin_bit_cast(i32x4, Bt[n][k]), __builtin_bit_cast(i32x4, At[m][k]), acc[ai][bj][m][n], 0, 0, 0); \
        else acc[ai][bj][m][n] = __builtin_amdgcn_mfma_f32_16x16x32_bf16(Bt[n][k], At[m][k], acc[ai][bj][m][n], 0, 0, 0); } __builtin_amdgcn_s_setprio(0); } while (0)
#define PG8_WAIT_V(n) asm volatile("s_waitcnt vmcnt(" #n ")" ::: "memory")
#define PG8_WAIT_L(n) asm volatile("s_waitcnt lgkmcnt(" #n ")" ::: "memory")
#define PG8_BAR __builtin_amdgcn_s_barrier()
#define PG8_SCHED __builtin_amdgcn_sched_barrier(0)
    Unit cur, nxt; int ui = 0;
    if (!S.next(0, cur)) return;
    typedef typename AccSel<I8>::t acc_t;
    acc_t acc[2][2][4][2];
#pragma unroll
    for (int a = 0; a < 2; ++a)
#pragma unroll
        for (int b = 0; b < 2; ++b)
#pragma unroll
            for (int m = 0; m < 4; ++m)
#pragma unroll
                for (int n = 0; n < 2; ++n) acc[a][b][m][n] = (acc_t){0, 0, 0, 0};
    bf16x8 At[4][2], B0[2][2], B1[2][2];
    const char* cA = (const char*)g.A + (GATHER ? 0 : (size_t)cur.pm * tA); const char* cB = (const char*)g.Bt + (size_t)cur.e * g.b_estride * 2 + (size_t)cur.pn * tB;
    PG8_GOFFS(cur, goC);
#define PG8_VA(cond_, h_) (GATHER ? ((cond_) ? goN[h_] : goC[h_]) : voffA)
    PG8_STAGE(PG8_SB(0, 0), cB, voffB); PG8_STAGE(PG8_SB(0, 1), cB + hB, voffB); PG8_STAGE(PG8_SA(0, 0), cA, PG8_VA(false, 0)); PG8_STAGE(PG8_SA(0, 1), cA + hA, PG8_VA(false, 1));
    if (wr == 1) PG8_BAR;
    PG8_WAIT_V(2); PG8_BAR;
    PG8_STAGE(PG8_SB(1, 0), cB + kstep, voffB); PG8_STAGE(PG8_SA(1, 0), cA + kstep, PG8_VA(false, 0)); PG8_STAGE(PG8_SB(1, 1), cB + hB + kstep, voffB);
    PG8_WAIT_V(6); PG8_BAR;
    for (;;) {
        const bool has_next = S.next(ui + 1, nxt);
        const char* nA = (has_next && !GATHER) ? (const char*)g.A + (size_t)nxt.pm * tA : cA;
        if (has_next) PG8_GOFFS(nxt, goN); else { goN[0][0] = goC[0][0]; goN[0][1] = goC[0][1]; goN[1][0] = goC[1][0]; goN[1][1] = goC[1][1]; }
        const char* nB = has_next ? (const char*)g.Bt + (size_t)nxt.e * g.b_estride * 2 + (size_t)nxt.pn * tB : cB;
#pragma unroll 1
        for (int t = 0; t < nt; t += 2) {
            const bool last = (t == nt - 2);
            const char* a1 = cA + (size_t)(t + 1) * kstep;
            const char* a2 = last ? nA : cA + (size_t)(t + 2) * kstep; const char* b2 = last ? nB : cB + (size_t)(t + 2) * kstep;
            const char* a3 = a2 + kstep; const char* b3 = b2 + kstep;
            PG8_LDB(B0, 0, 0); PG8_LDB(B1, 0, 1); PG8_SCHED; PG8_LDA(At, 0, 0); PG8_STAGE(PG8_SA(1, 1), a1 + hA, PG8_VA(false, 1));
            PG8_WAIT_V(8); PG8_WAIT_L(0); PG8_BAR; PG8_MMA(0, 0, At, B0); PG8_MMA(0, 1, At, B1); PG8_BAR; PG8_SCHED;
            PG8_LDA(At, 0, 1); PG8_STAGE(PG8_SB(0, 0), b2, voffB); PG8_STAGE(PG8_SB(0, 1), b2 + hB, voffB); PG8_STAGE(PG8_SA(0, 0), a2, PG8_VA(last, 0));
            PG8_WAIT_V(8); PG8_WAIT_L(0); PG8_BAR; PG8_MMA(1, 0, At, B0); PG8_MMA(1, 1, At, B1); PG8_BAR; PG8_SCHED;
            PG8_LDB(B0, 1, 0); PG8_LDB(B1, 1, 1); PG8_SCHED; PG8_LDA(At, 1, 0); PG8_STAGE(PG8_SA(0, 1), a2 + hA, PG8_VA(last, 1));
            PG8_WAIT_V(8); PG8_WAIT_L(0); PG8_BAR; PG8_MMA(0, 0, At, B0); PG8_MMA(0, 1, At, B1); PG8_BAR; PG8_SCHED;
            PG8_LDA(At, 1, 1); PG8_STAGE(PG8_SB(1, 0), b3, voffB); PG8_STAGE(PG8_SB(1, 1), b3 + hB, voffB); PG8_STAGE(PG8_SA(1, 0), a3, PG8_VA(last, 0));
            PG8_WAIT_V(8); PG8_WAIT_L(0); PG8_BAR; PG8_MMA(1, 0, At, B0); PG8_MMA(1, 1, At, B1); PG8_BAR; PG8_SCHED;
        }
        if (wr == 0) PG8_BAR;
        E(acc, cur, wr, wc, fr, fq);
        if (!has_next) break;
#pragma unroll
        for (int a = 0; a < 2; ++a)
#pragma unroll
            for (int b = 0; b < 2; ++b)
#pragma unroll
                for (int m = 0; m < 4; ++m)
#pragma unroll
                    for (int n = 0; n < 2; ++n) acc[a][b][m][n] = (acc_t){0, 0, 0, 0};
        cur = nxt; cA = nA; cB = nB; ++ui; goC[0][0] = goN[0][0]; goC[0][1] = goN[0][1]; goC[1][0] = goN[1][0]; goC[1][1] = goN[1][1];
        if (wr == 1) PG8_BAR;
    }
    PG8_WAIT_V(0);
    PG8_BAR;
#undef PG8_GOFFS
#undef PG8_VA
#undef PG8_SA
#undef PG8_SB
#undef PG8_STAGE
#undef PG8_LDA
#undef PG8_LDB
#undef PG8_MMA
#undef PG8_WAIT_V
#undef PG8_WAIT_L
#undef PG8_BAR
#undef PG8_SCHED
}

template <class Epi, class Sched>
__device__ __forceinline__ void gemm_chain3(PG8_LAS unsigned char* lds, const Gemm g0, const Gemm g1, const Gemm g2, const Sched& S, const Epi& E) {
    int tid_ = threadIdx.x; asm volatile("" : "+v"(tid_));
    const int tid = tid_, wid = __builtin_amdgcn_readfirstlane(tid >> 6), lane = tid & 63, wr = wid >> 2, wc = wid & 3, fr = lane & 15, fq = lane >> 4;
    int Rr[2], Cc[2], Rbb[2];
#pragma unroll
    for (int i = 0; i < 2; ++i) { int R, C; stage_rc(tid * 16 + i * 8192, R, C); Rr[i] = R; Cc[i] = C; Rbb[i] = (R & ~31) + perm32(R & 31); }
#define PG8_SEL(br_, f_) ((br_) == 0 ? g0.f_ : ((br_) == 1 ? g1.f_ : g2.f_))
#define PG8_VOFF(br_, va_, vb_) do { const int lda_ = PG8_SEL(br_, lda), ldb_ = PG8_SEL(br_, ldb); _Pragma("unroll") for (int i_ = 0; i_ < 2; ++i_) { \
        va_[i_] = (unsigned)(Rr[i_] * lda_ + Cc[i_]) * 2u; vb_[i_] = (unsigned)(Rbb[i_] * ldb_ + Cc[i_]) * 2u; } } while (0)
    const size_t kstep = (size_t)(BK * 2);
    const unsigned ldsw = (unsigned)wid * 1024u;
    const int aoff = lds_byte(wr * 64 + fr, fq * 8), boff = lds_byte(wc * 32 + fr, fq * 8);
#define PG8_SA(b, h) (((b) * 2 + (h)) * HTB)
#define PG8_SB(b, h) ((4 + (b) * 2 + (h)) * HTB)
#define PG8_STAGE(bufoff, gbase, voff) do { _Pragma("unroll") for (int _i = 0; _i < 2; ++_i) \
        __builtin_amdgcn_global_load_lds((const unsigned*)((const char*)(gbase) + (voff)[_i]), (PG8_LAS unsigned*)(lds + (bufoff) + ldsw + _i * 8192), 16, 0, 0); } while (0)
#define PG8_LDA(dst, b, h) do { _Pragma("unroll") for (int m = 0; m < 4; ++m) _Pragma("unroll") for (int k = 0; k < 2; ++k) dst[m][k] = *(const PG8_LAS bf16x8*)(lds + PG8_SA(b, h) + aoff + m * 2048 + k * 1024); } while (0)
#define PG8_LDB(dst, b, h) do { _Pragma("unroll") for (int n = 0; n < 2; ++n) _Pragma("unroll") for (int k = 0; k < 2; ++k) dst[n][k] = *(const PG8_LAS bf16x8*)(lds + PG8_SB(b, h) + boff + n * 2048 + k * 1024); } while (0)
#define PG8_MMA(ai, bj, At, Bt) do { __builtin_amdgcn_s_setprio(1); _Pragma("unroll") for (int m = 0; m < 4; ++m) _Pragma("unroll") for (int n = 0; n < 2; ++n) _Pragma("unroll") for (int k = 0; k < 2; ++k) \
        acc[ai][bj][m][n] = __builtin_amdgcn_mfma_f32_16x16x32_bf16(Bt[n][k], At[m][k], acc[ai][bj][m][n], 0, 0, 0); __builtin_amdgcn_s_setprio(0); } while (0)
#define PG8_WAIT_V(n) asm volatile("s_waitcnt vmcnt(" #n ")" ::: "memory")
#define PG8_WAIT_L(n) asm volatile("s_waitcnt lgkmcnt(" #n ")" ::: "memory")
#define PG8_BAR __builtin_amdgcn_s_barrier()
#define PG8_SCHED __builtin_amdgcn_sched_barrier(0)
    Unit cur, nxt; int ui = 0;
    if (!S.next(0, cur)) return;
    int brc = 0;
    f32x4 acc[2][2][4][2];
#pragma unroll
    for (int a = 0; a < 2; ++a)
#pragma unroll
        for (int b = 0; b < 2; ++b)
#pragma unroll
            for (int m = 0; m < 4; ++m)
#pragma unroll
                for (int n = 0; n < 2; ++n) acc[a][b][m][n] = (f32x4){0.f, 0.f, 0.f, 0.f};
    bf16x8 At[4][2], B0[2][2], B1[2][2];
    unsigned vAc[2], vBc[2], vAn[2], vBn[2];
    PG8_VOFF(0, vAc, vBc);
    size_t hAc = (size_t)HALF * g0.lda * 2, hBc = (size_t)HALF * g0.ldb * 2, hAn = hAc, hBn = hBc; int ntc = g0.K / BK;
    const char* cA = (const char*)g0.A + (size_t)cur.pm * 2 * hAc; const char* cB = (const char*)g0.Bt + (size_t)cur.pn * 2 * hBc;
    PG8_STAGE(PG8_SB(0, 0), cB, vBc); PG8_STAGE(PG8_SB(0, 1), cB + hBc, vBc); PG8_STAGE(PG8_SA(0, 0), cA, vAc); PG8_STAGE(PG8_SA(0, 1), cA + hAc, vAc);
    if (wr == 1) PG8_BAR;
    PG8_WAIT_V(2); PG8_BAR;
    PG8_STAGE(PG8_SB(1, 0), cB + kstep, vBc); PG8_STAGE(PG8_SA(1, 0), cA + kstep, vAc); PG8_STAGE(PG8_SB(1, 1), cB + hBc + kstep, vBc);
    PG8_WAIT_V(6); PG8_BAR;
    for (;;) {
        const int brn = (brc == 2) ? 0 : brc + 1; bool has_next = true;
        if (brc == 2) has_next = S.next(ui / 3 + 1, nxt); else nxt = cur;
        const char* nA = cA; const char* nB = cB;
        if (has_next) { PG8_VOFF(brn, vAn, vBn); hAn = (size_t)HALF * PG8_SEL(brn, lda) * 2; hBn = (size_t)HALF * PG8_SEL(brn, ldb) * 2;
            nA = (const char*)PG8_SEL(brn, A) + (size_t)nxt.pm * 2 * hAn; nB = (const char*)PG8_SEL(brn, Bt) + (size_t)nxt.pn * 2 * hBn; }
        else { vAn[0] = vAc[0]; vAn[1] = vAc[1]; vBn[0] = vBc[0]; vBn[1] = vBc[1]; hAn = hAc; hBn = hBc; }
#pragma unroll 1
        for (int t = 0; t < ntc; t += 2) {
            const bool last = (t == ntc - 2);
            const char* a1 = cA + (size_t)(t + 1) * kstep;
            const char* a2 = last ? nA : cA + (size_t)(t + 2) * kstep; const char* b2 = last ? nB : cB + (size_t)(t + 2) * kstep;
            const char* a3 = a2 + kstep; const char* b3 = b2 + kstep;
            const size_t hA2 = last ? hAn : hAc, hB2 = last ? hBn : hBc;
            PG8_LDB(B0, 0, 0); PG8_LDB(B1, 0, 1); PG8_SCHED; PG8_LDA(At, 0, 0); PG8_STAGE(PG8_SA(1, 1), a1 + hAc, vAc);
            PG8_WAIT_V(8); PG8_WAIT_L(0); PG8_BAR; PG8_MMA(0, 0, At, B0); PG8_MMA(0, 1, At, B1); PG8_BAR; PG8_SCHED;
            PG8_LDA(At, 0, 1); PG8_STAGE(PG8_SB(0, 0), b2, (last ? vBn : vBc)); PG8_STAGE(PG8_SB(0, 1), b2 + hB2, (last ? vBn : vBc)); PG8_STAGE(PG8_SA(0, 0), a2, (last ? vAn : vAc));
            PG8_WAIT_V(8); PG8_WAIT_L(0); PG8_BAR; PG8_MMA(1, 0, At, B0); PG8_MMA(1, 1, At, B1); PG8_BAR; PG8_SCHED;
            PG8_LDB(B0, 1, 0); PG8_LDB(B1, 1, 1); PG8_SCHED; PG8_LDA(At, 1, 0); PG8_STAGE(PG8_SA(0, 1), a2 + hA2, (last ? vAn : vAc));
            PG8_WAIT_V(8); PG8_WAIT_L(0); PG8_BAR; PG8_MMA(0, 0, At, B0); PG8_MMA(0, 1, At, B1); PG8_BAR; PG8_SCHED;
            PG8_LDA(At, 1, 1); PG8_STAGE(PG8_SB(1, 0), b3, (last ? vBn : vBc)); PG8_STAGE(PG8_SB(1, 1), b3 + hB2, (last ? vBn : vBc)); PG8_STAGE(PG8_SA(1, 0), a3, (last ? vAn : vAc));
            PG8_WAIT_V(8); PG8_WAIT_L(0); PG8_BAR; PG8_MMA(1, 0, At, B0); PG8_MMA(1, 1, At, B1); PG8_BAR; PG8_SCHED;
        }
        if (wr == 0) PG8_BAR;
        if (brc < 2) E.link(acc, cur, brc, wr, wc, fr, fq); else E.fin(acc, cur, wr, wc, fr, fq);
        if (!has_next) break;
        if (brc == 2) {
#pragma unroll
            for (int a = 0; a < 2; ++a)
#pragma unroll
                for (int b = 0; b < 2; ++b)
#pragma unroll
                    for (int m = 0; m < 4; ++m)
#pragma unroll
                        for (int n = 0; n < 2; ++n) acc[a][b][m][n] = (f32x4){0.f, 0.f, 0.f, 0.f}; }
        cur = nxt; cA = nA; cB = nB; ++ui; brc = brn; vAc[0] = vAn[0]; vAc[1] = vAn[1]; vBc[0] = vBn[0]; vBc[1] = vBn[1]; hAc = hAn; hBc = hBn; ntc = PG8_SEL(brc, K) / BK;
        if (wr == 1) PG8_BAR;
    }
    PG8_WAIT_V(0);
    PG8_BAR;
#undef PG8_SEL
#undef PG8_VOFF
#undef PG8_SA
#undef PG8_SB
#undef PG8_STAGE
#undef PG8_LDA
#undef PG8_LDB
#undef PG8_MMA
#undef PG8_WAIT_V
#undef PG8_WAIT_L
#undef PG8_BAR
#undef PG8_SCHED
}

__device__ __forceinline__ f32x2 gelu_pk(f32x2 v) {
    const f32x2 av = __builtin_elementwise_abs(v), d = av * 0.2316418882f + 1.0f;
    f32x2 t; t.x = __builtin_amdgcn_rcpf(d.x); t.y = __builtin_amdgcn_rcpf(d.y);
    f32x2 q = t * 0.5307027145f + (-0.7265760135f); q = q * t + 0.7107068705f; q = q * t + (-0.142248368f); q = q * t + 0.127414796f; q = q * t;
    const f32x2 s = (v * v) * (-0.72134752044f);
    f32x2 e; e.x = __builtin_amdgcn_exp2f(s.x); e.y = __builtin_amdgcn_exp2f(s.y);
    const f32x2 zero2 = {0.f, 0.f};
    return __builtin_elementwise_max(v, zero2) - av * (q * e);
}
__device__ __forceinline__ u32x4 pack8(f32x4 v0, f32x4 v1) { u32x4 w; w.x = cvt_pk_bf16(v0[0], v0[1]); w.y = cvt_pk_bf16(v0[2], v0[3]); w.z = cvt_pk_bf16(v1[0], v1[1]); w.w = cvt_pk_bf16(v1[2], v1[3]); return w; }

struct EpiBf16 {
    bf16* O; int ldc; int split_cols; size_t split_stride;
    __device__ __forceinline__ void operator()(const f32x4 (&acc)[2][2][4][2], const Unit& u, int wr, int wc, int fr, int fq) const {
        const int row0 = u.pm * BM + wr * 64 + fr; int colt = u.pn * BM; bf16* base = O;
        if (split_cols) { const int t = colt / split_cols; base += (size_t)t * split_stride; colt -= t * split_cols; }
        const int col0 = colt + wc * 32 + 8 * fq;
#pragma unroll
        for (int ai = 0; ai < 2; ++ai)
#pragma unroll
            for (int m = 0; m < 4; ++m) { bf16* rowp = base + (size_t)(row0 + ai * HALF + m * 16) * ldc + col0;
#pragma unroll
                for (int bj = 0; bj < 2; ++bj) *(u32x4*)(rowp + bj * HALF) = pack8(acc[ai][bj][m][0], acc[ai][bj][m][1]); }
    }
};
struct EpiProj {
    bf16 *za, *zb, *zc, *zg, *vlo; const float* gate_b; const float* rs; const unsigned* cmax;
    __device__ __forceinline__ void operator()(const i32x4 (&acc)[2][2][4][2], const Unit& u, int wr, int wc, int fr, int fq) const {
        const int row0 = u.pm * BM + wr * 64 + fr; const int pn = u.pn;
        bf16* base; int ld, ct, mode;
        if (pn < 13) { base = za; ld = A_COLS; ct = pn; mode = 0; }
        else if (pn < 22) { base = zb; ld = B_COLS; ct = pn - 13; mode = 0; }
        else if (pn < 30) { base = zc; ld = C_COLS; ct = pn - 22; mode = 1; }
        else if (pn < 42) { base = zg; ld = G_COLS; ct = pn - 30; mode = 2; }
        else { base = vlo; ld = 32; ct = 0; mode = 3; }
        const int col0 = ct * BM + wc * 32 + 8 * fq;
        f32x4 cs[2][2];
#pragma unroll
        for (int bj = 0; bj < 2; ++bj)
#pragma unroll
            for (int n = 0; n < 2; ++n) { const u32x4 b = *(const u32x4*)(cmax + pn * BM + wc * 32 + 8 * fq + bj * HALF + 4 * n);
                cs[bj][n] = (f32x4){__uint_as_float(b.x), __uint_as_float(b.y), __uint_as_float(b.z), __uint_as_float(b.w)} * (1.f / 127.f); }
        float rsv[2][4];
#pragma unroll
        for (int ai = 0; ai < 2; ++ai)
#pragma unroll
            for (int m = 0; m < 4; ++m) rsv[ai][m] = rs[row0 + ai * HALF + m * 16];
#define PG8_DQ(ai, bj, m, n, r) (__builtin_convertvector(acc[ai][bj][m][n], f32x4) * (cs[bj][n] * (r)))
        if (mode == 0) {
#pragma unroll
            for (int ai = 0; ai < 2; ++ai)
#pragma unroll
                for (int m = 0; m < 4; ++m) { const int row = row0 + ai * HALF + m * 16; const float r = rsv[ai][m]; bf16* rowp = base + (size_t)row * ld + col0;
#pragma unroll
                    for (int bj = 0; bj < 2; ++bj) *(u32x4*)(rowp + bj * HALF) = pack8(PG8_DQ(ai, bj, m, 0, r), PG8_DQ(ai, bj, m, 1, r)); }
        } else if (mode == 1) {
#pragma unroll
            for (int ai = 0; ai < 2; ++ai)
#pragma unroll
                for (int m = 0; m < 4; ++m) { const int row = row0 + ai * HALF + m * 16; const float r = rsv[ai][m]; bf16* rowp = base + (size_t)row * ld + col0;
#pragma unroll
                    for (int bj = 0; bj < 2; ++bj) { const f32x4 v0 = PG8_DQ(ai, bj, m, 0, r), v1 = PG8_DQ(ai, bj, m, 1, r);
                        const f32x2 a = gelu_pk((f32x2){v0[0], v0[1]}), b = gelu_pk((f32x2){v0[2], v0[3]}), c = gelu_pk((f32x2){v1[0], v1[1]}), d = gelu_pk((f32x2){v1[2], v1[3]});
                        *(u32x4*)(rowp + bj * HALF) = pack8((f32x4){a.x, a.y, b.x, b.y}, (f32x4){c.x, c.y, d.x, d.y}); } }
        } else if (mode == 2) {
            f32x4 bv[2][2];
#pragma unroll
            for (int bj = 0; bj < 2; ++bj)
#pragma unroll
                for (int n = 0; n < 2; ++n) bv[bj][n] = *(const f32x4*)(gate_b + col0 + bj * HALF + 4 * n);
#pragma unroll
            for (int ai = 0; ai < 2; ++ai)
#pragma unroll
                for (int m = 0; m < 4; ++m) { const int row = row0 + ai * HALF + m * 16; const float r = rsv[ai][m];
#pragma unroll
                    for (int bj = 0; bj < 2; ++bj) { f32x4 v0 = PG8_DQ(ai, bj, m, 0, r) + bv[bj][0], v1 = PG8_DQ(ai, bj, m, 1, r) + bv[bj][1];
                        const f32x4 one4 = {1.f, 1.f, 1.f, 1.f};
                        v0 = v0 * -1.44269504f; v1 = v1 * -1.44269504f;
#pragma unroll
                        for (int e = 0; e < 4; ++e) { v0[e] = __builtin_amdgcn_exp2f(v0[e]); v1[e] = __builtin_amdgcn_exp2f(v1[e]); }
                        v0 = v0 + one4; v1 = v1 + one4;
#pragma unroll
                        for (int e = 0; e < 4; ++e) { v0[e] = __builtin_amdgcn_rcpf(v0[e]); v1[e] = __builtin_amdgcn_rcpf(v1[e]); }
                        v0 = v0 * 255.f; v1 = v1 * 255.f;
#pragma unroll
                        for (int e = 0; e < 4; ++e) { v0[e] = __builtin_rintf(v0[e]); v1[e] = __builtin_rintf(v1[e]); }
                        v0 = __builtin_elementwise_max(v0, one4); v1 = __builtin_elementwise_max(v1, one4);
                        u32 w0 = 0u, w1 = 0u;
#pragma unroll
                        for (int e = 0; e < 4; ++e) { w0 = __builtin_amdgcn_cvt_pk_u8_f32(v0[e], e, w0); w1 = __builtin_amdgcn_cvt_pk_u8_f32(v1[e], e, w1); }
                        *(u32x2*)((unsigned char*)zg + (size_t)row * G_COLS + col0 + bj * HALF) = (u32x2){w0, w1}; } }
        } else {
            if (wc == 0) {
#pragma unroll
                for (int ai = 0; ai < 2; ++ai)
#pragma unroll
                    for (int m = 0; m < 4; ++m) { const int row = row0 + ai * HALF + m * 16; const float r = rsv[ai][m]; bf16* rowp = base + (size_t)row * 32 + 8 * fq;
                        *(u32x4*)(rowp) = pack8(PG8_DQ(ai, 0, m, 0, r), PG8_DQ(ai, 0, m, 1, r)); }
            }
        }
#undef PG8_DQ
    }
};
template <int MODE> struct EpiGate {
    const bf16* gate; bf16* tmp; bf16* merged;
    __device__ __forceinline__ void operator()(const f32x4 (&acc)[2][2][4][2], const Unit& u, int wr, int wc, int fr, int fq) const {
        const int row0 = u.pm * BM + wr * 64 + fr; const int col0 = u.pn * BM + wc * 32 + 8 * fq;
#pragma unroll
        for (int ai = 0; ai < 2; ++ai)
#pragma unroll
            for (int m = 0; m < 4; ++m) { const size_t row = (size_t)(row0 + ai * HALF + m * 16);
#pragma unroll
                for (int bj = 0; bj < 2; ++bj) { const int col = col0 + bj * HALF;
                    const u32x4 gq = *(const u32x4*)(gate + row * G_COLS + col);
                    f32x4 g0 = (f32x4){bflo(gq.x), bfhi(gq.x), bflo(gq.y), bfhi(gq.y)}, g1 = (f32x4){bflo(gq.z), bfhi(gq.z), bflo(gq.w), bfhi(gq.w)};
                    f32x4 v0 = acc[ai][bj][m][0] * g0, v1 = acc[ai][bj][m][1] * g1;
                    bf16* tp = tmp + row * D + col;
                    if (MODE != 0) { const u32x4 tq = *(const u32x4*)tp; v0 += (f32x4){bflo(tq.x), bfhi(tq.x), bflo(tq.y), bfhi(tq.y)}; v1 += (f32x4){bflo(tq.z), bfhi(tq.z), bflo(tq.w), bfhi(tq.w)}; }
                    if (MODE != 2) *(u32x4*)tp = pack8(v0, v1);
                    else *(u32x4*)(merged + row * D + col) = pack8(v0, v1); }
                asm volatile("" ::: "memory"); }
    }
};
struct EpiChainGate {
    const unsigned char* gate; bf16* merged;
    __device__ __forceinline__ void link(f32x4 (&acc)[2][2][4][2], const Unit& u, int br, int wr, int wc, int fr, int fq) const {
        const int row0 = u.pm * BM + wr * 64 + fr; const int col0 = u.pn * BM + wc * 32 + 8 * fq;
        u32x2 gav[2][4][2], gbv[2][4][2];
#pragma unroll
        for (int ai = 0; ai < 2; ++ai)
#pragma unroll
            for (int m = 0; m < 4; ++m)
#pragma unroll
                for (int bj = 0; bj < 2; ++bj) { const unsigned char* gp = gate + (size_t)(row0 + ai * HALF + m * 16) * G_COLS + br * 1024 + col0 + bj * HALF; gav[ai][m][bj] = *(const u32x2*)gp; gbv[ai][m][bj] = *(const u32x2*)(gp + 1024); }
#pragma unroll
        for (int ai = 0; ai < 2; ++ai)
#pragma unroll
            for (int m = 0; m < 4; ++m) {
#pragma unroll
                for (int bj = 0; bj < 2; ++bj) { const u32x2 ga = gav[ai][m][bj], gb = gbv[ai][m][bj];
#pragma unroll
                    for (int e = 0; e < 8; ++e) { const u32 wa = (e < 4) ? ga.x : ga.y, wb = (e < 4) ? gb.x : gb.y; const int sh = 8 * (e & 3);
                        const float r = (float)((wa >> sh) & 255u) * __builtin_amdgcn_rcpf((float)((wb >> sh) & 255u));
                        if (e < 4) acc[ai][bj][m][0][e] *= r; else acc[ai][bj][m][1][e - 4] *= r; } }
                asm volatile("" ::: "memory"); }
    }
    __device__ __forceinline__ void fin(const f32x4 (&acc)[2][2][4][2], const Unit& u, int wr, int wc, int fr, int fq) const {
        const int row0 = u.pm * BM + wr * 64 + fr; const int col0 = u.pn * BM + wc * 32 + 8 * fq;
        u32x2 gqv[2][4][2];
#pragma unroll
        for (int ai = 0; ai < 2; ++ai)
#pragma unroll
            for (int m = 0; m < 4; ++m)
#pragma unroll
                for (int bj = 0; bj < 2; ++bj) gqv[ai][m][bj] = *(const u32x2*)(gate + (size_t)(row0 + ai * HALF + m * 16) * G_COLS + 2048 + col0 + bj * HALF);
#pragma unroll
        for (int ai = 0; ai < 2; ++ai)
#pragma unroll
            for (int m = 0; m < 4; ++m) { const size_t row = (size_t)(row0 + ai * HALF + m * 16);
#pragma unroll
                for (int bj = 0; bj < 2; ++bj) { const int col = col0 + bj * HALF; const u32x2 gq = gqv[ai][m][bj]; f32x4 g0_, g1_;
#pragma unroll
                    for (int e = 0; e < 4; ++e) { g0_[e] = (float)((gq.x >> (8 * e)) & 255u) * (1.f / 255.f); g1_[e] = (float)((gq.y >> (8 * e)) & 255u) * (1.f / 255.f); }
                    *(u32x4*)(merged + row * D + col) = pack8(acc[ai][bj][m][0] * g0_, acc[ai][bj][m][1] * g1_); }
                asm volatile("" ::: "memory"); }
    }
};
struct EpiResid {
    const float* xin; float* xout;
    __device__ __forceinline__ void operator()(const f32x4 (&acc)[2][2][4][2], const Unit& u, int wr, int wc, int fr, int fq) const {
        const int row0 = u.pm * BM + wr * 64 + fr; const int col0 = u.pn * BM + wc * 32 + 8 * fq;
        f32x4 cur[4], nx[4];
#pragma unroll
        for (int bj = 0; bj < 2; ++bj) { const float* ip = xin + (size_t)row0 * D + col0 + bj * HALF; cur[2 * bj] = *(const f32x4*)ip; cur[2 * bj + 1] = *(const f32x4*)(ip + 4); }
#pragma unroll
        for (int rr = 0; rr < 8; ++rr) { const int ai = rr >> 2, m = rr & 3; const size_t off = (size_t)(row0 + ai * HALF + m * 16) * D + col0;
            if (rr < 7) { const int ai2 = (rr + 1) >> 2, m2 = (rr + 1) & 3; const size_t off2 = (size_t)(row0 + ai2 * HALF + m2 * 16) * D + col0;
#pragma unroll
                for (int bj = 0; bj < 2; ++bj) { const float* ip = xin + off2 + bj * HALF; nx[2 * bj] = *(const f32x4*)ip; nx[2 * bj + 1] = *(const f32x4*)(ip + 4); } }
            asm volatile("" ::: "memory");
#pragma unroll
            for (int bj = 0; bj < 2; ++bj) { float* op = xout + off + bj * HALF; *(f32x4*)op = cur[2 * bj] + acc[ai][bj][m][0]; *(f32x4*)(op + 4) = cur[2 * bj + 1] + acc[ai][bj][m][1]; }
            asm volatile("" ::: "memory");
#pragma unroll
            for (int q = 0; q < 4; ++q) cur[q] = nx[q]; }
    }
};
struct EpiSwiglu {
    bf16* hid; const float* rs; const int* rowmap; const LAS int* tb; const unsigned* cmax;
    __device__ __forceinline__ void operator()(const i32x4 (&acc)[2][2][4][2], const Unit& u, int wr, int wc, int fr, int fq) const {
        const int row0 = u.pm * BM + wr * 64 + fr; const int col0 = u.pn * HALF + wc * 32 + 8 * fq;
        const int e = u.e, slot0 = (u.pm - tb[e]) * BM + wr * 64 + fr, cn = tb[40 + e];
        f32x4 cs[2][2];
#pragma unroll
        for (int bj = 0; bj < 2; ++bj)
#pragma unroll
            for (int n = 0; n < 2; ++n) { const u32x4 b = *(const u32x4*)(cmax + e * 1024 + u.pn * BM + bj * HALF + wc * 32 + 8 * fq + 4 * n);
                cs[bj][n] = (f32x4){__uint_as_float(b.x), __uint_as_float(b.y), __uint_as_float(b.z), __uint_as_float(b.w)} * (1.f / 127.f); }
        float rsv[2][4]; int tk[2][4];
#pragma unroll
        for (int ai = 0; ai < 2; ++ai)
#pragma unroll
            for (int m = 0; m < 4; ++m) { const int slot = slot0 + ai * HALF + m * 16; tk[ai][m] = (slot < cn) ? rowmap[e * 16384 + slot] : -1; }
#pragma unroll
        for (int ai = 0; ai < 2; ++ai)
#pragma unroll
            for (int m = 0; m < 4; ++m) rsv[ai][m] = (tk[ai][m] >= 0) ? rs[tk[ai][m]] : 0.f;
#pragma unroll
        for (int ai = 0; ai < 2; ++ai)
#pragma unroll
            for (int m = 0; m < 4; ++m) { bf16* rowp = hid + (size_t)(row0 + ai * HALF + m * 16) * EFF + col0;
                const float r = rsv[ai][m];
                const f32x4 a0 = __builtin_convertvector(acc[ai][0][m][0], f32x4) * (cs[0][0] * r), a1 = __builtin_convertvector(acc[ai][0][m][1], f32x4) * (cs[0][1] * r);
                const f32x4 b0 = __builtin_convertvector(acc[ai][1][m][0], f32x4) * (cs[1][0] * r), b1 = __builtin_convertvector(acc[ai][1][m][1], f32x4) * (cs[1][1] * r);
                f32x4 h0, h1;
#pragma unroll
                for (int q = 0; q < 4; ++q) { h0[q] = a0[q] * sigmoidf_(a0[q]) * b0[q]; h1[q] = a1[q] * sigmoidf_(a1[q]) * b1[q]; }
                *(u32x4*)rowp = pack8(h0, h1); }
    }
};
struct EpiLora { bf16* w; bf16* a; bf16* g; bf16* v;
    __device__ __forceinline__ void operator()(const f32x4 (&acc)[2][2][4][2], const Unit& u, int wr, int wc, int fr, int fq) const {
        const int sec = u.pn >> 2; bf16* base = sec == 0 ? w : (sec == 1 ? a : (sec == 2 ? g : v)); Unit u2 = u; u2.pn = u.pn & 3;
        EpiBf16 e{base, D, 0, 0}; e(acc, u2, wr, wc, fr, fq); } };
}

#define XB_TMO      128
#define XB_XCNT(j)  (256  + 64 * (j))
#define XB_XSUB(j)  (1280 + 64 * (j))
#define XB_XGEN(j)  (2304 + 64 * (j))
#define XB_TOP      3328
#define XB_TOPGEN   3392
#define XCD_BAR_WORDS 3456
#define XB_SPIN_CAP (1u << 22)
__device__ __forceinline__ unsigned xb_ld(unsigned* p)              { return __hip_atomic_load(p, __ATOMIC_RELAXED, __HIP_MEMORY_SCOPE_AGENT); }
__device__ __forceinline__ unsigned xb_add(unsigned* p, unsigned v) { return __hip_atomic_fetch_add(p, v, __ATOMIC_RELAXED, __HIP_MEMORY_SCOPE_AGENT); }
__device__ __forceinline__ unsigned xb_xcc_id() { return (unsigned)__builtin_amdgcn_s_getreg((3 << 11) | 20) & 0xFu; }
#define XB_SPIN(cond, bar) do { unsigned _sp = 0; while (cond) { __builtin_amdgcn_s_sleep(1); \
    if ((++_sp & 255u) == 0u) { if (xb_ld(&(bar)[XB_TMO])) break; if (_sp > XB_SPIN_CAP) { atomicAdd(&(bar)[XB_TMO], 1u); break; } } } } while (0)
struct XcdBarrier { unsigned* bar; unsigned x; volatile LAS unsigned* st; };
__device__ __forceinline__ XcdBarrier xcd_barrier_post(unsigned* bar, volatile LAS unsigned* st) {
    XcdBarrier b; b.bar = bar; b.x = xb_xcc_id(); b.st = st;
    if (threadIdx.x == 0) (void)xb_add(&bar[XB_XCNT(b.x)], 1u);
    return b;
}
__device__ __forceinline__ void xcd_barrier_complete(unsigned* bar, unsigned x, unsigned& nloc, unsigned& nx) {
    const unsigned G = gridDim.x * gridDim.y * gridDim.z;
    unsigned sum, cnt, mine, sp = 0u;
    for (;;) {
        sum = 0u; cnt = 0u; mine = 0u;
#pragma unroll
        for (unsigned j = 0; j < 16; ++j) { const unsigned c = xb_ld(&bar[XB_XCNT(j)]); sum += c; cnt += (c > 0u) ? 1u : 0u; mine = (j == x) ? c : mine; }
        if (sum == G) break;
        __builtin_amdgcn_s_sleep(1);
        if ((++sp & 255u) == 0u) { if (xb_ld(&bar[XB_TMO])) break; if (sp > XB_SPIN_CAP) { atomicAdd(&bar[XB_TMO], 1u); break; } }
    }
    nloc = mine > 0u ? mine : 1u; nx = cnt > 0u ? cnt : 1u;
}
__device__ __forceinline__ void xcd_barrier(const XcdBarrier& b) {
    asm volatile("s_waitcnt vmcnt(0)" ::: "memory");
    __syncthreads();
    if (threadIdx.x == 0) {
        unsigned* bar = b.bar;
        __builtin_amdgcn_s_waitcnt(0);
        unsigned nloc = b.st[0], nx = b.st[1];
        if (nloc == 0u) { xcd_barrier_complete(bar, b.x, nloc, nx); b.st[0] = nloc; b.st[1] = nx; }
        const unsigned old = xb_add(&bar[XB_XSUB(b.x)], 1u);
        const unsigned gen = old / nloc;
        if (old + 1u == (gen + 1u) * nloc) {
            __builtin_amdgcn_fence(__ATOMIC_RELEASE, "agent");
            asm volatile("s_waitcnt vmcnt(0)" ::: "memory");
            const unsigned og = xb_add(&bar[XB_TOP], 1u);
            const unsigned tg = og / nx;
            if (og + 1u == (tg + 1u) * nx) xb_add(&bar[XB_TOPGEN], 1u);
            else XB_SPIN(xb_ld(&bar[XB_TOPGEN]) == tg, bar);
            __builtin_amdgcn_fence(__ATOMIC_ACQUIRE, "agent");
            xb_add(&bar[XB_XGEN(b.x)], 1u);
            asm volatile("s_waitcnt vmcnt(0)" ::: "memory");
        } else {
            XB_SPIN(xb_ld(&bar[XB_XGEN(b.x)]) == gen, bar);
            __builtin_amdgcn_fence(__ATOMIC_ACQUIRE, "agent");
            asm volatile("s_waitcnt vmcnt(0)" ::: "memory");
        }
    }
    __syncthreads();
}

struct Args { const float* in[36]; float* out; unsigned char* ws; int s_lo, s_hi; };
enum { I_X = 0, I_NORM_MIX, I_W_IN, I_MU_A, I_W_DECAY0, I_W_DECAY2, I_A0, I_A2, I_G2, I_K_K, I_K_A, I_R_K, I_LNX_W, I_LNX_B, I_VRES_MU, I_VRES_W1, I_VRES_W2, I_VRES_B,
       I_SGU_LN_W, I_SGU_LN_B, I_SGU_WS, I_SGU_BS, I_GATE_B, I_W_PA, I_W_PB, I_W_PC, I_W_OUT, I_NORM_FFN, I_RGRP, I_RGRP_B, I_REXP, I_REXP_B, I_MOE_W1, I_MOE_W3, I_MOE_W2, I_NORM_FINAL };

struct Ctx {
    LAS unsigned char* lds; unsigned char* ws; const float* const* in; float* out;
    int tid, lane, wave, G, bid, gw, ngw;
    __device__ __forceinline__ const float* inp(int k) const { return AS_GLOBAL(const float, in[k]); }
};
__device__ __forceinline__ Ctx launder(const Ctx& C0) {
    Ctx C = C0; asm volatile("" : "+v"(C.tid), "+v"(C.lane)); asm volatile("" : "+s"(C.wave), "+s"(C.bid), "+s"(C.gw), "+s"(C.ws)); C.ws = AS_GLOBAL(unsigned char, C.ws); C.out = AS_GLOBAL(float, C.out); return C;
}

__device__ __forceinline__ void tr_item(const float* W, int N, int k0, int n0, bf16* WT, int ldk, int drow0, LAS float* scr, int lane) {
    float wv_[32];
#pragma unroll
    for (int i = 0; i < 32; ++i) { const int kk = 2 * i + (lane >> 5); wv_[i] = W[(size_t)(k0 + kk) * N + n0 + (lane & 31)]; }
#pragma unroll
    for (int i = 0; i < 32; ++i) { const int kk = 2 * i + (lane >> 5); scr[kk * 33 + (lane & 31)] = wv_[i]; }
    LDS_WAIT(); asm volatile("" ::: "memory");
    const int c = lane & 7;
#pragma unroll
    for (int j = 0; j < 4; ++j) { const int n = (lane >> 3) + 8 * j; const LAS float* s = scr + (8 * c) * 33 + n;
        u32x4 o; o.x = cvt_pk_bf16(s[0 * 33], s[1 * 33]); o.y = cvt_pk_bf16(s[2 * 33], s[3 * 33]); o.z = cvt_pk_bf16(s[4 * 33], s[5 * 33]); o.w = cvt_pk_bf16(s[6 * 33], s[7 * 33]);
        *(u32x4*)(WT + (size_t)(drow0 + n) * ldk + k0 + 8 * c) = o; }
    LDS_WAIT(); asm volatile("" ::: "memory");
}

__device__ __forceinline__ void tr_item_i8(const float* W, int N, int k0, int n0, unsigned char* WT, int ldkb, int drow0, const unsigned* cmax, LAS float* scr, int lane) {
    float wv_[32];
    const float sc = 127.f / fmaxf(__uint_as_float(cmax[drow0 + (lane & 31)]), 1e-30f);
#pragma unroll
    for (int i = 0; i < 32; ++i) { const int kk = 2 * i + (lane >> 5); wv_[i] = W[(size_t)(k0 + kk) * N + n0 + (lane & 31)]; }
#pragma unroll
    for (int i = 0; i < 32; ++i) { const int kk = 2 * i + (lane >> 5); scr[kk * 33 + (lane & 31)] = __builtin_rintf(wv_[i] * sc); }
    LDS_WAIT(); asm volatile("" ::: "memory");
    const int c = lane & 7;
#pragma unroll
    for (int j = 0; j < 4; ++j) { const int n = (lane >> 3) + 8 * j; const LAS float* s = scr + (8 * c) * 33 + n; u32 q[8];
#pragma unroll
        for (int e = 0; e < 8; ++e) q[e] = (u32)(int)s[e * 33] & 255u;
        *(u32x2*)(WT + (size_t)(drow0 + n) * ldkb + k0 + 8 * c) = (u32x2){q[0] | (q[1] << 8) | (q[2] << 16) | (q[3] << 24), q[4] | (q[5] << 8) | (q[6] << 16) | (q[7] << 24)}; }
    LDS_WAIT(); asm volatile("" ::: "memory");
}
__device__ __forceinline__ void phase_wmax(const Ctx& C0, int l, int part, int nparts, int gt, int ngt) {
    const Ctx C = launder(C0);
    unsigned* cm = (unsigned*)(C.ws + WS_CTL) + CW_WMAX + l * WIN_ROWS;
    constexpr int NF4 = IN_COLS / 4;
    { constexpr int N = 32 * NF4; const int lo = (int)((long)N * part / nparts), hi = (int)((long)N * (part + 1) / nparts); const float* wbase = C.inp(I_W_IN) + (size_t)l * D * IN_COLS;
      for (int i = lo + gt; i < hi; i += ngt) { const int n4 = i % NF4, kb = i / NF4;
        const float* p = wbase + (size_t)(kb * 32) * IN_COLS + n4 * 4; f32x4 m = {0.f, 0.f, 0.f, 0.f};
#pragma unroll 8
        for (int k = 0; k < 32; ++k) { const f32x4 v = *(const f32x4*)(p + (size_t)k * IN_COLS); m = __builtin_elementwise_max(m, __builtin_elementwise_abs(v)); }
        unsigned* d = cm + n4 * 4;
#pragma unroll
        for (int e = 0; e < 4; ++e) __hip_atomic_fetch_max(d + e, __float_as_uint(m[e]), __ATOMIC_RELAXED, __HIP_MEMORY_SCOPE_AGENT); } }
    if (l == 1 && part == 0) for (int i = gt; i < 32 * 8; i += ngt) { const int n4 = i % 8, kb = i / 8;
        const float* p = C.inp(I_VRES_W1) + (size_t)(kb * 32) * 32 + n4 * 4; f32x4 m = {0.f, 0.f, 0.f, 0.f};
#pragma unroll 8
        for (int k = 0; k < 32; ++k) { const f32x4 v = *(const f32x4*)(p + (size_t)k * 32); m = __builtin_elementwise_max(m, __builtin_elementwise_abs(v)); }
        unsigned* d = cm + IN_COLS + n4 * 4;
#pragma unroll
        for (int e = 0; e < 4; ++e) __hip_atomic_fetch_max(d + e, __float_as_uint(m[e]), __ATOMIC_RELAXED, __HIP_MEMORY_SCOPE_AGENT); }
    unsigned* cm13 = (unsigned*)(C.ws + WS_CTL) + CW_WMAX13 + l * NEXP * 1024; const float* w1_ = C.inp(I_MOE_W1) + (size_t)l * NEXP * D * EFF; const float* w3_ = C.inp(I_MOE_W3) + (size_t)l * NEXP * D * EFF;
    { constexpr int N = NEXP * 2 * 16 * 128; const int lo = (int)((long)N * part / nparts), hi = (int)((long)N * (part + 1) / nparts);
      for (int i = lo + gt; i < hi; i += ngt) { const int n4 = i % 128, kb = (i / 128) % 16, sel = (i / 2048) % 2, e_ = i / 4096;
        const float* p = (sel ? w3_ : w1_) + ((size_t)e_ * D + kb * 64) * EFF + n4 * 4; f32x4 m = {0.f, 0.f, 0.f, 0.f};
#pragma unroll 8
        for (int k = 0; k < 64; ++k) { const f32x4 v = *(const f32x4*)(p + (size_t)k * EFF); m = __builtin_elementwise_max(m, __builtin_elementwise_abs(v)); }
        const int n = n4 * 4; unsigned* d = cm13 + e_ * 1024 + (n / 128) * 256 + (n % 128) + sel * 128;
#pragma unroll
        for (int e = 0; e < 4; ++e) __hip_atomic_fetch_max(d + e, __float_as_uint(m[e]), __ATOMIC_RELAXED, __HIP_MEMORY_SCOPE_AGENT); } }
}

__device__ __forceinline__ void phase_convert(const Ctx& C0, int l, bool first) {
    const Ctx C = launder(C0);
    LAS float* scr = (LAS float*)(C.lds + C.wave * 16384);
    unsigned char* ws = C.ws;
    constexpr int I_WIN = 16 * 336, I_VR = 16, I_SQ = 16 * 32, I_PB = 4 * 32, I_E13 = 256 * 32, I_E2 = 256 * 32;
    constexpr int NIT_ = I_WIN + I_VR + 3 * I_SQ + I_PB + 2 * I_E13 + I_E2;
    for (int it = C.gw; it < NIT_; it += C.ngw) {
        int r = it;
        if (r < I_WIN) { tr_item_i8(C.inp(I_W_IN) + (size_t)l * D * IN_COLS, IN_COLS, (r / 336) * 64, (r % 336) * 32, ws + WS_WIN, D, (r % 336) * 32, (const unsigned*)(ws + WS_CTL) + CW_WMAX + l * WIN_ROWS, scr, C.lane); continue; } r -= I_WIN;
        if (r < I_VR) { if (l == 1) tr_item_i8(C.inp(I_VRES_W1), 32, r * 64, 0, ws + WS_WIN, D, IN_COLS, (const unsigned*)(ws + WS_CTL) + CW_WMAX + WIN_ROWS, scr, C.lane); continue; } r -= I_VR;
        if (r < I_SQ) { tr_item(C.inp(I_W_PA) + (size_t)l * D * D, D, (r / 32) * 64, (r % 32) * 32, (bf16*)(ws + WS_PA), D, (r % 32) * 32, scr, C.lane); continue; } r -= I_SQ;
        if (r < I_SQ) { tr_item(C.inp(I_W_PC) + (size_t)l * D * D, D, (r / 32) * 64, (r % 32) * 32, (bf16*)(ws + WS_PC), D, (r % 32) * 32, scr, C.lane); continue; } r -= I_SQ;
        if (r < I_SQ) { tr_item(C.inp(I_W_OUT) + (size_t)l * D * D, D, (r / 32) * 64, (r % 32) * 32, (bf16*)(ws + WS_WOUT), D, (r % 32) * 32, scr, C.lane); continue; } r -= I_SQ;
        if (r < I_PB) { tr_item(C.inp(I_W_PB) + (size_t)l * 256 * D, D, (r / 32) * 64, (r % 32) * 32, (bf16*)(ws + WS_PB), 256, (r % 32) * 32, scr, C.lane); continue; } r -= I_PB;
        if (r < 2 * I_E13) { const int sel = r / I_E13; r -= sel * I_E13; const int e = r / 256, q = r % 256, kb = q / 16, nb = q % 16, n0 = nb * 32;
            tr_item_i8(C.inp(sel ? I_MOE_W3 : I_MOE_W1) + ((size_t)l * NEXP + e) * D * EFF, EFF, kb * 64, n0, ws + WS_W13 + (size_t)e * D * D, D, (n0 / 128) * 256 + (n0 % 128) + sel * 128, (const unsigned*)(ws + WS_CTL) + CW_WMAX13 + (l * NEXP + e) * 1024, scr, C.lane); continue; }
        r -= 2 * I_E13;
        { const int e = r / 256, q = r % 256, kb = q / 32, nb = q % 32;
            tr_item(C.inp(I_MOE_W2) + ((size_t)l * NEXP + e) * EFF * D, D, kb * 64, nb * 32, (bf16*)(ws + WS_W2) + (size_t)e * D * EFF, EFF, nb * 32, scr, C.lane); }
    }
    const int gt = C.bid * 512 + C.tid, ngt = C.G * 512;
    if (l == 1) { u32 zz_ = 0u; asm volatile("" : "+v"(zz_));
        for (int i = gt; i < 224 * 64; i += ngt) *(u32x4*)(ws + WS_WIN + (size_t)(10784 + i / 64) * D + (i % 64) * 16) = (u32x4){zz_, zz_, zz_, zz_}; }
    for (int i = gt; i < LORA_N * (LORA_K / 8); i += ngt) {
        const int n = i % LORA_N, k8 = i / LORA_N, sec = n >> 10, nn = n & 1023; float v[8];
#pragma unroll
        for (int e = 0; e < 8; ++e) { const int k = k8 * 8 + e; float x = 0.f;
            if (sec == 0) { if (k < 64) x = C.inp(I_W_DECAY2)[((size_t)l * 64 + k) * D + nn]; }
            else if (sec == 1) { if (k >= 64 && k < 128) x = C.inp(I_A2)[((size_t)l * 64 + (k - 64)) * D + nn]; }
            else if (sec == 2) { if (k >= 128 && k < 256) x = C.inp(I_G2)[((size_t)l * 128 + (k - 128)) * D + nn]; }
            else { if (l == 1 && k >= 256 && k < 288) x = C.inp(I_VRES_W2)[(size_t)(k - 256) * D + nn]; }
            v[e] = x; }
        u32x4 o; o.x = cvt_pk_bf16(v[0], v[1]); o.y = cvt_pk_bf16(v[2], v[3]); o.z = cvt_pk_bf16(v[4], v[5]); o.w = cvt_pk_bf16(v[6], v[7]);
        *(u32x4*)((bf16*)(ws + WS_LORAB) + (size_t)n * LORA_K + k8 * 8) = o;
    }
    for (int i = gt; i < 8 * 128 * 16; i += ngt) { const int s8 = i & 15, t = (i >> 4) & 127, g = i >> 11; const float* src = C.inp(I_SGU_WS) + (((size_t)l * 8 + g) * 128 + t) * 128 + s8 * 8; float v[8];
#pragma unroll
        for (int e = 0; e < 8; ++e) v[e] = (s8 * 8 + e <= t) ? src[e] : 0.f;
        u32x4 o; o.x = cvt_pk_bf16(v[0], v[1]); o.y = cvt_pk_bf16(v[2], v[3]); o.z = cvt_pk_bf16(v[4], v[5]); o.w = cvt_pk_bf16(v[6], v[7]);
        *(u32x4*)((bf16*)(ws + WS_WSC) + (size_t)i * 8) = o; }
    for (int i = gt; i < 48 * (D / 8); i += ngt) { const int e = i / (D / 8), k8 = i % (D / 8); u32 hi[4], lo[4]; float h2[8], l2[8];
#pragma unroll
        for (int q = 0; q < 8; ++q) { const int k = k8 * 8 + q; float w = 0.f;
            if (e < 4) w = C.inp(I_RGRP)[((size_t)l * D + k) * 4 + e]; else if (e < 36) w = C.inp(I_REXP)[((size_t)l * D + k) * 32 + (e - 4)];
            w *= C.inp(I_NORM_FFN)[(size_t)l * D + k];
            const float wh = bf2f(f2bf(w)); h2[q] = wh; l2[q] = w - wh; }
#pragma unroll
        for (int q = 0; q < 4; ++q) { hi[q] = cvt_pk_bf16(h2[2 * q], h2[2 * q + 1]); lo[q] = cvt_pk_bf16(l2[2 * q], l2[2 * q + 1]); }
        *(u32x4*)((bf16*)(ws + WS_WSC + 512 * 1024) + (size_t)e * D + k8 * 8) = (u32x4){hi[0], hi[1], hi[2], hi[3]};
        *(u32x4*)((bf16*)(ws + WS_WSC + 640 * 1024) + (size_t)e * D + k8 * 8) = (u32x4){lo[0], lo[1], lo[2], lo[3]}; }
    if (first) for (int i = gt; i < T * 32; i += ngt) { const int t = i >> 5, f = i & 31;
        double invd = 1.0; for (int q = 0; q < f; ++q) invd *= 0.74989420933245582;
        const float inv = (float)invd;
        const float ang = (float)t * inv;
        double rev = (double)ang * 0.15915494309189535; rev -= __builtin_rint(rev);
        const float rv = (float)rev;
        ((f32x2*)(ws + WS_ROPE))[i] = (f32x2){__builtin_amdgcn_cosf(rv), __builtin_amdgcn_sinf(rv)}; }
}

__device__ __forceinline__ void row_load(const float* p, int lane, f32x4 (&v)[4]) {
#pragma unroll
    for (int j = 0; j < 4; ++j) v[j] = ((const f32x4*)p)[lane + 64 * j];
}
__device__ __forceinline__ float row_ss(const f32x4 (&v)[4]) {
    float s = 0.f;
#pragma unroll
    for (int j = 0; j < 4; ++j) s += (v[j].x * v[j].x + v[j].y * v[j].y) + (v[j].z * v[j].z + v[j].w * v[j].w);
    return wave_sum(s);
}
__device__ __forceinline__ void norm2_rows(const float* xsrc, const float* g, bf16* out, int gw, int ngw, int lane) {
    f32x4 gv[4];
#pragma unroll
    for (int j = 0; j < 4; ++j) gv[j] = ((const f32x4*)g)[lane + 64 * j];
    for (int ml = gw; ml < M; ml += 2 * ngw) { const int m2 = ml + ngw; const bool has2 = m2 < M; const int mb = has2 ? m2 : ml;
        f32x4 va[4], vb[4]; row_load(xsrc + (size_t)ml * D, lane, va); row_load(xsrc + (size_t)mb * D, lane, vb);
        const float ra = __builtin_amdgcn_rsqf(row_ss(va) * (1.f / D) + 1e-6f), rb = __builtin_amdgcn_rsqf(row_ss(vb) * (1.f / D) + 1e-6f);
#pragma unroll
        for (int j = 0; j < 4; ++j) { const f32x4 oa = va[j] * ra * gv[j]; ((u32x2*)(out + (size_t)ml * D))[lane + 64 * j] = (u32x2){cvt_pk_bf16(oa.x, oa.y), cvt_pk_bf16(oa.z, oa.w)}; }
        if (has2) {
#pragma unroll
            for (int j = 0; j < 4; ++j) { const f32x4 ob = vb[j] * rb * gv[j]; ((u32x2*)(out + (size_t)m2 * D))[lane + 64 * j] = (u32x2){cvt_pk_bf16(ob.x, ob.y), cvt_pk_bf16(ob.z, ob.w)}; } } }
}
__device__ __forceinline__ float wave_max(float v) {
#pragma unroll
    for (int o = 1; o < 64; o <<= 1) v = fmaxf(v, __shfl_xor(v, o));
    return v;
}
__device__ __forceinline__ void norm_q8_store(f32x4 (&v)[4], const f32x4 (&gv)[4], float r, unsigned char* orow, float* rsp, int lane) {
    float mx = 0.f;
#pragma unroll
    for (int j = 0; j < 4; ++j) { v[j] = v[j] * r * gv[j]; const f32x4 a = __builtin_elementwise_abs(v[j]); mx = fmaxf(mx, fmaxf(fmaxf(a.x, a.y), fmaxf(a.z, a.w))); }
    mx = fmaxf(wave_max(mx), 1e-20f);
    const float sc = 127.f / mx;
#pragma unroll
    for (int j = 0; j < 4; ++j) { const u32 q0 = (u32)(int)__builtin_rintf(v[j].x * sc) & 255u, q1 = (u32)(int)__builtin_rintf(v[j].y * sc) & 255u, q2 = (u32)(int)__builtin_rintf(v[j].z * sc) & 255u, q3 = (u32)(int)__builtin_rintf(v[j].w * sc);
        ((u32*)orow)[lane + 64 * j] = q0 | (q1 << 8) | (q2 << 16) | (q3 << 24); }
    if (lane == 0) *rsp = mx * (1.f / 127.f);
}
__device__ __forceinline__ void norm2_rows_i8(const float* xsrc, const float* g, unsigned char* out8, float* rs, int gw, int ngw, int lane) {
    f32x4 gv[4];
#pragma unroll
    for (int j = 0; j < 4; ++j) gv[j] = ((const f32x4*)g)[lane + 64 * j];
    for (int ml = gw; ml < M; ml += 2 * ngw) { const int m2 = ml + ngw; const bool has2 = m2 < M; const int mb = has2 ? m2 : ml;
        f32x4 va[4], vb[4]; row_load(xsrc + (size_t)ml * D, lane, va); row_load(xsrc + (size_t)mb * D, lane, vb);
        const float ra = __builtin_amdgcn_rsqf(row_ss(va) * (1.f / D) + 1e-6f), rb = __builtin_amdgcn_rsqf(row_ss(vb) * (1.f / D) + 1e-6f);
        norm_q8_store(va, gv, ra, out8 + (size_t)ml * D, rs + ml, lane);
        if (has2) norm_q8_store(vb, gv, rb, out8 + (size_t)m2 * D, rs + m2, lane); }
}
__device__ __forceinline__ void row_add_moe(const Ctx& C, int ml, f32x4 (&v)[4], const LAS int* tb) {
#ifdef DBG_NOMOE
    return;
#endif
    const int* tk = (const int*)(C.ws + WS_TOK) + 4 * ml; const float* wt = (const float*)(C.ws + WS_TOK + 512 * 1024) + 2 * ml;
    const int d0 = tb[tk[0]] * 256 + tk[1], d1 = tb[tk[2]] * 256 + tk[3]; const float w0 = wt[0], w1 = wt[1];
    const bf16* y0 = (const bf16*)(C.ws + WS_R1 + R1_YEXP) + (size_t)d0 * D; const bf16* y1 = (const bf16*)(C.ws + WS_R1 + R1_YEXP) + (size_t)d1 * D;
#pragma unroll
    for (int j = 0; j < 4; ++j) { const u32x2 a = ((const u32x2*)y0)[C.lane + 64 * j], b = ((const u32x2*)y1)[C.lane + 64 * j];
        v[j].x += w0 * bflo(a.x) + w1 * bflo(b.x); v[j].y += w0 * bfhi(a.x) + w1 * bfhi(b.x); v[j].z += w0 * bflo(a.y) + w1 * bflo(b.y); v[j].w += w0 * bfhi(a.y) + w1 * bfhi(b.y); }
}

__device__ __forceinline__ void mixer_norm(const Ctx& C, int it, int widx, int nw) {
    const int l = it / NCH, c = it % NCH;
    norm2_rows_i8((l == 0 ? C.inp(I_X) : C.out) + (size_t)c * M * D, C.inp(I_NORM_MIX) + (size_t)l * D, C.ws + WS_R1 + R1_HNX, (float*)(C.ws + WS_R1 + R1_HNX + HNX_RS), widx, nw, C.lane);
}
__device__ __forceinline__ void moe_table(const Ctx& C, int it, LAS int* tb);
__device__ __forceinline__ void phase_prep(const Ctx& C0, int it, LAS int* tb) {
    const Ctx C = launder(C0);
    if (it > 0) moe_table(C, it - 1, tb);
    const int l = it / NCH, c = it % NCH;
    if (it > 0) {
        const int pl = (it - 1) / NCH, pc = (it - 1) % NCH; const float* nf = C.inp(I_NORM_FINAL);
        const int* tkb = (const int*)(C.ws + WS_TOK); const float* wtb = (const float*)(C.ws + WS_TOK + 512 * 1024); const bf16* yex = (const bf16*)(C.ws + WS_R1 + R1_YEXP);
        int t0 = 0, t1 = 0, t2 = 0, t3 = 0; float w0 = 0.f, w1 = 0.f;
        if (C.gw < M) { const int* tk = tkb + 4 * C.gw; t0 = tk[0]; t1 = tk[1]; t2 = tk[2]; t3 = tk[3]; w0 = wtb[2 * C.gw]; w1 = wtb[2 * C.gw + 1]; }
        for (int ml = C.gw; ml < M; ml += C.ngw) { float* xr = C.out + ((size_t)pc * M + ml) * D; f32x4 v[4];
            const int d0 = tb[t0] * 256 + t1, d1 = tb[t2] * 256 + t3; const float cw0 = w0, cw1 = w1;
            { const int mn = (ml + C.ngw < M) ? ml + C.ngw : ml; const int* tk = tkb + 4 * mn; t0 = tk[0]; t1 = tk[1]; t2 = tk[2]; t3 = tk[3]; w0 = wtb[2 * mn]; w1 = wtb[2 * mn + 1]; }
            row_load(xr, C.lane, v);
            { const bf16* y0 = yex + (size_t)d0 * D; const bf16* y1 = yex + (size_t)d1 * D;
#pragma unroll
              for (int j = 0; j < 4; ++j) { const u32x2 a = ((const u32x2*)y0)[C.lane + 64 * j], b = ((const u32x2*)y1)[C.lane + 64 * j];
                  v[j].x += cw0 * bflo(a.x) + cw1 * bflo(b.x); v[j].y += cw0 * bfhi(a.x) + cw1 * bfhi(b.x); v[j].z += cw0 * bflo(a.y) + cw1 * bflo(b.y); v[j].w += cw0 * bfhi(a.y) + cw1 * bfhi(b.y); } }
            if (pl == 1) { const float rs = __builtin_amdgcn_rsqf(row_ss(v) * (1.f / D) + 1e-6f);
#pragma unroll
                for (int j = 0; j < 4; ++j) v[j] = v[j] * rs * ((const f32x4*)nf)[C.lane + 64 * j]; }
#pragma unroll
            for (int j = 0; j < 4; ++j) ((f32x4*)xr)[C.lane + 64 * j] = v[j]; }
    }
    if (it == 0) mixer_norm(C, 0, C.gw, C.ngw);
}

__device__ __forceinline__ void sub_lora_prep(const Ctx& C0, int l) {
    const Ctx C = launder(C0);
    const bf16* za = (const bf16*)(C.ws + WS_R2 + R2_ZA); const bf16* vlo = (const bf16*)(C.ws + WS_VLO); bf16* al = (bf16*)(C.ws + WS_R1 + R1_ALORA);
    const float* mu = C.inp(I_MU_A) + (size_t)l * A_COLS + 3072; const float* vmu = C.inp(I_VRES_MU);
    const int gt = C.bid * 512 + C.tid, ngt = C.G * 512;
    for (int i = gt; i < M * 48; i += ngt) { const int ml = i / 48, k8 = i % 48; const int t = ml & (T - 1); float v[8];
        if (k8 < 32) { const u32x4 cur = *(const u32x4*)(za + (size_t)ml * A_COLS + 3072 + k8 * 8); u32x4 prv = (u32x4){0u, 0u, 0u, 0u};
            if (t > 0) prv = *(const u32x4*)(za + (size_t)(ml - 1) * A_COLS + 3072 + k8 * 8);
            const u32 cw[4] = {cur.x, cur.y, cur.z, cur.w}, pw[4] = {prv.x, prv.y, prv.z, prv.w};
#pragma unroll
            for (int e = 0; e < 8; ++e) { const float zc = (e & 1) ? bfhi(cw[e >> 1]) : bflo(cw[e >> 1]), zp = (e & 1) ? bfhi(pw[e >> 1]) : bflo(pw[e >> 1]);
                float x = zc + (zp - zc) * mu[k8 * 8 + e];
                if (k8 < 8) x = 1.f - 2.f * __builtin_amdgcn_rcpf(__expf(2.f * x) + 1.f);
                else if (k8 >= 16) x = sigmoidf_(x);
                v[e] = x; }
        } else if (k8 < 36 && l == 1) { const int c8 = k8 - 32; const u32x4 cur = *(const u32x4*)(vlo + (size_t)ml * 32 + c8 * 8); u32x4 prv = (u32x4){0u, 0u, 0u, 0u};
            if (t > 0) prv = *(const u32x4*)(vlo + (size_t)(ml - 1) * 32 + c8 * 8);
            const u32 cw[4] = {cur.x, cur.y, cur.z, cur.w}, pw[4] = {prv.x, prv.y, prv.z, prv.w};
#pragma unroll
            for (int e = 0; e < 8; ++e) { const float zc = (e & 1) ? bfhi(cw[e >> 1]) : bflo(cw[e >> 1]), zp = (e & 1) ? bfhi(pw[e >> 1]) : bflo(pw[e >> 1]);
                v[e] = zc + (zp - zc) * vmu[c8 * 8 + e]; }
        } else {
#pragma unroll
            for (int e = 0; e < 8; ++e) v[e] = 0.f;
        }
        u32x4 o; o.x = cvt_pk_bf16(v[0], v[1]); o.y = cvt_pk_bf16(v[2], v[3]); o.z = cvt_pk_bf16(v[4], v[5]); o.w = cvt_pk_bf16(v[6], v[7]);
        *(u32x4*)(al + (size_t)ml * LORA_K + k8 * 8) = o; }
}

__device__ __forceinline__ void sub_gmlp(const Ctx& C0, int l) {
    const Ctx C = launder(C0);
    const bf16* zc = (const bf16*)(C.ws + WS_R1 + R1_ZC); bf16* yc = (bf16*)(C.ws + WS_YC); const bf16* wsc = (const bf16*)(C.ws + WS_WSC);
    const float* lnw = C.inp(I_SGU_LN_W) + (size_t)l * D; const float* lnb = C.inp(I_SGU_LN_B) + (size_t)l * D; const float* bs = C.inp(I_SGU_BS) + (size_t)l * 8 * 128;
    LAS bf16* VT = (LAS bf16*)C.lds;
    LAS float* ST = (LAS float*)(C.lds + 40960);
    const int lane = C.lane, w = C.wave;
    for (int u = C.bid; u < 256; u += C.G) {
        const int nloc = u >> 1, gq = u & 1; const int r0 = nloc * 128;
#pragma unroll 1
        for (int tb4 = 0; tb4 < 4; ++tb4) { u32x4 ra[4], rb4[4]; float s1[4], s2[4];
#pragma unroll
            for (int q4 = 0; q4 < 4; ++q4) { const bf16* vr = zc + (size_t)(r0 + 16 * w + 4 * tb4 + q4) * C_COLS + 1024; ra[q4] = ((const u32x4*)vr)[lane]; rb4[q4] = ((const u32x4*)vr)[lane + 64]; }
#pragma unroll
            for (int q4 = 0; q4 < 4; ++q4) { const u32 q[8] = {ra[q4].x, ra[q4].y, ra[q4].z, ra[q4].w, rb4[q4].x, rb4[q4].y, rb4[q4].z, rb4[q4].w}; float a = 0.f, b = 0.f;
#pragma unroll
                for (int e = 0; e < 8; ++e) { const float x0 = bflo(q[e]), x1 = bfhi(q[e]); a += x0 + x1; b += x0 * x0 + x1 * x1; }
                s1[q4] = a; s2[q4] = b; }
#pragma unroll
            for (int o = 1; o < 64; o <<= 1) {
#pragma unroll
                for (int q4 = 0; q4 < 4; ++q4) { const float t1 = __shfl_xor(s1[q4], o), t2 = __shfl_xor(s2[q4], o); s1[q4] += t1; s2[q4] += t2; } }
            if (lane == 0) {
#pragma unroll
                for (int q4 = 0; q4 < 4; ++q4) { const int tk = 16 * w + 4 * tb4 + q4; const float mean = s1[q4] * (1.f / 1024.f); const float var = fmaxf(s2[q4] * (1.f / 1024.f) - mean * mean, 0.f);
                    ST[2 * tk] = mean; ST[2 * tk + 1] = __builtin_amdgcn_rsqf(var + 1e-5f); } } }
        __syncthreads();
        u32x4 gr[4];
#define GM_ISSUE(g_) do { _Pragma("unroll") for (int p_ = 0; p_ < 4; ++p_) { const int idx_ = C.tid + 512 * p_; gr[p_] = *(const u32x4*)(zc + (size_t)(r0 + (idx_ >> 4)) * C_COLS + 1024 + (g_) * 128 + (idx_ & 15) * 8); } } while (0)
        GM_ISSUE(gq * 4);
        for (int gi = 0; gi < 4; ++gi) { const int g = gq * 4 + gi;
#pragma unroll
            for (int p = 0; p < 4; ++p) { const int idx = C.tid + 512 * p; const int tk = idx >> 4, c8 = idx & 15;
                const u32 q[4] = {gr[p].x, gr[p].y, gr[p].z, gr[p].w};
                const float mean = ST[2 * tk], rstd = ST[2 * tk + 1];
#pragma unroll
                for (int e = 0; e < 8; ++e) { const int cc = c8 * 8 + e; const float x = (e & 1) ? bfhi(q[e >> 1]) : bflo(q[e >> 1]);
                    const float y = (x - mean) * rstd * lnw[g * 128 + cc] + lnb[g * 128 + cc];
                    VT[cc * 136 + ((((tk >> 3) + c8) & 15) << 3) + (tk & 7)] = (bf16)f2bf(y); } }
            asm volatile("" ::: "memory");
            if (gi < 3) GM_ISSUE(g + 1);
            __syncthreads();
            const int ct = w & 3, th = w >> 2;
#pragma unroll 1
            for (int tq = 0; tq < 2; ++tq) { const int tau = 2 * th + tq; f32x16 acc;
#pragma unroll
                for (int e = 0; e < 16; ++e) acc[e] = 0.f;
                const int nks = 2 * tau + 2; const int crow = ct * 32 + (lane & 31); const bf16* wrow = wsc + ((size_t)g * 128 + tau * 32 + (lane & 31)) * 128 + (lane >> 5) * 8;
                bf16x8 bb[8];
#pragma unroll
                for (int ks = 0; ks < 8; ++ks) if (ks < nks) bb[ks] = *(const bf16x8*)(wrow + ks * 16);
#pragma unroll
                for (int ks = 0; ks < 8; ++ks) if (ks < nks) { const int s0 = ks * 16 + (lane >> 5) * 8;
                    const bf16x8 a = *(const LAS bf16x8*)(VT + crow * 136 + ((((s0 >> 3) + (crow >> 3)) & 15) << 3));
                    acc = __builtin_amdgcn_mfma_f32_32x32x16_bf16(a, bb[ks], acc, 0, 0, 0); }
                const int tk = tau * 32 + (lane & 31); const float bsv = bs[g * 128 + tk];
                const bf16* ur = zc + (size_t)(r0 + tk) * C_COLS + g * 128 + ct * 32; bf16* yr = yc + (size_t)(r0 + tk) * D + g * 128 + ct * 32;
#pragma unroll
                for (int rq = 0; rq < 4; ++rq) { const int cb = 8 * rq + 4 * (lane >> 5); const u32x2 uu = *(const u32x2*)(ur + cb);
                    const float o0 = bflo(uu.x) * (acc[4 * rq + 0] + bsv), o1 = bfhi(uu.x) * (acc[4 * rq + 1] + bsv), o2 = bflo(uu.y) * (acc[4 * rq + 2] + bsv), o3 = bfhi(uu.y) * (acc[4 * rq + 3] + bsv);
                    *(u32x2*)(yr + cb) = (u32x2){cvt_pk_bf16(o0, o1), cvt_pk_bf16(o2, o3)}; } }
            __syncthreads();
        }
    }
}

__device__ __forceinline__ void sub_attn(const Ctx& C0) {
    const Ctx C = launder(C0);
    const bf16* zb = (const bf16*)(C.ws + WS_R1 + R1_ZB); bf16* og = (bf16*)(C.ws + WS_R1 + R1_OG); float* lse = (float*)(C.ws + WS_LSE); const f32x2* rope = (const f32x2*)(C.ws + WS_ROPE);
    LAS bf16* Qs = (LAS bf16*)C.lds;
    LAS bf16* Ks = (LAS bf16*)(C.lds + 18432);
    LAS bf16* Vs = (LAS bf16*)(C.lds + 18432 + 36864);
    const int lane = C.lane, w = C.wave, fr = lane & 15, fq = lane >> 4;
    u32x4 rqa, rqb, rka[2], rkb[2], rv[4];
#define AT_DECODE(u_, bl_, hd_, gi_, d_, r_, n_) const int bl_ = (u_) / 768, rem_##bl_ = (u_) % 768, hd_ = rem_##bl_ / 64, blk_##bl_ = rem_##bl_ % 64; \
        const int gi_ = hd_ >> 2, d_ = (gi_ == 0) ? 1 : (gi_ == 1 ? 4 : 16), nb_##bl_ = 64 / d_, r_ = blk_##bl_ / nb_##bl_, n_ = blk_##bl_ % nb_##bl_
#define AT_ISSUE(u_) do { AT_DECODE(u_, xbl, xhd, xgi, xd, xr, xn); const int rb_ = xbl * T; const u32x4 z4_ = (u32x4){0u, 0u, 0u, 0u}; \
        { const int row_ = C.tid >> 2, c0_ = (C.tid & 3) * 8; const int t_ = (128 * xn + row_) * xd + xr; const bf16* s_ = zb + (size_t)(rb_ + t_) * B_COLS + xhd * 64; rqa = *(const u32x4*)(s_ + c0_); rqb = *(const u32x4*)(s_ + 32 + c0_); } \
        _Pragma("unroll") for (int p_ = 0; p_ < 2; ++p_) { const int row_ = (C.tid >> 2) + 128 * p_, c0_ = (C.tid & 3) * 8; const int ms_ = 128 * (xn - 1) + row_; rka[p_] = z4_; rkb[p_] = z4_; \
            if (ms_ >= 0) { const int t_ = ms_ * xd + xr; const bf16* s_ = zb + (size_t)(rb_ + t_) * B_COLS + 768 + xhd * 64; rka[p_] = *(const u32x4*)(s_ + c0_); rkb[p_] = *(const u32x4*)(s_ + 32 + c0_); } } \
        _Pragma("unroll") for (int p_ = 0; p_ < 4; ++p_) { const int idx_ = C.tid + 512 * p_; const int row_ = idx_ >> 3, c8_ = idx_ & 7; const int ms_ = 128 * (xn - 1) + row_; rv[p_] = z4_; \
            if (ms_ >= 0) { const int t_ = ms_ * xd + xr; rv[p_] = *(const u32x4*)(zb + (size_t)(rb_ + t_) * B_COLS + 1536 + xhd * 64 + c8_ * 8); } } } while (0)
    if (C.bid < 1536) AT_ISSUE(C.bid);
    for (int u = C.bid; u < 1536; u += C.G) {
        AT_DECODE(u, bl, hd, gi, d, r, n);
        const int rowbase = bl * T;
        { const int row = C.tid >> 2, c0 = (C.tid & 3) * 8; const int t = (128 * n + row) * d + r;
            const u32 qa[4] = {rqa.x, rqa.y, rqa.z, rqa.w}, qb[4] = {rqb.x, rqb.y, rqb.z, rqb.w}; float o1[8], o2[8];
#pragma unroll
            for (int e = 0; e < 8; ++e) { const f32x2 cs = rope[t * 32 + c0 + e]; const float z1 = (e & 1) ? bfhi(qa[e >> 1]) : bflo(qa[e >> 1]), z2 = (e & 1) ? bfhi(qb[e >> 1]) : bflo(qb[e >> 1]);
                o1[e] = (z1 * cs.x - z2 * cs.y) * 0.125f; o2[e] = (z1 * cs.y + z2 * cs.x) * 0.125f; }
            *(LAS u32x4*)(Qs + row * 72 + c0) = (u32x4){cvt_pk_bf16(o1[0], o1[1]), cvt_pk_bf16(o1[2], o1[3]), cvt_pk_bf16(o1[4], o1[5]), cvt_pk_bf16(o1[6], o1[7])};
            *(LAS u32x4*)(Qs + row * 72 + 32 + c0) = (u32x4){cvt_pk_bf16(o2[0], o2[1]), cvt_pk_bf16(o2[2], o2[3]), cvt_pk_bf16(o2[4], o2[5]), cvt_pk_bf16(o2[6], o2[7])}; }
#pragma unroll
        for (int p = 0; p < 2; ++p) { const int row = (C.tid >> 2) + 128 * p, c0 = (C.tid & 3) * 8; const int ms = 128 * (n - 1) + row; u32x4 oa = (u32x4){0u, 0u, 0u, 0u}, ob = oa;
            if (ms >= 0) { const int t = ms * d + r;
                const u32 qa[4] = {rka[p].x, rka[p].y, rka[p].z, rka[p].w}, qb[4] = {rkb[p].x, rkb[p].y, rkb[p].z, rkb[p].w}; float o1[8], o2[8];
#pragma unroll
                for (int e = 0; e < 8; ++e) { const f32x2 cs = rope[t * 32 + c0 + e]; const float z1 = (e & 1) ? bfhi(qa[e >> 1]) : bflo(qa[e >> 1]), z2 = (e & 1) ? bfhi(qb[e >> 1]) : bflo(qb[e >> 1]);
                    o1[e] = z1 * cs.x - z2 * cs.y; o2[e] = z1 * cs.y + z2 * cs.x; }
                oa = (u32x4){cvt_pk_bf16(o1[0], o1[1]), cvt_pk_bf16(o1[2], o1[3]), cvt_pk_bf16(o1[4], o1[5]), cvt_pk_bf16(o1[6], o1[7])};
                ob = (u32x4){cvt_pk_bf16(o2[0], o2[1]), cvt_pk_bf16(o2[2], o2[3]), cvt_pk_bf16(o2[4], o2[5]), cvt_pk_bf16(o2[6], o2[7])}; }
            *(LAS u32x4*)(Ks + row * 72 + c0) = oa; *(LAS u32x4*)(Ks + row * 72 + 32 + c0) = ob; }
#pragma unroll
        for (int p = 0; p < 4; ++p) { const int idx = C.tid + 512 * p; const int row = idx >> 3, c8 = idx & 7;
            *(LAS u32x4*)(Vs + row * 72 + c8 * 8) = rv[p]; }
        asm volatile("" ::: "memory");
        if (u + C.G < 1536) AT_ISSUE(u + C.G);
        __syncthreads();
        f32x4 sc[9];
        { const bf16x8 q0 = *(const LAS bf16x8*)(Qs + (16 * w + fr) * 72 + fq * 8), q1 = *(const LAS bf16x8*)(Qs + (16 * w + fr) * 72 + 32 + fq * 8);
#pragma unroll
            for (int ti = 0; ti < 9; ++ti) { const int kr = 16 * w + 16 * ti + fr;
                const bf16x8 k0 = *(const LAS bf16x8*)(Ks + kr * 72 + fq * 8), k1 = *(const LAS bf16x8*)(Ks + kr * 72 + 32 + fq * 8);
                f32x4 a = (f32x4){0.f, 0.f, 0.f, 0.f};
                a = __builtin_amdgcn_mfma_f32_16x16x32_bf16(k0, q0, a, 0, 0, 0); a = __builtin_amdgcn_mfma_f32_16x16x32_bf16(k1, q1, a, 0, 0, 0); sc[ti] = a; } }
        float mx = -3.0e38f;
#pragma unroll
        for (int ti = 0; ti < 9; ++ti)
#pragma unroll
            for (int e = 0; e < 4; ++e) { const int rel = 16 * ti + 4 * fq + e; const bool ok = (rel >= fr) && (rel <= fr + 128) && (n > 0 || (16 * w + rel) >= 128);
                sc[ti][e] = ok ? sc[ti][e] : -3.0e38f; mx = fmaxf(mx, sc[ti][e]); }
        mx = fmaxf(mx, __shfl_xor(mx, 16)); mx = fmaxf(mx, __shfl_xor(mx, 32));
        float sum = 0.f;
#pragma unroll
        for (int ti = 0; ti < 9; ++ti)
#pragma unroll
            for (int e = 0; e < 4; ++e) { const float p = __expf(sc[ti][e] - mx); sc[ti][e] = p; sum += p; }
        sum += __shfl_xor(sum, 16); sum += __shfl_xor(sum, 32);
        f32x4 oacc[4];
#pragma unroll
        for (int ct = 0; ct < 4; ++ct) oacc[ct] = (f32x4){0.f, 0.f, 0.f, 0.f};
#pragma unroll
        for (int kp = 0; kp < 5; ++kp) { const int t0 = 2 * kp, t1 = (2 * kp + 1 < 9) ? 2 * kp + 1 : 8;
            u32x4 pw; pw.x = cvt_pk_bf16(sc[t0][0], sc[t0][1]); pw.y = cvt_pk_bf16(sc[t0][2], sc[t0][3]);
            if (2 * kp + 1 < 9) { pw.z = cvt_pk_bf16(sc[t1][0], sc[t1][1]); pw.w = cvt_pk_bf16(sc[t1][2], sc[t1][3]); } else { pw.z = 0u; pw.w = 0u; }
            const bf16x8 pb = __builtin_bit_cast(bf16x8, pw);
            const int k0 = 16 * w + 16 * t0 + 4 * fq, k1 = 16 * w + 16 * t1 + 4 * fq;
#pragma unroll
            for (int ct = 0; ct < 4; ++ct) {
                const u32x2 va = lds_tr16(Vs + (k0 + (fr >> 2)) * 72 + ct * 16 + 4 * (fr & 3)), vb = lds_tr16(Vs + (k1 + (fr >> 2)) * 72 + ct * 16 + 4 * (fr & 3));
                const bf16x8 av = __builtin_bit_cast(bf16x8, (u32x4){va.x, va.y, vb.x, vb.y});
                oacc[ct] = __builtin_amdgcn_mfma_f32_16x16x32_bf16(av, pb, oacc[ct], 0, 0, 0); } }
        { const float inv = __builtin_amdgcn_rcpf(sum); const int t = (128 * n + 16 * w + fr) * d + r; const size_t ml = (size_t)(rowbase + t);
            bf16* orow = og + ((size_t)gi * M + ml) * 256 + (hd & 3) * 64;
#pragma unroll
            for (int ct = 0; ct < 4; ++ct) *(u32x2*)(orow + ct * 16 + 4 * fq) = (u32x2){cvt_pk_bf16(oacc[ct][0] * inv, oacc[ct][1] * inv), cvt_pk_bf16(oacc[ct][2] * inv, oacc[ct][3] * inv)};
            if (fq == 0) lse[((size_t)gi * M + ml) * 4 + (hd & 3)] = mx + __logf(sum); }
        __syncthreads();
    }
}

__device__ __forceinline__ void sub_yb_combine(const Ctx& C0) {
    const Ctx C = launder(C0);
    const bf16* og = (const bf16*)(C.ws + WS_R1 + R1_OG); const float* lse = (const float*)(C.ws + WS_LSE); bf16* yb = (bf16*)(C.ws + WS_YB);
    const int gt = C.bid * 512 + C.tid, ngt = C.G * 512;
    for (int i = gt; i < M * 32; i += ngt) { const int ml = i >> 5, c8 = i & 31, hp = c8 >> 3;
        const float l0 = lse[((size_t)0 * M + ml) * 4 + hp], l1 = lse[((size_t)1 * M + ml) * 4 + hp], l2 = lse[((size_t)2 * M + ml) * 4 + hp];
        const float mx = fmaxf(l0, fmaxf(l1, l2)); float w0 = __expf(l0 - mx), w1 = __expf(l1 - mx), w2 = __expf(l2 - mx); const float inv = __builtin_amdgcn_rcpf(w0 + w1 + w2); w0 *= inv; w1 *= inv; w2 *= inv;
        const u32x4 a = *(const u32x4*)(og + ((size_t)0 * M + ml) * 256 + c8 * 8), b = *(const u32x4*)(og + ((size_t)1 * M + ml) * 256 + c8 * 8), c = *(const u32x4*)(og + ((size_t)2 * M + ml) * 256 + c8 * 8);
        const u32 qa[4] = {a.x, a.y, a.z, a.w}, qb[4] = {b.x, b.y, b.z, b.w}, qc[4] = {c.x, c.y, c.z, c.w}; u32 o[4];
#pragma unroll
        for (int e = 0; e < 4; ++e) o[e] = cvt_pk_bf16(w0 * bflo(qa[e]) + w1 * bflo(qb[e]) + w2 * bflo(qc[e]), w0 * bfhi(qa[e]) + w1 * bfhi(qb[e]) + w2 * bfhi(qc[e]));
        *(u32x4*)(yb + (size_t)ml * 256 + c8 * 8) = (u32x4){o[0], o[1], o[2], o[3]}; }
}

__device__ __forceinline__ void ld8(const bf16* p, float (&v)[8]) { const u32x4 a = *(const u32x4*)p; v[0] = bflo(a.x); v[1] = bfhi(a.x); v[2] = bflo(a.y); v[3] = bfhi(a.y); v[4] = bflo(a.z); v[5] = bfhi(a.z); v[6] = bflo(a.w); v[7] = bfhi(a.w); }
__device__ __forceinline__ void ldl8(const LAS float* p, float (&v)[8]) { const f32x4 a = *(const LAS f32x4*)p, b = *(const LAS f32x4*)(p + 4); v[0] = a.x; v[1] = a.y; v[2] = a.z; v[3] = a.w; v[4] = b.x; v[5] = b.y; v[6] = b.z; v[7] = b.w; }
__device__ __forceinline__ void ldf8(const float* p, float (&v)[8]) { const f32x4 a = *(const f32x4*)p, b = *(const f32x4*)(p + 4); v[0] = a.x; v[1] = a.y; v[2] = a.z; v[3] = a.w; v[4] = b.x; v[5] = b.y; v[6] = b.z; v[7] = b.w; }
constexpr int TS = 9216;
template <int KS, bool SW1, bool SW2>
__device__ __forceinline__ f32x16 mm_tile(const LAS bf16* t1, int r1, const LAS bf16* t2, int r2, f32x16 acc, int lane) {
    const int row1 = r1 + (lane & 31), row2 = r2 + (lane & 31), hb = lane >> 5;
    const LAS bf16* p1 = t1 + row1 * 72; const LAS bf16* p2 = t2 + row2 * 72; const int s1 = SW1 ? (row1 >> 3) : 0, s2 = SW2 ? (row2 >> 3) : 0;
#pragma unroll
    for (int ks = 0; ks < KS; ++ks) { const int cb = 2 * ks + hb;
        acc = __builtin_amdgcn_mfma_f32_32x32x16_bf16(*(const LAS bf16x8*)(p1 + ((cb + s1) & 7) * 8), *(const LAS bf16x8*)(p2 + ((cb + s2) & 7) * 8), acc, 0, 0, 0); }
    return acc;
}
__device__ __forceinline__ f32x16 zero16() { f32x16 a;
#pragma unroll
    for (int e = 0; e < 16; ++e) a[e] = 0.f;
    return a; }

__device__ __forceinline__ void phase_chunkpre(const Ctx& C0, int l, int c) {
    const Ctx C = launder(C0);
    LAS unsigned char* L = C.lds;
    LAS bf16* sA = (LAS bf16*)(L + 0 * TS);  LAS bf16* sR = (LAS bf16*)(L + 1 * TS);  LAS bf16* sB = (LAS bf16*)(L + 2 * TS);  LAS bf16* sK = (LAS bf16*)(L + 3 * TS);
    LAS bf16* sBhT = (LAS bf16*)(L + 4 * TS); LAS bf16* sKhT = (LAS bf16*)(L + 5 * TS); LAS bf16* sVT = (LAS bf16*)(L + 6 * TS); LAS bf16* sAT = (LAS bf16*)(L + 7 * TS);
    LAS bf16* sUT = (LAS bf16*)(L + 8 * TS); LAS bf16* sAab = (LAS bf16*)(L + 9 * TS);
    LAS bf16* sPT = (LAS bf16*)(L + 0 * TS);
    LAS bf16* sAak = (LAS bf16*)(L + 10 * TS); LAS bf16* sArb = (LAS bf16*)(L + 11 * TS); LAS bf16* sArk = (LAS bf16*)(L + 12 * TS);
    LAS float* TOT = (LAS float*)(L + 13 * TS);
    LAS bf16* TBB = (LAS bf16*)(L + 13 * TS + 2048);
    LAS float* WC = (LAS float*)(L + 13 * TS + 2048 + 4352);
    LAS float* PAR = (LAS float*)(L + 13 * TS + 2048 + 4352 + 256);
    LAS bf16* sZT = sB;
    const int tid = C.tid, w = C.wave;
    const bf16* ZAg = (const bf16*)(C.ws + WS_R2 + R2_ZA); const bf16* WPg = (const bf16*)(C.ws + WS_R4 + R4_WPRE); const bf16* APg = (const bf16*)(C.ws + WS_R4 + R4_APRE); const bf16* VRg = (const bf16*)(C.ws + WS_R4 + R4_VPRE);
    bf16* VFg = (bf16*)(C.ws + WS_VFIRST) + (size_t)c * M * D; bf16* VPg = (bf16*)(C.ws + WS_VP); float* BNg = (float*)(C.ws + WS_BONUS);
    bf16* YLg = (bf16*)(C.ws + WS_R1 + R1_YLOC); bf16* Qg = (bf16*)(C.ws + WS_R1 + R1_Q); bf16* MTg = (bf16*)(C.ws + WS_R1 + R1_MT); bf16* NCg = (bf16*)(C.ws + WS_R1 + R1_NC);
    const float* mu = C.inp(I_MU_A) + (size_t)l * A_COLS;
    u32x4 qr, qk, qv, qrp, qkp, qvp, qw, qa, qvr, qvf;
#define CP_ISSUE(u_) do { const int bh_ = (u_) / NCHK, ck_ = (u_) % NCHK; const size_t row_ = (size_t)(bh_ >> 4) * T + ck_ * CHK + (tid >> 3); const int chn_ = (bh_ & 15) * 64 + (tid & 7) * 8; \
        const bf16* z_ = ZAg + row_ * A_COLS + chn_; const bool hp_ = (ck_ * CHK + (tid >> 3)) > 0; const u32x4 zero_ = (u32x4){0u, 0u, 0u, 0u}; \
        qr = *(const u32x4*)z_; qk = *(const u32x4*)(z_ + 1024); qv = *(const u32x4*)(z_ + 2048); \
        qrp = hp_ ? *(const u32x4*)(z_ - A_COLS) : zero_; qkp = hp_ ? *(const u32x4*)(z_ - A_COLS + 1024) : zero_; qvp = hp_ ? *(const u32x4*)(z_ - A_COLS + 2048) : zero_; \
        qw = *(const u32x4*)(WPg + row_ * D + chn_); qa = *(const u32x4*)(APg + row_ * D + chn_); \
        if (l == 1) { qvr = *(const u32x4*)(VRg + row_ * D + chn_); qvf = *(const u32x4*)(VFg + row_ * D + chn_); } } while (0)
#define CP_UNPK(v_, q_) do { v_[0] = bflo(q_.x); v_[1] = bfhi(q_.x); v_[2] = bflo(q_.y); v_[3] = bfhi(q_.y); v_[4] = bflo(q_.z); v_[5] = bfhi(q_.z); v_[6] = bflo(q_.w); v_[7] = bfhi(q_.w); } while (0)
    qvr = qvf = (u32x4){0u, 0u, 0u, 0u};
    const int UPB = (32 * NCHK + C.G - 1) / C.G; const int u_lo = C.bid * UPB, u_hi = (u_lo + UPB < 32 * NCHK) ? u_lo + UPB : 32 * NCHK;
    if (u_lo < u_hi) CP_ISSUE(u_lo);
    int par_bh = -1;
#pragma unroll 1
    for (int unit = u_lo; unit < u_hi; ++unit) {
        const int bh = unit / NCHK, ck = unit % NCHK, bl = bh >> 4, h = bh & 15; const size_t row0 = (size_t)bl * T + ck * CHK;
        int lane = C.lane; asm volatile("" : "+v"(lane));
        if (bh != par_bh) { par_bh = bh; __syncthreads();
            for (int i = tid; i < 9 * 64; i += 512) { const int k9 = i >> 6, jj = i & 63, chn = h * 64 + jj; float v;
                if (k9 < 3) v = mu[k9 * 1024 + chn]; else if (k9 == 3) v = C.inp(I_W_DECAY0)[(size_t)l * D + chn]; else if (k9 == 4) v = C.inp(I_A0)[(size_t)l * D + chn];
                else if (k9 == 5) v = C.inp(I_K_K)[(size_t)l * D + chn]; else if (k9 == 6) v = C.inp(I_K_A)[(size_t)l * D + chn]; else if (k9 == 7) v = C.inp(I_R_K)[(size_t)l * D + chn];
                else v = (l == 1) ? C.inp(I_VRES_B)[chn] : 0.f;
                PAR[i] = v; }
            __syncthreads(); }
        { const int t = tid >> 3, o = tid & 7, j0 = o * 8; const int ch = h * 64 + j0; const size_t row = row0 + t;
          float lw[8], av[8], bv[8], kv[8], rv[8], vv[8], Lc[8];
          { float tmp[8], p[8], kk[8], aa[8];
            CP_UNPK(rv, qr); CP_UNPK(tmp, qrp); ldl8(PAR + 0 * 64 + j0, p);
#pragma unroll
            for (int e = 0; e < 8; ++e) rv[e] = rv[e] + (tmp[e] - rv[e]) * p[e];
            CP_UNPK(kv, qk); CP_UNPK(tmp, qkp); ldl8(PAR + 1 * 64 + j0, p);
#pragma unroll
            for (int e = 0; e < 8; ++e) kv[e] = kv[e] + (tmp[e] - kv[e]) * p[e];
            CP_UNPK(vv, qv); CP_UNPK(tmp, qvp); ldl8(PAR + 2 * 64 + j0, p);
#pragma unroll
            for (int e = 0; e < 8; ++e) vv[e] = vv[e] + (tmp[e] - vv[e]) * p[e];
            if (l == 0) { *(u32x4*)(VFg + row * D + ch) = (u32x4){cvt_pk_bf16(vv[0], vv[1]), cvt_pk_bf16(vv[2], vv[3]), cvt_pk_bf16(vv[4], vv[5]), cvt_pk_bf16(vv[6], vv[7])}; }
            else { float vf[8], vb[8]; CP_UNPK(vf, qvf); CP_UNPK(tmp, qvr); ldl8(PAR + 8 * 64 + j0, vb);
#pragma unroll
                for (int e = 0; e < 8; ++e) vv[e] = vv[e] + (vf[e] - vv[e]) * sigmoidf_(vb[e] + tmp[e]); }
            const u32x4 vpk = (u32x4){cvt_pk_bf16(vv[0], vv[1]), cvt_pk_bf16(vv[2], vv[3]), cvt_pk_bf16(vv[4], vv[5]), cvt_pk_bf16(vv[6], vv[7])};
            *(u32x4*)(VPg + row * D + ch) = vpk; CP_UNPK(vv, vpk);
            CP_UNPK(tmp, qw); ldl8(PAR + 3 * 64 + j0, p);
#pragma unroll
            for (int e = 0; e < 8; ++e) { const float x = -(p[e] + tmp[e]); const float sp = fmaxf(x, 0.f) + __logf(1.f + __expf(-fabsf(x))); lw[e] = -__expf(-sp - 0.5f); }
            CP_UNPK(tmp, qa); ldl8(PAR + 4 * 64 + j0, p);
#pragma unroll
            for (int e = 0; e < 8; ++e) aa[e] = sigmoidf_(p[e] + tmp[e]);
            ldl8(PAR + 5 * 64 + j0, p); float ss = 0.f;
#pragma unroll
            for (int e = 0; e < 8; ++e) { kk[e] = kv[e] * p[e]; ss += kk[e] * kk[e]; }
            ss += __shfl_xor(ss, 1); ss += __shfl_xor(ss, 2); ss += __shfl_xor(ss, 4);
            const float kn = 1.0f / fmaxf(sqrtf(ss), 1e-12f);
            ldl8(PAR + 6 * 64 + j0, p); ldl8(PAR + 7 * 64 + j0, tmp); float bs = 0.f;
#pragma unroll
            for (int e = 0; e < 8; ++e) { kk[e] *= kn; kv[e] = kv[e] * (1.f + (aa[e] - 1.f) * p[e]); bs += rv[e] * kv[e] * tmp[e]; av[e] = -kk[e]; bv[e] = kk[e] * aa[e]; }
            bs += __shfl_xor(bs, 1); bs += __shfl_xor(bs, 2); bs += __shfl_xor(bs, 4);
            if (o == 0) BNg[row * 16 + h] = bs;
          }
#pragma unroll
          for (int e = 0; e < 8; ++e) { float x = lw[e]; float y;
              y = __shfl_up(x, 8); if (lane >= 8) x += y; y = __shfl_up(x, 16); if (lane >= 16) x += y; y = __shfl_up(x, 32); if (lane >= 32) x += y; Lc[e] = x; }
          if (lane >= 56) {
#pragma unroll
              for (int e = 0; e < 8; ++e) TOT[w * 64 + j0 + e] = Lc[e]; }
          __syncthreads();
          float LC[8];
#pragma unroll
          for (int e = 0; e < 8; ++e) { float off = 0.f, tot = 0.f;
#pragma unroll
              for (int q = 0; q < 8; ++q) { const float x = TOT[q * 64 + j0 + e]; tot += x; off += (q < w) ? x : 0.f; }
              Lc[e] += off; LC[e] = tot; }
          float ta[8], tr[8], tb[8], tk[8], hb[8], hk[8];
#pragma unroll
          for (int e = 0; e < 8; ++e) { const float eL = __expf(Lc[e]), emL = __expf(-Lc[e]), eLm = __expf(Lc[e] - lw[e]), eh = __expf(LC[e] - Lc[e]);
              ta[e] = av[e] * eLm; tr[e] = rv[e] * eL; tb[e] = bv[e] * emL; tk[e] = kv[e] * emL; hb[e] = bv[e] * eh; hk[e] = kv[e] * eh; }
          *(LAS u32x4*)(sA + t * 72 + j0) = (u32x4){cvt_pk_bf16(ta[0], ta[1]), cvt_pk_bf16(ta[2], ta[3]), cvt_pk_bf16(ta[4], ta[5]), cvt_pk_bf16(ta[6], ta[7])};
          *(LAS u32x4*)(sR + t * 72 + j0) = (u32x4){cvt_pk_bf16(tr[0], tr[1]), cvt_pk_bf16(tr[2], tr[3]), cvt_pk_bf16(tr[4], tr[5]), cvt_pk_bf16(tr[6], tr[7])};
          *(LAS u32x4*)(sB + t * 72 + j0) = (u32x4){cvt_pk_bf16(tb[0], tb[1]), cvt_pk_bf16(tb[2], tb[3]), cvt_pk_bf16(tb[4], tb[5]), cvt_pk_bf16(tb[6], tb[7])};
          *(LAS u32x4*)(sK + t * 72 + j0) = (u32x4){cvt_pk_bf16(tk[0], tk[1]), cvt_pk_bf16(tk[2], tk[3]), cvt_pk_bf16(tk[4], tk[5]), cvt_pk_bf16(tk[6], tk[7])};
#pragma unroll
          for (int e = 0; e < 8; ++e) { const int ad = (j0 + e) * 72 + ((((t >> 3) + o) & 7) << 3) + (t & 7); sAT[ad] = (bf16)f2bf(ta[e]); sBhT[ad] = (bf16)f2bf(hb[e]); sKhT[ad] = (bf16)f2bf(hk[e]); sVT[ad] = (bf16)f2bf(vv[e]); }
          if (t == 0) {
#pragma unroll
              for (int e = 0; e < 8; ++e) WC[j0 + e] = __expf(LC[e]); }
          asm volatile("" ::: "memory");
          if (unit + 1 < u_hi) CP_ISSUE(unit + 1);
        }
        __syncthreads();
        { const int mq = w >> 1, tt = w & 1; const LAS bf16* o1b = (mq & 1) ? sK : sB; const LAS bf16* o2b = (mq & 2) ? sR : sA; const bool incl = (mq & 2) != 0;
          LAS bf16* dst = (mq == 0) ? sAab : ((mq == 1) ? sAak : (mq == 2 ? sArb : sArk));
#pragma unroll
          for (int mt = 0; mt < 2; ++mt) { f32x16 acc = zero16();
              if (mt <= tt) acc = mm_tile<4, false, false>(o1b, mt * 32, o2b, tt * 32, acc, lane);
              const int tg = tt * 32 + (lane & 31);
#pragma unroll
              for (int rq = 0; rq < 4; ++rq) { const int tau0 = mt * 32 + 8 * rq + 4 * (lane >> 5); float v4[4];
#pragma unroll
                  for (int e = 0; e < 4; ++e) { const int tau = tau0 + e; const bool keep = incl ? (tau <= tg) : (tau < tg); v4[e] = keep ? acc[4 * rq + e] : 0.f; }
                  *(LAS u32x2*)(dst + tg * 72 + tau0) = (u32x2){cvt_pk_bf16(v4[0], v4[1]), cvt_pk_bf16(v4[2], v4[3])}; } } }
        __syncthreads();
        if (w < 4) { if (lane < 16) { const int b0 = 16 * w; float tc[16];
#pragma unroll
            for (int r = 0; r < 16; ++r) tc[r] = (r == lane) ? 1.f : 0.f;
#pragma unroll
            for (int q = 0; q < 15; ++q) { const float tq = tc[q];
#pragma unroll
                for (int r = q + 1; r < 16; ++r) tc[r] += bf2f(sAab[(b0 + r) * 72 + b0 + q]) * tq; }
#pragma unroll
            for (int r = 0; r < 16; ++r) TBB[(w * 16 + r) * 16 + lane] = (bf16)f2bf(tc[r]); } }
        else { const int tt = w & 1, itl = (w >> 1) & 1; f32x16 acc = zero16();
            acc = mm_tile<4, false, true>(sAak, tt * 32, sVT, itl * 32, acc, lane);
            const int i = itl * 32 + (lane & 31);
#pragma unroll
            for (int rq = 0; rq < 4; ++rq) { const int t0 = tt * 32 + 8 * rq + 4 * (lane >> 5);
                *(LAS u32x2*)(sZT + i * 72 + t0) = (u32x2){cvt_pk_bf16(acc[4 * rq], acc[4 * rq + 1]), cvt_pk_bf16(acc[4 * rq + 2], acc[4 * rq + 3])}; } }
        __syncthreads();
        { const int fr = lane & 15, fq = lane >> 4; LAS bf16* xt = ((w < 4) ? sUT : sPT) + ((w & 3) * 16) * 72;
          const int zr = (w & 3) * 16 + fr;
          { u32 zz_ = 0u; asm volatile("" : "+v"(zz_)); const u32x4 z4 = (u32x4){zz_, zz_, zz_, zz_};
            *(LAS u32x4*)(xt + (lane >> 2) * 72 + (lane & 3) * 16) = z4; *(LAS u32x4*)(xt + (lane >> 2) * 72 + (lane & 3) * 16 + 8) = z4; }
          LDS_WAIT();
#pragma unroll
          for (int b = 0; b < 4; ++b) { const int t0 = 16 * b + 4 * fq;
              u32x2 zq;
              if (w < 4) zq = *(const LAS u32x2*)(sZT + zr * 72 + t0); else zq = *(const LAS u32x2*)(sAT + zr * 72 + ((((t0 >> 3) + (zr >> 3)) & 7) << 3) + (t0 & 7));
              f32x4 acc = (f32x4){bflo(zq.x), bfhi(zq.x), bflo(zq.y), bfhi(zq.y)};
              if (b > 0) {
#pragma unroll
                  for (int ks = 0; ks < (b + 1) / 2; ++ks) { const bf16x8 oa = *(const LAS bf16x8*)(sAab + (16 * b + fr) * 72 + 32 * ks + 8 * fq), ox = *(const LAS bf16x8*)(xt + fr * 72 + 32 * ks + 8 * fq);
                      acc = __builtin_amdgcn_mfma_f32_16x16x32_bf16(oa, ox, acc, 0, 0, 0); } }
              const u32x2 tq = *(const LAS u32x2*)(TBB + (b * 16 + fr) * 16 + 4 * fq);
              const bf16x8 ot = __builtin_bit_cast(bf16x8, (u32x4){tq.x, tq.y, 0u, 0u}), ow = __builtin_bit_cast(bf16x8, (u32x4){cvt_pk_bf16(acc[0], acc[1]), cvt_pk_bf16(acc[2], acc[3]), 0u, 0u});
              const f32x4 xb = __builtin_amdgcn_mfma_f32_16x16x32_bf16(ot, ow, (f32x4){0.f, 0.f, 0.f, 0.f}, 0, 0, 0);
              *(LAS u32x2*)(xt + fr * 72 + t0) = (u32x2){cvt_pk_bf16(xb[0], xb[1]), cvt_pk_bf16(xb[2], xb[3])};
              LDS_WAIT(); asm volatile("" ::: "memory"); } }
        __syncthreads();
        { const int mt = (w >> 1) & 1, nt = w & 1, ln = lane & 31, lh = lane >> 5;
          if (w < 4) {
              { f32x16 acc = zero16();
                acc = mm_tile<4, false, false>(sUT, mt * 32, sArb, nt * 32, acc, lane); acc = mm_tile<4, true, false>(sVT, mt * 32, sArk, nt * 32, acc, lane);
                bf16* yr = YLg + (row0 + nt * 32 + ln) * D + h * 64 + mt * 32;
#pragma unroll
                for (int rq = 0; rq < 4; ++rq) *(u32x2*)(yr + 8 * rq + 4 * lh) = (u32x2){cvt_pk_bf16(acc[4 * rq], acc[4 * rq + 1]), cvt_pk_bf16(acc[4 * rq + 2], acc[4 * rq + 3])}; }
              { f32x16 acc = zero16();
                acc = mm_tile<4, false, false>(sPT, mt * 32, sArb, nt * 32, acc, lane);
                const int tl = nt * 32 + ln; bf16* qr_ = Qg + (row0 + tl) * D + h * 64 + mt * 32;
#pragma unroll
                for (int rq = 0; rq < 4; ++rq) { const int m0 = mt * 32 + 8 * rq + 4 * lh; const u32x2 rr = *(const LAS u32x2*)(sR + tl * 72 + m0);
                    *(u32x2*)(qr_ + 8 * rq + 4 * lh) = (u32x2){cvt_pk_bf16(acc[4 * rq] + bflo(rr.x), acc[4 * rq + 1] + bfhi(rr.x)), cvt_pk_bf16(acc[4 * rq + 2] + bflo(rr.y), acc[4 * rq + 3] + bfhi(rr.y))}; } }
          } else {
              { f32x16 acc = zero16();
                acc = mm_tile<4, true, false>(sBhT, mt * 32, sUT, nt * 32, acc, lane); acc = mm_tile<4, true, true>(sKhT, mt * 32, sVT, nt * 32, acc, lane);
                const int i_ = nt * 32 + ln;
#pragma unroll
                for (int rq = 0; rq < 4; ++rq) { const int j0_ = mt * 32 + 8 * rq + 4 * lh;
                    bf16* np = NCg + ((((size_t)unit * 4 + (i_ >> 4)) * 64 + (i_ & 15) + 16 * ((j0_ & 15) >> 2)) * 4 + (j0_ >> 4)) * 4;
                    *(u32x2*)np = (u32x2){cvt_pk_bf16(acc[4 * rq], acc[4 * rq + 1]), cvt_pk_bf16(acc[4 * rq + 2], acc[4 * rq + 3])}; } }
              { f32x16 acc = zero16();
                acc = mm_tile<4, false, true>(sPT, mt * 32, sBhT, nt * 32, acc, lane);
                const int j = nt * 32 + ln; const float wc = WC[j];
#pragma unroll
                for (int rq = 0; rq < 4; ++rq) { const int m0 = mt * 32 + 8 * rq + 4 * lh; float v4[4];
#pragma unroll
                    for (int e = 0; e < 4; ++e) v4[e] = acc[4 * rq + e] + ((m0 + e == j) ? wc : 0.f);
                    bf16* mp = MTg + ((((size_t)unit * 8 + 2 * (j >> 4) + (m0 >> 5)) * 64 + (j & 15) + 16 * ((m0 & 15) >> 2)) * 2 + ((m0 >> 4) & 1)) * 4;
                    *(u32x2*)mp = (u32x2){cvt_pk_bf16(v4[0], v4[1]), cvt_pk_bf16(v4[2], v4[3])}; } }
          } }
        __syncthreads();
    }
}

struct CarryBuf { u32x4 m[8]; u32x4 n[2]; };
__device__ __forceinline__ void carry_load(CarryBuf& B, const bf16* MTg, const bf16* NCg, size_t unit, int slab, int lane) {
    const bf16* mb = MTg + unit * 4096; const bf16* nb = NCg + (unit * 4 + slab) * 1024; const unsigned vm = (unsigned)lane * 16u, vm2 = vm + 4096u, vn = (unsigned)lane * 32u;
    asm volatile("global_load_dwordx4 %0, %1, %2" : "=v"(B.m[0]) : "v"(vm), "s"(mb) : "memory");
    asm volatile("global_load_dwordx4 %0, %1, %2 offset:1024" : "=v"(B.m[1]) : "v"(vm), "s"(mb) : "memory");
    asm volatile("global_load_dwordx4 %0, %1, %2 offset:2048" : "=v"(B.m[2]) : "v"(vm), "s"(mb) : "memory");
    asm volatile("global_load_dwordx4 %0, %1, %2 offset:3072" : "=v"(B.m[3]) : "v"(vm), "s"(mb) : "memory");
    asm volatile("global_load_dwordx4 %0, %1, %2" : "=v"(B.m[4]) : "v"(vm2), "s"(mb) : "memory");
    asm volatile("global_load_dwordx4 %0, %1, %2 offset:1024" : "=v"(B.m[5]) : "v"(vm2), "s"(mb) : "memory");
    asm volatile("global_load_dwordx4 %0, %1, %2 offset:2048" : "=v"(B.m[6]) : "v"(vm2), "s"(mb) : "memory");
    asm volatile("global_load_dwordx4 %0, %1, %2 offset:3072" : "=v"(B.m[7]) : "v"(vm2), "s"(mb) : "memory");
    asm volatile("global_load_dwordx4 %0, %1, %2" : "=v"(B.n[0]) : "v"(vn), "s"(nb) : "memory");
    asm volatile("global_load_dwordx4 %0, %1, %2 offset:16" : "=v"(B.n[1]) : "v"(vn), "s"(nb) : "memory");
}
#define CARRY_WAIT(B, N) asm volatile("s_waitcnt vmcnt(" #N ")" : "+v"(B.m[0]), "+v"(B.m[1]), "+v"(B.m[2]), "+v"(B.m[3]), "+v"(B.m[4]), "+v"(B.m[5]), "+v"(B.m[6]), "+v"(B.m[7]), "+v"(B.n[0]), "+v"(B.n[1]) :: "memory")
__device__ __forceinline__ void carry_step(f32x4 (&acc)[4], const CarryBuf& B, bf16* sp) {
    u32 pk[4][2];
#pragma unroll
    for (int jt = 0; jt < 4; ++jt) { pk[jt][0] = cvt_pk_bf16(acc[jt][0], acc[jt][1]); pk[jt][1] = cvt_pk_bf16(acc[jt][2], acc[jt][3]); }
#pragma unroll
    for (int jt = 0; jt < 4; ++jt) *(GAS u32x2*)(sp + jt * 16) = (u32x2){pk[jt][0], pk[jt][1]};
    const bf16x8 sb0 = __builtin_bit_cast(bf16x8, (u32x4){pk[0][0], pk[0][1], pk[1][0], pk[1][1]}), sb1 = __builtin_bit_cast(bf16x8, (u32x4){pk[2][0], pk[2][1], pk[3][0], pk[3][1]});
    const u32 nw[8] = {B.n[0].x, B.n[0].y, B.n[0].z, B.n[0].w, B.n[1].x, B.n[1].y, B.n[1].z, B.n[1].w};
#pragma unroll
    for (int jt = 0; jt < 4; ++jt) { f32x4 a = (f32x4){bflo(nw[2 * jt]), bfhi(nw[2 * jt]), bflo(nw[2 * jt + 1]), bfhi(nw[2 * jt + 1])};
        a = __builtin_amdgcn_mfma_f32_16x16x32_bf16(__builtin_bit_cast(bf16x8, B.m[2 * jt]), sb0, a, 0, 0, 0);
        a = __builtin_amdgcn_mfma_f32_16x16x32_bf16(__builtin_bit_cast(bf16x8, B.m[2 * jt + 1]), sb1, a, 0, 0, 0);
        acc[jt] = a; }
}
__device__ __forceinline__ void phase_carry2(const Ctx& C0) {
    const Ctx C = launder(C0);
    const bf16* MTg = (const bf16*)(C.ws + WS_R1 + R1_MT); const bf16* NCg = (const bf16*)(C.ws + WS_R1 + R1_NC); bf16* sst = (bf16*)(C.ws + WS_R1 + R1_SST);
    const int lane = C.lane, fr = lane & 15, fq = lane >> 4;
    if (C.wave != 0) return;
    for (int task = C.bid; task < 128; task += C.G) { const int bh = task >> 2, slab = task & 3; const size_t u0 = (size_t)bh * NCHK;
        f32x4 acc[4]; acc[0] = acc[1] = acc[2] = acc[3] = (f32x4){0.f, 0.f, 0.f, 0.f};
        CarryBuf B0, B1, B2, B3;
        asm volatile("s_waitcnt vmcnt(0)" ::: "memory");
        carry_load(B0, MTg, NCg, u0, slab, lane); carry_load(B1, MTg, NCg, u0 + 1, slab, lane); carry_load(B2, MTg, NCg, u0 + 2, slab, lane); carry_load(B3, MTg, NCg, u0 + 3, slab, lane);
        bf16* sp = sst + (u0 * 64 + slab * 16 + fr) * 64 + 4 * fq;
        CARRY_WAIT(B0, 30); carry_step(acc, B0, sp + (size_t)0 * 4096); carry_load(B0, MTg, NCg, u0 + 4, slab, lane);
        CARRY_WAIT(B1, 34); carry_step(acc, B1, sp + (size_t)1 * 4096); carry_load(B1, MTg, NCg, u0 + 5, slab, lane);
        CARRY_WAIT(B2, 38); carry_step(acc, B2, sp + (size_t)2 * 4096); carry_load(B2, MTg, NCg, u0 + 6, slab, lane);
        CARRY_WAIT(B3, 42); carry_step(acc, B3, sp + (size_t)3 * 4096); carry_load(B3, MTg, NCg, u0 + 7, slab, lane);
#pragma unroll 1
        for (int c = 4; c < NCHK; c += 4) {
            const size_t un = u0 + ((c + 4 < NCHK) ? c + 4 : c);
            CARRY_WAIT(B0, 42); carry_step(acc, B0, sp + (size_t)(c + 0) * 4096); carry_load(B0, MTg, NCg, un + 0, slab, lane);
            CARRY_WAIT(B1, 42); carry_step(acc, B1, sp + (size_t)(c + 1) * 4096); carry_load(B1, MTg, NCg, un + 1, slab, lane);
            CARRY_WAIT(B2, 42); carry_step(acc, B2, sp + (size_t)(c + 2) * 4096); carry_load(B2, MTg, NCg, un + 2, slab, lane);
            CARRY_WAIT(B3, 42); carry_step(acc, B3, sp + (size_t)(c + 3) * 4096); carry_load(B3, MTg, NCg, un + 3, slab, lane);
        }
        asm volatile("s_waitcnt vmcnt(0)" ::: "memory");
    }
}

__device__ __forceinline__ void phase_post2(const Ctx& C0, int l) {
    const Ctx C = launder(C0);
    const bf16* yl = (const bf16*)(C.ws + WS_R1 + R1_YLOC); const bf16* zz = (const bf16*)(C.ws + WS_R1 + R1_Q); const bf16* sst = (const bf16*)(C.ws + WS_R1 + R1_SST);
    const bf16* vp = (const bf16*)(C.ws + WS_VP); const bf16* gg = (const bf16*)(C.ws + WS_R4 + R4_G); const float* bonus = (const float*)(C.ws + WS_BONUS); bf16* ya = (bf16*)(C.ws + WS_HN);
    LAS float* LWs = (LAS float*)C.lds; LAS float* LBs = LWs + 1024;
    for (int i = C.tid; i < 1024; i += 512) { LWs[i] = C.inp(I_LNX_W)[(size_t)l * D + i]; LBs[i] = C.inp(I_LNX_B)[(size_t)l * D + i]; }
    __syncthreads();
    const int lane = C.lane, lr = lane & 31, lh = lane >> 5;
    for (int task = C.gw; task < 8192; task += C.ngw) { const int unit = task >> 1, sub = task & 1; const int bh = unit / NCHK, ck = unit % NCHK, bl = bh >> 4, h = bh & 15;
        const size_t ml = (size_t)bl * T + ck * CHK + sub * 32 + lr;
        const bf16* srow = sst + (size_t)unit * 4096; const bf16* zrow = zz + ml * D + h * 64; const bf16* ylr = yl + ml * D + h * 64;
        bf16x8 ob[4], oa0[4], oa1[4]; u32x2 yq[8], vq[8], gq[8];
#pragma unroll
        for (int ks = 0; ks < 4; ++ks) { const int m0 = ks * 16 + lh * 8; ob[ks] = *(const bf16x8*)(zrow + m0); oa0[ks] = *(const bf16x8*)(srow + (size_t)lr * 64 + m0); oa1[ks] = *(const bf16x8*)(srow + (size_t)(32 + lr) * 64 + m0); }
#pragma unroll
        for (int q = 0; q < 8; ++q) { const int i0 = (q >> 2) * 32 + 8 * (q & 3) + 4 * lh; yq[q] = *(const u32x2*)(ylr + i0); vq[q] = *(const u32x2*)(vp + ml * D + h * 64 + i0); gq[q] = *(const u32x2*)(gg + ml * D + h * 64 + i0); }
        const float bn = bonus[ml * 16 + h];
        f32x16 d0 = zero16(), d1 = zero16();
#pragma unroll
        for (int ks = 0; ks < 4; ++ks) { d0 = __builtin_amdgcn_mfma_f32_32x32x16_bf16(oa0[ks], ob[ks], d0, 0, 0, 0); d1 = __builtin_amdgcn_mfma_f32_32x32x16_bf16(oa1[ks], ob[ks], d1, 0, 0, 0); }
        float y[32]; float s = 0.f;
#pragma unroll
        for (int itl = 0; itl < 2; ++itl)
#pragma unroll
            for (int rq = 0; rq < 4; ++rq) { const u32x2 q = yq[itl * 4 + rq];
                const float dd0 = itl ? d1[4 * rq] : d0[4 * rq], dd1 = itl ? d1[4 * rq + 1] : d0[4 * rq + 1], dd2 = itl ? d1[4 * rq + 2] : d0[4 * rq + 2], dd3 = itl ? d1[4 * rq + 3] : d0[4 * rq + 3];
                float* yy = y + itl * 16 + rq * 4; yy[0] = bflo(q.x) + dd0; yy[1] = bfhi(q.x) + dd1; yy[2] = bflo(q.y) + dd2; yy[3] = bfhi(q.y) + dd3; s += (yy[0] + yy[1]) + (yy[2] + yy[3]); }
        s += __shfl_xor(s, 32); const float mean = s * (1.f / 64.f); float s2 = 0.f;
#pragma unroll
        for (int e = 0; e < 32; ++e) { const float dlt = y[e] - mean; s2 += dlt * dlt; }
        s2 += __shfl_xor(s2, 32); const float rstd = __builtin_amdgcn_rsqf(s2 * (1.f / 64.f) + 64e-5f);
#pragma unroll
        for (int itl = 0; itl < 2; ++itl)
#pragma unroll
            for (int rq = 0; rq < 4; ++rq) { const int i0 = itl * 32 + 8 * rq + 4 * lh; const int cc = h * 64 + i0; const float* yy = y + itl * 16 + rq * 4;
                const f32x4 w4 = *(const LAS f32x4*)(LWs + cc), b4 = *(const LAS f32x4*)(LBs + cc); const u32x2 vv = vq[itl * 4 + rq], gv = gq[itl * 4 + rq];
                const float o0 = ((yy[0] - mean) * rstd * w4.x + b4.x + bn * bflo(vv.x)) * bflo(gv.x), o1 = ((yy[1] - mean) * rstd * w4.y + b4.y + bn * bfhi(vv.x)) * bfhi(gv.x);
                const float o2 = ((yy[2] - mean) * rstd * w4.z + b4.z + bn * bflo(vv.y)) * bflo(gv.y), o3 = ((yy[3] - mean) * rstd * w4.w + b4.w + bn * bfhi(vv.y)) * bfhi(gv.y);
                *(u32x2*)(ya + ml * D + cc) = (u32x2){cvt_pk_bf16(o0, o1), cvt_pk_bf16(o2, o3)}; }
    }
}

__device__ __forceinline__ void phase_route(const Ctx& C0, int it) {
    const Ctx C = launder(C0);
    const int l = it / NCH, c = it % NCH; const float* xs = C.out + (size_t)c * M * D; const float* g = C.inp(I_NORM_FFN) + (size_t)l * D; bf16* hn = (bf16*)(C.ws + WS_HN);
    const float* rgb = C.inp(I_RGRP_B) + (size_t)l * 4; const float* reb = C.inp(I_REXP_B) + (size_t)l * 32;
    unsigned* cnt = (unsigned*)(C.ws + WS_CTL) + CW_CNT + it * 64; int* tok = (int*)(C.ws + WS_TOK); float* wt = (float*)(C.ws + WS_TOK + 512 * 1024);
    const bf16* wrh = (const bf16*)(C.ws + WS_WSC + 512 * 1024); const bf16* wrl = (const bf16*)(C.ws + WS_WSC + 640 * 1024);
    const int lane = C.lane, fr = lane & 15, fq = lane >> 4;
    for (int rep15 = 0; rep15 < 1 + ((DUP_MASK >> 15) & 1); ++rep15)
    norm2_rows_i8(xs, g, (unsigned char*)hn, (float*)(C.ws + WS_HN + HNX_RS), C.gw, C.ngw, lane);
    LAS float* LG = (LAS float*)(C.lds + C.wave * 4096);
    LAS float* PX = (LAS float*)(C.lds + 32768) + (C.wave >> 1) * (64 * 13);
    const int half = C.wave & 1;
    for (int tbase = C.bid * 4; tbase < M / 16; tbase += C.G * 4) { const int task = tbase + (C.wave >> 1); const int ml = task * 16 + fr; const float* xr = xs + (size_t)ml * D + fq * 8;
        f32x4 acc[3]; acc[0] = acc[1] = acc[2] = (f32x4){0.f, 0.f, 0.f, 0.f}; float ss = 0.f;
#pragma unroll 4
        for (int ks = half * 16; ks < half * 16 + 16; ++ks) { const f32x4 xa = *(const f32x4*)(xr + ks * 32), xb = *(const f32x4*)(xr + ks * 32 + 4);
            ss += (xa.x * xa.x + xa.y * xa.y) + (xa.z * xa.z + xa.w * xa.w) + (xb.x * xb.x + xb.y * xb.y) + (xb.z * xb.z + xb.w * xb.w);
            u32x4 hq; hq.x = cvt_pk_bf16(xa.x, xa.y); hq.y = cvt_pk_bf16(xa.z, xa.w); hq.z = cvt_pk_bf16(xb.x, xb.y); hq.w = cvt_pk_bf16(xb.z, xb.w);
            u32x4 lq; lq.x = cvt_pk_bf16(xa.x - bflo(hq.x), xa.y - bfhi(hq.x)); lq.y = cvt_pk_bf16(xa.z - bflo(hq.y), xa.w - bfhi(hq.y));
            lq.z = cvt_pk_bf16(xb.x - bflo(hq.z), xb.y - bfhi(hq.z)); lq.w = cvt_pk_bf16(xb.z - bflo(hq.w), xb.w - bfhi(hq.w));
            const bf16x8 xh = __builtin_bit_cast(bf16x8, hq), xl = __builtin_bit_cast(bf16x8, lq);
#pragma unroll
            for (int nt = 0; nt < 3; ++nt) { const size_t wo = (size_t)(nt * 16 + fr) * D + ks * 32 + fq * 8;
                const bf16x8 wh = *(const bf16x8*)(wrh + wo), wl = *(const bf16x8*)(wrl + wo);
                acc[nt] = __builtin_amdgcn_mfma_f32_16x16x32_bf16(wh, xh, acc[nt], 0, 0, 0);
                acc[nt] = __builtin_amdgcn_mfma_f32_16x16x32_bf16(wl, xh, acc[nt], 0, 0, 0);
                acc[nt] = __builtin_amdgcn_mfma_f32_16x16x32_bf16(wh, xl, acc[nt], 0, 0, 0); } }
        if (half) {
#pragma unroll
            for (int nt = 0; nt < 3; ++nt)
#pragma unroll
                for (int i = 0; i < 4; ++i) PX[lane * 13 + nt * 4 + i] = acc[nt][i];
            PX[lane * 13 + 12] = ss; }
        __syncthreads();
        if (!half) {
#pragma unroll
            for (int nt = 0; nt < 3; ++nt)
#pragma unroll
                for (int i = 0; i < 4; ++i) acc[nt][i] += PX[lane * 13 + nt * 4 + i];
            ss += PX[lane * 13 + 12]; }
        ss += __shfl_xor(ss, 16); ss += __shfl_xor(ss, 32); const float rs = __builtin_amdgcn_rsqf(ss * (1.f / D) + 1e-6f);
#pragma unroll
        for (int nt = 0; nt < 3; ++nt)
#pragma unroll
            for (int i = 0; i < 4; ++i) LG[fr * 48 + nt * 16 + 4 * fq + i] = acc[nt][i] * rs;
        LDS_WAIT(); asm volatile("" ::: "memory");
        if (lane < 16 && !half) { const LAS float* lg = LG + lane * 48;
            float gl[4]; int gs = 0; float gm;
#pragma unroll
            for (int e = 0; e < 4; ++e) gl[e] = lg[e] + rgb[e];
            gm = gl[0];
#pragma unroll
            for (int e = 1; e < 4; ++e) if (gl[e] > gm) { gm = gl[e]; gs = e; }
            float den = 0.f;
#pragma unroll
            for (int e = 0; e < 4; ++e) den += __expf(gl[e] - gm);
            const float pg = 1.f / den;
            float el[8];
#pragma unroll
            for (int e = 0; e < 8; ++e) el[e] = lg[4 + gs * 8 + e] + reb[gs * 8 + e];
            int i1 = 0; float v1 = el[0];
#pragma unroll
            for (int e = 1; e < 8; ++e) if (el[e] > v1) { v1 = el[e]; i1 = e; }
            int i2 = -1; float v2 = -3.0e38f;
#pragma unroll
            for (int e = 0; e < 8; ++e) if (e != i1 && el[e] > v2) { v2 = el[e]; i2 = e; }
            const float ex = __expf(v2 - v1); const float w1 = pg / (1.f + ex), w2 = pg * ex / (1.f + ex);
            const int e1 = gs * 8 + i1, e2 = gs * 8 + i2;
            const unsigned s1 = atomicAdd(cnt + e1, 1u), s2 = atomicAdd(cnt + e2, 1u);
            const int mt = task * 16 + lane;
            tok[4 * mt] = e1; tok[4 * mt + 1] = (int)s1; tok[4 * mt + 2] = e2; tok[4 * mt + 3] = (int)s2; wt[2 * mt] = w1; wt[2 * mt + 1] = w2;
            int* rowmap = (int*)(C.ws + WS_R1 + R1_ROWMAP); rowmap[e1 * 16384 + (int)s1] = mt; rowmap[e2 * 16384 + (int)s2] = mt;
        }
        __syncthreads();
    }
}
__device__ __forceinline__ void moe_table(const Ctx& C, int it, LAS int* tb) {
    __syncthreads();
    int tl_ = C.tid; asm volatile("" : "+v"(tl_));
    if (C.tid < 64) { const unsigned* cnt = (const unsigned*)(C.ws + WS_CTL) + CW_CNT + it * 64;
        const unsigned cv = (C.tid < 32) ? __hip_atomic_load(cnt + tl_, __ATOMIC_RELAXED, __HIP_MEMORY_SCOPE_AGENT) : 0u; const int tiles = (int)((cv + 255u) >> 8); int x = tiles;
#pragma unroll
        for (int o = 1; o < 32; o <<= 1) { const int y = __shfl_up(x, o); if (C.lane >= o) x += y; }
        if (C.tid < 32) { tb[tl_] = x - tiles; tb[40 + tl_] = (int)cv; } if (C.tid == 31) tb[32] = x; }
    __syncthreads();
}
constexpr int NPH = 14;
__global__ void __launch_bounds__(512, 2) mk_fwd(Args args) {
    extern __shared__ __attribute__((aligned(16))) unsigned char lds_raw[];
    Ctx C; C.lds = (LAS unsigned char*)lds_raw; C.ws = args.ws; C.in = args.in; C.out = args.out;
    C.tid = threadIdx.x; C.lane = C.tid & 63; C.wave = __builtin_amdgcn_readfirstlane(C.tid >> 6); C.G = gridDim.x; C.bid = blockIdx.x; C.gw = C.bid * 8 + C.wave; C.ngw = C.G * 8;
    volatile LAS unsigned* MISC = (volatile LAS unsigned*)(C.lds + LDSCTL_OFF);
    LAS int* tb = (LAS int*)(C.lds + LDSCTL_OFF + 256);
    for (int u = C.tid; u < 64; u += 512) MISC[u] = 0u;
    __syncthreads();
    XcdBarrier bar; bar.bar = (unsigned*)(C.ws + WS_CTL) + CW_BAR; bar.x = 0; bar.st = nullptr;
#if MK_ONE_LAUNCH
    bar = xcd_barrier_post((unsigned*)(C.ws + WS_CTL) + CW_BAR, MISC + 8);
#define GRID_BAR() xcd_barrier(bar)
#else
#define GRID_BAR() do {} while (0)
#endif
    const int s_lo = args.s_lo, s_hi = args.s_hi;
#pragma unroll 1
    for (int it = (s_lo == 0 ? -1 : 0); it <= NIT; ++it) {
        const int l = it / NCH, c = it % NCH; const int sb = it * NPH;
#define IN(k) (((PH_MASK >> (k)) & 1) && s_lo <= sb + (k) && sb + (k) < s_hi)
        if (IN(0)) for (int rep_ = 0; rep_ < 1 + ((DUP_MASK >> 0) & 1); ++rep_) { unsigned char* ws = C.ws; asm volatile("" : "+s"(ws)); ws = AS_GLOBAL(unsigned char, ws); if (it < NIT && c == 0) phase_convert(C, l, it == 0); phase_prep(C, it, tb); GRID_BAR(); }
        if (it == NIT) break;
        if (IN(1)) for (int rep_ = 0; rep_ < 1 + ((DUP_MASK >> 1) & 1); ++rep_) { unsigned char* ws = C.ws; asm volatile("" : "+s"(ws)); ws = AS_GLOBAL(unsigned char, ws); pg8::Gemm g{(const bf16*)(ws + WS_R1 + R1_HNX), (const bf16*)(ws + WS_WIN), D / 2, D / 2, D / 2, 0, nullptr, nullptr};   pg8::StaticOrder S; S.init(M, DBG_PROJ_N, C.G, C.bid);
            pg8::EpiProj E{(bf16*)(ws + WS_R2 + R2_ZA), (bf16*)(ws + WS_R1 + R1_ZB), (bf16*)(ws + WS_R1 + R1_ZC), (bf16*)(ws + WS_ZG), (bf16*)(ws + WS_VLO), C.inp(I_GATE_B) + (size_t)l * G_COLS, (const float*)(ws + WS_R1 + R1_HNX + HNX_RS), (const unsigned*)(ws + WS_CTL) + CW_WMAX + l * WIN_ROWS};
            pg8::gemm_phase<pg8::EpiProj, pg8::StaticOrder, false, true>(C.lds, g, S, E); GRID_BAR(); }
        if (IN(2)) for (int rep_ = 0; rep_ < 1 + ((DUP_MASK >> 2) & 1); ++rep_) { unsigned char* ws = C.ws; asm volatile("" : "+s"(ws)); ws = AS_GLOBAL(unsigned char, ws); sub_gmlp(C, l); sub_attn(C); sub_lora_prep(C, l); GRID_BAR(); }
        if (IN(3)) for (int rep_ = 0; rep_ < 1 + ((DUP_MASK >> 3) & 1); ++rep_) { unsigned char* ws = C.ws; asm volatile("" : "+s"(ws)); ws = AS_GLOBAL(unsigned char, ws); pg8::Gemm g{(const bf16*)(ws + WS_R1 + R1_ALORA), (const bf16*)(ws + WS_LORAB), LORA_K, LORA_K, (l == 0 ? 256 : LORA_K), 0, nullptr, nullptr};   pg8::StaticOrder S; S.init(M, l == 0 ? 3072 : 4096, C.G, C.bid);
            pg8::EpiLora EL{(bf16*)(ws + WS_R4 + R4_WPRE), (bf16*)(ws + WS_R4 + R4_APRE), (bf16*)(ws + WS_R4 + R4_G), (bf16*)(ws + WS_R4 + R4_VPRE)};
            pg8::gemm_phase(C.lds, g, S, EL); sub_yb_combine(C); GRID_BAR(); }
        if (IN(4)) for (int rep_ = 0; rep_ < 1 + ((DUP_MASK >> 4) & 1); ++rep_) { unsigned char* ws = C.ws; asm volatile("" : "+s"(ws)); ws = AS_GLOBAL(unsigned char, ws); }
        if (IN(5)) for (int rep_ = 0; rep_ < 1 + ((DUP_MASK >> 5) & 1); ++rep_) { unsigned char* ws = C.ws; asm volatile("" : "+s"(ws)); ws = AS_GLOBAL(unsigned char, ws); phase_chunkpre(C, l, c); GRID_BAR(); }
        if (it < 0 || IN(6)) for (int rep_ = 0; rep_ < 1 + ((DUP_MASK >> 6) & 1); ++rep_) { unsigned char* ws = C.ws; asm volatile("" : "+s"(ws)); ws = AS_GLOBAL(unsigned char, ws);
            const bool pre = it < 0;
            if (pre || (l == 0 && C.bid >= 128)) phase_wmax(C, pre ? 0 : 1, pre ? 0 : c, pre ? 1 : NCH, (pre ? C.bid : C.bid - 128) * 512 + C.tid, (pre ? C.G : C.G - 128) * 512); else phase_carry2(C);
            GRID_BAR(); }
        if (IN(7)) for (int rep_ = 0; rep_ < 1 + ((DUP_MASK >> 7) & 1); ++rep_) { unsigned char* ws = C.ws; asm volatile("" : "+s"(ws)); ws = AS_GLOBAL(unsigned char, ws); phase_post2(C, l); GRID_BAR(); }
        if (IN(8)) for (int rep_ = 0; rep_ < 1 + ((DUP_MASK >> 8) & 1); ++rep_) { unsigned char* ws = C.ws; asm volatile("" : "+s"(ws)); ws = AS_GLOBAL(unsigned char, ws); pg8::StaticOrder S; S.init(M, D, C.G, C.bid);
            pg8::Gemm ga{(const bf16*)(ws + WS_HN), (const bf16*)(ws + WS_PA), D, D, D, 0, nullptr, nullptr}; pg8::Gemm gb{(const bf16*)(ws + WS_YB), (const bf16*)(ws + WS_PB), 256, 256, 256, 0, nullptr, nullptr};
            pg8::Gemm gc{(const bf16*)(ws + WS_YC), (const bf16*)(ws + WS_PC), D, D, D, 0, nullptr, nullptr};
            pg8::EpiChainGate E{(const unsigned char*)(ws + WS_ZG), (bf16*)(ws + WS_R4 + R4_MERGED)}; pg8::gemm_chain3(C.lds, ga, gb, gc, S, E); GRID_BAR(); }
        if (IN(9)) for (int rep_ = 0; rep_ < 1 + ((DUP_MASK >> 9) & 1); ++rep_) { unsigned char* ws = C.ws; asm volatile("" : "+s"(ws)); ws = AS_GLOBAL(unsigned char, ws);
#ifdef DBG_WOUT_ZG
            pg8::Gemm g{(const bf16*)(ws + WS_ZG), (const bf16*)(ws + WS_WOUT), G_COLS, D, D, 0, nullptr, nullptr};
#else
            pg8::Gemm g{(const bf16*)(ws + WS_R4 + R4_MERGED), (const bf16*)(ws + WS_WOUT), D, D, D, 0, nullptr, nullptr};
#endif
            pg8::StaticOrder S; S.init(M, D, C.G, C.bid);
            pg8::EpiResid E{(l == 0 ? C.inp(I_X) : C.out) + (size_t)c * M * D, C.out + (size_t)c * M * D}; pg8::gemm_phase(C.lds, g, S, E); GRID_BAR(); }
        if (IN(10)) for (int rep_ = 0; rep_ < 1 + ((DUP_MASK >> 10) & 1); ++rep_) { unsigned char* ws = C.ws; asm volatile("" : "+s"(ws)); ws = AS_GLOBAL(unsigned char, ws); phase_route(C, it); GRID_BAR(); }
        if (IN(11)) for (int rep_ = 0; rep_ < 1 + ((DUP_MASK >> 11) & 1); ++rep_) { unsigned char* ws = C.ws; asm volatile("" : "+s"(ws)); ws = AS_GLOBAL(unsigned char, ws); }
        if (IN(12)) for (int rep_ = 0; rep_ < 1 + ((DUP_MASK >> 12) & 1); ++rep_) { unsigned char* ws = C.ws; asm volatile("" : "+s"(ws)); ws = AS_GLOBAL(unsigned char, ws); moe_table(C, it, tb); pg8::Gemm g{(const bf16*)(ws + WS_HN), (const bf16*)(ws + WS_W13), D / 2, D / 2, D / 2, (size_t)D * D / 2, (const int*)(ws + WS_R1 + R1_ROWMAP), tb};   pg8::MoeOrder S{tb, 4, C.G, C.bid};
            pg8::EpiSwiglu E{(bf16*)(ws + WS_R1 + R1_HID), (const float*)(ws + WS_HN + HNX_RS), (const int*)(ws + WS_R1 + R1_ROWMAP), tb, (const unsigned*)(ws + WS_CTL) + CW_WMAX13 + l * NEXP * 1024}; pg8::gemm_phase<pg8::EpiSwiglu, pg8::MoeOrder, true, true>(C.lds, g, S, E);
            if (it + 1 < NIT) {
                const int U = tb[32] * 4, rem = U % C.G; const int first = rem, nlow = C.G - rem;
                if (C.bid >= first) { const Ctx Cn = launder(C); mixer_norm(Cn, it + 1, (C.bid - first) * 8 + Cn.wave, nlow * 8); } }
            GRID_BAR(); }
        if (IN(13)) for (int rep_ = 0; rep_ < 1 + ((DUP_MASK >> 13) & 1); ++rep_) { unsigned char* ws = C.ws; asm volatile("" : "+s"(ws)); ws = AS_GLOBAL(unsigned char, ws); moe_table(C, it, tb); pg8::Gemm g{(const bf16*)(ws + WS_R1 + R1_HID), (const bf16*)(ws + WS_W2), EFF, EFF, EFF, (size_t)D * EFF, nullptr, nullptr}; pg8::MoeOrder S{tb, 4, C.G, C.bid};
            pg8::EpiBf16 E{(bf16*)(ws + WS_R1 + R1_YEXP), D, 0, 0}; pg8::gemm_phase(C.lds, g, S, E); GRID_BAR(); }
#undef IN
    }
}

extern "C" void kernel_launch(void* const* d_in, const int* in_sizes, int n_in, void* d_out, int out_size, void* d_ws, size_t ws_size, hipStream_t stream) {
    static int grid = 0;
    if (grid == 0) {
        if (n_in != 36 || out_size != NBATCH * T * D || ws_size < WS_END) { fprintf(stderr, "kernel_launch: unexpected shapes (n_in %d out %d ws %zu)\n", n_in, out_size, ws_size); grid = -1; return; }
        int dev = 0, cus = 0;
        if (hipGetDevice(&dev) != hipSuccess || hipDeviceGetAttribute(&cus, hipDeviceAttributeMultiprocessorCount, dev) != hipSuccess) { grid = -1; return; }
        if (hipFuncSetAttribute((const void*)mk_fwd, hipFuncAttributeMaxDynamicSharedMemorySize, LDS_BYTES) != hipSuccess) { grid = -1; return; }
        int per_cu = 0;
        if (hipOccupancyMaxActiveBlocksPerMultiprocessor(&per_cu, (const void*)mk_fwd, 512, LDS_BYTES) != hipSuccess || per_cu < 1) fprintf(stderr, "kernel_launch: occupancy query says %d\n", per_cu);
        (void)hipGetLastError();
        grid = cus;
    }
    if (grid < 0) return;
    (void)hipMemsetAsync((char*)d_ws + WS_CTL, 0, CTL_ZERO_BYTES, stream);
    Args a{};
    for (int i = 0; i < 36; ++i) a.in[i] = (const float*)d_in[i];
    a.out = (float*)d_out; a.ws = (unsigned char*)d_ws;
    const int total = NIT * NPH + 1;
#if MK_ONE_LAUNCH
    a.s_lo = 0; a.s_hi = total;
    hipLaunchKernelGGL(mk_fwd, dim3(grid), dim3(512), LDS_BYTES, stream, a);
#else
    for (int s = 0; s < total; ++s) { a.s_lo = s; a.s_hi = s + 1; hipLaunchKernelGGL(mk_fwd, dim3(grid), dim3(512), LDS_BYTES, stream, a); }
#endif
}
```
